# Optimizing an MI355X kernel written in HIP

```python
import math
import jax
import jax.numpy as jnp
from jax import lax
import numpy as np

D_MODEL = 1024
BATCH = 4
SEQ = 8192
DEPTH = 4
DEC_BATCH = 32
DEC_SEQ = 32
PAST_LEN = 2048

CHUNK = 64
QBLOCK = 128
H_A = 4
DH_A = 64
DV_A = 2 * DH_A
W_A = H_A * DV_A
N_QK = H_A * 2 * DH_A
N_ATT = 2 * N_QK + W_A
H_B = 8
DH_B = 64
W_B = H_B * DH_B
W_LORA = 64
A_LORA = 64
G_LORA = 128
N_RWKV = 3 * W_B + W_LORA + A_LORA + G_LORA
N_IN = N_ATT + N_RWKV
D_FF = 2816
N_BUCKETS = 32
MAX_DISTANCE = 128
ALPHA = (2 * DEPTH) ** 0.25
BETA = (8 * DEPTH) ** -0.25
LN_EPS = 1e-5
GN_EPS = 64e-5

kernel_name = "streaming_diffattn_rwkv7_hybrid_step"


def layer_norm(x, g=None, b=None, eps=LN_EPS):
    xf = x.astype(jnp.float32)
    mu = jnp.mean(xf, axis=-1, keepdims=True)
    var = jnp.mean(jnp.square(xf - mu), axis=-1, keepdims=True)
    y = ((xf - mu) * lax.rsqrt(var + eps)).astype(x.dtype)
    if g is None:
        return y
    return y * g + b


def rms_norm(x, g, eps=LN_EPS):
    xf = x.astype(jnp.float32)
    y = (xf * lax.rsqrt(jnp.mean(jnp.square(xf), axis=-1, keepdims=True) + eps)).astype(x.dtype)
    return y * g


def rel_bucket(rel):
    nb = N_BUCKETS // 2
    ret = jnp.where(rel > 0, nb, 0)
    n = jnp.abs(rel)
    max_exact = nb // 2
    nf = jnp.maximum(n, 1).astype(jnp.float32)
    large = max_exact + (jnp.log(nf / max_exact) / math.log(MAX_DISTANCE / max_exact)
                         * (nb - max_exact)).astype(jnp.int32)
    large = jnp.minimum(large, nb - 1)
    return ret + jnp.where(n < max_exact, n, large)


def diff_attn_block(q, k, v, q_pos, k_pos, rel_bias, lam):
    s = jnp.einsum("bqhmd,bkhmd->bhmqk", q, k).astype(jnp.float32) * (DH_A ** -0.5)
    bias = jnp.take(rel_bias, rel_bucket(k_pos[None, :] - q_pos[:, None]), axis=0)
    s = s + jnp.transpose(bias, (2, 0, 1)).astype(jnp.float32)[None, :, None]
    visible = (k_pos[None, :] // CHUNK) <= (q_pos[:, None] // CHUNK)
    s = jnp.where(visible, s, -jnp.inf)
    p = jax.nn.softmax(s, axis=-1)
    a = (p[:, :, 0] - lam * p[:, :, 1]).astype(v.dtype)
    return jnp.einsum("bhqk,bkhd->bqhd", a, v)


def diff_attention(q, k, v, q_pos, k_pos, rel_bias, lam):
    b, sq = q.shape[:2]
    qb = QBLOCK if sq % QBLOCK == 0 else sq
    nblk = sq // qb
    q_blocks = jnp.swapaxes(q.reshape(b, nblk, qb, H_A, 2, DH_A), 0, 1)
    pos_blocks = q_pos.reshape(nblk, qb)
    out = lax.map(lambda qp: diff_attn_block(qp[0], k, v, qp[1], k_pos, rel_bias, lam),
                  (q_blocks, pos_blocks))
    return jnp.swapaxes(out, 0, 1).reshape(b, sq, H_A, DV_A)


def diff_mixer(p_att, past_k, past_v, q_pos, k_pos, lam_qk, subln_g, rel_bias, layer_idx):
    b, s = p_att.shape[:2]
    q = p_att[..., :N_QK].reshape(b, s, H_A, 2, DH_A)
    k_new = p_att[..., N_QK:2 * N_QK].reshape(b, s, H_A, 2 * DH_A)
    v_new = p_att[..., 2 * N_QK:].reshape(b, s, H_A, DV_A)
    if past_k is None:
        k_all, v_all = k_new, v_new
    else:
        k_all = jnp.concatenate([past_k.astype(k_new.dtype), k_new], axis=1)
        v_all = jnp.concatenate([past_v.astype(v_new.dtype), v_new], axis=1)
    lam_init = 0.8 - 0.6 * math.exp(-0.3 * layer_idx)
    lq = lam_qk.astype(jnp.float32)
    lam = jnp.exp(jnp.sum(lq[0] * lq[1])) - jnp.exp(jnp.sum(lq[2] * lq[3])) + lam_init
    o = diff_attention(q, k_all.reshape(b, -1, H_A, 2, DH_A), v_all, q_pos, k_pos, rel_bias, lam)
    o = rms_norm(o, subln_g) * (1.0 - lam_init)
    return o.reshape(b, s, W_A), k_new, v_new


def wkv_step(state, inp):
    r_t, w_t, k_t, v_t, kk_t, a_t = inp
    sa = jnp.einsum("bhvk,bhk->bhv", state, -kk_t)
    state = (state * w_t[:, :, None, :] + sa[..., None] * (kk_t * a_t)[:, :, None, :]
             + v_t[..., None] * k_t[:, :, None, :])
    return state, jnp.einsum("bhvk,bhk->bhv", state, r_t)


def rwkv_mixer(p_rw, shift, wkv, mu, w0, w2, a0, a2, g2, k_k, k_a, r_k, lnx_g, lnx_b):
    b, s = p_rw.shape[:2]
    prev = jnp.concatenate([shift[:, None].astype(p_rw.dtype), p_rw[:, :-1]], axis=1)
    xm = p_rw + (prev - p_rw) * mu
    o0 = 3 * W_B
    r = xm[..., :W_B]
    k = xm[..., W_B:2 * W_B]
    v = xm[..., 2 * W_B:o0]
    dw = xm[..., o0:o0 + W_LORA]
    da = xm[..., o0 + W_LORA:o0 + W_LORA + A_LORA]
    dg = xm[..., o0 + W_LORA + A_LORA:]
    w_log = -jax.nn.softplus(-(w0 + jnp.tanh(dw) @ w2)) - 0.5
    decay = jnp.exp(-jnp.exp(w_log.astype(jnp.float32)))
    a = jax.nn.sigmoid(a0 + da @ a2)
    g = jax.nn.sigmoid(dg) @ g2

    def heads(t):
        return t.reshape(b, s, H_B, DH_B)

    kk = heads(k * k_k).astype(jnp.float32)
    kk = kk * lax.rsqrt(jnp.maximum(jnp.sum(kk * kk, axis=-1, keepdims=True), 1e-24))
    k = k * (1.0 + (a - 1.0) * k_a)
    rh, kh, vh, ah = heads(r), heads(k), heads(v), heads(a)

    def tmajor(t):
        return jnp.swapaxes(t.astype(jnp.float32), 0, 1)

    xs = (tmajor(rh), tmajor(heads(decay)), tmajor(kh), tmajor(vh), tmajor(kk), tmajor(ah))
    s_final, o = lax.scan(wkv_step, wkv.astype(jnp.float32), xs)
    o = jnp.swapaxes(o, 0, 1)
    m = jnp.mean(o, axis=-1, keepdims=True)
    var = jnp.mean(jnp.square(o - m), axis=-1, keepdims=True)
    o = ((o - m) * lax.rsqrt(var + GN_EPS)).astype(p_rw.dtype).reshape(b, s, W_B) * lnx_g + lnx_b
    bonus = jnp.sum(rh * kh * r_k, axis=-1, keepdims=True) * vh
    o = (o + bonus.reshape(b, s, W_B)) * g
    return o, p_rw[:, -1], s_final.astype(p_rw.dtype)


def swiglu(u, w_gu, w_down):
    h = u @ w_gu
    return (jax.nn.silu(h[..., :D_FF]) * h[..., D_FF:]) @ w_down


def trunk_layer(x, c, l, W, rel_bias, past_k, past_v, wkv, shift, q_pos, k_pos):
    b = x.shape[0]
    mod = (jax.nn.silu(c) @ W["w_ada"][l] + W["b_ada"][l]).reshape(b, 3, 3, D_MODEL)

    def adaln(h, i):
        return layer_norm(h) * (1.0 + mod[:, i, 1, None]) + mod[:, i, 0, None]

    f = swiglu(adaln(x, 0), W["w_gu"][l, 0], W["w_down"][l, 0])
    x = layer_norm(ALPHA * x + 0.5 * mod[:, 0, 2, None] * f, W["ln_g"][l, 0], W["ln_b"][l, 0])
    u = adaln(x, 1)
    proj = u @ W["w_in"][l]
    y_a, k_new, v_new = diff_mixer(proj[..., :N_ATT], past_k, past_v, q_pos, k_pos,
                                   W["lam_qk"][l], W["subln_g"][l], rel_bias, l)
    y_b, shift_new, wkv_new = rwkv_mixer(proj[..., N_ATT:], shift, wkv, W["rw_mu"][l], W["rw_w0"][l],
                                         W["rw_w2"][l], W["rw_a0"][l], W["rw_a2"][l], W["rw_g2"][l],
                                         W["rw_k_k"][l], W["rw_k_a"][l], W["rw_r_k"][l],
                                         W["rw_lnx_g"][l], W["rw_lnx_b"][l])
    gates = jax.nn.sigmoid(u @ W["w_gate"][l] + W["b_gate"][l])
    merged = (gates[..., :D_MODEL] * (y_a @ W["w_br_a"][l])
              + gates[..., D_MODEL:] * (y_b @ W["w_br_b"][l]))
    x = layer_norm(ALPHA * x + mod[:, 1, 2, None] * (merged @ W["w_o"][l]),
                   W["ln_g"][l, 1], W["ln_b"][l, 1])
    f = swiglu(adaln(x, 2), W["w_gu"][l, 1], W["w_down"][l, 1])
    x = layer_norm(ALPHA * x + 0.5 * mod[:, 2, 2, None] * f, W["ln_g"][l, 2], W["ln_b"][l, 2])
    return x, k_new, v_new, wkv_new, shift_new


def setup_inputs(seed: int = 0) -> dict:
    key = jax.random.key(seed)
    keys = iter(jax.random.split(key, 40))

    def nrm(shape, scale):
        return scale * jax.random.normal(next(keys), shape, jnp.float32)

    def uni(shape, lo, hi):
        return jax.random.uniform(next(keys), shape, jnp.float32, lo, hi)

    L, D = DEPTH, D_MODEL
    return {
        "x_prompt": nrm((BATCH, SEQ, D), 1.0),
        "x_sample": nrm((DEC_BATCH, DEC_SEQ, D), 1.0),
        "c_prompt": nrm((BATCH, D), 1.0),
        "c_sample": nrm((DEC_BATCH, D), 1.0),
        "cache_k": nrm((L, DEC_BATCH, PAST_LEN, H_A, 2 * DH_A), 1.0),
        "cache_v": nrm((L, DEC_BATCH, PAST_LEN, H_A, DV_A), 1.0),
        "state_wkv": nrm((L, DEC_BATCH, H_B, DH_B, DH_B), 0.5),
        "state_shift": nrm((L, DEC_BATCH, N_RWKV), 1.0),
        "rel_bias": nrm((N_BUCKETS, H_A), 0.5),
        "w_ada": nrm((L, D, 9 * D), 0.5 * D ** -0.5),
        "b_ada": nrm((L, 9 * D), 0.01),
        "ln_g": 1.0 + nrm((L, 3, D), 0.05),
        "ln_b": nrm((L, 3, D), 0.01),
        "w_gu": nrm((L, 2, D, 2 * D_FF), D ** -0.5),
        "w_down": nrm((L, 2, D_FF, D), BETA * D_FF ** -0.5),
        "w_in": nrm((L, D, N_IN), D ** -0.5),
        "lam_qk": nrm((L, 4, DH_A), 0.1),
        "subln_g": 1.0 + nrm((L, DV_A), 0.1),
        "rw_mu": uni((L, N_RWKV), 0.0, 1.0),
        "rw_w0": uni((L, W_B), -4.0, 1.0),
        "rw_w2": nrm((L, W_LORA, W_B), 0.1 * W_LORA ** -0.5),
        "rw_a0": nrm((L, W_B), 0.1),
        "rw_a2": nrm((L, A_LORA, W_B), 0.1 * A_LORA ** -0.5),
        "rw_g2": nrm((L, G_LORA, W_B), G_LORA ** -0.5),
        "rw_k_k": 0.85 + nrm((L, W_B), 0.05),
        "rw_k_a": 1.0 + nrm((L, W_B), 0.05),
        "rw_r_k": nrm((L, H_B, DH_B), 0.1),
        "rw_lnx_g": 1.0 + nrm((L, W_B), 0.1),
        "rw_lnx_b": nrm((L, W_B), 0.01),
        "w_br_a": nrm((L, W_A, D), BETA * W_A ** -0.5),
        "w_br_b": nrm((L, W_B, D), BETA * W_B ** -0.5),
        "w_gate": nrm((L, D, 2 * D), D ** -0.5),
        "b_gate": nrm((L, 2 * D), 0.01),
        "w_o": nrm((L, D, D), BETA * D ** -0.5),
    }


def reference(x_prompt, x_sample, c_prompt, c_sample, cache_k, cache_v, state_wkv, state_shift,
              rel_bias, w_ada, b_ada, ln_g, ln_b, w_gu, w_down, w_in, lam_qk, subln_g,
              rw_mu, rw_w0, rw_w2, rw_a0, rw_a2, rw_g2, rw_k_k, rw_k_a, rw_r_k, rw_lnx_g, rw_lnx_b,
              w_br_a, w_br_b, w_gate, b_gate, w_o):
    W = {"w_ada": w_ada, "b_ada": b_ada, "ln_g": ln_g, "ln_b": ln_b, "w_gu": w_gu,
         "w_down": w_down, "w_in": w_in, "lam_qk": lam_qk, "subln_g": subln_g,
         "rw_mu": rw_mu, "rw_w0": rw_w0, "rw_w2": rw_w2, "rw_a0": rw_a0, "rw_a2": rw_a2,
         "rw_g2": rw_g2, "rw_k_k": rw_k_k, "rw_k_a": rw_k_a, "rw_r_k": rw_r_k,
         "rw_lnx_g": rw_lnx_g, "rw_lnx_b": rw_lnx_b, "w_br_a": w_br_a, "w_br_b": w_br_b,
         "w_gate": w_gate, "b_gate": b_gate, "w_o": w_o}
    b_p, s_p = x_prompt.shape[:2]
    past = cache_k.shape[2]
    s_d = x_sample.shape[1]
    pos_p = jnp.arange(s_p, dtype=jnp.int32)
    pos_d = past + jnp.arange(s_d, dtype=jnp.int32)
    k_pos_d = jnp.concatenate([jnp.arange(past, dtype=jnp.int32), pos_d])
    zero_wkv = jnp.zeros((b_p, H_B, DH_B, DH_B), x_prompt.dtype)
    zero_shift = jnp.zeros((b_p, N_RWKV), x_prompt.dtype)

    hp, hd = x_prompt, x_sample
    kps, vps, sps, shps = [], [], [], []
    kds, vds, sds, shds = [], [], [], []
    for l in range(DEPTH):
        hp, kp, vp, sp, shp = trunk_layer(hp, c_prompt, l, W, rel_bias, None, None,
                                          zero_wkv, zero_shift, pos_p, pos_p)
        hd, kd, vd, sd, shd = trunk_layer(hd, c_sample, l, W, rel_bias, cache_k[l], cache_v[l],
                                          state_wkv[l], state_shift[l], pos_d, k_pos_d)
        kps.append(kp); vps.append(vp); sps.append(sp); shps.append(shp)
        kds.append(kd); vds.append(vd); sds.append(sd); shds.append(shd)
    return (hp, hd, jnp.stack(kps), jnp.stack(vps), jnp.stack(sps), jnp.stack(shps),
            jnp.stack(kds), jnp.stack(vds), jnp.stack(sds), jnp.stack(shds))
```

```cpp
#include <hip/hip_runtime.h>
#include <hip/hip_bf16.h>
#include <cstdio>
#include <cstdint>
#include <cmath>
namespace pg8 {
#define PG8_LAS __attribute__((address_space(3)))
typedef unsigned short bf16_t;
typedef short bf16x8 __attribute__((ext_vector_type(8)));
typedef float f32x4 __attribute__((ext_vector_type(4)));
typedef unsigned u32x4 __attribute__((ext_vector_type(4)));
constexpr int BM = 256, BK = 64, HALF = 128, HTB = HALF * BK * 2  , STAGE_BYTES = 8 * HTB, NXCD = 8, WGM = 8;

__host__ __device__ __forceinline__ int lds_byte(int r, int c) { const int st = (r >> 4) * 2 + (c >> 5), rr = r & 15, cc = c & 31, ob = rr * 64 + cc * 2; return st * 1024 + (ob ^ (((ob >> 9) & 1) << 5)); }
__host__ __device__ __forceinline__ void stage_rc(int b, int& R, int& C) { const int st = b / 1024, sb = b % 1024, swz = sb ^ (((sb >> 9) & 1) << 5); R = (st >> 1) * 16 + swz / 64; C = (st & 1) * 32 + (swz % 64) / 2; }
__host__ __device__ __forceinline__ int perm32(int rho) { const int n = rho >> 4, i = rho & 15; return 8 * (i >> 2) + 4 * n + (i & 3); }

struct Unit { int pm, pn; };
struct Gemm { const bf16_t* A; const bf16_t* Bt; int M, N, K; };

struct StaticOrder {
    int nM, nN, nwg, G, c;
    __host__ __device__ void init(int M, int N, int G_, int c_) { nM = M / BM; nN = N / BM; nwg = nM * nN; G = G_; c = c_; }
    __host__ __device__ bool next(int i, Unit& u) const {
        const long L = (long)i * G + c; if (L >= nwg) return false;
        int wgid = (int)L; { const int q = nwg / NXCD, r = nwg % NXCD, xcd = wgid % NXCD, off = wgid / NXCD; wgid = (xcd < r ? xcd * (q + 1) : r * (q + 1) + (xcd - r) * q) + off; }
        const int nig = WGM * nN, gid = wgid / nig, fm = gid * WGM, gsz = (nM - fm) < WGM ? (nM - fm) : WGM;
        u.pm = fm + ((wgid % nig) % gsz); u.pn = (wgid % nig) / gsz; return true;
    }
    __device__ __forceinline__ void a_ready(const Unit&) const {}
    __device__ __forceinline__ void done(const Unit&) const {}
};

typedef float f32x2c_t __attribute__((ext_vector_type(2))); typedef __bf16 bf16x2c_t __attribute__((ext_vector_type(2)));
__device__ __forceinline__ unsigned cvt_pk_bf16(float lo, float hi) { f32x2c_t v = {lo, hi}; bf16x2c_t b = __builtin_convertvector(v, bf16x2c_t); return __builtin_bit_cast(unsigned, b); }
typedef float f32x2 __attribute__((ext_vector_type(2)));
__device__ __forceinline__ float fast_sigmoid(float x) { return __builtin_amdgcn_rcpf(1.0f + __expf(-x)); }
struct EpiSwiglu {
    static constexpr bool PERM = true, AFTER_DRAIN = false;
    bf16_t* O; int ldc;
    __device__ __forceinline__ void operator()(const f32x4 (&acc)[2][2][4][2], const Unit& u, int wr, int wc, int fr, int fq) const {
        const int row0 = u.pm * BM + wr * 64 + fr; const int col0 = u.pn * 128 + wc * 32 + 8 * fq;
#pragma unroll
        for (int ai = 0; ai < 2; ++ai)
#pragma unroll
            for (int m = 0; m < 4; ++m) { bf16_t* rowp = O + (size_t)(row0 + ai * HALF + m * 16) * ldc + col0;
                float v[8];
#pragma unroll
                for (int n = 0; n < 2; ++n)
#pragma unroll
                    for (int e = 0; e < 4; ++e) { const float g = acc[ai][0][m][n][e], up = acc[ai][1][m][n][e]; v[n * 4 + e] = g * fast_sigmoid(g) * up; }
                u32x4 w; w.x = cvt_pk_bf16(v[0], v[1]); w.y = cvt_pk_bf16(v[2], v[3]); w.z = cvt_pk_bf16(v[4], v[5]); w.w = cvt_pk_bf16(v[6], v[7]);
                *(u32x4*)rowp = w; }
    }
};
struct EpiF32 {
    static constexpr bool PERM = false, AFTER_DRAIN = false;
    float* O; int ldc;
    __device__ __forceinline__ void operator()(const f32x4 (&acc)[2][2][4][2], const Unit& u, int wr, int wc, int fr, int fq) const {
        const int row0 = u.pm * BM + wr * 64 + fr; const int col0 = u.pn * BM + wc * 32 + 4 * fq;
#pragma unroll
        for (int ai = 0; ai < 2; ++ai)
#pragma unroll
            for (int m = 0; m < 4; ++m) { float* rowp = O + (size_t)(row0 + ai * HALF + m * 16) * ldc + col0;
#pragma unroll
                for (int bj = 0; bj < 2; ++bj)
#pragma unroll
                    for (int n = 0; n < 2; ++n) *(f32x4*)(rowp + bj * HALF + n * 16) = acc[ai][bj][m][n]; }
    }
};
struct EpiProj {
    static constexpr bool PERM = false, AFTER_DRAIN = false;
    bf16_t* Q; bf16_t* Kb; bf16_t* Vb; float* PRW; bf16_t* GATES; const float* bgate;
    float* outKp; float* outVp; float* outKs; float* outVs; float* outShp; float* outShs;
    float qscale;
    __device__ __forceinline__ void operator()(const f32x4 (&acc)[2][2][4][2], const Unit& u, int wr, int wc, int fr, int fq) const {
        const int row0 = u.pm * BM + wr * 64 + fr; const int pn = u.pn; const int cw = wc * 32 + 4 * fq;
        const bool prompt = u.pm < 128;
#pragma unroll
        for (int ai = 0; ai < 2; ++ai)
#pragma unroll
            for (int m = 0; m < 4; ++m) { const int row = row0 + ai * HALF + m * 16;
#pragma unroll
                for (int bj = 0; bj < 2; ++bj)
#pragma unroll
                    for (int n = 0; n < 2; ++n) { const f32x4 v = acc[ai][bj][m][n]; const int ct = bj * HALF + n * 16 + cw;
                        if (pn < 2) { const int c = pn * 256 + ct; typedef unsigned u32x2v __attribute__((ext_vector_type(2))); u32x2v w; w.x = cvt_pk_bf16(v[0] * qscale, v[1] * qscale); w.y = cvt_pk_bf16(v[2] * qscale, v[3] * qscale);
                            *(u32x2v*)(Q + (size_t)row * 512 + c) = w; }
                        else if (pn < 6) { const bool isk = pn < 4; const int c = (pn - (isk ? 2 : 4)) * 256 + ct; typedef unsigned u32x2v __attribute__((ext_vector_type(2))); u32x2v w; w.x = cvt_pk_bf16(v[0], v[1]); w.y = cvt_pk_bf16(v[2], v[3]);
                            *(u32x2v*)((isk ? Kb : Vb) + (size_t)row * 512 + c) = w;
                            float* o = prompt ? (isk ? outKp : outVp) + (size_t)row * 512 + c : (isk ? outKs : outVs) + (size_t)(row - 32768) * 512 + c;
                            *(f32x4*)o = v; }
                        else if (pn < 13) { const int c = (pn - 6) * 256 + ct; *(f32x4*)(PRW + (size_t)row * 1792 + c) = v;
                            if (prompt) { if ((row & 8191) == 8191) *(f32x4*)(outShp + (size_t)(row >> 13) * 1792 + c) = v; }
                            else { const int rd = row - 32768; if ((rd & 31) == 31) *(f32x4*)(outShs + (size_t)(rd >> 5) * 1792 + c) = v; } }
                        else { const int c = (pn - 13) * 256 + ct; const f32x4 b = *(const f32x4*)(bgate + c); typedef unsigned u32x2v __attribute__((ext_vector_type(2))); u32x2v w;
                            w.x = cvt_pk_bf16(fast_sigmoid(v[0] + b[0]), fast_sigmoid(v[1] + b[1])); w.y = cvt_pk_bf16(fast_sigmoid(v[2] + b[2]), fast_sigmoid(v[3] + b[3]));
                            *(u32x2v*)(GATES + (size_t)row * 2048 + c) = w; }
                    } }
    }
};
struct EpiMerge {
    static constexpr bool PERM = false, AFTER_DRAIN = false;
    float* TMP; bf16_t* OUT; const bf16_t* GATES; int npan;
    __device__ __forceinline__ void operator()(const f32x4 (&acc)[2][2][4][2], const Unit& u, int wr, int wc, int fr, int fq) const {
        const int which = u.pm >= npan ? 1 : 0; const int pm = u.pm - which * npan, pn = u.pn - which * 4;
        const int row0 = pm * BM + wr * 64 + fr; const int col0 = pn * BM + wc * 32 + 4 * fq;
        typedef unsigned u32x2v __attribute__((ext_vector_type(2)));
#pragma unroll
        for (int ai = 0; ai < 2; ++ai)
#pragma unroll
            for (int m = 0; m < 4; ++m) { const int row = row0 + ai * HALF + m * 16;
#pragma unroll
                for (int bj = 0; bj < 2; ++bj)
#pragma unroll
                    for (int n = 0; n < 2; ++n) { const int c = col0 + bj * HALF + n * 16; const f32x4 v = acc[ai][bj][m][n];
                        const u32x2v gw = *(const u32x2v*)(GATES + (size_t)row * 2048 + which * 1024 + c);
                        f32x4 g; g[0] = __uint_as_float(gw.x << 16); g[1] = __uint_as_float(gw.x & 0xffff0000u); g[2] = __uint_as_float(gw.y << 16); g[3] = __uint_as_float(gw.y & 0xffff0000u);
                        float* tp = TMP + (size_t)row * 1024 + c;
                        if (which == 0) { *(f32x4*)tp = g * v; }
                        else { const f32x4 t = *(const f32x4*)tp + g * v; u32x2v w; w.x = cvt_pk_bf16(t[0], t[1]); w.y = cvt_pk_bf16(t[2], t[3]); *(u32x2v*)(OUT + (size_t)row * 1024 + c) = w; }
                    } }
    }
};
struct PairOrder {
    int ntile, G, c, npan;
    __device__ __forceinline__ bool next(int i, Unit& u) const { const int tile = (i >> 1) * G + c; if (tile >= ntile) return false; const int which = i & 1; u.pm = (tile >> 2) + which * npan; u.pn = (tile & 3) + which * 4; return true; }
    __device__ __forceinline__ void a_ready(const Unit&) const {}
    __device__ __forceinline__ void done(const Unit&) const {}
};
template <class Epi, class Sched, bool ALIGN_EPI = false, bool SP2 = false>
__device__ __forceinline__ void gemm_phase(PG8_LAS unsigned char* lds, const Gemm g, const Sched& S, const Epi& E) {
    const int tid = threadIdx.x, wid = __builtin_amdgcn_readfirstlane(tid >> 6), lane = tid & 63, wr = wid >> 2, wc = wid & 3, fr = lane & 15, fq = lane >> 4;
    const int K = g.K, nt = K / BK;
    unsigned voffA[2], voffB[2];
#pragma unroll
    for (int i = 0; i < 2; ++i) { int R, C; stage_rc(tid * 16 + i * 8192, R, C); const int Rb = Epi::PERM ? ((R & ~31) + perm32(R & 31)) : R;
        voffA[i] = (unsigned)(R * K + C) * 2u; voffB[i] = (unsigned)(Rb * K + C) * 2u; }
    const size_t kstep = (size_t)(BK * 2);
    const size_t hstep = (size_t)HALF * K * 2;
    const size_t tstep = 2 * hstep;
    const unsigned ldsw = (unsigned)wid * 1024u;
    const int aoff = lds_byte(wr * 64 + fr, fq * 8), boff = lds_byte(wc * 32 + fr, fq * 8);
#define PG8_SA(b, h) (((b) * 2 + (h)) * HTB)
#define PG8_SB(b, h) ((4 + (b) * 2 + (h)) * HTB)
#define PG8_STAGE(bufoff, gbase, voff) do { _Pragma("unroll") for (int _i = 0; _i < 2; ++_i) \
        __builtin_amdgcn_global_load_lds((const unsigned*)((const char*)(gbase) + (voff)[_i]), (PG8_LAS unsigned*)(lds + (bufoff) + ldsw + _i * 8192), 16, 0, 0); } while (0)
#define PG8_LDA(dst, b, h) do { _Pragma("unroll") for (int m = 0; m < 4; ++m) _Pragma("unroll") for (int k = 0; k < 2; ++k) dst[m][k] = *(const PG8_LAS bf16x8*)(lds + PG8_SA(b, h) + aoff + m * 2048 + k * 1024); } while (0)
#define PG8_LDB(dst, b, h) do { _Pragma("unroll") for (int n = 0; n < 2; ++n) _Pragma("unroll") for (int k = 0; k < 2; ++k) dst[n][k] = *(const PG8_LAS bf16x8*)(lds + PG8_SB(b, h) + boff + n * 2048 + k * 1024); } while (0)
#define PG8_MMA(ai, bj, At, Bt) do { __builtin_amdgcn_s_setprio(1); _Pragma("unroll") for (int m = 0; m < 4; ++m) _Pragma("unroll") for (int n = 0; n < 2; ++n) _Pragma("unroll") for (int k = 0; k < 2; ++k) \
        acc[ai][bj][m][n] = __builtin_amdgcn_mfma_f32_16x16x32_bf16(Bt[n][k], At[m][k], acc[ai][bj][m][n], 0, 0, 0); __builtin_amdgcn_s_setprio(0); } while (0)
#define PG8_WAIT_V(n) asm volatile("s_waitcnt vmcnt(" #n ")" ::: "memory")
#define PG8_WAIT_L(n) asm volatile("s_waitcnt lgkmcnt(" #n ")" ::: "memory")
#define PG8_BAR __builtin_amdgcn_s_barrier()
#define PG8_SCHED __builtin_amdgcn_sched_barrier(0)
    Unit cur, nxt; int ui = 0;
    if (!S.next(0, cur)) return;
    f32x4 acc[2][2][4][2];
#pragma unroll
    for (int a = 0; a < 2; ++a)
#pragma unroll
        for (int b = 0; b < 2; ++b)
#pragma unroll
            for (int m = 0; m < 4; ++m)
#pragma unroll
                for (int n = 0; n < 2; ++n) acc[a][b][m][n] = (f32x4){0.f, 0.f, 0.f, 0.f};
    bf16x8 At[4][2], B0[2][2], B1[2][2];
    const char* cA = (const char*)g.A + (size_t)cur.pm * tstep; const char* cB = (const char*)g.Bt + (size_t)cur.pn * tstep;
    S.a_ready(cur);
    if constexpr (SP2) {
        PG8_STAGE(PG8_SB(0, 0), cB, voffB); PG8_STAGE(PG8_SB(0, 1), cB + hstep, voffB); PG8_STAGE(PG8_SA(0, 0), cA, voffA); PG8_STAGE(PG8_SA(0, 1), cA + hstep, voffA);
        if (wr == 1) PG8_BAR;
        PG8_WAIT_V(2); PG8_BAR;
        PG8_STAGE(PG8_SB(1, 0), cB + kstep, voffB); PG8_STAGE(PG8_SA(1, 0), cA + kstep, voffA); PG8_STAGE(PG8_SB(1, 1), cB + hstep + kstep, voffB);
        PG8_WAIT_V(6); PG8_BAR;
    } else {
        PG8_STAGE(PG8_SB(0, 0), cB, voffB); PG8_STAGE(PG8_SA(0, 0), cA, voffA); PG8_STAGE(PG8_SB(0, 1), cB + hstep, voffB); PG8_STAGE(PG8_SA(0, 1), cA + hstep, voffA);
        if (wr == 1) PG8_BAR;
        PG8_WAIT_V(4); PG8_BAR;
        PG8_STAGE(PG8_SB(1, 0), cB + kstep, voffB); PG8_STAGE(PG8_SA(1, 0), cA + kstep, voffA); PG8_STAGE(PG8_SB(1, 1), cB + hstep + kstep, voffB);
        PG8_WAIT_V(6); PG8_BAR;
    }
    for (;;) {
        const bool has_next = S.next(ui + 1, nxt);
        const char* nA = has_next ? (const char*)g.A + (size_t)nxt.pm * tstep : cA; const char* nB = has_next ? (const char*)g.Bt + (size_t)nxt.pn * tstep : cB;
        for (int t = 0; t < nt; t += 2) {
            const bool last = (t == nt - 2);
            const char* a1 = cA + (size_t)(t + 1) * kstep;
            const char* a2 = last ? nA : cA + (size_t)(t + 2) * kstep; const char* b2 = last ? nB : cB + (size_t)(t + 2) * kstep;
            const char* a3 = a2 + kstep; const char* b3 = b2 + kstep;
            if (last && has_next) S.a_ready(nxt);
            if constexpr (SP2) {
            PG8_LDB(B0, 0, 0); PG8_LDB(B1, 0, 1); PG8_SCHED; PG8_LDA(At, 0, 0); PG8_STAGE(PG8_SA(1, 1), a1 + hstep, voffA);
            PG8_WAIT_V(8); PG8_WAIT_L(0); PG8_BAR; PG8_MMA(0, 0, At, B0); PG8_MMA(0, 1, At, B1); PG8_BAR; PG8_SCHED;
            PG8_LDA(At, 0, 1); PG8_STAGE(PG8_SB(0, 0), b2, voffB); PG8_STAGE(PG8_SB(0, 1), b2 + hstep, voffB); PG8_STAGE(PG8_SA(0, 0), a2, voffA);
            PG8_WAIT_V(8); PG8_WAIT_L(0); PG8_BAR; PG8_MMA(1, 0, At, B0); PG8_MMA(1, 1, At, B1); PG8_BAR; PG8_SCHED;
            PG8_LDB(B0, 1, 0); PG8_LDB(B1, 1, 1); PG8_SCHED; PG8_LDA(At, 1, 0); PG8_STAGE(PG8_SA(0, 1), a2 + hstep, voffA);
            PG8_WAIT_V(8); PG8_WAIT_L(0); PG8_BAR; PG8_MMA(0, 0, At, B0); PG8_MMA(0, 1, At, B1); PG8_BAR; PG8_SCHED;
            PG8_LDA(At, 1, 1); PG8_STAGE(PG8_SB(1, 0), b3, voffB); PG8_STAGE(PG8_SB(1, 1), b3 + hstep, voffB); PG8_STAGE(PG8_SA(1, 0), a3, voffA);
            PG8_WAIT_V(8); PG8_WAIT_L(0); PG8_BAR; PG8_MMA(1, 0, At, B0); PG8_MMA(1, 1, At, B1); PG8_BAR; PG8_SCHED;
            } else {
            PG8_LDB(B0, 0, 0); PG8_SCHED; PG8_LDA(At, 0, 0); PG8_STAGE(PG8_SA(1, 1), a1 + hstep, voffA);
            PG8_WAIT_L(8); PG8_BAR; PG8_WAIT_L(0); PG8_MMA(0, 0, At, B0); PG8_BAR; PG8_SCHED;
            PG8_LDB(B1, 0, 1); PG8_STAGE(PG8_SB(0, 0), b2, voffB);
            PG8_BAR; PG8_WAIT_L(0); PG8_MMA(0, 1, At, B1); PG8_BAR;
            PG8_LDA(At, 0, 1); PG8_STAGE(PG8_SA(0, 0), a2, voffA);
            PG8_BAR; PG8_WAIT_L(0); PG8_MMA(1, 0, At, B0); PG8_BAR; PG8_SCHED;
            PG8_STAGE(PG8_SB(0, 1), b2 + hstep, voffB);
            PG8_WAIT_V(6); PG8_BAR; PG8_MMA(1, 1, At, B1); PG8_BAR;
            PG8_LDB(B0, 1, 0); PG8_SCHED; PG8_LDA(At, 1, 0); PG8_STAGE(PG8_SA(0, 1), a2 + hstep, voffA);
            PG8_WAIT_L(8); PG8_BAR; PG8_WAIT_L(0); PG8_MMA(0, 0, At, B0); PG8_BAR; PG8_SCHED;
            PG8_LDB(B1, 1, 1); PG8_STAGE(PG8_SB(1, 0), b3, voffB);
            PG8_BAR; PG8_WAIT_L(0); PG8_MMA(0, 1, At, B1); PG8_BAR;
            PG8_LDA(At, 1, 1); PG8_STAGE(PG8_SA(1, 0), a3, voffA);
            PG8_BAR; PG8_WAIT_L(0); PG8_MMA(1, 0, At, B0); PG8_BAR; PG8_SCHED;
            PG8_STAGE(PG8_SB(1, 1), b3 + hstep, voffB);
            PG8_WAIT_V(6); PG8_BAR; PG8_MMA(1, 1, At, B1); PG8_BAR;
            }
        }
        if constexpr (ALIGN_EPI) { if (wr == 0) PG8_BAR; }
        if constexpr (!Epi::AFTER_DRAIN) { E(acc, cur, wr, wc, fr, fq); S.done(cur); }
        if (!has_next) break;
#pragma unroll
        for (int a = 0; a < 2; ++a)
#pragma unroll
            for (int b = 0; b < 2; ++b)
#pragma unroll
                for (int m = 0; m < 4; ++m)
#pragma unroll
                    for (int n = 0; n < 2; ++n) acc[a][b][m][n] = (f32x4){0.f, 0.f, 0.f, 0.f};
        cur = nxt; cA = nA; cB = nB; ++ui;
        if constexpr (ALIGN_EPI) { if (wr == 1) PG8_BAR; }
    }
    PG8_WAIT_V(0);
    if constexpr (!ALIGN_EPI) { if (wr == 0) PG8_BAR; }
    PG8_BAR;
    if constexpr (Epi::AFTER_DRAIN) { E.fused(acc, cur, wr, wc, fr, fq, lds, wid, lane); S.done(cur); }
#undef PG8_SA
#undef PG8_SB
#undef PG8_STAGE
#undef PG8_LDA
#undef PG8_LDB
#undef PG8_MMA
#undef PG8_WAIT_V
#undef PG8_WAIT_L
#undef PG8_BAR
#undef PG8_SCHED
}
}
using pg8::fast_sigmoid;
#define GAS __attribute__((address_space(1)))
#define LAS __attribute__((address_space(3)))
typedef unsigned short bf16;
typedef unsigned v4u __attribute__((ext_vector_type(4)));
typedef float f32x4 __attribute__((ext_vector_type(4)));
typedef short bf16x8 __attribute__((ext_vector_type(8)));
typedef GAS unsigned gu32;
typedef GAS unsigned long long gu64;
#define RLX_AGENT __ATOMIC_RELAXED, __HIP_MEMORY_SCOPE_AGENT
#define LDS_WAIT() asm volatile("s_waitcnt lgkmcnt(0)" ::: "memory")
#define VM_WAIT() asm volatile("s_waitcnt vmcnt(0)" ::: "memory")
__device__ __forceinline__ unsigned long long rt() { return __builtin_amdgcn_s_memrealtime(); }
__device__ __forceinline__ unsigned f2bf(float f) { unsigned u = __builtin_bit_cast(unsigned, f); return (u + 0x7fffu + ((u >> 16) & 1u)) >> 16; }
__device__ __forceinline__ unsigned pk2(float lo, float hi) { return f2bf(lo) | (f2bf(hi) << 16); }

#define XB_TMO      128
#define XB_XCNT(j)  (256  + 64 * (j))
#define XB_XSUB(j)  (1280 + 64 * (j))
#define XB_XGEN(j)  (2304 + 64 * (j))
#define XB_TOP      3328
#define XB_TOPGEN   3392
#define XCD_BAR_WORDS 3456
#define XB_SPIN_CAP (1u << 18)

__device__ __forceinline__ unsigned xb_ld(unsigned* p)              { return __hip_atomic_load(p, __ATOMIC_RELAXED, __HIP_MEMORY_SCOPE_AGENT); }
__device__ __forceinline__ unsigned xb_add(unsigned* p, unsigned v) { return __hip_atomic_fetch_add(p, v, __ATOMIC_RELAXED, __HIP_MEMORY_SCOPE_AGENT); }
__device__ __forceinline__ unsigned xb_xcc_id() { return (unsigned)__builtin_amdgcn_s_getreg((3 << 11) | 20) & 0xFu; }
#define XB_SPIN(cond, bar) do { unsigned _sp = 0; while (cond) { __builtin_amdgcn_s_sleep(1); \
    if ((++_sp & 255u) == 0u) { if (xb_ld(&(bar)[XB_TMO])) break; if (_sp > XB_SPIN_CAP) { atomicAdd(&(bar)[XB_TMO], 1u); break; } } } } while (0)

struct XcdBarrier {
    unsigned* bar; unsigned x;
    volatile LAS unsigned* st;
};

__device__ __forceinline__ XcdBarrier xcd_barrier_post(unsigned* bar, volatile LAS unsigned* st) {
    XcdBarrier b; b.bar = bar; b.x = xb_xcc_id(); b.st = st;
    if (threadIdx.x == 0) (void)xb_add(&bar[XB_XCNT(b.x)], 1u);
    return b;
}
__device__ __forceinline__ void xcd_barrier_complete(unsigned* bar, unsigned x, unsigned& nloc, unsigned& nx) {
    const unsigned G = gridDim.x * gridDim.y * gridDim.z;
    unsigned sum, cnt, mine, sp = 0u;
    for (;;) {
        sum = 0u; cnt = 0u; mine = 0u;
#pragma unroll
        for (unsigned j = 0; j < 16; ++j) { const unsigned c = xb_ld(&bar[XB_XCNT(j)]); sum += c; cnt += (c > 0u) ? 1u : 0u; mine = (j == x) ? c : mine; }
        if (sum == G) break;
        __builtin_amdgcn_s_sleep(1);
        if ((++sp & 255u) == 0u) { if (xb_ld(&bar[XB_TMO])) break; if (sp > XB_SPIN_CAP) { atomicAdd(&bar[XB_TMO], 1u); break; } }
    }
    nloc = mine > 0u ? mine : 1u; nx = cnt > 0u ? cnt : 1u;
}

__device__ __forceinline__ void xcd_barrier(const XcdBarrier& b) {
    asm volatile("s_waitcnt vmcnt(0)" ::: "memory");
    __syncthreads();
    if (threadIdx.x == 0) {
        unsigned* bar = b.bar;
        __builtin_amdgcn_s_waitcnt(0);
        unsigned nloc = b.st[0], nx = b.st[1];
        if (nloc == 0u) { xcd_barrier_complete(bar, b.x, nloc, nx); b.st[0] = nloc; b.st[1] = nx; }
        const unsigned old = xb_add(&bar[XB_XSUB(b.x)], 1u);
        const unsigned gen = old / nloc;
        if (old + 1u == (gen + 1u) * nloc) {
            __builtin_amdgcn_fence(__ATOMIC_RELEASE, "agent");
            asm volatile("s_waitcnt vmcnt(0)" ::: "memory");
            const unsigned og = xb_add(&bar[XB_TOP], 1u);
            const unsigned tg = og / nx;
            if (og + 1u == (tg + 1u) * nx) xb_add(&bar[XB_TOPGEN], 1u);
            else XB_SPIN(xb_ld(&bar[XB_TOPGEN]) == tg, bar);
            __builtin_amdgcn_fence(__ATOMIC_ACQUIRE, "agent");
            xb_add(&bar[XB_XGEN(b.x)], 1u);
            asm volatile("s_waitcnt vmcnt(0)" ::: "memory");
        } else {
            XB_SPIN(xb_ld(&bar[XB_XGEN(b.x)]) == gen, bar);
            __builtin_amdgcn_fence(__ATOMIC_ACQUIRE, "agent");
            asm volatile("s_waitcnt vmcnt(0)" ::: "memory");
        }
    }
    __syncthreads();
}
constexpr int NWAVES = 8, NTHR = 512;
constexpr int D = 1024, NB = 4, SEQ = 8192, DEPTH = 4, DECB = 32, DECS = 32, PAST = 2048;
constexpr int MP = NB * SEQ, MD = DECB * DECS, M = MP + MD, NPAN = M / 256, NSEQ = NB + DECB;
constexpr int DFF = 2816, NGU = 2 * DFF, NIN = 3328, NRW = 1792, NIG = NIN + 2 * D;
constexpr int HA = 4, HB = 8;
constexpr float LN_EPS = 1e-5f, GN_EPS = 64e-5f;
constexpr float ALPHA = 1.681792830507429f;
constexpr float QSCALE = 0.125f * 1.4426950408889634f;
constexpr float LOG2E = 1.4426950408889634f;
constexpr size_t OFF_Y = 0, OFF_KP = (size_t)M * D, OFF_VP = OFF_KP + (size_t)DEPTH * MP * 512, OFF_WKVP = OFF_VP + (size_t)DEPTH * MP * 512,
    OFF_SHP = OFF_WKVP + (size_t)DEPTH * NB * HB * 4096, OFF_KS = OFF_SHP + (size_t)DEPTH * NB * NRW, OFF_VS = OFF_KS + (size_t)DEPTH * MD * 512,
    OFF_WKVS = OFF_VS + (size_t)DEPTH * MD * 512, OFF_SHS = OFF_WKVS + (size_t)DEPTH * DECB * HB * 4096, OUT_TOTAL = OFF_SHS + (size_t)DEPTH * DECB * NRW;
static_assert(OUT_TOTAL == 177991680ull, "output size");
constexpr size_t al256(size_t x) { return (x + 255) & ~(size_t)255; }
constexpr size_t WS_CTL = 0, CTL_ZERO_BYTES = 1u << 20;
constexpr size_t WS_MOD = CTL_ZERO_BYTES;
constexpr size_t WS_LAM = WS_MOD + al256((size_t)DEPTH * NSEQ * 9 * D * 4);
constexpr size_t WS_W = WS_LAM + 256;
constexpr size_t WL_GU0 = 0, WL_GU1 = WL_GU0 + (size_t)NGU * D * 2, WL_DN0 = WL_GU1 + (size_t)NGU * D * 2, WL_DN1 = WL_DN0 + (size_t)D * DFF * 2,
    WL_IG = WL_DN1 + (size_t)D * DFF * 2, WL_BR = WL_IG + (size_t)NIG * D * 2, WL_O = WL_BR + (size_t)2048 * 512 * 2, WL_W2 = WL_O + (size_t)D * D * 2,
    WL_A2 = WL_W2 + 512 * 64 * 2, WL_G2 = WL_A2 + 512 * 64 * 2, WL_SIZE = WL_G2 + 512 * 128 * 2;
constexpr size_t WS_U = WS_W + (size_t)DEPTH * WL_SIZE;
constexpr size_t WS_ACT = WS_U + (size_t)M * D * 2;
constexpr size_t WS_F = WS_ACT + (size_t)M * DFF * 2;
constexpr size_t WS_Q = WS_F + (size_t)M * D * 4;
constexpr size_t WS_KB = WS_Q + (size_t)M * 512 * 2, WS_VB = WS_KB + (size_t)M * 512 * 2;
constexpr size_t WS_PRW = WS_VB + (size_t)M * 512 * 2;
constexpr size_t WS_GATES = WS_PRW + (size_t)M * NRW * 4;
constexpr size_t WS_YAB = WS_GATES + (size_t)M * 2048 * 2;
constexpr size_t WS_MERGED = WS_YAB + (size_t)2 * M * 512 * 2;
constexpr int NITEM_P = NB * (SEQ / 64) * HB, NITEM = NITEM_P + DECB * HB;
constexpr size_t WS_PT = WS_MERGED + (size_t)M * D * 2;
constexpr size_t WS_QT = WS_PT + (size_t)NITEM * 8192;
constexpr size_t WS_HT = WS_QT + (size_t)NITEM * 8192;
constexpr size_t WS_OB = WS_HT + (size_t)NITEM * 16384;
constexpr size_t WS_GG = WS_OB + (size_t)M * 512 * 4, WS_BON = WS_GG + (size_t)M * 512 * 4;
constexpr size_t WS_END = WS_BON + (size_t)M * 512 * 4;
constexpr int CW_TMO = 0, CW_BAR = 4096;
constexpr int RING_BYTES = 131072, EXTRA_OFF = 131072, LDSCTL_OFF = 146944, LDS_BYTES = 147456;

struct Args { const float* in[34]; float* out; unsigned char* ws; int ph_lo, ph_hi; };
static_assert(sizeof(Args) == 36 * 8 + 8, "Args has no padding");
enum { I_XP = 0, I_XS, I_CP, I_CS, I_CK, I_CV, I_SWKV, I_SSH, I_RELB, I_WADA, I_BADA, I_LNG, I_LNB, I_WGU, I_WDN, I_WIN, I_LAMQK, I_SUBG, I_MU, I_W0, I_W2, I_A0, I_A2, I_G2,
       I_KK, I_KA, I_RK, I_LNXG, I_LNXB, I_BRA, I_BRB, I_WGATE, I_BGATE, I_WO };

struct Frame { LAS unsigned char* lds; int tid, lane, wave, vcu, G; };

__device__ __forceinline__ int row_seq(int row) { return row < MP ? (row >> 13) : NB + ((row - MP) >> 5); }
__device__ __forceinline__ int crow(int r, int hi) { return (r & 3) + 8 * (r >> 2) + 4 * hi; }
__device__ __forceinline__ float wave_sum(float v) {
#pragma unroll
    for (int o = 1; o < 64; o <<= 1) v += __shfl_xor(v, o);
    return v;
}
__device__ __forceinline__ unsigned cvtpk(float lo, float hi) { return pg8::cvt_pk_bf16(lo, hi); }
__device__ __forceinline__ float bf2f(bf16 b) { return __uint_as_float((unsigned)b << 16); }
typedef float f32x16 __attribute__((ext_vector_type(16)));
typedef unsigned u32x2 __attribute__((ext_vector_type(2)));
#define LP(T, p) ((LAS T*)(p))

__device__ __forceinline__ void p0_transpose_item(const float* W, int K, int N, bf16* WT, int k0, int n0, int drow0, LAS float* scr, int lane) {
#pragma unroll 8
    for (int i = 0; i < 32; ++i) { const int kk = 2 * i + (lane >> 5); scr[kk * 33 + (lane & 31)] = W[(size_t)(k0 + kk) * N + n0 + (lane & 31)]; }
    LDS_WAIT(); asm volatile("" ::: "memory");
    const int c = lane & 7;
#pragma unroll
    for (int j = 0; j < 4; ++j) { const int n = (lane >> 3) + 8 * j; const LAS float* s = scr + (8 * c) * 33 + n;
        v4u o; o.x = pk2(s[0 * 33], s[1 * 33]); o.y = pk2(s[2 * 33], s[3 * 33]); o.z = pk2(s[4 * 33], s[5 * 33]); o.w = pk2(s[6 * 33], s[7 * 33]);
        *(GAS v4u*)(WT + (size_t)(drow0 + n) * K + k0 + 8 * c) = o; }
    LDS_WAIT(); asm volatile("" ::: "memory");
}
__device__ __forceinline__ void conv_mat(const float* W, int K, int N, bf16* WT, int r, int row_off, bool gu, LAS float* scr, int lane) {
    const int nblk = N / 32, kb = r / nblk, nb = r % nblk, n0 = 32 * nb; int drow0 = row_off + n0;
    if (gu) { drow0 = n0 < DFF ? 256 * (n0 / 128) + (n0 % 128) : 256 * ((n0 - DFF) / 128) + 128 + ((n0 - DFF) % 128); }
    p0_transpose_item(W, K, N, WT, 64 * kb, n0, drow0, scr, lane);
}
__device__ __forceinline__ void ph_prologue(const Frame& F, const Args& a) {
    unsigned char* ws = a.ws;
    LAS bf16* sc = LP(bf16, F.lds);
    for (int i = F.tid; i < NSEQ * D; i += NTHR) { const int s = i >> 10, k = i & 1023; const float c = s < NB ? a.in[I_CP][s * D + k] : a.in[I_CS][(s - NB) * D + k];
        sc[s * 1032 + k] = (bf16)f2bf(c * fast_sigmoid(c)); }
    __syncthreads();
    const int gw = F.vcu * NWAVES + F.wave, NGW = F.G * NWAVES; const int lane = F.lane, r32 = lane & 31, hi = lane >> 5;
    float* MOD = (float*)(ws + WS_MOD);
    for (int it = gw; it < DEPTH * 288; it += NGW) {
        const int l = it / 288, n0 = (it % 288) * 32;
        const float* W = a.in[I_WADA] + (size_t)l * D * 9216 + n0 + r32;
        f32x16 acc0 = {}, acc1 = {};
        const int rowB = (32 + r32) < NSEQ ? 32 + r32 : NSEQ - 1;
#pragma unroll 4
        for (int s = 0; s < 64; ++s) {
            const float* wp = W + (size_t)(16 * s + 8 * hi) * 9216;
            float w[8];
#pragma unroll
            for (int j = 0; j < 8; ++j) w[j] = wp[(size_t)j * 9216];
            v4u bw; bw.x = cvtpk(w[0], w[1]); bw.y = cvtpk(w[2], w[3]); bw.z = cvtpk(w[4], w[5]); bw.w = cvtpk(w[6], w[7]);
            const bf16x8 bfrag = __builtin_bit_cast(bf16x8, bw);
            const bf16x8 a0 = *LP(const bf16x8, sc + r32 * 1032 + 16 * s + 8 * hi);
            const bf16x8 a1 = *LP(const bf16x8, sc + rowB * 1032 + 16 * s + 8 * hi);
            acc0 = __builtin_amdgcn_mfma_f32_32x32x16_bf16(a0, bfrag, acc0, 0, 0, 0);
            acc1 = __builtin_amdgcn_mfma_f32_32x32x16_bf16(a1, bfrag, acc1, 0, 0, 0);
        }
        const float bias = a.in[I_BADA][(size_t)l * 9216 + n0 + r32];
#pragma unroll
        for (int r = 0; r < 16; ++r) { const int s0 = crow(r, hi); MOD[((size_t)l * NSEQ + s0) * 9216 + n0 + r32] = acc0[r] + bias;
            const int s1 = 32 + s0; if (s1 < NSEQ) MOD[((size_t)l * NSEQ + s1) * 9216 + n0 + r32] = acc1[r] + bias; }
    }
    LAS float* scr = LP(float, F.lds + 74304 + F.wave * 8448);
    constexpr int C0 = 16 * 176, C2 = 44 * 32, C4 = 16 * 104, C5 = 16 * 64, C6 = 8 * 32, C8 = 16 * 32, C9 = 16, C11 = 32;
    constexpr int PER_L = 2 * C0 + 2 * C2 + C4 + C5 + 2 * C6 + C8 + 2 * C9 + C11;
    for (int it = gw; it < DEPTH * PER_L; it += NGW) {
        const int l = it / PER_L; int r = it % PER_L; unsigned char* wl = ws + WS_W + (size_t)l * WL_SIZE;
        if (r < C0) { conv_mat(a.in[I_WGU] + (size_t)(l * 2 + 0) * D * NGU, D, NGU, (bf16*)(wl + WL_GU0), r, 0, true, scr, lane); continue; } r -= C0;
        if (r < C0) { conv_mat(a.in[I_WGU] + (size_t)(l * 2 + 1) * D * NGU, D, NGU, (bf16*)(wl + WL_GU1), r, 0, true, scr, lane); continue; } r -= C0;
        if (r < C2) { conv_mat(a.in[I_WDN] + (size_t)(l * 2 + 0) * DFF * D, DFF, D, (bf16*)(wl + WL_DN0), r, 0, false, scr, lane); continue; } r -= C2;
        if (r < C2) { conv_mat(a.in[I_WDN] + (size_t)(l * 2 + 1) * DFF * D, DFF, D, (bf16*)(wl + WL_DN1), r, 0, false, scr, lane); continue; } r -= C2;
        if (r < C4) { conv_mat(a.in[I_WIN] + (size_t)l * D * NIN, D, NIN, (bf16*)(wl + WL_IG), r, 0, false, scr, lane); continue; } r -= C4;
        if (r < C5) { conv_mat(a.in[I_WGATE] + (size_t)l * D * 2048, D, 2048, (bf16*)(wl + WL_IG), r, NIN, false, scr, lane); continue; } r -= C5;
        if (r < C6) { conv_mat(a.in[I_BRA] + (size_t)l * 512 * D, 512, D, (bf16*)(wl + WL_BR), r, 0, false, scr, lane); continue; } r -= C6;
        if (r < C6) { conv_mat(a.in[I_BRB] + (size_t)l * 512 * D, 512, D, (bf16*)(wl + WL_BR), r, 1024, false, scr, lane); continue; } r -= C6;
        if (r < C8) { conv_mat(a.in[I_WO] + (size_t)l * D * D, D, D, (bf16*)(wl + WL_O), r, 0, false, scr, lane); continue; } r -= C8;
        if (r < C9) { conv_mat(a.in[I_W2] + (size_t)l * 64 * 512, 64, 512, (bf16*)(wl + WL_W2), r, 0, false, scr, lane); continue; } r -= C9;
        if (r < C9) { conv_mat(a.in[I_A2] + (size_t)l * 64 * 512, 64, 512, (bf16*)(wl + WL_A2), r, 0, false, scr, lane); continue; } r -= C9;
        conv_mat(a.in[I_G2] + (size_t)l * 128 * 512, 128, 512, (bf16*)(wl + WL_G2), r, 0, false, scr, lane);
    }
    if (blockIdx.x == 0 && F.wave == 0) {
        for (int l = 0; l < DEPTH; ++l) { const float* lq = a.in[I_LAMQK] + l * 256;
            const float s1 = wave_sum(lq[lane] * lq[64 + lane]), s2 = wave_sum(lq[128 + lane] * lq[192 + lane]);
            const float lam_init = 0.8f - 0.6f * expf(-0.3f * (float)l);
            if (lane == 0) ((float*)(ws + WS_LAM))[l] = expf(s1) - expf(s2) + lam_init; }
    }
}

__device__ __forceinline__ void ph_ln(const Frame& F, const float* xin_p, const float* xin_s, const float* f, float gs, const float* gate_mod  ,
                                      const float* lng, const float* lnb, const float* modn  , float* xout, bf16* uout) {
    const int gw = F.vcu * NWAVES + F.wave, NGW = F.G * NWAVES, lane = F.lane;
    for (int m = gw; m < M; m += NGW) {
        const int seq = row_seq(m);
        const float* xr = (xin_s && m >= MP) ? xin_s + (size_t)(m - MP) * D : xin_p + (size_t)m * D;
        f32x4 v[4];
#pragma unroll
        for (int j = 0; j < 4; ++j) v[j] = *(const f32x4*)(xr + 4 * lane + 256 * j);
        if (f) {
            const float* fr = f + (size_t)m * D; const float* gm = gate_mod + (size_t)seq * 9216; float s = 0.f;
#pragma unroll
            for (int j = 0; j < 4; ++j) { const f32x4 fv = *(const f32x4*)(fr + 4 * lane + 256 * j); const f32x4 gv = *(const f32x4*)(gm + 4 * lane + 256 * j);
                v[j] = v[j] * ALPHA + (gv * gs) * fv; s += (v[j].x + v[j].y) + (v[j].z + v[j].w); }
            const float mean = wave_sum(s) * (1.f / D); float s2 = 0.f;
#pragma unroll
            for (int j = 0; j < 4; ++j) { v[j] = v[j] - mean; s2 += (v[j].x * v[j].x + v[j].y * v[j].y) + (v[j].z * v[j].z + v[j].w * v[j].w); }
            const float rstd = 1.0f / sqrtf(wave_sum(s2) * (1.f / D) + LN_EPS);
#pragma unroll
            for (int j = 0; j < 4; ++j) { const f32x4 g = *(const f32x4*)(lng + 4 * lane + 256 * j), b = *(const f32x4*)(lnb + 4 * lane + 256 * j); v[j] = v[j] * rstd * g + b;
                *(f32x4*)(xout + (size_t)m * D + 4 * lane + 256 * j) = v[j]; }
        }
        if (modn) {
            const float* mm = modn + (size_t)seq * 9216; float s = 0.f;
#pragma unroll
            for (int j = 0; j < 4; ++j) s += (v[j].x + v[j].y) + (v[j].z + v[j].w);
            const float mean = wave_sum(s) * (1.f / D); float s2 = 0.f;
#pragma unroll
            for (int j = 0; j < 4; ++j) { v[j] = v[j] - mean; s2 += (v[j].x * v[j].x + v[j].y * v[j].y) + (v[j].z * v[j].z + v[j].w * v[j].w); }
            const float rstd = 1.0f / sqrtf(wave_sum(s2) * (1.f / D) + LN_EPS);
#pragma unroll
            for (int j = 0; j < 4; ++j) { const f32x4 sh = *(const f32x4*)(mm + 4 * lane + 256 * j), scl = *(const f32x4*)(mm + D + 4 * lane + 256 * j);
                const f32x4 o = v[j] * rstd * (scl + 1.0f) + sh; u32x2 w; w.x = cvtpk(o.x, o.y); w.y = cvtpk(o.z, o.w);
                *(u32x2*)(uout + (size_t)m * D + 4 * lane + 256 * j) = w; }
        }
    }
}
__device__ __forceinline__ int t5_bucket(int rel) {
    const int n = rel < 0 ? -rel : rel; int b;
    if (n < 8) b = n; else if (n < 12) b = 8; else if (n < 16) b = 9; else if (n < 23) b = 10; else if (n < 32) b = 11; else if (n < 46) b = 12; else if (n < 64) b = 13; else if (n < 91) b = 14; else b = 15;
    return (rel > 0 ? 16 : 0) + b;
}
typedef short v4i16_t __attribute__((ext_vector_type(4)));
__device__ __forceinline__ v4i16_t vtr(LAS const unsigned char* p) { return __builtin_amdgcn_ds_read_tr16_b64_v4i16((LAS v4i16_t*)p); }
constexpr int ATT_SLOT = 32768;
constexpr int ATT_TAB = EXTRA_OFF;
struct AttnP { const bf16* Q; const bf16* Kb; const bf16* Vb; const float* ck; const float* cv; bf16* YA; const float* relb; const float* subg; float lam, oml; };

__device__ __forceinline__ void attn_tile(LAS const unsigned char* slot, LAS const float* tab, const bf16x8 (&qf)[4], f32x16 (&o)[4], float& mrun, float& lrun,
                                          int map, int lane, int k0, int qpos, bool constb, int nvalid) {
    const int r32 = lane & 31, hi = lane >> 5;
    LAS const unsigned char* kb = slot + map * 8192 + hi * 1024 + r32 * 16;
    f32x16 p0, p1;
    const float cb = constb ? tab[0] : 0.f;
#pragma unroll
    for (int r = 0; r < 16; ++r) { p0[r] = cb; p1[r] = cb; }
#pragma unroll
    for (int d0 = 0; d0 < 4; ++d0) {
        const bf16x8 k0f = *LP(const bf16x8, kb + d0 * 2048), k1f = *LP(const bf16x8, kb + d0 * 2048 + 512);
        p0 = __builtin_amdgcn_mfma_f32_32x32x16_bf16(k0f, qf[d0], p0, 0, 0, 0);
        p1 = __builtin_amdgcn_mfma_f32_32x32x16_bf16(k1f, qf[d0], p1, 0, 0, 0);
    }
    if (!constb) {
        const int base = k0 - qpos + 128;
#pragma unroll
        for (int r = 0; r < 16; ++r) { int i0 = base + crow(r, hi); int i1 = i0 + 32; i0 = i0 < 0 ? 0 : (i0 > 191 ? 191 : i0); i1 = i1 < 0 ? 0 : (i1 > 191 ? 191 : i1); p0[r] += tab[i0]; p1[r] += tab[i1]; }
    }
    if (nvalid < 64) {
#pragma unroll
        for (int r = 0; r < 16; ++r) { if (crow(r, hi) >= nvalid) p0[r] = -INFINITY; if (crow(r, hi) + 32 >= nvalid) p1[r] = -INFINITY; }
    }
    float mx = p0[0];
#pragma unroll
    for (int r = 1; r < 16; ++r) mx = fmaxf(mx, p0[r]);
#pragma unroll
    for (int r = 0; r < 16; ++r) mx = fmaxf(mx, p1[r]);
    mx = fmaxf(mx, __shfl_xor(mx, 32));
    const float mnew = fmaxf(mrun, mx);
    const float alpha = __builtin_amdgcn_exp2f(mrun - mnew);
    mrun = mnew;
    float ls = 0.f;
#pragma unroll
    for (int r = 0; r < 16; ++r) { p0[r] = __builtin_amdgcn_exp2f(p0[r] - mnew); p1[r] = __builtin_amdgcn_exp2f(p1[r] - mnew); ls += p0[r] + p1[r]; }
    lrun = lrun * alpha + ls;
#pragma unroll
    for (int c = 0; c < 4; ++c)
#pragma unroll
        for (int r = 0; r < 16; ++r) o[c][r] *= alpha;
    bf16x8 pf[4];
#pragma unroll
    for (int ks = 0; ks < 4; ++ks) { v4u w;
        if (ks < 2) { const int b = 8 * ks; w.x = cvtpk(p0[b], p0[b + 1]); w.y = cvtpk(p0[b + 2], p0[b + 3]); w.z = cvtpk(p0[b + 4], p0[b + 5]); w.w = cvtpk(p0[b + 6], p0[b + 7]); }
        else { const int b = 8 * (ks - 2); w.x = cvtpk(p1[b], p1[b + 1]); w.y = cvtpk(p1[b + 2], p1[b + 3]); w.z = cvtpk(p1[b + 4], p1[b + 5]); w.w = cvtpk(p1[b + 6], p1[b + 7]); }
        pf[ks] = __builtin_bit_cast(bf16x8, w); }
    LAS const unsigned char* vb = slot + 16384 + ((lane >> 4) & 1) * 32 + (lane & 3) * 8 + (4 * hi + ((lane & 15) >> 2)) * 64;
#pragma unroll
    for (int c = 0; c < 4; ++c)
#pragma unroll
        for (int ks = 0; ks < 4; ++ks) {
            const v4i16_t lo = vtr(vb + c * 4096 + (2 * ks) * 512), hh = vtr(vb + c * 4096 + (2 * ks + 1) * 512);
            const bf16x8 vf = (bf16x8){lo[0], lo[1], lo[2], lo[3], hh[0], hh[1], hh[2], hh[3]};
            o[c] = __builtin_amdgcn_mfma_f32_32x32x16_bf16(vf, pf[ks], o[c], 0, 0, 0);
        }
}

__device__ __forceinline__ int att_koff(int key, int ch) { return (ch >> 3) * 8192 + ((ch & 7) >> 1) * 2048 + (ch & 1) * 1024 + (key >> 5) * 512 + (key & 31) * 16; }
__device__ __forceinline__ int att_voff(int key, int ch) { return 16384 + (ch >> 2) * 4096 + (key >> 3) * 512 + (key & 7) * 64 + (ch & 3) * 16; }

__device__ __forceinline__ void attn_unit(const Frame& F, const AttnP& P, bool dec, int bidx, int h, int qb) {
    const int tid = F.tid, lane = F.lane, wave = F.wave, r32 = lane & 31, hi = lane >> 5;
    const int map = wave & 1, qs = wave >> 1;
    LAS unsigned char* lds = F.lds;
    LAS float* tab = LP(float, lds + ATT_TAB);
    const int rowbase = dec ? MP + bidx * DECS : bidx * SEQ;
    const int q0 = dec ? 0 : qb * 128;
    const int qpos0 = dec ? PAST : q0;
    const bool active = dec ? (qs == 0) : true;
    const int NT = dec ? (PAST / 64 + 1) : (2 * qb + 2);
    const int myNT = dec ? NT : (2 * qb + 1 + (qs >> 1));
    if (tid < 192) tab[tid] = P.relb[t5_bucket(tid - 128) * HA + h] * LOG2E;
    bf16x8 qf[4];
    { const bf16* qp = P.Q + (size_t)(rowbase + q0 + (active ? qs * 32 : 0) + r32) * 512 + h * 128 + map * 64 + 8 * hi;
#pragma unroll
      for (int d0 = 0; d0 < 4; ++d0) qf[d0] = *(const bf16x8*)(qp + 16 * d0); }
    f32x16 o[4];
#pragma unroll
    for (int c = 0; c < 4; ++c)
#pragma unroll
        for (int r = 0; r < 16; ++r) o[c][r] = 0.f;
    float mrun = -INFINITY, lrun = 0.f;
    const int qposw = qpos0 + qs * 32;
    v4u kreg[2], vreg[2];
    auto load_tile = [&](int t) {
#pragma unroll
        for (int i = 0; i < 2; ++i) { const int id = tid + 512 * i, key = id >> 4, ch = id & 15;
            if (!dec) { const size_t g = (size_t)(rowbase + 64 * t + key) * 512 + h * 128 + ch * 8; kreg[i] = *(const v4u*)(P.Kb + g); vreg[i] = *(const v4u*)(P.Vb + g); }
            else if (t < PAST / 64) { const size_t g = ((size_t)(bidx * PAST + 64 * t + key) * HA + h) * 128 + ch * 8;
                const f32x4 a0 = *(const f32x4*)(P.ck + g), a1 = *(const f32x4*)(P.ck + g + 4), b0 = *(const f32x4*)(P.cv + g), b1 = *(const f32x4*)(P.cv + g + 4);
                kreg[i] = (v4u){cvtpk(a0[0], a0[1]), cvtpk(a0[2], a0[3]), cvtpk(a1[0], a1[1]), cvtpk(a1[2], a1[3])};
                vreg[i] = (v4u){cvtpk(b0[0], b0[1]), cvtpk(b0[2], b0[3]), cvtpk(b1[0], b1[1]), cvtpk(b1[2], b1[3])}; }
            else { if (key < DECS) { const size_t g = (size_t)(rowbase + key) * 512 + h * 128 + ch * 8; kreg[i] = *(const v4u*)(P.Kb + g); vreg[i] = *(const v4u*)(P.Vb + g); }
                   else { kreg[i] = (v4u){0u, 0u, 0u, 0u}; vreg[i] = (v4u){0u, 0u, 0u, 0u}; } }
        }
    };
    auto store_tile = [&](int slot) {
        LAS unsigned char* sb = lds + slot * ATT_SLOT;
#pragma unroll
        for (int i = 0; i < 2; ++i) { const int id = tid + 512 * i, key = id >> 4, ch = id & 15; *LP(v4u, sb + att_koff(key, ch)) = kreg[i]; *LP(v4u, sb + att_voff(key, ch)) = vreg[i]; }
    };
    __syncthreads();
    load_tile(0); store_tile(0);
    __syncthreads();
    for (int t = 0; t < NT; ++t) {
        if (t + 1 < NT) load_tile(t + 1);
        if (active && t < myNT) {
            const int k0 = 64 * t;
            const bool constb = (k0 + 63 - qposw) <= -91;
            attn_tile(lds + (t & 1) * ATT_SLOT, tab, qf, o, mrun, lrun, map, lane, k0, qposw + r32, constb, (dec && t == NT - 1) ? DECS : 64);
        }
        if (t + 1 < NT) store_tile((t + 1) & 1);
        __syncthreads();
    }
    lrun += __shfl_xor(lrun, 32);
    const float inv = 1.0f / lrun;
    LAS float* ex = LP(float, lds + (wave >> 1) * 16384);
    if (map == 1) {
#pragma unroll
        for (int c = 0; c < 4; ++c)
#pragma unroll
            for (int r = 0; r < 16; ++r) ex[(c * 16 + r) * 64 + lane] = o[c][r] * inv;
    }
    __syncthreads();
    LAS bf16* yst = LP(bf16, lds + 65536 + (wave >> 1) * 8448);
    if (map == 0) {
        float ss = 0.f;
#pragma unroll
        for (int c = 0; c < 4; ++c)
#pragma unroll
            for (int r = 0; r < 16; ++r) { const float v = o[c][r] * inv - P.lam * ex[(c * 16 + r) * 64 + lane]; o[c][r] = v; ss += v * v; }
        ss += __shfl_xor(ss, 32);
        const float rs = 1.0f / sqrtf(ss * (1.f / 128.f) + LN_EPS) * P.oml;
#pragma unroll
        for (int c = 0; c < 4; ++c)
#pragma unroll
            for (int r = 0; r < 16; ++r) { const int dv = 32 * c + crow(r, hi); yst[r32 * 132 + dv] = (bf16)f2bf(o[c][r] * rs * P.subg[dv]); }
    }
    __syncthreads();
    if (map == 0 && active) {
#pragma unroll
        for (int i = 0; i < 8; ++i) { const int row = i * 4 + (lane >> 4), ch = lane & 15;
            const u32x2 a = *LP(const u32x2, yst + row * 132 + ch * 8), b = *LP(const u32x2, yst + row * 132 + ch * 8 + 4);
            *(v4u*)(P.YA + (size_t)(rowbase + q0 + qs * 32 + row) * 512 + h * 128 + ch * 8) = (v4u){a.x, a.y, b.x, b.y}; }
    }
}
__device__ __forceinline__ void ph_attn(const Frame& F, const AttnP& P) {
    for (int u = F.vcu; u < 1024 + DECB * HA; u += F.G) {
        if (u < 1024) { const int j = u >> 8, v = u & 255, bh = v >> 4, s = v & 15; const int qb = j == 0 ? s : j == 1 ? 31 - s : j == 2 ? 32 + s : 63 - s;
            attn_unit(F, P, false, bh >> 2, bh & 3, qb); }
        else { const int d = u - 1024; attn_unit(F, P, true, d >> 2, d & 3, 0); }
    }
}
constexpr int R1_RT = 0, R1_KH = 9216, R1_BH = 18432, R1_KAP = 27648, R1_KAPT = 36864, R1_VT = 46080, R1_BBT = 55296, R1_KBT = 64512;
constexpr int R1_ABKF = 73728, R1_AKK = 90368, R1_ABR = 99584, R1_AKR = 108800, R1_MB = 118016;
constexpr int R1_MF = R1_KH, R1_GT = R1_KAP, R1_WT = R1_ABKF, R1_UT = R1_KH;
constexpr int R1_LW = 73728, R1_LA = 82944, R1_LG = 92160;
constexpr int R1_RED = EXTRA_OFF, R1_CS = EXTRA_OFF + 1024, R1_GTV = EXTRA_OFF + 2048, R1_T16 = EXTRA_OFF + 2304;
typedef unsigned short u16;
__device__ __forceinline__ f32x4 mfma16(bf16x8 a, bf16x8 b, f32x4 c) { return __builtin_amdgcn_mfma_f32_16x16x32_bf16(a, b, c, 0, 0, 0); }
__device__ __forceinline__ void mm64(f32x4 (&acc)[2], LAS const unsigned char* X, LAS const unsigned char* Y, int tm, int tn0, int lane) {
    const int i = lane & 15, q = lane >> 4;
#pragma unroll
    for (int s = 0; s < 2; ++s) {
        const bf16x8 af = *LP(const bf16x8, X + ((16 * tm + i) * 72 + 32 * s + 8 * q) * 2);
#pragma unroll
        for (int j = 0; j < 2; ++j) { const bf16x8 bfr = *LP(const bf16x8, Y + ((16 * (tn0 + j) + i) * 72 + 32 * s + 8 * q) * 2); acc[j] = mfma16(af, bfr, acc[j]); }
    }
}
__device__ __forceinline__ void st_tr(LAS unsigned char* arr, const f32x4& v, int n, int t0) {
    u32x2 w; w.x = cvtpk(v[0], v[1]); w.y = cvtpk(v[2], v[3]); *LP(u32x2, arr + (n * 72 + t0) * 2) = w;
}
__device__ __forceinline__ f32x4 prod16(f32x4 acc, LAS const float* X, int sx, LAS const float* Y, int sy, int lane) {
    const int i = lane & 15, q = lane >> 4;
#pragma unroll
    for (int s = 0; s < 4; ++s) acc = __builtin_amdgcn_mfma_f32_16x16x4f32(X[i * sx + 4 * s + q], Y[(4 * s + q) * sy + i], acc, 0, 0, 0);
    return acc;
}
__device__ __forceinline__ float tanh_fast(float x) { return 1.0f - 2.0f * __builtin_amdgcn_rcpf(1.0f + __expf(2.0f * x)); }

__device__ __forceinline__ void ph_rwkv1(const Frame& F, const Args& a, int l) {
    unsigned char* ws = a.ws; LAS unsigned char* lds = F.lds;
    const int tid = F.tid, lane = F.lane, wave = F.wave, i = lane & 15, q = lane >> 4, tm = wave >> 1, tnb = 2 * (wave & 1);
    const float* PRW = (const float*)(ws + WS_PRW);
    const unsigned char* wl = ws + WS_W + (size_t)l * WL_SIZE;
    const bf16* W2t = (const bf16*)(wl + WL_W2); const bf16* A2t = (const bf16*)(wl + WL_A2); const bf16* G2t = (const bf16*)(wl + WL_G2);
    const float* mu = a.in[I_MU] + (size_t)l * NRW; const float* w0 = a.in[I_W0] + l * 512; const float* a0 = a.in[I_A0] + l * 512;
    const float* k_k = a.in[I_KK] + l * 512; const float* k_a = a.in[I_KA] + l * 512; const float* r_k = a.in[I_RK] + l * 512;
    float* OB = (float*)(ws + WS_OB); float* GG = (float*)(ws + WS_GG); float* BON = (float*)(ws + WS_BON);
    LAS float* RED = LP(float, lds + R1_RED); LAS float* CS = LP(float, lds + R1_CS); LAS float* GTV = LP(float, lds + R1_GTV);
    LAS float* ABKF = LP(float, lds + R1_ABKF); LAS float* MF = LP(float, lds + R1_MF);
    for (int it = F.vcu; it < NITEM; it += F.G) {
        const bool dec = it >= NITEM_P; int h, row0, tval; const float* prev0;
        if (!dec) { const int s = it >> 10, c = (it >> 3) & 127; h = it & 7; row0 = s * SEQ + 64 * c; tval = 64; prev0 = c > 0 ? PRW + (size_t)(row0 - 1) * NRW : nullptr; }
        else { const int b = (it - NITEM_P) >> 3; h = it & 7; row0 = MP + DECS * b; tval = DECS; prev0 = a.in[I_SSH] + (size_t)(l * DECB + b) * NRW; }
        { const int t0 = tid >> 3, part = tid & 7;
          LAS unsigned char* dst = part < 2 ? lds + R1_LW + (t0 * 72 + 32 * part) * 2 : (part < 4 ? lds + R1_LA + (t0 * 72 + 32 * (part - 2)) * 2 : lds + R1_LG + (t0 * 136 + 32 * (part - 4)) * 2);
          const float* pp = t0 > 0 ? PRW + (size_t)(row0 + t0 - 1) * NRW : prev0;
#pragma unroll 1
          for (int hf = 0; hf < 2; ++hf) { const int cb = 1536 + 32 * part + 16 * hf; float x[16];
            if (t0 < tval) { const float* p = PRW + (size_t)(row0 + t0) * NRW + cb;
#pragma unroll
              for (int e = 0; e < 16; e += 4) { const f32x4 pv = *(const f32x4*)(p + e); const f32x4 qv = pp ? *(const f32x4*)(pp + cb + e) : (f32x4){0.f, 0.f, 0.f, 0.f}; const f32x4 m4 = *(const f32x4*)(mu + cb + e);
                  const f32x4 xm = pv + (qv - pv) * m4;
#pragma unroll
                  for (int z = 0; z < 4; ++z) x[e + z] = part < 2 ? tanh_fast(xm[z]) : (part < 4 ? xm[z] : fast_sigmoid(xm[z])); } }
            else {
#pragma unroll
              for (int e = 0; e < 16; ++e) x[e] = 0.f; }
#pragma unroll
            for (int e = 0; e < 16; e += 8) *LP(v4u, dst + (16 * hf + e) * 2) = (v4u){cvtpk(x[e], x[e + 1]), cvtpk(x[e + 2], x[e + 3]), cvtpk(x[e + 4], x[e + 5]), cvtpk(x[e + 6], x[e + 7])};
          }
        }
        __syncthreads();
        f32x4 aw[2], aa[2], ag[2];
#pragma unroll
        for (int j = 0; j < 2; ++j) { aw[j] = (f32x4){0.f, 0.f, 0.f, 0.f}; aa[j] = aw[j]; ag[j] = aw[j]; }
#pragma unroll
        for (int s = 0; s < 2; ++s) {
            const bf16x8 fw = *LP(const bf16x8, lds + R1_LW + ((16 * tm + i) * 72 + 32 * s + 8 * q) * 2), fa = *LP(const bf16x8, lds + R1_LA + ((16 * tm + i) * 72 + 32 * s + 8 * q) * 2);
#pragma unroll
            for (int j = 0; j < 2; ++j) { const int n = h * 64 + 16 * (tnb + j) + i;
                aw[j] = mfma16(fw, *(const bf16x8*)(W2t + (size_t)n * 64 + 32 * s + 8 * q), aw[j]); aa[j] = mfma16(fa, *(const bf16x8*)(A2t + (size_t)n * 64 + 32 * s + 8 * q), aa[j]); }
        }
#pragma unroll
        for (int s = 0; s < 4; ++s) {
            const bf16x8 fg = *LP(const bf16x8, lds + R1_LG + ((16 * tm + i) * 136 + 32 * s + 8 * q) * 2);
#pragma unroll
            for (int j = 0; j < 2; ++j) { const int n = h * 64 + 16 * (tnb + j) + i; ag[j] = mfma16(fg, *(const bf16x8*)(G2t + (size_t)n * 128 + 32 * s + 8 * q), ag[j]); }
        }
        asm volatile("" ::: "memory");
        float xr[2][4], kp[2][4], xv[2][4], lw[2][4], av[2][4], kkr[2][4];
        float ssq[4] = {0.f, 0.f, 0.f, 0.f}, bsum[4] = {0.f, 0.f, 0.f, 0.f};
#pragma unroll
        for (int j = 0; j < 2; ++j) { const int n = 16 * (tnb + j) + i, col = h * 64 + n;
            const float mur = mu[col], muk = mu[512 + col], muv = mu[1024 + col], w0c = w0[l * 0 + col], a0c = a0[col], kkc = k_k[col], kac = k_a[col], rkc = r_k[col];
#pragma unroll
            for (int r = 0; r < 4; ++r) { const int t = 16 * tm + 4 * q + r; const bool valid = t < tval;
                const unsigned po = (unsigned)(row0 + (valid ? t : 0)) * NRW + col;
                const float pr = PRW[po], pk = PRW[po + 512], pv = PRW[po + 1024];
                float qr, qk, qv;
                if (valid && t > 0) { const unsigned qo = po - NRW; qr = PRW[qo]; qk = PRW[qo + 512]; qv = PRW[qo + 1024]; }
                else if (prev0) { qr = prev0[col]; qk = prev0[512 + col]; qv = prev0[1024 + col]; }
                else { qr = 0.f; qk = 0.f; qv = 0.f; }
                const float r_ = pr + (qr - pr) * mur, k_ = pk + (qk - pk) * muk, v_ = pv + (qv - pv) * muv;
                const float wpre = w0c + aw[j][r];
                const float sp = fmaxf(-wpre, 0.f) + log1pf(__expf(-fabsf(wpre)));
                const float wlog = -sp - 0.5f;
                const float a_ = fast_sigmoid(a0c + aa[j][r]);
                const float kk_ = k_ * kkc, kp_ = k_ * (1.0f + (a_ - 1.0f) * kac);
                xr[j][r] = valid ? r_ : 0.f; kp[j][r] = valid ? kp_ : 0.f; xv[j][r] = valid ? v_ : 0.f; lw[j][r] = valid ? -__expf(wlog) : 0.f; av[j][r] = valid ? a_ : 0.f; kkr[j][r] = valid ? kk_ : 0.f;
                ssq[r] += kkr[j][r] * kkr[j][r]; bsum[r] += xr[j][r] * kp[j][r] * rkc;
                if (valid) GG[(size_t)(row0 + t) * 512 + col] = ag[j][r];
            }
            asm volatile("" ::: "memory"); }
#pragma unroll
        for (int r = 0; r < 4; ++r) {
#pragma unroll
            for (int o = 1; o < 16; o <<= 1) { ssq[r] += __shfl_xor(ssq[r], o); bsum[r] += __shfl_xor(bsum[r], o); }
            if (i == 0) { const int t = 16 * tm + 4 * q + r; RED[(t * 2 + (wave & 1)) * 2 + 0] = ssq[r]; RED[(t * 2 + (wave & 1)) * 2 + 1] = bsum[r]; } }
        float cin[2][4], exq[2];
#pragma unroll
        for (int j = 0; j < 2; ++j) { cin[j][0] = lw[j][0]; cin[j][1] = cin[j][0] + lw[j][1]; cin[j][2] = cin[j][1] + lw[j][2]; cin[j][3] = cin[j][2] + lw[j][3];
            const float tot = cin[j][3]; float ex = 0.f, wt = 0.f;
#pragma unroll
            for (int qq = 0; qq < 4; ++qq) { const float tq = __shfl(tot, i + 16 * qq); wt += tq; ex += qq < q ? tq : 0.f; }
            exq[j] = ex; if (q == 0) CS[tm * 64 + 16 * (tnb + j) + i] = wt; }
        for (int z = tid; z < 2304; z += NTHR) LP(unsigned, lds + R1_MB)[z] = 0u;
        __syncthreads();
#pragma unroll
        for (int j = 0; j < 2; ++j) { const int n = 16 * (tnb + j) + i, col = h * 64 + n; float tmex = 0.f, csT = 0.f;
#pragma unroll
            for (int z = 0; z < 4; ++z) { const float c_ = CS[z * 64 + n]; csT += c_; tmex += z < tm ? c_ : 0.f; }
            if (tm == 0 && q == 0) GTV[n] = __expf(csT);
            f32x4 vKapT, vVT, vBbT, vKbT;
#pragma unroll
            for (int r = 0; r < 4; ++r) { const int t = 16 * tm + 4 * q + r;
                const float cst = tmex + exq[j] + cin[j][r], csp = cst - lw[j][r];
                const float sq = RED[(t * 2 + 0) * 2 + 0] + RED[(t * 2 + 1) * 2 + 0], bt = RED[(t * 2 + 0) * 2 + 1] + RED[(t * 2 + 1) * 2 + 1];
                const float kk_ = kkr[j][r] * (1.0f / sqrtf(fmaxf(sq, 1e-24f))), b_ = kk_ * av[j][r];
                const float gt = __expf(cst), gi = __expf(-cst), gp = __expf(csp), ge = __expf(csT - cst);
                LP(u16, lds + R1_RT)[t * 72 + n] = (u16)f2bf(xr[j][r] * gt);
                LP(u16, lds + R1_KH)[t * 72 + n] = (u16)f2bf(kp[j][r] * gi);
                LP(u16, lds + R1_BH)[t * 72 + n] = (u16)f2bf(b_ * gi);
                LP(u16, lds + R1_KAP)[t * 72 + n] = (u16)f2bf(kk_ * gp);
                vKapT[r] = kk_ * gp; vVT[r] = xv[j][r]; vBbT[r] = b_ * ge; vKbT[r] = kp[j][r] * ge;
                if (t < tval) BON[(size_t)(row0 + t) * 512 + col] = bt * xv[j][r];
            }
            const int t0 = 16 * tm + 4 * q;
            st_tr(lds + R1_KAPT, vKapT, n, t0); st_tr(lds + R1_VT, vVT, n, t0); st_tr(lds + R1_BBT, vBbT, n, t0); st_tr(lds + R1_KBT, vKbT, n, t0);
        }
        __syncthreads();
        { f32x4 c1[2], c2[2], c3[2], c4[2];
#pragma unroll
          for (int j = 0; j < 2; ++j) { c1[j] = (f32x4){0.f, 0.f, 0.f, 0.f}; c2[j] = c1[j]; c3[j] = c1[j]; c4[j] = c1[j]; }
          mm64(c1, lds + R1_KAP, lds + R1_BH, tm, tnb, lane); mm64(c2, lds + R1_KAP, lds + R1_KH, tm, tnb, lane);
          mm64(c3, lds + R1_RT, lds + R1_BH, tm, tnb, lane);  mm64(c4, lds + R1_RT, lds + R1_KH, tm, tnb, lane);
          __syncthreads();
#pragma unroll
          for (int j = 0; j < 2; ++j) { const int ic = 16 * (tnb + j) + i;
#pragma unroll
              for (int r = 0; r < 4; ++r) { const int t = 16 * tm + 4 * q + r;
                  ABKF[t * 65 + ic] = ic < t ? c1[j][r] : 0.f;
                  LP(u16, lds + R1_AKK)[t * 72 + ic] = (u16)f2bf(ic < t ? c2[j][r] : 0.f);
                  LP(u16, lds + R1_ABR)[t * 72 + ic] = (u16)f2bf(ic <= t ? c3[j][r] : 0.f);
                  LP(u16, lds + R1_AKR)[t * 72 + ic] = (u16)f2bf(ic <= t ? c4[j][r] : 0.f); } }
        }
        __syncthreads();
        if (wave == 0) { const int g = q, c = i; float m[16];
#pragma unroll
            for (int ii = 0; ii < 16; ++ii) { float acc = ii == c ? 1.f : 0.f;
#pragma unroll
                for (int jj = 0; jj < ii; ++jj) acc -= ABKF[(16 * g + ii) * 65 + 16 * g + jj] * m[jj];
                m[ii] = acc; MF[(16 * g + ii) * 65 + 16 * g + c] = acc; LP(u16, lds + R1_MB)[(16 * g + ii) * 72 + 16 * g + c] = (u16)f2bf(acc); } }
        __syncthreads();
#define BLK(P, bi, bj) ((P) + (16 * (bi)) * 65 + 16 * (bj))
#define PUTM(bi, bj, acc) do { _Pragma("unroll") for (int r = 0; r < 4; ++r) { MF[(16 * (bi) + 4 * q + r) * 65 + 16 * (bj) + i] = -(acc)[r]; LP(u16, lds + R1_MB)[(16 * (bi) + 4 * q + r) * 72 + 16 * (bj) + i] = (u16)f2bf(-(acc)[r]); } } while (0)
        { LAS float* T = LP(float, lds + R1_T16) + wave * 272; const f32x4 z4 = {0.f, 0.f, 0.f, 0.f};
          if (wave < 3) { const int bi = wave + 1, bj = wave; f32x4 t = prod16(z4, BLK(ABKF, bi, bj), 65, BLK(MF, bj, bj), 65, lane);
#pragma unroll
              for (int r = 0; r < 4; ++r) T[(4 * q + r) * 17 + i] = t[r];
              f32x4 mres = prod16(z4, BLK(MF, bi, bi), 65, T, 17, lane); PUTM(bi, bj, mres); }
          __syncthreads();
          if (wave < 2) { const int bi = wave + 2, bj = wave; f32x4 t = prod16(z4, BLK(ABKF, bi, bj), 65, BLK(MF, bj, bj), 65, lane); t = prod16(t, BLK(ABKF, bi, bj + 1), 65, BLK(MF, bj + 1, bj), 65, lane);
#pragma unroll
              for (int r = 0; r < 4; ++r) T[(4 * q + r) * 17 + i] = t[r];
              f32x4 mres = prod16(z4, BLK(MF, bi, bi), 65, T, 17, lane); PUTM(bi, bj, mres); }
          __syncthreads();
          if (wave == 0) { f32x4 t = prod16(z4, BLK(ABKF, 3, 0), 65, BLK(MF, 0, 0), 65, lane); t = prod16(t, BLK(ABKF, 3, 1), 65, BLK(MF, 1, 0), 65, lane); t = prod16(t, BLK(ABKF, 3, 2), 65, BLK(MF, 2, 0), 65, lane);
#pragma unroll
              for (int r = 0; r < 4; ++r) T[(4 * q + r) * 17 + i] = t[r];
              f32x4 mres = prod16(z4, BLK(MF, 3, 3), 65, T, 17, lane); PUTM(3, 0, mres); }
          __syncthreads();
        }
#undef BLK
#undef PUTM
        const int t0 = 16 * tm + 4 * q;
        { f32x4 cg[2], cw[2];
#pragma unroll
          for (int j = 0; j < 2; ++j) { cg[j] = (f32x4){0.f, 0.f, 0.f, 0.f}; cw[j] = cg[j]; }
          mm64(cg, lds + R1_AKK, lds + R1_VT, tm, tnb, lane); mm64(cw, lds + R1_MB, lds + R1_KAPT, tm, tnb, lane);
#pragma unroll
          for (int j = 0; j < 2; ++j) { const int n = 16 * (tnb + j) + i; st_tr(lds + R1_GT, cg[j], n, t0); st_tr(lds + R1_WT, cw[j], n, t0); } }
        __syncthreads();
        { f32x4 cu[2], cq[2], cp[2];
#pragma unroll
          for (int j = 0; j < 2; ++j) { cu[j] = (f32x4){0.f, 0.f, 0.f, 0.f}; cq[j] = cu[j]; cp[j] = cu[j]; }
          mm64(cu, lds + R1_MB, lds + R1_GT, tm, tnb, lane); mm64(cq, lds + R1_ABR, lds + R1_WT, tm, tnb, lane); mm64(cp, lds + R1_BBT, lds + R1_WT, tm, tnb, lane);
          bf16* QT = (bf16*)(ws + WS_QT) + (size_t)it * 4096; bf16* PT = (bf16*)(ws + WS_PT) + (size_t)it * 4096;
#pragma unroll
          for (int j = 0; j < 2; ++j) { const int n = 16 * (tnb + j) + i; st_tr(lds + R1_UT, cu[j], n, t0);
#pragma unroll
              for (int r = 0; r < 4; ++r) { const int t = t0 + r;
                  QT[t * 64 + n] = (bf16)f2bf(bf2f(LP(u16, lds + R1_RT)[t * 72 + n]) - cq[j][r]);
                  PT[t * 64 + n] = (bf16)f2bf((t == n ? GTV[n] : 0.f) - cp[j][r]); } } }
        __syncthreads();
        { f32x4 c1[2], c2[2], c3[2], c4[2];
#pragma unroll
          for (int j = 0; j < 2; ++j) { c1[j] = (f32x4){0.f, 0.f, 0.f, 0.f}; c2[j] = c1[j]; c3[j] = c1[j]; c4[j] = c1[j]; }
          mm64(c1, lds + R1_AKR, lds + R1_VT, tm, tnb, lane); mm64(c2, lds + R1_ABR, lds + R1_UT, tm, tnb, lane);
          mm64(c3, lds + R1_KBT, lds + R1_VT, tm, tnb, lane); mm64(c4, lds + R1_BBT, lds + R1_UT, tm, tnb, lane);
          float* HT = (float*)(ws + WS_HT) + (size_t)it * 4096;
#pragma unroll
          for (int j = 0; j < 2; ++j) { const int n = 16 * (tnb + j) + i;
#pragma unroll
              for (int r = 0; r < 4; ++r) { const int t = t0 + r; if (t < tval) OB[(size_t)(row0 + t) * 512 + h * 64 + n] = c1[j][r] - c2[j][r]; HT[t * 64 + n] = c3[j][r] - c4[j][r]; } } }
        __syncthreads();
    }
}

struct R2Ops { u32x2 qa[4][2][2]; u32x2 pa[4][2][2]; f32x4 hh[4]; };
__device__ __forceinline__ void r2_load(R2Ops& o, const unsigned char* ws, int it, int i, int q, int v) {
    const bf16* QT = (const bf16*)(ws + WS_QT) + (size_t)it * 4096; const bf16* PT = (const bf16*)(ws + WS_PT) + (size_t)it * 4096; const float* HT = (const float*)(ws + WS_HT) + (size_t)it * 4096;
#pragma unroll
    for (int tt = 0; tt < 4; ++tt) {
#pragma unroll
        for (int s = 0; s < 2; ++s) { o.qa[tt][s][0] = *(const u32x2*)(QT + (16 * tt + i) * 64 + 32 * s + 4 * q); o.qa[tt][s][1] = *(const u32x2*)(QT + (16 * tt + i) * 64 + 32 * s + 16 + 4 * q);
            o.pa[tt][s][0] = *(const u32x2*)(PT + (16 * tt + i) * 64 + 32 * s + 4 * q); o.pa[tt][s][1] = *(const u32x2*)(PT + (16 * tt + i) * 64 + 32 * s + 16 + 4 * q); }
#pragma unroll
        for (int r = 0; r < 4; ++r) o.hh[tt][r] = HT[(16 * tt + 4 * q + r) * 64 + v];
    }
}
__device__ __forceinline__ void ph_rwkv2(const Frame& F, const Args& a, int l) {
    const unsigned char* ws = a.ws; float* OB = (float*)(a.ws + WS_OB);
    const int lane = F.lane, i = lane & 15, q = lane >> 4;
    for (int slot = F.vcu * NWAVES + F.wave; slot < 2048; slot += F.G * NWAVES) {
        int nchunk, item0, row0, h, vs, tval; float* sout; f32x4 S[4];
        if ((slot & 15) == 0) { const int pu = slot >> 4; const int s = pu >> 5; h = (pu >> 2) & 7; vs = pu & 3; nchunk = SEQ / 64; item0 = s * 1024 + h; row0 = s * SEQ; tval = 64;
            sout = a.out + OFF_WKVP + ((size_t)(l * NB + s) * HB + h) * 4096;
#pragma unroll
            for (int kt = 0; kt < 4; ++kt) S[kt] = (f32x4){0.f, 0.f, 0.f, 0.f}; }
        else { const int d = slot - (slot >> 4) - 1; if (d >= DECB * HB * 4) continue; const int b = d >> 5; h = (d >> 2) & 7; vs = d & 3; nchunk = 1; item0 = NITEM_P + b * 8 + h; row0 = MP + DECS * b; tval = DECS;
            sout = a.out + OFF_WKVS + ((size_t)(l * DECB + b) * HB + h) * 4096;
            const float* sin = a.in[I_SWKV] + ((size_t)(l * DECB + b) * HB + h) * 4096 + (16 * vs + i) * 64 + 4 * q;
#pragma unroll
            for (int kt = 0; kt < 4; ++kt) S[kt] = *(const f32x4*)(sin + 16 * kt); }
        const int v = 16 * vs + i;
        R2Ops cur, nxt;
        r2_load(cur, ws, item0, i, q, v);
        for (int c = 0; c < nchunk; ++c) {
            if (c + 1 < nchunk) r2_load(nxt, ws, item0 + 8 * (c + 1), i, q, v);
            bf16x8 bs[2];
#pragma unroll
            for (int s = 0; s < 2; ++s) { v4u w; w.x = cvtpk(S[2 * s][0], S[2 * s][1]); w.y = cvtpk(S[2 * s][2], S[2 * s][3]); w.z = cvtpk(S[2 * s + 1][0], S[2 * s + 1][1]); w.w = cvtpk(S[2 * s + 1][2], S[2 * s + 1][3]); bs[s] = __builtin_bit_cast(bf16x8, w); }
            float* ob = OB + (size_t)(row0 + 64 * c) * 512 + h * 64 + v;
#pragma unroll
            for (int tt = 0; tt < 4; ++tt) {
                if (16 * tt < tval) {
                    f32x4 acc;
#pragma unroll
                    for (int r = 0; r < 4; ++r) acc[r] = ob[(size_t)(16 * tt + 4 * q + r) * 512];
#pragma unroll
                    for (int s = 0; s < 2; ++s) { const v4u aw = (v4u){cur.qa[tt][s][0].x, cur.qa[tt][s][0].y, cur.qa[tt][s][1].x, cur.qa[tt][s][1].y}; acc = mfma16(__builtin_bit_cast(bf16x8, aw), bs[s], acc); }
#pragma unroll
                    for (int r = 0; r < 4; ++r) ob[(size_t)(16 * tt + 4 * q + r) * 512] = acc[r];
                }
            }
#pragma unroll
            for (int kt = 0; kt < 4; ++kt) { f32x4 acc = cur.hh[kt];
#pragma unroll
                for (int s = 0; s < 2; ++s) { const v4u aw = (v4u){cur.pa[kt][s][0].x, cur.pa[kt][s][0].y, cur.pa[kt][s][1].x, cur.pa[kt][s][1].y}; acc = mfma16(__builtin_bit_cast(bf16x8, aw), bs[s], acc); }
                S[kt] = acc; }
            cur = nxt;
        }
#pragma unroll
        for (int kt = 0; kt < 4; ++kt) *(f32x4*)(sout + (size_t)v * 64 + 16 * kt + 4 * q) = S[kt];
    }
}
__device__ __forceinline__ void ph_rwkv3(const Frame& F, const Args& a, int l) {
    const float* OB = (const float*)(a.ws + WS_OB); const float* GG = (const float*)(a.ws + WS_GG); const float* BON = (const float*)(a.ws + WS_BON);
    bf16* YB = (bf16*)(a.ws + WS_YAB) + (size_t)M * 512; const float* lg = a.in[I_LNXG] + l * 512; const float* lb = a.in[I_LNXB] + l * 512;
    const int lane = F.lane;
    for (int m = F.vcu * NWAVES + F.wave; m < M; m += F.G * NWAVES) {
        const size_t off = (size_t)m * 512 + 8 * lane;
        const f32x4 o0 = *(const f32x4*)(OB + off), o1 = *(const f32x4*)(OB + off + 4);
        float s = (o0[0] + o0[1]) + (o0[2] + o0[3]) + (o1[0] + o1[1]) + (o1[2] + o1[3]);
        s += __shfl_xor(s, 1); s += __shfl_xor(s, 2); s += __shfl_xor(s, 4);
        const float mean = s * (1.f / 64.f);
        const f32x4 d0 = o0 - mean, d1 = o1 - mean;
        float s2 = (d0[0] * d0[0] + d0[1] * d0[1]) + (d0[2] * d0[2] + d0[3] * d0[3]) + (d1[0] * d1[0] + d1[1] * d1[1]) + (d1[2] * d1[2] + d1[3] * d1[3]);
        s2 += __shfl_xor(s2, 1); s2 += __shfl_xor(s2, 2); s2 += __shfl_xor(s2, 4);
        const float rstd = 1.0f / sqrtf(s2 * (1.f / 64.f) + GN_EPS);
        const f32x4 g0 = *(const f32x4*)(lg + 8 * lane), g1 = *(const f32x4*)(lg + 8 * lane + 4), b0 = *(const f32x4*)(lb + 8 * lane), b1 = *(const f32x4*)(lb + 8 * lane + 4);
        const f32x4 bn0 = *(const f32x4*)(BON + off), bn1 = *(const f32x4*)(BON + off + 4), gg0 = *(const f32x4*)(GG + off), gg1 = *(const f32x4*)(GG + off + 4);
        const f32x4 y0 = (d0 * rstd * g0 + b0 + bn0) * gg0, y1 = (d1 * rstd * g1 + b1 + bn1) * gg1;
        *(v4u*)(YB + off) = (v4u){cvtpk(y0[0], y0[1]), cvtpk(y0[2], y0[3]), cvtpk(y1[0], y1[1]), cvtpk(y1[2], y1[3])};
    }
}
constexpr int NPH_LAYER = 14, NPH = 2 + DEPTH * NPH_LAYER;
#ifndef MK_LAUNCH_PER_PHASE
#define MK_LAUNCH_PER_PHASE 1
#endif
template <unsigned PHMASK> __global__ void __launch_bounds__(NTHR, 2) fwd(Args args) {
    extern __shared__ __attribute__((aligned(16))) unsigned char lds_raw[];
    Frame F;
    F.lds = (LAS unsigned char*)lds_raw;
    F.tid = threadIdx.x; F.lane = F.tid & 63; F.wave = __builtin_amdgcn_readfirstlane(F.tid >> 6);
    F.G = gridDim.x; { const int bx = blockIdx.x; F.vcu = (F.G % 8 == 0) ? (bx % 8) * (F.G / 8) + bx / 8 : bx; }
    unsigned char* ws = args.ws;
    volatile LAS unsigned* MISC = (volatile LAS unsigned*)(F.lds + LDSCTL_OFF);
    for (int u = F.tid; u < (LDS_BYTES - LDSCTL_OFF) / 4; u += NTHR) ((LAS unsigned*)(F.lds + LDSCTL_OFF))[u] = 0u;
    __syncthreads();
    const int lo = args.ph_lo, hi = args.ph_hi;
    XcdBarrier bar; bar.bar = (unsigned*)(ws + WS_CTL) + CW_BAR; bar.x = 0; bar.st = nullptr;
    if (hi - lo > 1) bar = xcd_barrier_post((unsigned*)(ws + WS_CTL) + CW_BAR, MISC + 8);
#define IN(k) (lo <= (k) && (k) < hi)
#define SEAM(k) do { if (IN(k) && IN((k) + 1)) xcd_barrier(bar); } while (0)
    float* MOD = (float*)(ws + WS_MOD);
    bf16* U = (bf16*)(ws + WS_U); bf16* ACT = (bf16*)(ws + WS_ACT); float* Fb = (float*)(ws + WS_F);
    bf16* Qb = (bf16*)(ws + WS_Q); bf16* Kb = (bf16*)(ws + WS_KB); bf16* Vb = (bf16*)(ws + WS_VB); float* PRW = (float*)(ws + WS_PRW);
    bf16* GATES = (bf16*)(ws + WS_GATES); bf16* YAB = (bf16*)(ws + WS_YAB); bf16* MERGED = (bf16*)(ws + WS_MERGED);
    float* X = args.out;

    if (((PHMASK >> 14) & 1u) && IN(0)) { ph_prologue(F, args); } SEAM(0);
    if (((PHMASK >> 15) & 1u) && IN(1)) { ph_ln(F, args.in[I_XP], args.in[I_XS], nullptr, 0.f, nullptr, nullptr, nullptr, MOD, nullptr, U); } SEAM(1);
    for (int l = 0; l < DEPTH; ++l) {
        const int pb = 2 + l * NPH_LAYER;
        const unsigned char* wl = ws + WS_W + (size_t)l * WL_SIZE;
        const float* modl = MOD + (size_t)l * NSEQ * 9216;
        if (((PHMASK >> 0) & 1u) && IN(pb + 0)) { pg8::Gemm g{U, (const bf16*)(wl + WL_GU0), M, NGU, D}; pg8::StaticOrder S; S.init(M, NGU, F.G, (int)blockIdx.x); pg8::EpiSwiglu E{ACT, DFF};
            pg8::gemm_phase<pg8::EpiSwiglu, pg8::StaticOrder, true, true>(F.lds, g, S, E); } SEAM(pb + 0);
        if (((PHMASK >> 1) & 1u) && IN(pb + 1)) { pg8::Gemm g{ACT, (const bf16*)(wl + WL_DN0), M, D, DFF}; pg8::StaticOrder S; S.init(M, D, F.G, (int)blockIdx.x); pg8::EpiF32 E{Fb, D};
            pg8::gemm_phase<pg8::EpiF32, pg8::StaticOrder, true, true>(F.lds, g, S, E); } SEAM(pb + 1);
        if (((PHMASK >> 2) & 1u) && IN(pb + 2)) { ph_ln(F, l == 0 ? args.in[I_XP] : X, l == 0 ? args.in[I_XS] : nullptr, Fb, 0.5f, modl + 2 * D, args.in[I_LNG] + (l * 3 + 0) * D, args.in[I_LNB] + (l * 3 + 0) * D, modl + 3 * D, X, U); } SEAM(pb + 2);
        if (((PHMASK >> 3) & 1u) && IN(pb + 3)) { pg8::Gemm g{U, (const bf16*)(wl + WL_IG), M, NIG, D}; pg8::StaticOrder S; S.init(M, NIG, F.G, (int)blockIdx.x);
            pg8::EpiProj E{Qb, Kb, Vb, PRW, GATES, args.in[I_BGATE] + l * 2048,
                args.out + OFF_KP + (size_t)l * MP * 512, args.out + OFF_VP + (size_t)l * MP * 512, args.out + OFF_KS + (size_t)l * MD * 512, args.out + OFF_VS + (size_t)l * MD * 512,
                args.out + OFF_SHP + (size_t)l * NB * NRW, args.out + OFF_SHS + (size_t)l * DECB * NRW, QSCALE};
            pg8::gemm_phase<pg8::EpiProj, pg8::StaticOrder, true, true>(F.lds, g, S, E); } SEAM(pb + 3);
        if (((PHMASK >> 4) & 1u) && IN(pb + 4)) { ph_rwkv1(F, args, l); } SEAM(pb + 4);
        if (((PHMASK >> 5) & 1u) && IN(pb + 5)) { ph_rwkv2(F, args, l); } SEAM(pb + 5);
        if (((PHMASK >> 6) & 1u) && IN(pb + 6)) {
            AttnP P{Qb, Kb, Vb, args.in[I_CK] + (size_t)l * DECB * PAST * 512, args.in[I_CV] + (size_t)l * DECB * PAST * 512, YAB, args.in[I_RELB], args.in[I_SUBG] + l * 128,
                    ((const float*)(ws + WS_LAM))[l], 1.0f - (0.8f - 0.6f * expf(-0.3f * (float)l))};
            ph_attn(F, P); } SEAM(pb + 6);
        if (((PHMASK >> 7) & 1u) && IN(pb + 7)) { ph_rwkv3(F, args, l); } SEAM(pb + 7);
        if (((PHMASK >> 8) & 1u) && IN(pb + 8)) { pg8::Gemm g{YAB, (const bf16*)(wl + WL_BR), 2 * M, 2048, 512}; pg8::PairOrder S{NPAN * 4, F.G, (int)blockIdx.x, NPAN}; pg8::EpiMerge E{Fb, MERGED, GATES, NPAN};
            pg8::gemm_phase<pg8::EpiMerge, pg8::PairOrder, true, true>(F.lds, g, S, E); } SEAM(pb + 8);
        if (((PHMASK >> 9) & 1u) && IN(pb + 9)) { pg8::Gemm g{MERGED, (const bf16*)(wl + WL_O), M, D, D}; pg8::StaticOrder S; S.init(M, D, F.G, (int)blockIdx.x); pg8::EpiF32 E{Fb, D};
            pg8::gemm_phase<pg8::EpiF32, pg8::StaticOrder, true, true>(F.lds, g, S, E); } SEAM(pb + 9);
        if (((PHMASK >> 10) & 1u) && IN(pb + 10)) { ph_ln(F, X, nullptr, Fb, 1.0f, modl + 5 * D, args.in[I_LNG] + (l * 3 + 1) * D, args.in[I_LNB] + (l * 3 + 1) * D, modl + 6 * D, X, U); } SEAM(pb + 10);
        if (((PHMASK >> 11) & 1u) && IN(pb + 11)) { pg8::Gemm g{U, (const bf16*)(wl + WL_GU1), M, NGU, D}; pg8::StaticOrder S; S.init(M, NGU, F.G, (int)blockIdx.x); pg8::EpiSwiglu E{ACT, DFF};
            pg8::gemm_phase<pg8::EpiSwiglu, pg8::StaticOrder, true, true>(F.lds, g, S, E); } SEAM(pb + 11);
        if (((PHMASK >> 12) & 1u) && IN(pb + 12)) { pg8::Gemm g{ACT, (const bf16*)(wl + WL_DN1), M, D, DFF}; pg8::StaticOrder S; S.init(M, D, F.G, (int)blockIdx.x); pg8::EpiF32 E{Fb, D};
            pg8::gemm_phase<pg8::EpiF32, pg8::StaticOrder, true, true>(F.lds, g, S, E); } SEAM(pb + 12);
        if (((PHMASK >> 13) & 1u) && IN(pb + 13)) { ph_ln(F, X, nullptr, Fb, 0.5f, modl + 8 * D, args.in[I_LNG] + (l * 3 + 2) * D, args.in[I_LNB] + (l * 3 + 2) * D, l + 1 < DEPTH ? modl + (size_t)NSEQ * 9216 : nullptr, X, U); } SEAM(pb + 13);
    }
#undef IN
#undef SEAM
}

#if MK_LAUNCH_PER_PHASE
static const void* phase_fn(int k) {
    switch (k) { case 0: return (const void*)fwd<1u << 0>; case 1: return (const void*)fwd<1u << 1>; case 2: return (const void*)fwd<1u << 2>; case 3: return (const void*)fwd<1u << 3>;
        case 4: return (const void*)fwd<1u << 4>; case 5: return (const void*)fwd<1u << 5>; case 6: return (const void*)fwd<1u << 6>; case 7: return (const void*)fwd<1u << 7>;
        case 8: return (const void*)fwd<1u << 8>; case 9: return (const void*)fwd<1u << 9>; case 10: return (const void*)fwd<1u << 10>; case 11: return (const void*)fwd<1u << 11>;
        case 12: return (const void*)fwd<1u << 12>; case 13: return (const void*)fwd<1u << 13>; case 14: return (const void*)fwd<1u << 14>; default: return (const void*)fwd<1u << 15>; }
}
#else
static const void* phase_fn(int) { return (const void*)fwd<0xFFFFFFFFu>; }
#endif

extern "C" void kernel_launch(void* const* d_in, const int* in_sizes, int n_in, void* d_out, int out_size, void* d_ws, size_t ws_size, hipStream_t stream) {
    static int grid = 0;
    if (grid == 0) {
        if (n_in != 34 || (size_t)out_size != OUT_TOTAL || ws_size < WS_END) { fprintf(stderr, "kernel_launch: unexpected shapes: n_in %d out %d ws %zu (need %zu)\n", n_in, out_size, ws_size, (size_t)WS_END); grid = -1; return; }
        int dev = 0, cus = 0, per_cu = 0;
        if (hipGetDevice(&dev) != hipSuccess || hipDeviceGetAttribute(&cus, hipDeviceAttributeMultiprocessorCount, dev) != hipSuccess) { grid = -1; return; }
        for (int k = 0; k < 16; ++k) if (hipFuncSetAttribute(phase_fn(k), hipFuncAttributeMaxDynamicSharedMemorySize, LDS_BYTES) != hipSuccess) { fprintf(stderr, "kernel_launch: hipFuncSetAttribute failed\n"); grid = -1; return; }
        if (hipOccupancyMaxActiveBlocksPerMultiprocessor(&per_cu, phase_fn(15), NTHR, LDS_BYTES) != hipSuccess || per_cu < 1) fprintf(stderr, "kernel_launch: occupancy query reports %d\n", per_cu);
        (void)hipGetLastError();
        grid = cus;
    }
    if (grid < 0) return;
    (void)hipMemsetAsync((char*)d_ws + WS_CTL, 0, CTL_ZERO_BYTES, stream);
    Args a{};
    for (int i = 0; i < 34; ++i) a.in[i] = (const float*)d_in[i];
    a.out = (float*)d_out; a.ws = (unsigned char*)d_ws;
#if MK_LAUNCH_PER_PHASE
#ifndef MAXPH
#define MAXPH NPH
#endif
    for (int p = 0; p < MAXPH; ++p) { a.ph_lo = p; a.ph_hi = p + 1; const int kind = p < 2 ? 14 + p : (p - 2) % NPH_LAYER; void* kargs[] = {&a}; (void)hipLaunchKernel(phase_fn(kind), dim3(grid), dim3(NTHR), kargs, LDS_BYTES, stream); }
#else
    a.ph_lo = 0; a.ph_hi = NPH; { void* kargs[] = {&a}; (void)hipLaunchKernel(phase_fn(15), dim3(grid), dim3(NTHR), kargs, LDS_BYTES, stream); }
#endif
}
```

```cpp
#include <hip/hip_runtime.h>
#include <hip/hip_bf16.h>
#include <cstdio>
#include <cstdint>
#include <cmath>
namespace pg8 {
#define PG8_LAS __attribute__((address_space(3)))
typedef unsigned short bf16_t;
typedef short bf16x8 __attribute__((ext_vector_type(8)));
typedef float f32x4 __attribute__((ext_vector_type(4)));
typedef unsigned u32x4 __attribute__((ext_vector_type(4)));
constexpr int BM = 256, BK = 64, HALF = 128, HTB = HALF * BK * 2  , STAGE_BYTES = 8 * HTB, NXCD = 8, WGM = 8;

__host__ __device__ __forceinline__ int lds_byte(int r, int c) { const int st = (r >> 4) * 2 + (c >> 5), rr = r & 15, cc = c & 31, ob = rr * 64 + cc * 2; return st * 1024 + (ob ^ (((ob >> 9) & 1) << 5)); }
__host__ __device__ __forceinline__ void stage_rc(int b, int& R, int& C) { const int st = b / 1024, sb = b % 1024, swz = sb ^ (((sb >> 9) & 1) << 5); R = (st >> 1) * 16 + swz / 64; C = (st & 1) * 32 + (swz % 64) / 2; }
__host__ __device__ __forceinline__ int perm32(int rho) { const int n = rho >> 4, i = rho & 15; return 8 * (i >> 2) + 4 * n + (i & 3); }

struct Unit { int pm, pn; };
struct Gemm { const bf16_t* A; const bf16_t* Bt; int M, N, K; };

struct StaticOrder {
    int nM, nN, nwg, G, c;
    __host__ __device__ void init(int M, int N, int G_, int c_) { nM = M / BM; nN = N / BM; nwg = nM * nN; G = G_; c = c_; }
    __host__ __device__ bool next(int i, Unit& u) const {
        const long L = (long)i * G + c; if (L >= nwg) return false;
        int wgid = (int)L; { const int q = nwg / NXCD, r = nwg % NXCD, xcd = wgid % NXCD, off = wgid / NXCD; wgid = (xcd < r ? xcd * (q + 1) : r * (q + 1) + (xcd - r) * q) + off; }
        const int nig = WGM * nN, gid = wgid / nig, fm = gid * WGM, gsz = (nM - fm) < WGM ? (nM - fm) : WGM;
        u.pm = fm + ((wgid % nig) % gsz); u.pn = (wgid % nig) / gsz; return true;
    }
    __device__ __forceinline__ void a_ready(const Unit&) const {}
    __device__ __forceinline__ void done(const Unit&) const {}
};

typedef float f32x2c_t __attribute__((ext_vector_type(2))); typedef __bf16 bf16x2c_t __attribute__((ext_vector_type(2)));
__device__ __forceinline__ unsigned cvt_pk_bf16(float lo, float hi) { f32x2c_t v = {lo, hi}; bf16x2c_t b = __builtin_convertvector(v, bf16x2c_t); return __builtin_bit_cast(unsigned, b); }
typedef float f32x2 __attribute__((ext_vector_type(2)));
__device__ __forceinline__ float fast_sigmoid(float x) { return __builtin_amdgcn_rcpf(1.0f + __expf(-x)); }
struct EpiSwiglu {
    static constexpr bool PERM = true, AFTER_DRAIN = false;
    bf16_t* O; int ldc;
    __device__ __forceinline__ void operator()(const f32x4 (&acc)[2][2][4][2], const Unit& u, int wr, int wc, int fr, int fq) const {
        const int row0 = u.pm * BM + wr * 64 + fr; const int col0 = u.pn * 128 + wc * 32 + 8 * fq;
#pragma unroll
        for (int ai = 0; ai < 2; ++ai)
#pragma unroll
            for (int m = 0; m < 4; ++m) { bf16_t* rowp = O + (size_t)(row0 + ai * HALF + m * 16) * ldc + col0;
                float v[8];
#pragma unroll
                for (int n = 0; n < 2; ++n)
#pragma unroll
                    for (int e = 0; e < 4; ++e) { const float g = acc[ai][0][m][n][e], up = acc[ai][1][m][n][e]; v[n * 4 + e] = g * fast_sigmoid(g) * up; }
                u32x4 w; w.x = cvt_pk_bf16(v[0], v[1]); w.y = cvt_pk_bf16(v[2], v[3]); w.z = cvt_pk_bf16(v[4], v[5]); w.w = cvt_pk_bf16(v[6], v[7]);
                *(u32x4*)rowp = w; }
    }
};
struct EpiF32 {
    static constexpr bool PERM = false, AFTER_DRAIN = false;
    float* O; int ldc;
    __device__ __forceinline__ void operator()(const f32x4 (&acc)[2][2][4][2], const Unit& u, int wr, int wc, int fr, int fq) const {
        const int row0 = u.pm * BM + wr * 64 + fr; const int col0 = u.pn * BM + wc * 32 + 4 * fq;
#pragma unroll
        for (int ai = 0; ai < 2; ++ai)
#pragma unroll
            for (int m = 0; m < 4; ++m) { float* rowp = O + (size_t)(row0 + ai * HALF + m * 16) * ldc + col0;
#pragma unroll
                for (int bj = 0; bj < 2; ++bj)
#pragma unroll
                    for (int n = 0; n < 2; ++n) *(f32x4*)(rowp + bj * HALF + n * 16) = acc[ai][bj][m][n]; }
    }
};
struct EpiProj {
    static constexpr bool PERM = false, AFTER_DRAIN = false;
    bf16_t* Q; bf16_t* Kb; bf16_t* Vb; float* PRW; bf16_t* GATES; const float* bgate;
    float* outKp; float* outVp; float* outKs; float* outVs; float* outShp; float* outShs;
    float qscale;
    __device__ __forceinline__ void operator()(const f32x4 (&acc)[2][2][4][2], const Unit& u, int wr, int wc, int fr, int fq) const {
        const int row0 = u.pm * BM + wr * 64 + fr; const int pn = u.pn; const int cw = wc * 32 + 4 * fq;
        const bool prompt = u.pm < 128;
#pragma unroll
        for (int ai = 0; ai < 2; ++ai)
#pragma unroll
            for (int m = 0; m < 4; ++m) { const int row = row0 + ai * HALF + m * 16;
#pragma unroll
                for (int bj = 0; bj < 2; ++bj)
#pragma unroll
                    for (int n = 0; n < 2; ++n) { const f32x4 v = acc[ai][bj][m][n]; const int ct = bj * HALF + n * 16 + cw;
                        if (pn < 2) { const int c = pn * 256 + ct; typedef unsigned u32x2v __attribute__((ext_vector_type(2))); u32x2v w; w.x = cvt_pk_bf16(v[0] * qscale, v[1] * qscale); w.y = cvt_pk_bf16(v[2] * qscale, v[3] * qscale);
                            *(u32x2v*)(Q + (size_t)row * 512 + c) = w; }
                        else if (pn < 6) { const bool isk = pn < 4; const int c = (pn - (isk ? 2 : 4)) * 256 + ct; typedef unsigned u32x2v __attribute__((ext_vector_type(2))); u32x2v w; w.x = cvt_pk_bf16(v[0], v[1]); w.y = cvt_pk_bf16(v[2], v[3]);
                            *(u32x2v*)((isk ? Kb : Vb) + (size_t)row * 512 + c) = w;
                            float* o = prompt ? (isk ? outKp : outVp) + (size_t)row * 512 + c : (isk ? outKs : outVs) + (size_t)(row - 32768) * 512 + c;
                            *(f32x4*)o = v; }
                        else if (pn < 13) { const int c = (pn - 6) * 256 + ct; *(f32x4*)(PRW + (size_t)row * 1792 + c) = v;
                            if (prompt) { if ((row & 8191) == 8191) *(f32x4*)(outShp + (size_t)(row >> 13) * 1792 + c) = v; }
                            else { const int rd = row - 32768; if ((rd & 31) == 31) *(f32x4*)(outShs + (size_t)(rd >> 5) * 1792 + c) = v; } }
                        else { const int c = (pn - 13) * 256 + ct; const f32x4 b = *(const f32x4*)(bgate + c); typedef unsigned u32x2v __attribute__((ext_vector_type(2))); u32x2v w;
                            w.x = cvt_pk_bf16(fast_sigmoid(v[0] + b[0]), fast_sigmoid(v[1] + b[1])); w.y = cvt_pk_bf16(fast_sigmoid(v[2] + b[2]), fast_sigmoid(v[3] + b[3]));
                            *(u32x2v*)(GATES + (size_t)row * 2048 + c) = w; }
                    } }
    }
};
struct EpiMerge {
    static constexpr bool PERM = false, AFTER_DRAIN = false;
    float* TMP; bf16_t* OUT; const bf16_t* GATES; int npan;
    __device__ __forceinline__ void operator()(const f32x4 (&acc)[2][2][4][2], const Unit& u, int wr, int wc, int fr, int fq) const {
        const int which = u.pm >= npan ? 1 : 0; const int pm = u.pm - which * npan, pn = u.pn - which * 4;
        const int row0 = pm * BM + wr * 64 + fr; const int col0 = pn * BM + wc * 32 + 4 * fq;
        typedef unsigned u32x2v __attribute__((ext_vector_type(2)));
#pragma unroll
        for (int ai = 0; ai < 2; ++ai)
#pragma unroll
            for (int m = 0; m < 4; ++m) { const int row = row0 + ai * HALF + m * 16;
#pragma unroll
                for (int bj = 0; bj < 2; ++bj)
#pragma unroll
                    for (int n = 0; n < 2; ++n) { const int c = col0 + bj * HALF + n * 16; const f32x4 v = acc[ai][bj][m][n];
                        const u32x2v gw = *(const u32x2v*)(GATES + (size_t)row * 2048 + which * 1024 + c);
                        f32x4 g; g[0] = __uint_as_float(gw.x << 16); g[1] = __uint_as_float(gw.x & 0xffff0000u); g[2] = __uint_as_float(gw.y << 16); g[3] = __uint_as_float(gw.y & 0xffff0000u);
                        float* tp = TMP + (size_t)row * 1024 + c;
                        if (which == 0) { *(f32x4*)tp = g * v; }
                        else { const f32x4 t = *(const f32x4*)tp + g * v; u32x2v w; w.x = cvt_pk_bf16(t[0], t[1]); w.y = cvt_pk_bf16(t[2], t[3]); *(u32x2v*)(OUT + (size_t)row * 1024 + c) = w; }
                    } }
    }
};
struct PairOrder {
    int ntile, G, c, npan;
    __device__ __forceinline__ bool next(int i, Unit& u) const { const int tile = (i >> 1) * G + c; if (tile >= ntile) return false; const int which = i & 1; u.pm = (tile >> 2) + which * npan; u.pn = (tile & 3) + which * 4; return true; }
    __device__ __forceinline__ void a_ready(const Unit&) const {}
    __device__ __forceinline__ void done(const Unit&) const {}
};
template <class Epi, class Sched, bool ALIGN_EPI = false, bool SP2 = false>
__device__ __forceinline__ void gemm_phase(PG8_LAS unsigned char* lds, const Gemm g, const Sched& S, const Epi& E) {
    int tid_ = threadIdx.x; asm volatile("" : "+v"(tid_));
    const int tid = tid_, wid = __builtin_amdgcn_readfirstlane(tid >> 6), lane = tid & 63, wr = wid >> 2, wc = wid & 3, fr = lane & 15, fq = lane >> 4;
    const int K = g.K, nt = K / BK;
    unsigned voffA[2], voffB[2];
#pragma unroll
    for (int i = 0; i < 2; ++i) { int R, C; stage_rc(tid * 16 + i * 8192, R, C); const int Rb = Epi::PERM ? ((R & ~31) + perm32(R & 31)) : R;
        voffA[i] = (unsigned)(R * K + C) * 2u; voffB[i] = (unsigned)(Rb * K + C) * 2u; }
    const size_t kstep = (size_t)(BK * 2);
    const size_t hstep = (size_t)HALF * K * 2;
    const size_t tstep = 2 * hstep;
    const unsigned ldsw = (unsigned)wid * 1024u;
    const int aoff = lds_byte(wr * 64 + fr, fq * 8), boff = lds_byte(wc * 32 + fr, fq * 8);
#define PG8_SA(b, h) (((b) * 2 + (h)) * HTB)
#define PG8_SB(b, h) ((4 + (b) * 2 + (h)) * HTB)
#define PG8_STAGE(bufoff, gbase, voff) do { _Pragma("unroll") for (int _i = 0; _i < 2; ++_i) \
        __builtin_amdgcn_global_load_lds((const unsigned*)((const char*)(gbase) + (voff)[_i]), (PG8_LAS unsigned*)(lds + (bufoff) + ldsw + _i * 8192), 16, 0, 0); } while (0)
#define PG8_LDA(dst, b, h) do { _Pragma("unroll") for (int m = 0; m < 4; ++m) _Pragma("unroll") for (int k = 0; k < 2; ++k) dst[m][k] = *(const PG8_LAS bf16x8*)(lds + PG8_SA(b, h) + aoff + m * 2048 + k * 1024); } while (0)
#define PG8_LDB(dst, b, h) do { _Pragma("unroll") for (int n = 0; n < 2; ++n) _Pragma("unroll") for (int k = 0; k < 2; ++k) dst[n][k] = *(const PG8_LAS bf16x8*)(lds + PG8_SB(b, h) + boff + n * 2048 + k * 1024); } while (0)
#define PG8_MMA(ai, bj, At, Bt) do { __builtin_amdgcn_s_setprio(1); _Pragma("unroll") for (int m = 0; m < 4; ++m) _Pragma("unroll") for (int n = 0; n < 2; ++n) _Pragma("unroll") for (int k = 0; k < 2; ++k) \
        acc[ai][bj][m][n] = __builtin_amdgcn_mfma_f32_16x16x32_bf16(Bt[n][k], At[m][k], acc[ai][bj][m][n], 0, 0, 0); __builtin_amdgcn_s_setprio(0); } while (0)
#define PG8_WAIT_V(n) asm volatile("s_waitcnt vmcnt(" #n ")" ::: "memory")
#define PG8_WAIT_L(n) asm volatile("s_waitcnt lgkmcnt(" #n ")" ::: "memory")
#define PG8_BAR __builtin_amdgcn_s_barrier()
#define PG8_SCHED __builtin_amdgcn_sched_barrier(0)
    Unit cur, nxt; int ui = 0;
    if (!S.next(0, cur)) return;
    f32x4 acc[2][2][4][2];
#pragma unroll
    for (int a = 0; a < 2; ++a)
#pragma unroll
        for (int b = 0; b < 2; ++b)
#pragma unroll
            for (int m = 0; m < 4; ++m)
#pragma unroll
                for (int n = 0; n < 2; ++n) acc[a][b][m][n] = (f32x4){0.f, 0.f, 0.f, 0.f};
    bf16x8 At[4][2], B0[2][2], B1[2][2];
    const char* cA = (const char*)g.A + (size_t)cur.pm * tstep; const char* cB = (const char*)g.Bt + (size_t)cur.pn * tstep;
    S.a_ready(cur);
    if constexpr (SP2) {
        PG8_STAGE(PG8_SB(0, 0), cB, voffB); PG8_STAGE(PG8_SB(0, 1), cB + hstep, voffB); PG8_STAGE(PG8_SA(0, 0), cA, voffA); PG8_STAGE(PG8_SA(0, 1), cA + hstep, voffA);
        if (wr == 1) PG8_BAR;
        PG8_WAIT_V(2); PG8_BAR;
        PG8_STAGE(PG8_SB(1, 0), cB + kstep, voffB); PG8_STAGE(PG8_SA(1, 0), cA + kstep, voffA); PG8_STAGE(PG8_SB(1, 1), cB + hstep + kstep, voffB);
        PG8_WAIT_V(6); PG8_BAR;
    } else {
        PG8_STAGE(PG8_SB(0, 0), cB, voffB); PG8_STAGE(PG8_SA(0, 0), cA, voffA); PG8_STAGE(PG8_SB(0, 1), cB + hstep, voffB); PG8_STAGE(PG8_SA(0, 1), cA + hstep, voffA);
        if (wr == 1) PG8_BAR;
        PG8_WAIT_V(4); PG8_BAR;
        PG8_STAGE(PG8_SB(1, 0), cB + kstep, voffB); PG8_STAGE(PG8_SA(1, 0), cA + kstep, voffA); PG8_STAGE(PG8_SB(1, 1), cB + hstep + kstep, voffB);
        PG8_WAIT_V(6); PG8_BAR;
    }
    for (;;) {
        const bool has_next = S.next(ui + 1, nxt);
        const char* nA = has_next ? (const char*)g.A + (size_t)nxt.pm * tstep : cA; const char* nB = has_next ? (const char*)g.Bt + (size_t)nxt.pn * tstep : cB;
        for (int t = 0; t < nt; t += 2) {
            const bool last = (t == nt - 2);
            const char* a1 = cA + (size_t)(t + 1) * kstep;
            const char* a2 = last ? nA : cA + (size_t)(t + 2) * kstep; const char* b2 = last ? nB : cB + (size_t)(t + 2) * kstep;
            const char* a3 = a2 + kstep; const char* b3 = b2 + kstep;
            if (last && has_next) S.a_ready(nxt);
            if constexpr (SP2) {
            PG8_LDB(B0, 0, 0); PG8_LDB(B1, 0, 1); PG8_SCHED; PG8_LDA(At, 0, 0); PG8_STAGE(PG8_SA(1, 1), a1 + hstep, voffA);
            PG8_WAIT_V(8); PG8_WAIT_L(0); PG8_BAR; PG8_MMA(0, 0, At, B0); PG8_MMA(0, 1, At, B1); PG8_BAR; PG8_SCHED;
            PG8_LDA(At, 0, 1); PG8_STAGE(PG8_SB(0, 0), b2, voffB); PG8_STAGE(PG8_SB(0, 1), b2 + hstep, voffB); PG8_STAGE(PG8_SA(0, 0), a2, voffA);
            PG8_WAIT_V(8); PG8_WAIT_L(0); PG8_BAR; PG8_MMA(1, 0, At, B0); PG8_MMA(1, 1, At, B1); PG8_BAR; PG8_SCHED;
            PG8_LDB(B0, 1, 0); PG8_LDB(B1, 1, 1); PG8_SCHED; PG8_LDA(At, 1, 0); PG8_STAGE(PG8_SA(0, 1), a2 + hstep, voffA);
            PG8_WAIT_V(8); PG8_WAIT_L(0); PG8_BAR; PG8_MMA(0, 0, At, B0); PG8_MMA(0, 1, At, B1); PG8_BAR; PG8_SCHED;
            PG8_LDA(At, 1, 1); PG8_STAGE(PG8_SB(1, 0), b3, voffB); PG8_STAGE(PG8_SB(1, 1), b3 + hstep, voffB); PG8_STAGE(PG8_SA(1, 0), a3, voffA);
            PG8_WAIT_V(8); PG8_WAIT_L(0); PG8_BAR; PG8_MMA(1, 0, At, B0); PG8_MMA(1, 1, At, B1); PG8_BAR; PG8_SCHED;
            } else {
            PG8_LDB(B0, 0, 0); PG8_SCHED; PG8_LDA(At, 0, 0); PG8_STAGE(PG8_SA(1, 1), a1 + hstep, voffA);
            PG8_WAIT_L(8); PG8_BAR; PG8_WAIT_L(0); PG8_MMA(0, 0, At, B0); PG8_BAR; PG8_SCHED;
            PG8_LDB(B1, 0, 1); PG8_STAGE(PG8_SB(0, 0), b2, voffB);
            PG8_BAR; PG8_WAIT_L(0); PG8_MMA(0, 1, At, B1); PG8_BAR;
            PG8_LDA(At, 0, 1); PG8_STAGE(PG8_SA(0, 0), a2, voffA);
            PG8_BAR; PG8_WAIT_L(0); PG8_MMA(1, 0, At, B0); PG8_BAR; PG8_SCHED;
            PG8_STAGE(PG8_SB(0, 1), b2 + hstep, voffB);
            PG8_WAIT_V(6); PG8_BAR; PG8_MMA(1, 1, At, B1); PG8_BAR;
            PG8_LDB(B0, 1, 0); PG8_SCHED; PG8_LDA(At, 1, 0); PG8_STAGE(PG8_SA(0, 1), a2 + hstep, voffA);
            PG8_WAIT_L(8); PG8_BAR; PG8_WAIT_L(0); PG8_MMA(0, 0, At, B0); PG8_BAR; PG8_SCHED;
            PG8_LDB(B1, 1, 1); PG8_STAGE(PG8_SB(1, 0), b3, voffB);
            PG8_BAR; PG8_WAIT_L(0); PG8_MMA(0, 1, At, B1); PG8_BAR;
            PG8_LDA(At, 1, 1); PG8_STAGE(PG8_SA(1, 0), a3, voffA);
            PG8_BAR; PG8_WAIT_L(0); PG8_MMA(1, 0, At, B0); PG8_BAR; PG8_SCHED;
            PG8_STAGE(PG8_SB(1, 1), b3 + hstep, voffB);
            PG8_WAIT_V(6); PG8_BAR; PG8_MMA(1, 1, At, B1); PG8_BAR;
            }
        }
        if constexpr (ALIGN_EPI) { if (wr == 0) PG8_BAR; }
        if constexpr (!Epi::AFTER_DRAIN) { E(acc, cur, wr, wc, fr, fq); S.done(cur); }
        if (!has_next) break;
#pragma unroll
        for (int a = 0; a < 2; ++a)
#pragma unroll
            for (int b = 0; b < 2; ++b)
#pragma unroll
                for (int m = 0; m < 4; ++m)
#pragma unroll
                    for (int n = 0; n < 2; ++n) acc[a][b][m][n] = (f32x4){0.f, 0.f, 0.f, 0.f};
        cur = nxt; cA = nA; cB = nB; ++ui;
        if constexpr (ALIGN_EPI) { if (wr == 1) PG8_BAR; }
    }
    PG8_WAIT_V(0);
    if constexpr (!ALIGN_EPI) { if (wr == 0) PG8_BAR; }
    PG8_BAR;
    if constexpr (Epi::AFTER_DRAIN) { E.fused(acc, cur, wr, wc, fr, fq, lds, wid, lane); S.done(cur); }
#undef PG8_SA
#undef PG8_SB
#undef PG8_STAGE
#undef PG8_LDA
#undef PG8_LDB
#undef PG8_MMA
#undef PG8_WAIT_V
#undef PG8_WAIT_L
#undef PG8_BAR
#undef PG8_SCHED
}
}
using pg8::fast_sigmoid;
#define GAS __attribute__((address_space(1)))
#define LAS __attribute__((address_space(3)))
typedef unsigned short bf16;
typedef unsigned v4u __attribute__((ext_vector_type(4)));
typedef float f32x4 __attribute__((ext_vector_type(4)));
typedef short bf16x8 __attribute__((ext_vector_type(8)));
typedef GAS unsigned gu32;
typedef GAS unsigned long long gu64;
#define RLX_AGENT __ATOMIC_RELAXED, __HIP_MEMORY_SCOPE_AGENT
#define LDS_WAIT() asm volatile("s_waitcnt lgkmcnt(0)" ::: "memory")
#define VM_WAIT() asm volatile("s_waitcnt vmcnt(0)" ::: "memory")
__device__ __forceinline__ unsigned long long rt() { return __builtin_amdgcn_s_memrealtime(); }
__device__ __forceinline__ unsigned f2bf(float f) { unsigned u = __builtin_bit_cast(unsigned, f); return (u + 0x7fffu + ((u >> 16) & 1u)) >> 16; }
__device__ __forceinline__ unsigned pk2(float lo, float hi) { return f2bf(lo) | (f2bf(hi) << 16); }

#define XB_TMO      128
#define XB_XCNT(j)  (256  + 64 * (j))
#define XB_XSUB(j)  (1280 + 64 * (j))
#define XB_XGEN(j)  (2304 + 64 * (j))
#define XB_TOP      3328
#define XB_TOPGEN   3392
#define XCD_BAR_WORDS 3456
#define XB_SPIN_CAP (1u << 18)

__device__ __forceinline__ unsigned xb_ld(unsigned* p)              { return __hip_atomic_load(p, __ATOMIC_RELAXED, __HIP_MEMORY_SCOPE_AGENT); }
__device__ __forceinline__ unsigned xb_add(unsigned* p, unsigned v) { return __hip_atomic_fetch_add(p, v, __ATOMIC_RELAXED, __HIP_MEMORY_SCOPE_AGENT); }
__device__ __forceinline__ unsigned xb_xcc_id() { return (unsigned)__builtin_amdgcn_s_getreg((3 << 11) | 20) & 0xFu; }
#define XB_SPIN(cond, bar) do { unsigned _sp = 0; while (cond) { __builtin_amdgcn_s_sleep(1); \
    if ((++_sp & 255u) == 0u) { if (xb_ld(&(bar)[XB_TMO])) break; if (_sp > XB_SPIN_CAP) { atomicAdd(&(bar)[XB_TMO], 1u); break; } } } } while (0)

struct XcdBarrier {
    unsigned* bar; unsigned x;
    volatile LAS unsigned* st;
};

__device__ __forceinline__ XcdBarrier xcd_barrier_post(unsigned* bar, volatile LAS unsigned* st) {
    XcdBarrier b; b.bar = bar; b.x = xb_xcc_id(); b.st = st;
    if (threadIdx.x == 0) (void)xb_add(&bar[XB_XCNT(b.x)], 1u);
    return b;
}
__device__ __forceinline__ void xcd_barrier_complete(unsigned* bar, unsigned x, unsigned& nloc, unsigned& nx) {
    const unsigned G = gridDim.x * gridDim.y * gridDim.z;
    unsigned sum, cnt, mine, sp = 0u;
    for (;;) {
        sum = 0u; cnt = 0u; mine = 0u;
#pragma unroll
        for (unsigned j = 0; j < 16; ++j) { const unsigned c = xb_ld(&bar[XB_XCNT(j)]); sum += c; cnt += (c > 0u) ? 1u : 0u; mine = (j == x) ? c : mine; }
        if (sum == G) break;
        __builtin_amdgcn_s_sleep(1);
        if ((++sp & 255u) == 0u) { if (xb_ld(&bar[XB_TMO])) break; if (sp > XB_SPIN_CAP) { atomicAdd(&bar[XB_TMO], 1u); break; } }
    }
    nloc = mine > 0u ? mine : 1u; nx = cnt > 0u ? cnt : 1u;
}

__device__ __forceinline__ void xcd_barrier(const XcdBarrier& b) {
    asm volatile("s_waitcnt vmcnt(0)" ::: "memory");
    __syncthreads();
    if (threadIdx.x == 0) {
        unsigned* bar = b.bar;
        __builtin_amdgcn_s_waitcnt(0);
        unsigned nloc = b.st[0], nx = b.st[1];
        if (nloc == 0u) { xcd_barrier_complete(bar, b.x, nloc, nx); b.st[0] = nloc; b.st[1] = nx; }
        const unsigned old = xb_add(&bar[XB_XSUB(b.x)], 1u);
        const unsigned gen = old / nloc;
        if (old + 1u == (gen + 1u) * nloc) {
            __builtin_amdgcn_fence(__ATOMIC_RELEASE, "agent");
            asm volatile("s_waitcnt vmcnt(0)" ::: "memory");
            const unsigned og = xb_add(&bar[XB_TOP], 1u);
            const unsigned tg = og / nx;
            if (og + 1u == (tg + 1u) * nx) xb_add(&bar[XB_TOPGEN], 1u);
            else XB_SPIN(xb_ld(&bar[XB_TOPGEN]) == tg, bar);
            __builtin_amdgcn_fence(__ATOMIC_ACQUIRE, "agent");
            xb_add(&bar[XB_XGEN(b.x)], 1u);
            asm volatile("s_waitcnt vmcnt(0)" ::: "memory");
        } else {
            XB_SPIN(xb_ld(&bar[XB_XGEN(b.x)]) == gen, bar);
            __builtin_amdgcn_fence(__ATOMIC_ACQUIRE, "agent");
            asm volatile("s_waitcnt vmcnt(0)" ::: "memory");
        }
    }
    __syncthreads();
}
constexpr int NWAVES = 8, NTHR = 512;
constexpr int D = 1024, NB = 4, SEQ = 8192, DEPTH = 4, DECB = 32, DECS = 32, PAST = 2048;
constexpr int MP = NB * SEQ, MD = DECB * DECS, M = MP + MD, NPAN = M / 256, NSEQ = NB + DECB;
constexpr int DFF = 2816, NGU = 2 * DFF, NIN = 3328, NRW = 1792, NIG = NIN + 2 * D;
constexpr int HA = 4, HB = 8;
constexpr float LN_EPS = 1e-5f, GN_EPS = 64e-5f;
constexpr float ALPHA = 1.681792830507429f;
constexpr float QSCALE = 0.125f * 1.4426950408889634f;
constexpr float LOG2E = 1.4426950408889634f;
constexpr size_t OFF_Y = 0, OFF_KP = (size_t)M * D, OFF_VP = OFF_KP + (size_t)DEPTH * MP * 512, OFF_WKVP = OFF_VP + (size_t)DEPTH * MP * 512,
    OFF_SHP = OFF_WKVP + (size_t)DEPTH * NB * HB * 4096, OFF_KS = OFF_SHP + (size_t)DEPTH * NB * NRW, OFF_VS = OFF_KS + (size_t)DEPTH * MD * 512,
    OFF_WKVS = OFF_VS + (size_t)DEPTH * MD * 512, OFF_SHS = OFF_WKVS + (size_t)DEPTH * DECB * HB * 4096, OUT_TOTAL = OFF_SHS + (size_t)DEPTH * DECB * NRW;
static_assert(OUT_TOTAL == 177991680ull, "output size");
constexpr size_t al256(size_t x) { return (x + 255) & ~(size_t)255; }
constexpr size_t WS_CTL = 0, CTL_ZERO_BYTES = 1u << 20;
constexpr size_t WS_MOD = CTL_ZERO_BYTES;
constexpr size_t WS_LAM = WS_MOD + al256((size_t)DEPTH * NSEQ * 9 * D * 4);
constexpr size_t WS_W = WS_LAM + 256;
constexpr size_t WL_GU0 = 0, WL_GU1 = WL_GU0 + (size_t)NGU * D * 2, WL_DN0 = WL_GU1 + (size_t)NGU * D * 2, WL_DN1 = WL_DN0 + (size_t)D * DFF * 2,
    WL_IG = WL_DN1 + (size_t)D * DFF * 2, WL_BR = WL_IG + (size_t)NIG * D * 2, WL_O = WL_BR + (size_t)2048 * 512 * 2, WL_W2 = WL_O + (size_t)D * D * 2,
    WL_A2 = WL_W2 + 512 * 64 * 2, WL_G2 = WL_A2 + 512 * 64 * 2, WL_SIZE = WL_G2 + 512 * 128 * 2;
constexpr size_t WS_U = WS_W + (size_t)DEPTH * WL_SIZE;
constexpr size_t WS_ACT = WS_U + (size_t)M * D * 2;
constexpr size_t WS_F = WS_ACT + (size_t)M * DFF * 2;
constexpr size_t WS_Q = WS_F + (size_t)M * D * 4;
constexpr size_t WS_KB = WS_Q + (size_t)M * 512 * 2, WS_VB = WS_KB + (size_t)M * 512 * 2;
constexpr size_t WS_PRW = WS_VB + (size_t)M * 512 * 2;
constexpr size_t WS_GATES = WS_PRW + (size_t)M * NRW * 4;
constexpr size_t WS_YAB = WS_GATES + (size_t)M * 2048 * 2;
constexpr size_t WS_MERGED = WS_YAB + (size_t)2 * M * 512 * 2;
constexpr int NITEM_P = NB * (SEQ / 64) * HB, NITEM = NITEM_P + DECB * HB;
constexpr size_t WS_PT = WS_MERGED + (size_t)M * D * 2;
constexpr size_t WS_QT = WS_PT + (size_t)NITEM * 8192;
constexpr size_t WS_HT = WS_QT + (size_t)NITEM * 8192;
constexpr size_t WS_OB = WS_HT + (size_t)NITEM * 16384;
constexpr size_t WS_GG = WS_OB + (size_t)M * 512 * 4, WS_BON = WS_GG + (size_t)M * 512 * 4;
constexpr size_t WS_END = WS_BON + (size_t)M * 512 * 4;
constexpr int CW_TMO = 0, CW_BAR = 4096;
constexpr int RING_BYTES = 131072, EXTRA_OFF = 131072, LDSCTL_OFF = 146944, LDS_BYTES = 147456;

struct Args { const float* in[34]; float* out; unsigned char* ws; int ph_lo, ph_hi; };
static_assert(sizeof(Args) == 36 * 8 + 8, "Args has no padding");
enum { I_XP = 0, I_XS, I_CP, I_CS, I_CK, I_CV, I_SWKV, I_SSH, I_RELB, I_WADA, I_BADA, I_LNG, I_LNB, I_WGU, I_WDN, I_WIN, I_LAMQK, I_SUBG, I_MU, I_W0, I_W2, I_A0, I_A2, I_G2,
       I_KK, I_KA, I_RK, I_LNXG, I_LNXB, I_BRA, I_BRB, I_WGATE, I_BGATE, I_WO };

struct Frame { LAS unsigned char* lds; int tid, lane, wave, vcu, G; };

__device__ __forceinline__ int opq(int x) { asm volatile("" : "+s"(x)); return x; }
__device__ __forceinline__ Frame relaunder(const Frame& F) { Frame G = F; asm volatile("" : "+v"(G.tid)); G.vcu = opq(G.vcu); G.G = opq(G.G); G.lane = G.tid & 63; G.wave = __builtin_amdgcn_readfirstlane(G.tid >> 6); return G; }
__device__ __forceinline__ int row_seq(int row) { return row < MP ? (row >> 13) : NB + ((row - MP) >> 5); }
__device__ __forceinline__ int crow(int r, int hi) { return (r & 3) + 8 * (r >> 2) + 4 * hi; }
__device__ __forceinline__ float wave_sum(float v) {
#pragma unroll
    for (int o = 1; o < 64; o <<= 1) v += __shfl_xor(v, o);
    return v;
}
__device__ __forceinline__ unsigned cvtpk(float lo, float hi) { return pg8::cvt_pk_bf16(lo, hi); }
__device__ __forceinline__ float bf2f(bf16 b) { return __uint_as_float((unsigned)b << 16); }
typedef float f32x16 __attribute__((ext_vector_type(16)));
typedef unsigned u32x2 __attribute__((ext_vector_type(2)));
#define LP(T, p) ((LAS T*)(p))

__device__ __forceinline__ void p0_transpose_item(const float* W, int K, int N, bf16* WT, int k0, int n0, int drow0, LAS float* scr, int lane) {
#pragma unroll 8
    for (int i = 0; i < 32; ++i) { const int kk = 2 * i + (lane >> 5); scr[kk * 33 + (lane & 31)] = W[(size_t)(k0 + kk) * N + n0 + (lane & 31)]; }
    LDS_WAIT(); asm volatile("" ::: "memory");
    const int c = lane & 7;
#pragma unroll
    for (int j = 0; j < 4; ++j) { const int n = (lane >> 3) + 8 * j; const LAS float* s = scr + (8 * c) * 33 + n;
        v4u o; o.x = pk2(s[0 * 33], s[1 * 33]); o.y = pk2(s[2 * 33], s[3 * 33]); o.z = pk2(s[4 * 33], s[5 * 33]); o.w = pk2(s[6 * 33], s[7 * 33]);
        *(GAS v4u*)(WT + (size_t)(drow0 + n) * K + k0 + 8 * c) = o; }
    LDS_WAIT(); asm volatile("" ::: "memory");
}
__device__ __forceinline__ void conv_mat(const float* W, int K, int N, bf16* WT, int r, int row_off, bool gu, LAS float* scr, int lane) {
    const int nblk = N / 32, kb = r / nblk, nb = r % nblk, n0 = 32 * nb; int drow0 = row_off + n0;
    if (gu) { drow0 = n0 < DFF ? 256 * (n0 / 128) + (n0 % 128) : 256 * ((n0 - DFF) / 128) + 128 + ((n0 - DFF) % 128); }
    p0_transpose_item(W, K, N, WT, 64 * kb, n0, drow0, scr, lane);
}
__device__ __forceinline__ void ph_prologue(const Frame& F0, const Args& a) {
    const Frame F = relaunder(F0);
    unsigned char* ws = a.ws;
    LAS bf16* sc = LP(bf16, F.lds);
    for (int i = F.tid; i < NSEQ * D; i += NTHR) { const int s = i >> 10, k = i & 1023; const float c = s < NB ? a.in[I_CP][s * D + k] : a.in[I_CS][(s - NB) * D + k];
        sc[s * 1032 + k] = (bf16)f2bf(c * fast_sigmoid(c)); }
    __syncthreads();
    const int gw = F.vcu * NWAVES + F.wave, NGW = F.G * NWAVES; const int lane = F.lane, r32 = lane & 31, hi = lane >> 5;
    float* MOD = (float*)(ws + WS_MOD);
    for (int it = gw; it < DEPTH * 288; it += NGW) {
        const int l = it / 288, n0 = (it % 288) * 32;
        const float* W = a.in[I_WADA] + (size_t)l * D * 9216 + n0 + r32;
        f32x16 acc0 = {}, acc1 = {};
        const int rowB = (32 + r32) < NSEQ ? 32 + r32 : NSEQ - 1;
#pragma unroll 4
        for (int s = 0; s < 64; ++s) {
            const float* wp = W + (size_t)(16 * s + 8 * hi) * 9216;
            float w[8];
#pragma unroll
            for (int j = 0; j < 8; ++j) w[j] = wp[(size_t)j * 9216];
            v4u bw; bw.x = cvtpk(w[0], w[1]); bw.y = cvtpk(w[2], w[3]); bw.z = cvtpk(w[4], w[5]); bw.w = cvtpk(w[6], w[7]);
            const bf16x8 bfrag = __builtin_bit_cast(bf16x8, bw);
            const bf16x8 a0 = *LP(const bf16x8, sc + r32 * 1032 + 16 * s + 8 * hi);
            const bf16x8 a1 = *LP(const bf16x8, sc + rowB * 1032 + 16 * s + 8 * hi);
            acc0 = __builtin_amdgcn_mfma_f32_32x32x16_bf16(a0, bfrag, acc0, 0, 0, 0);
            acc1 = __builtin_amdgcn_mfma_f32_32x32x16_bf16(a1, bfrag, acc1, 0, 0, 0);
        }
        const float bias = a.in[I_BADA][(size_t)l * 9216 + n0 + r32];
#pragma unroll
        for (int r = 0; r < 16; ++r) { const int s0 = crow(r, hi); MOD[((size_t)l * NSEQ + s0) * 9216 + n0 + r32] = acc0[r] + bias;
            const int s1 = 32 + s0; if (s1 < NSEQ) MOD[((size_t)l * NSEQ + s1) * 9216 + n0 + r32] = acc1[r] + bias; }
    }
    LAS float* scr = LP(float, F.lds + 74304 + F.wave * 8448);
    constexpr int C0 = 16 * 176, C2 = 44 * 32, C4 = 16 * 104, C5 = 16 * 64, C6 = 8 * 32, C8 = 16 * 32, C9 = 16, C11 = 32;
    constexpr int PER_L = 2 * C0 + 2 * C2 + C4 + C5 + 2 * C6 + C8 + 2 * C9 + C11;
    for (int it = gw; it < DEPTH * PER_L; it += NGW) {
        const int l = it / PER_L; int r = it % PER_L; unsigned char* wl = ws + WS_W + (size_t)l * WL_SIZE;
        if (r < C0) { conv_mat(a.in[I_WGU] + (size_t)(l * 2 + 0) * D * NGU, D, NGU, (bf16*)(wl + WL_GU0), r, 0, true, scr, lane); continue; } r -= C0;
        if (r < C0) { conv_mat(a.in[I_WGU] + (size_t)(l * 2 + 1) * D * NGU, D, NGU, (bf16*)(wl + WL_GU1), r, 0, true, scr, lane); continue; } r -= C0;
        if (r < C2) { conv_mat(a.in[I_WDN] + (size_t)(l * 2 + 0) * DFF * D, DFF, D, (bf16*)(wl + WL_DN0), r, 0, false, scr, lane); continue; } r -= C2;
        if (r < C2) { conv_mat(a.in[I_WDN] + (size_t)(l * 2 + 1) * DFF * D, DFF, D, (bf16*)(wl + WL_DN1), r, 0, false, scr, lane); continue; } r -= C2;
        if (r < C4) { conv_mat(a.in[I_WIN] + (size_t)l * D * NIN, D, NIN, (bf16*)(wl + WL_IG), r, 0, false, scr, lane); continue; } r -= C4;
        if (r < C5) { conv_mat(a.in[I_WGATE] + (size_t)l * D * 2048, D, 2048, (bf16*)(wl + WL_IG), r, NIN, false, scr, lane); continue; } r -= C5;
        if (r < C6) { conv_mat(a.in[I_BRA] + (size_t)l * 512 * D, 512, D, (bf16*)(wl + WL_BR), r, 0, false, scr, lane); continue; } r -= C6;
        if (r < C6) { conv_mat(a.in[I_BRB] + (size_t)l * 512 * D, 512, D, (bf16*)(wl + WL_BR), r, 1024, false, scr, lane); continue; } r -= C6;
        if (r < C8) { conv_mat(a.in[I_WO] + (size_t)l * D * D, D, D, (bf16*)(wl + WL_O), r, 0, false, scr, lane); continue; } r -= C8;
        if (r < C9) { conv_mat(a.in[I_W2] + (size_t)l * 64 * 512, 64, 512, (bf16*)(wl + WL_W2), r, 0, false, scr, lane); continue; } r -= C9;
        if (r < C9) { conv_mat(a.in[I_A2] + (size_t)l * 64 * 512, 64, 512, (bf16*)(wl + WL_A2), r, 0, false, scr, lane); continue; } r -= C9;
        conv_mat(a.in[I_G2] + (size_t)l * 128 * 512, 128, 512, (bf16*)(wl + WL_G2), r, 0, false, scr, lane);
    }
    if (blockIdx.x == 0 && F.wave == 0) {
        for (int l = 0; l < DEPTH; ++l) { const float* lq = a.in[I_LAMQK] + l * 256;
            const float s1 = wave_sum(lq[lane] * lq[64 + lane]), s2 = wave_sum(lq[128 + lane] * lq[192 + lane]);
            const float lam_init = 0.8f - 0.6f * expf(-0.3f * (float)l);
            if (lane == 0) ((float*)(ws + WS_LAM))[l] = expf(s1) - expf(s2) + lam_init; }
    }
}

__device__ __forceinline__ void ph_ln(const Frame& F0, const float* xin_p, const float* xin_s, const float* f, float gs, const float* gate_mod  ,
                                      const float* lng, const float* lnb, const float* modn  , float* xout, bf16* uout) {
    const Frame F = relaunder(F0);
    const int gw = F.vcu * NWAVES + F.wave, NGW = F.G * NWAVES, lane = F.lane;
    for (int m = gw; m < M; m += NGW) {
        const int seq = row_seq(m);
        const float* xr = (xin_s && m >= MP) ? xin_s + (size_t)(m - MP) * D : xin_p + (size_t)m * D;
        f32x4 v[4];
#pragma unroll
        for (int j = 0; j < 4; ++j) v[j] = *(const f32x4*)(xr + 4 * lane + 256 * j);
        if (f) {
            const float* fr = f + (size_t)m * D; const float* gm = gate_mod + (size_t)seq * 9216; float s = 0.f;
#pragma unroll
            for (int j = 0; j < 4; ++j) { const f32x4 fv = *(const f32x4*)(fr + 4 * lane + 256 * j); const f32x4 gv = *(const f32x4*)(gm + 4 * lane + 256 * j);
                v[j] = v[j] * ALPHA + (gv * gs) * fv; s += (v[j].x + v[j].y) + (v[j].z + v[j].w); }
            const float mean = wave_sum(s) * (1.f / D); float s2 = 0.f;
#pragma unroll
            for (int j = 0; j < 4; ++j) { v[j] = v[j] - mean; s2 += (v[j].x * v[j].x + v[j].y * v[j].y) + (v[j].z * v[j].z + v[j].w * v[j].w); }
            const float rstd = 1.0f / sqrtf(wave_sum(s2) * (1.f / D) + LN_EPS);
#pragma unroll
            for (int j = 0; j < 4; ++j) { const f32x4 g = *(const f32x4*)(lng + 4 * lane + 256 * j), b = *(const f32x4*)(lnb + 4 * lane + 256 * j); v[j] = v[j] * rstd * g + b;
                *(f32x4*)(xout + (size_t)m * D + 4 * lane + 256 * j) = v[j]; }
        }
        if (modn) {
            const float* mm = modn + (size_t)seq * 9216; float s = 0.f;
#pragma unroll
            for (int j = 0; j < 4; ++j) s += (v[j].x + v[j].y) + (v[j].z + v[j].w);
            const float mean = wave_sum(s) * (1.f / D); float s2 = 0.f;
#pragma unroll
            for (int j = 0; j < 4; ++j) { v[j] = v[j] - mean; s2 += (v[j].x * v[j].x + v[j].y * v[j].y) + (v[j].z * v[j].z + v[j].w * v[j].w); }
            const float rstd = 1.0f / sqrtf(wave_sum(s2) * (1.f / D) + LN_EPS);
#pragma unroll
            for (int j = 0; j < 4; ++j) { const f32x4 sh = *(const f32x4*)(mm + 4 * lane + 256 * j), scl = *(const f32x4*)(mm + D + 4 * lane + 256 * j);
                const f32x4 o = v[j] * rstd * (scl + 1.0f) + sh; u32x2 w; w.x = cvtpk(o.x, o.y); w.y = cvtpk(o.z, o.w);
                *(u32x2*)(uout + (size_t)m * D + 4 * lane + 256 * j) = w; }
        }
    }
}
__device__ __forceinline__ int t5_bucket(int rel) {
    const int n = rel < 0 ? -rel : rel; int b;
    if (n < 8) b = n; else if (n < 12) b = 8; else if (n < 16) b = 9; else if (n < 23) b = 10; else if (n < 32) b = 11; else if (n < 46) b = 12; else if (n < 64) b = 13; else if (n < 91) b = 14; else b = 15;
    return (rel > 0 ? 16 : 0) + b;
}
typedef short v4i16_t __attribute__((ext_vector_type(4)));
__device__ __forceinline__ v4i16_t vtr(LAS const unsigned char* p) { return __builtin_amdgcn_ds_read_tr16_b64_v4i16((LAS v4i16_t*)p); }
constexpr int ATT_SLOT = 32768;
constexpr int ATT_TAB = EXTRA_OFF;
struct AttnP { const bf16* Q; const bf16* Kb; const bf16* Vb; const float* ck; const float* cv; bf16* YA; const float* relb; const float* subg; float lam, oml; };

__device__ __forceinline__ void attn_tile(LAS const unsigned char* slot, LAS const float* tab, const bf16x8 (&qf)[4], f32x16 (&o)[4], float& mrun, float& lrun,
                                          int map, int lane, int k0, int qpos, bool constb, int nvalid) {
    const int r32 = lane & 31, hi = lane >> 5;
    LAS const unsigned char* kb = slot + map * 8192 + hi * 1024 + r32 * 16;
    f32x16 p0, p1;
    const float cb = constb ? tab[0] : 0.f;
#pragma unroll
    for (int r = 0; r < 16; ++r) { p0[r] = cb; p1[r] = cb; }
#pragma unroll
    for (int d0 = 0; d0 < 4; ++d0) {
        const bf16x8 k0f = *LP(const bf16x8, kb + d0 * 2048), k1f = *LP(const bf16x8, kb + d0 * 2048 + 512);
        p0 = __builtin_amdgcn_mfma_f32_32x32x16_bf16(k0f, qf[d0], p0, 0, 0, 0);
        p1 = __builtin_amdgcn_mfma_f32_32x32x16_bf16(k1f, qf[d0], p1, 0, 0, 0);
    }
    if (!constb) {
        const int base = k0 - qpos + 128;
#pragma unroll
        for (int r = 0; r < 16; ++r) { int i0 = base + crow(r, hi); int i1 = i0 + 32; i0 = i0 < 0 ? 0 : (i0 > 191 ? 191 : i0); i1 = i1 < 0 ? 0 : (i1 > 191 ? 191 : i1); p0[r] += tab[i0]; p1[r] += tab[i1]; }
    }
    if (nvalid < 64) {
#pragma unroll
        for (int r = 0; r < 16; ++r) { if (crow(r, hi) >= nvalid) p0[r] = -INFINITY; if (crow(r, hi) + 32 >= nvalid) p1[r] = -INFINITY; }
    }
    float mx = p0[0];
#pragma unroll
    for (int r = 1; r < 16; ++r) mx = fmaxf(mx, p0[r]);
#pragma unroll
    for (int r = 0; r < 16; ++r) mx = fmaxf(mx, p1[r]);
    mx = fmaxf(mx, __shfl_xor(mx, 32));
    const float mnew = fmaxf(mrun, mx);
    const float alpha = __builtin_amdgcn_exp2f(mrun - mnew);
    mrun = mnew;
    float ls = 0.f;
#pragma unroll
    for (int r = 0; r < 16; ++r) { p0[r] = __builtin_amdgcn_exp2f(p0[r] - mnew); p1[r] = __builtin_amdgcn_exp2f(p1[r] - mnew); ls += p0[r] + p1[r]; }
    lrun = lrun * alpha + ls;
#pragma unroll
    for (int c = 0; c < 4; ++c)
#pragma unroll
        for (int r = 0; r < 16; ++r) o[c][r] *= alpha;
    bf16x8 pf[4];
#pragma unroll
    for (int ks = 0; ks < 4; ++ks) { v4u w;
        if (ks < 2) { const int b = 8 * ks; w.x = cvtpk(p0[b], p0[b + 1]); w.y = cvtpk(p0[b + 2], p0[b + 3]); w.z = cvtpk(p0[b + 4], p0[b + 5]); w.w = cvtpk(p0[b + 6], p0[b + 7]); }
        else { const int b = 8 * (ks - 2); w.x = cvtpk(p1[b], p1[b + 1]); w.y = cvtpk(p1[b + 2], p1[b + 3]); w.z = cvtpk(p1[b + 4], p1[b + 5]); w.w = cvtpk(p1[b + 6], p1[b + 7]); }
        pf[ks] = __builtin_bit_cast(bf16x8, w); }
    LAS const unsigned char* vb = slot + 16384 + ((lane >> 4) & 1) * 32 + (lane & 3) * 8 + (4 * hi + ((lane & 15) >> 2)) * 64;
#pragma unroll
    for (int c = 0; c < 4; ++c)
#pragma unroll
        for (int ks = 0; ks < 4; ++ks) {
            const v4i16_t lo = vtr(vb + c * 4096 + (2 * ks) * 512), hh = vtr(vb + c * 4096 + (2 * ks + 1) * 512);
            const bf16x8 vf = (bf16x8){lo[0], lo[1], lo[2], lo[3], hh[0], hh[1], hh[2], hh[3]};
            o[c] = __builtin_amdgcn_mfma_f32_32x32x16_bf16(vf, pf[ks], o[c], 0, 0, 0);
        }
}

__device__ __forceinline__ int att_koff(int key, int ch) { return (ch >> 3) * 8192 + ((ch & 7) >> 1) * 2048 + (ch & 1) * 1024 + (key >> 5) * 512 + (key & 31) * 16; }
__device__ __forceinline__ int att_voff(int key, int ch) { return 16384 + (ch >> 2) * 4096 + (key >> 3) * 512 + (key & 7) * 64 + (ch & 3) * 16; }

__device__ __forceinline__ void attn_unit(const Frame& F, const AttnP& P, bool dec, int bidx, int h, int qb) {
    const int tid = F.tid, lane = F.lane, wave = F.wave, r32 = lane & 31, hi = lane >> 5;
    const int map = wave & 1, qs = wave >> 1;
    LAS unsigned char* lds = F.lds;
    LAS float* tab = LP(float, lds + ATT_TAB);
    const int rowbase = dec ? MP + bidx * DECS : bidx * SEQ;
    const int q0 = dec ? 0 : qb * 128;
    const int qpos0 = dec ? PAST : q0;
    const bool active = dec ? (qs == 0) : true;
    const int NT = dec ? (PAST / 64 + 1) : (2 * qb + 2);
    const int myNT = dec ? NT : (2 * qb + 1 + (qs >> 1));
    if (tid < 192) tab[tid] = P.relb[t5_bucket(tid - 128) * HA + h] * LOG2E;
    bf16x8 qf[4];
    { const bf16* qp = P.Q + (size_t)(rowbase + q0 + (active ? qs * 32 : 0) + r32) * 512 + h * 128 + map * 64 + 8 * hi;
#pragma unroll
      for (int d0 = 0; d0 < 4; ++d0) qf[d0] = *(const bf16x8*)(qp + 16 * d0); }
    f32x16 o[4];
#pragma unroll
    for (int c = 0; c < 4; ++c)
#pragma unroll
        for (int r = 0; r < 16; ++r) o[c][r] = 0.f;
    float mrun = -INFINITY, lrun = 0.f;
    const int qposw = qpos0 + qs * 32;
    v4u kreg[2], vreg[2];
    auto load_tile = [&](int t) {
#pragma unroll
        for (int i = 0; i < 2; ++i) { const int id = tid + 512 * i, key = id >> 4, ch = id & 15;
            if (!dec) { const size_t g = (size_t)(rowbase + 64 * t + key) * 512 + h * 128 + ch * 8; kreg[i] = *(const v4u*)(P.Kb + g); vreg[i] = *(const v4u*)(P.Vb + g); }
            else if (t < PAST / 64) { const size_t g = ((size_t)(bidx * PAST + 64 * t + key) * HA + h) * 128 + ch * 8;
                const f32x4 a0 = *(const f32x4*)(P.ck + g), a1 = *(const f32x4*)(P.ck + g + 4), b0 = *(const f32x4*)(P.cv + g), b1 = *(const f32x4*)(P.cv + g + 4);
                kreg[i] = (v4u){cvtpk(a0[0], a0[1]), cvtpk(a0[2], a0[3]), cvtpk(a1[0], a1[1]), cvtpk(a1[2], a1[3])};
                vreg[i] = (v4u){cvtpk(b0[0], b0[1]), cvtpk(b0[2], b0[3]), cvtpk(b1[0], b1[1]), cvtpk(b1[2], b1[3])}; }
            else { if (key < DECS) { const size_t g = (size_t)(rowbase + key) * 512 + h * 128 + ch * 8; kreg[i] = *(const v4u*)(P.Kb + g); vreg[i] = *(const v4u*)(P.Vb + g); }
                   else { kreg[i] = (v4u){0u, 0u, 0u, 0u}; vreg[i] = (v4u){0u, 0u, 0u, 0u}; } }
        }
    };
    auto store_tile = [&](int slot) {
        LAS unsigned char* sb = lds + slot * ATT_SLOT;
#pragma unroll
        for (int i = 0; i < 2; ++i) { const int id = tid + 512 * i, key = id >> 4, ch = id & 15; *LP(v4u, sb + att_koff(key, ch)) = kreg[i]; *LP(v4u, sb + att_voff(key, ch)) = vreg[i]; }
    };
    __syncthreads();
    load_tile(0); store_tile(0);
    __syncthreads();
    for (int t = 0; t < NT; ++t) {
        if (t + 1 < NT) load_tile(t + 1);
        if (active && t < myNT) {
            const int k0 = 64 * t;
            const bool constb = (k0 + 63 - qposw) <= -91;
            attn_tile(lds + (t & 1) * ATT_SLOT, tab, qf, o, mrun, lrun, map, lane, k0, qposw + r32, constb, (dec && t == NT - 1) ? DECS : 64);
        }
        if (t + 1 < NT) store_tile((t + 1) & 1);
        __syncthreads();
    }
    lrun += __shfl_xor(lrun, 32);
    const float inv = 1.0f / lrun;
    LAS float* ex = LP(float, lds + (wave >> 1) * 16384);
    if (map == 1) {
#pragma unroll
        for (int c = 0; c < 4; ++c)
#pragma unroll
            for (int r = 0; r < 16; ++r) ex[(c * 16 + r) * 64 + lane] = o[c][r] * inv;
    }
    __syncthreads();
    LAS bf16* yst = LP(bf16, lds + 65536 + (wave >> 1) * 8448);
    if (map == 0) {
        float ss = 0.f;
#pragma unroll
        for (int c = 0; c < 4; ++c)
#pragma unroll
            for (int r = 0; r < 16; ++r) { const float v = o[c][r] * inv - P.lam * ex[(c * 16 + r) * 64 + lane]; o[c][r] = v; ss += v * v; }
        ss += __shfl_xor(ss, 32);
        const float rs = 1.0f / sqrtf(ss * (1.f / 128.f) + LN_EPS) * P.oml;
#pragma unroll
        for (int c = 0; c < 4; ++c)
#pragma unroll
            for (int r = 0; r < 16; ++r) { const int dv = 32 * c + crow(r, hi); yst[r32 * 132 + dv] = (bf16)f2bf(o[c][r] * rs * P.subg[dv]); }
    }
    __syncthreads();
    if (map == 0 && active) {
#pragma unroll
        for (int i = 0; i < 8; ++i) { const int row = i * 4 + (lane >> 4), ch = lane & 15;
            const u32x2 a = *LP(const u32x2, yst + row * 132 + ch * 8), b = *LP(const u32x2, yst + row * 132 + ch * 8 + 4);
            *(v4u*)(P.YA + (size_t)(rowbase + q0 + qs * 32 + row) * 512 + h * 128 + ch * 8) = (v4u){a.x, a.y, b.x, b.y}; }
    }
}
__device__ __forceinline__ void ph_attn(const Frame& F0, const AttnP& P) {
    const Frame F = relaunder(F0);
    for (int u = F.vcu; u < 1024 + DECB * HA; u += F.G) {
        if (u < 1024) { const int j = u >> 8, v = u & 255, bh = v >> 4, s = v & 15; const int qb = j == 0 ? s : j == 1 ? 31 - s : j == 2 ? 32 + s : 63 - s;
            attn_unit(F, P, false, bh >> 2, bh & 3, qb); }
        else { const int d = u - 1024; attn_unit(F, P, true, d >> 2, d & 3, 0); }
    }
}
constexpr int R1_RT = 0, R1_KH = 9216, R1_BH = 18432, R1_KAP = 27648, R1_KAPT = 36864, R1_VT = 46080, R1_BBT = 55296, R1_KBT = 64512;
constexpr int R1_ABKF = 73728, R1_AKK = 90368, R1_ABR = 99584, R1_AKR = 108800, R1_MB = 118016;
constexpr int R1_MF = R1_KH, R1_GT = R1_KAP, R1_WT = R1_ABKF, R1_UT = R1_KH;
constexpr int R1_LW = 73728, R1_LA = 82944, R1_LG = 92160;
constexpr int R1_RED = EXTRA_OFF, R1_CS = EXTRA_OFF + 1024, R1_GTV = EXTRA_OFF + 2048, R1_T16 = EXTRA_OFF + 2304;
typedef unsigned short u16;
__device__ __forceinline__ f32x4 mfma16(bf16x8 a, bf16x8 b, f32x4 c) { return __builtin_amdgcn_mfma_f32_16x16x32_bf16(a, b, c, 0, 0, 0); }
__device__ __forceinline__ void mm64(f32x4 (&acc)[2], LAS const unsigned char* X, LAS const unsigned char* Y, int tm, int tn0, int lane) {
    const int i = lane & 15, q = lane >> 4;
#pragma unroll
    for (int s = 0; s < 2; ++s) {
        const bf16x8 af = *LP(const bf16x8, X + ((16 * tm + i) * 72 + 32 * s + 8 * q) * 2);
#pragma unroll
        for (int j = 0; j < 2; ++j) { const bf16x8 bfr = *LP(const bf16x8, Y + ((16 * (tn0 + j) + i) * 72 + 32 * s + 8 * q) * 2); acc[j] = mfma16(af, bfr, acc[j]); }
    }
}
__device__ __forceinline__ void st_tr(LAS unsigned char* arr, const f32x4& v, int n, int t0) {
    u32x2 w; w.x = cvtpk(v[0], v[1]); w.y = cvtpk(v[2], v[3]); *LP(u32x2, arr + (n * 72 + t0) * 2) = w;
}
__device__ __forceinline__ f32x4 prod16(f32x4 acc, LAS const float* X, int sx, LAS const float* Y, int sy, int lane) {
    const int i = lane & 15, q = lane >> 4;
#pragma unroll
    for (int s = 0; s < 4; ++s) acc = __builtin_amdgcn_mfma_f32_16x16x4f32(X[i * sx + 4 * s + q], Y[(4 * s + q) * sy + i], acc, 0, 0, 0);
    return acc;
}
__device__ __forceinline__ float tanh_fast(float x) { return 1.0f - 2.0f * __builtin_amdgcn_rcpf(1.0f + __expf(2.0f * x)); }

__device__ __forceinline__ void ph_rwkv1(const Frame& F0, const Args& a, int l) {
    const Frame F = relaunder(F0);
    unsigned char* ws = a.ws; LAS unsigned char* lds = F.lds;
    const int tid = F.tid, lane = F.lane, wave = F.wave, i = lane & 15, q = lane >> 4, tm = wave >> 1, tnb = 2 * (wave & 1);
    const float* PRW = (const float*)(ws + WS_PRW);
    const unsigned char* wl = ws + WS_W + (size_t)l * WL_SIZE;
    const bf16* W2t = (const bf16*)(wl + WL_W2); const bf16* A2t = (const bf16*)(wl + WL_A2); const bf16* G2t = (const bf16*)(wl + WL_G2);
    const float* mu = a.in[I_MU] + (size_t)l * NRW; const float* w0 = a.in[I_W0] + l * 512; const float* a0 = a.in[I_A0] + l * 512;
    const float* k_k = a.in[I_KK] + l * 512; const float* k_a = a.in[I_KA] + l * 512; const float* r_k = a.in[I_RK] + l * 512;
    float* OB = (float*)(ws + WS_OB); float* GG = (float*)(ws + WS_GG); float* BON = (float*)(ws + WS_BON);
    LAS float* RED = LP(float, lds + R1_RED); LAS float* CS = LP(float, lds + R1_CS); LAS float* GTV = LP(float, lds + R1_GTV);
    LAS float* ABKF = LP(float, lds + R1_ABKF); LAS float* MF = LP(float, lds + R1_MF);
    for (int it = F.vcu; it < NITEM; it += F.G) {
        const bool dec = it >= NITEM_P; int h, row0, tval; const float* prev0;
        if (!dec) { const int s = it >> 10, c = (it >> 3) & 127; h = it & 7; row0 = s * SEQ + 64 * c; tval = 64; prev0 = c > 0 ? PRW + (size_t)(row0 - 1) * NRW : nullptr; }
        else { const int b = (it - NITEM_P) >> 3; h = it & 7; row0 = MP + DECS * b; tval = DECS; prev0 = a.in[I_SSH] + (size_t)(l * DECB + b) * NRW; }
        { const int t0 = tid >> 3, part = tid & 7;
          LAS unsigned char* dst = part < 2 ? lds + R1_LW + (t0 * 72 + 32 * part) * 2 : (part < 4 ? lds + R1_LA + (t0 * 72 + 32 * (part - 2)) * 2 : lds + R1_LG + (t0 * 136 + 32 * (part - 4)) * 2);
          const float* pp = t0 > 0 ? PRW + (size_t)(row0 + t0 - 1) * NRW : prev0;
#pragma unroll 1
          for (int hf = 0; hf < 2; ++hf) { const int cb = 1536 + 32 * part + 16 * hf; float x[16];
            if (t0 < tval) { const float* p = PRW + (size_t)(row0 + t0) * NRW + cb;
#pragma unroll
              for (int e = 0; e < 16; e += 4) { const f32x4 pv = *(const f32x4*)(p + e); const f32x4 qv = pp ? *(const f32x4*)(pp + cb + e) : (f32x4){0.f, 0.f, 0.f, 0.f}; const f32x4 m4 = *(const f32x4*)(mu + cb + e);
                  const f32x4 xm = pv + (qv - pv) * m4;
#pragma unroll
                  for (int z = 0; z < 4; ++z) x[e + z] = part < 2 ? tanh_fast(xm[z]) : (part < 4 ? xm[z] : fast_sigmoid(xm[z])); } }
            else {
#pragma unroll
              for (int e = 0; e < 16; ++e) x[e] = 0.f; }
#pragma unroll
            for (int e = 0; e < 16; e += 8) *LP(v4u, dst + (16 * hf + e) * 2) = (v4u){cvtpk(x[e], x[e + 1]), cvtpk(x[e + 2], x[e + 3]), cvtpk(x[e + 4], x[e + 5]), cvtpk(x[e + 6], x[e + 7])};
          }
        }
        __syncthreads();
        f32x4 aw[2], aa[2], ag[2];
#pragma unroll
        for (int j = 0; j < 2; ++j) { aw[j] = (f32x4){0.f, 0.f, 0.f, 0.f}; aa[j] = aw[j]; ag[j] = aw[j]; }
#pragma unroll
        for (int s = 0; s < 2; ++s) {
            const bf16x8 fw = *LP(const bf16x8, lds + R1_LW + ((16 * tm + i) * 72 + 32 * s + 8 * q) * 2), fa = *LP(const bf16x8, lds + R1_LA + ((16 * tm + i) * 72 + 32 * s + 8 * q) * 2);
#pragma unroll
            for (int j = 0; j < 2; ++j) { const int n = h * 64 + 16 * (tnb + j) + i;
                aw[j] = mfma16(fw, *(const bf16x8*)(W2t + (size_t)n * 64 + 32 * s + 8 * q), aw[j]); aa[j] = mfma16(fa, *(const bf16x8*)(A2t + (size_t)n * 64 + 32 * s + 8 * q), aa[j]); }
        }
#pragma unroll
        for (int s = 0; s < 4; ++s) {
            const bf16x8 fg = *LP(const bf16x8, lds + R1_LG + ((16 * tm + i) * 136 + 32 * s + 8 * q) * 2);
#pragma unroll
            for (int j = 0; j < 2; ++j) { const int n = h * 64 + 16 * (tnb + j) + i; ag[j] = mfma16(fg, *(const bf16x8*)(G2t + (size_t)n * 128 + 32 * s + 8 * q), ag[j]); }
        }
        asm volatile("" ::: "memory");
        float xr[2][4], kp[2][4], xv[2][4], lw[2][4], av[2][4], kkr[2][4];
        float ssq[4] = {0.f, 0.f, 0.f, 0.f}, bsum[4] = {0.f, 0.f, 0.f, 0.f};
#pragma unroll
        for (int j = 0; j < 2; ++j) { const int n = 16 * (tnb + j) + i, col = h * 64 + n;
            const float mur = mu[col], muk = mu[512 + col], muv = mu[1024 + col], w0c = w0[l * 0 + col], a0c = a0[col], kkc = k_k[col], kac = k_a[col], rkc = r_k[col];
#pragma unroll
            for (int r = 0; r < 4; ++r) { const int t = 16 * tm + 4 * q + r; const bool valid = t < tval;
                const unsigned po = (unsigned)(row0 + (valid ? t : 0)) * NRW + col;
                const float pr = PRW[po], pk = PRW[po + 512], pv = PRW[po + 1024];
                float qr, qk, qv;
                if (valid && t > 0) { const unsigned qo = po - NRW; qr = PRW[qo]; qk = PRW[qo + 512]; qv = PRW[qo + 1024]; }
                else if (prev0) { qr = prev0[col]; qk = prev0[512 + col]; qv = prev0[1024 + col]; }
                else { qr = 0.f; qk = 0.f; qv = 0.f; }
                const float r_ = pr + (qr - pr) * mur, k_ = pk + (qk - pk) * muk, v_ = pv + (qv - pv) * muv;
                const float wpre = w0c + aw[j][r];
                const float sp = fmaxf(-wpre, 0.f) + log1pf(__expf(-fabsf(wpre)));
                const float wlog = -sp - 0.5f;
                const float a_ = fast_sigmoid(a0c + aa[j][r]);
                const float kk_ = k_ * kkc, kp_ = k_ * (1.0f + (a_ - 1.0f) * kac);
                xr[j][r] = valid ? r_ : 0.f; kp[j][r] = valid ? kp_ : 0.f; xv[j][r] = valid ? v_ : 0.f; lw[j][r] = valid ? -__expf(wlog) : 0.f; av[j][r] = valid ? a_ : 0.f; kkr[j][r] = valid ? kk_ : 0.f;
                ssq[r] += kkr[j][r] * kkr[j][r]; bsum[r] += xr[j][r] * kp[j][r] * rkc;
                if (valid) GG[(size_t)(row0 + t) * 512 + col] = ag[j][r];
            }
            asm volatile("" ::: "memory"); }
#pragma unroll
        for (int r = 0; r < 4; ++r) {
#pragma unroll
            for (int o = 1; o < 16; o <<= 1) { ssq[r] += __shfl_xor(ssq[r], o); bsum[r] += __shfl_xor(bsum[r], o); }
            if (i == 0) { const int t = 16 * tm + 4 * q + r; RED[(t * 2 + (wave & 1)) * 2 + 0] = ssq[r]; RED[(t * 2 + (wave & 1)) * 2 + 1] = bsum[r]; } }
        float cin[2][4], exq[2];
#pragma unroll
        for (int j = 0; j < 2; ++j) { cin[j][0] = lw[j][0]; cin[j][1] = cin[j][0] + lw[j][1]; cin[j][2] = cin[j][1] + lw[j][2]; cin[j][3] = cin[j][2] + lw[j][3];
            const float tot = cin[j][3]; float ex = 0.f, wt = 0.f;
#pragma unroll
            for (int qq = 0; qq < 4; ++qq) { const float tq = __shfl(tot, i + 16 * qq); wt += tq; ex += qq < q ? tq : 0.f; }
            exq[j] = ex; if (q == 0) CS[tm * 64 + 16 * (tnb + j) + i] = wt; }
        for (int z = tid; z < 2304; z += NTHR) LP(unsigned, lds + R1_MB)[z] = 0u;
        __syncthreads();
#pragma unroll
        for (int j = 0; j < 2; ++j) { const int n = 16 * (tnb + j) + i, col = h * 64 + n; float tmex = 0.f, csT = 0.f;
#pragma unroll
            for (int z = 0; z < 4; ++z) { const float c_ = CS[z * 64 + n]; csT += c_; tmex += z < tm ? c_ : 0.f; }
            if (tm == 0 && q == 0) GTV[n] = __expf(csT);
            f32x4 vKapT, vVT, vBbT, vKbT;
#pragma unroll
            for (int r = 0; r < 4; ++r) { const int t = 16 * tm + 4 * q + r;
                const float cst = tmex + exq[j] + cin[j][r], csp = cst - lw[j][r];
                const float sq = RED[(t * 2 + 0) * 2 + 0] + RED[(t * 2 + 1) * 2 + 0], bt = RED[(t * 2 + 0) * 2 + 1] + RED[(t * 2 + 1) * 2 + 1];
                const float kk_ = kkr[j][r] * (1.0f / sqrtf(fmaxf(sq, 1e-24f))), b_ = kk_ * av[j][r];
                const float gt = __expf(cst), gi = __expf(-cst), gp = __expf(csp), ge = __expf(csT - cst);
                LP(u16, lds + R1_RT)[t * 72 + n] = (u16)f2bf(xr[j][r] * gt);
                LP(u16, lds + R1_KH)[t * 72 + n] = (u16)f2bf(kp[j][r] * gi);
                LP(u16, lds + R1_BH)[t * 72 + n] = (u16)f2bf(b_ * gi);
                LP(u16, lds + R1_KAP)[t * 72 + n] = (u16)f2bf(kk_ * gp);
                vKapT[r] = kk_ * gp; vVT[r] = xv[j][r]; vBbT[r] = b_ * ge; vKbT[r] = kp[j][r] * ge;
                if (t < tval) BON[(size_t)(row0 + t) * 512 + col] = bt * xv[j][r];
                asm volatile("" ::: "memory");
            }
            const int t0 = 16 * tm + 4 * q;
            st_tr(lds + R1_KAPT, vKapT, n, t0); st_tr(lds + R1_VT, vVT, n, t0); st_tr(lds + R1_BBT, vBbT, n, t0); st_tr(lds + R1_KBT, vKbT, n, t0);
            asm volatile("" ::: "memory");
        }
        __syncthreads();
        { f32x4 c1[2], c2[2];
#pragma unroll
          for (int j = 0; j < 2; ++j) { c1[j] = (f32x4){0.f, 0.f, 0.f, 0.f}; c2[j] = c1[j]; }
          mm64(c1, lds + R1_KAP, lds + R1_BH, tm, tnb, lane); mm64(c2, lds + R1_KAP, lds + R1_KH, tm, tnb, lane);
#pragma unroll
          for (int j = 0; j < 2; ++j) { const int ic = 16 * (tnb + j) + i;
#pragma unroll
              for (int r = 0; r < 4; ++r) { const int t = 16 * tm + 4 * q + r;
                  ABKF[t * 65 + ic] = ic < t ? c1[j][r] : 0.f;
                  LP(u16, lds + R1_AKK)[t * 72 + ic] = (u16)f2bf(ic < t ? c2[j][r] : 0.f); } }
        }
        asm volatile("" ::: "memory");
        { f32x4 c3[2], c4[2];
#pragma unroll
          for (int j = 0; j < 2; ++j) { c3[j] = (f32x4){0.f, 0.f, 0.f, 0.f}; c4[j] = c3[j]; }
          mm64(c3, lds + R1_RT, lds + R1_BH, tm, tnb, lane);  mm64(c4, lds + R1_RT, lds + R1_KH, tm, tnb, lane);
#pragma unroll
          for (int j = 0; j < 2; ++j) { const int ic = 16 * (tnb + j) + i;
#pragma unroll
              for (int r = 0; r < 4; ++r) { const int t = 16 * tm + 4 * q + r;
                  LP(u16, lds + R1_ABR)[t * 72 + ic] = (u16)f2bf(ic <= t ? c3[j][r] : 0.f);
                  LP(u16, lds + R1_AKR)[t * 72 + ic] = (u16)f2bf(ic <= t ? c4[j][r] : 0.f); } }
        }
        __syncthreads();
        if (wave == 0) { const int g = q, c = i; float m[16];
#pragma unroll
            for (int ii = 0; ii < 16; ++ii) { float acc = ii == c ? 1.f : 0.f;
#pragma unroll
                for (int jj = 0; jj < ii; ++jj) acc -= ABKF[(16 * g + ii) * 65 + 16 * g + jj] * m[jj];
                m[ii] = acc; MF[(16 * g + ii) * 65 + 16 * g + c] = acc; LP(u16, lds + R1_MB)[(16 * g + ii) * 72 + 16 * g + c] = (u16)f2bf(acc); } }
        __syncthreads();
#define BLK(P, bi, bj) ((P) + (16 * (bi)) * 65 + 16 * (bj))
#define PUTM(bi, bj, acc) do { _Pragma("unroll") for (int r = 0; r < 4; ++r) { MF[(16 * (bi) + 4 * q + r) * 65 + 16 * (bj) + i] = -(acc)[r]; LP(u16, lds + R1_MB)[(16 * (bi) + 4 * q + r) * 72 + 16 * (bj) + i] = (u16)f2bf(-(acc)[r]); } } while (0)
        { LAS float* T = LP(float, lds + R1_T16) + wave * 272; const f32x4 z4 = {0.f, 0.f, 0.f, 0.f};
          if (wave < 3) { const int bi = wave + 1, bj = wave; f32x4 t = prod16(z4, BLK(ABKF, bi, bj), 65, BLK(MF, bj, bj), 65, lane);
#pragma unroll
              for (int r = 0; r < 4; ++r) T[(4 * q + r) * 17 + i] = t[r];
              f32x4 mres = prod16(z4, BLK(MF, bi, bi), 65, T, 17, lane); PUTM(bi, bj, mres); }
          __syncthreads();
          if (wave < 2) { const int bi = wave + 2, bj = wave; f32x4 t = prod16(z4, BLK(ABKF, bi, bj), 65, BLK(MF, bj, bj), 65, lane); t = prod16(t, BLK(ABKF, bi, bj + 1), 65, BLK(MF, bj + 1, bj), 65, lane);
#pragma unroll
              for (int r = 0; r < 4; ++r) T[(4 * q + r) * 17 + i] = t[r];
              f32x4 mres = prod16(z4, BLK(MF, bi, bi), 65, T, 17, lane); PUTM(bi, bj, mres); }
          __syncthreads();
          if (wave == 0) { f32x4 t = prod16(z4, BLK(ABKF, 3, 0), 65, BLK(MF, 0, 0), 65, lane); t = prod16(t, BLK(ABKF, 3, 1), 65, BLK(MF, 1, 0), 65, lane); t = prod16(t, BLK(ABKF, 3, 2), 65, BLK(MF, 2, 0), 65, lane);
#pragma unroll
              for (int r = 0; r < 4; ++r) T[(4 * q + r) * 17 + i] = t[r];
              f32x4 mres = prod16(z4, BLK(MF, 3, 3), 65, T, 17, lane); PUTM(3, 0, mres); }
          __syncthreads();
        }
#undef BLK
#undef PUTM
        const int t0 = 16 * tm + 4 * q;
        { f32x4 cg[2], cw[2];
#pragma unroll
          for (int j = 0; j < 2; ++j) { cg[j] = (f32x4){0.f, 0.f, 0.f, 0.f}; cw[j] = cg[j]; }
          mm64(cg, lds + R1_AKK, lds + R1_VT, tm, tnb, lane); mm64(cw, lds + R1_MB, lds + R1_KAPT, tm, tnb, lane);
#pragma unroll
          for (int j = 0; j < 2; ++j) { const int n = 16 * (tnb + j) + i; st_tr(lds + R1_GT, cg[j], n, t0); st_tr(lds + R1_WT, cw[j], n, t0); } }
        __syncthreads();
        { f32x4 cu[2];
#pragma unroll
          for (int j = 0; j < 2; ++j) cu[j] = (f32x4){0.f, 0.f, 0.f, 0.f};
          mm64(cu, lds + R1_MB, lds + R1_GT, tm, tnb, lane);
#pragma unroll
          for (int j = 0; j < 2; ++j) st_tr(lds + R1_UT, cu[j], 16 * (tnb + j) + i, t0); }
        asm volatile("" ::: "memory");
        { f32x4 cq[2], cp[2];
#pragma unroll
          for (int j = 0; j < 2; ++j) { cq[j] = (f32x4){0.f, 0.f, 0.f, 0.f}; cp[j] = cq[j]; }
          mm64(cq, lds + R1_ABR, lds + R1_WT, tm, tnb, lane); mm64(cp, lds + R1_BBT, lds + R1_WT, tm, tnb, lane);
          bf16* QT = (bf16*)(ws + WS_QT) + (size_t)it * 4096; bf16* PT = (bf16*)(ws + WS_PT) + (size_t)it * 4096;
#pragma unroll
          for (int j = 0; j < 2; ++j) { const int n = 16 * (tnb + j) + i;
#pragma unroll
              for (int r = 0; r < 4; ++r) { const int t = t0 + r;
                  QT[t * 64 + n] = (bf16)f2bf(bf2f(LP(u16, lds + R1_RT)[t * 72 + n]) - cq[j][r]);
                  PT[t * 64 + n] = (bf16)f2bf((t == n ? GTV[n] : 0.f) - cp[j][r]); } } }
        __syncthreads();
        { f32x4 c1[2], c2[2];
#pragma unroll
          for (int j = 0; j < 2; ++j) { c1[j] = (f32x4){0.f, 0.f, 0.f, 0.f}; c2[j] = c1[j]; }
          mm64(c1, lds + R1_AKR, lds + R1_VT, tm, tnb, lane); mm64(c2, lds + R1_ABR, lds + R1_UT, tm, tnb, lane);
#pragma unroll
          for (int j = 0; j < 2; ++j) { const int n = 16 * (tnb + j) + i;
#pragma unroll
              for (int r = 0; r < 4; ++r) { const int t = t0 + r; if (t < tval) OB[(size_t)(row0 + t) * 512 + h * 64 + n] = c1[j][r] - c2[j][r]; } } }
        asm volatile("" ::: "memory");
        { f32x4 c3[2], c4[2];
#pragma unroll
          for (int j = 0; j < 2; ++j) { c3[j] = (f32x4){0.f, 0.f, 0.f, 0.f}; c4[j] = c3[j]; }
          mm64(c3, lds + R1_KBT, lds + R1_VT, tm, tnb, lane); mm64(c4, lds + R1_BBT, lds + R1_UT, tm, tnb, lane);
          float* HT = (float*)(ws + WS_HT) + (size_t)it * 4096;
#pragma unroll
          for (int j = 0; j < 2; ++j) { const int n = 16 * (tnb + j) + i;
#pragma unroll
              for (int r = 0; r < 4; ++r) HT[(t0 + r) * 64 + n] = c3[j][r] - c4[j][r]; } }
        __syncthreads();
    }
}

struct R2St { u32x2 pa[4][2][2]; f32x4 hh[4]; };
__device__ __forceinline__ void r2_load(R2St& o, const unsigned char* ws, int it, int i, int q, int v) {
    const bf16* PT = (const bf16*)(ws + WS_PT) + (size_t)it * 4096; const float* HT = (const float*)(ws + WS_HT) + (size_t)it * 4096;
#pragma unroll
    for (int tt = 0; tt < 4; ++tt) {
#pragma unroll
        for (int s = 0; s < 2; ++s) { o.pa[tt][s][0] = *(const u32x2*)(PT + (16 * tt + i) * 64 + 32 * s + 4 * q); o.pa[tt][s][1] = *(const u32x2*)(PT + (16 * tt + i) * 64 + 32 * s + 16 + 4 * q); }
#pragma unroll
        for (int r = 0; r < 4; ++r) o.hh[tt][r] = HT[(16 * tt + 4 * q + r) * 64 + v];
    }
}
__device__ __forceinline__ void ph_rwkv2(const Frame& F0, const Args& a, int l) {
    const Frame F = relaunder(F0);
    const unsigned char* ws = a.ws; float* OB = (float*)(a.ws + WS_OB);
    const int lane = F.lane, i = lane & 15, q = lane >> 4;
    for (int slot = F.vcu * NWAVES + F.wave; slot < 2048; slot += F.G * NWAVES) {
        int nchunk, item0, row0, h, vs, tval; float* sout; f32x4 S[4];
        if ((slot & 15) == 0) { const int pu = slot >> 4; const int s = pu >> 5; h = (pu >> 2) & 7; vs = pu & 3; nchunk = SEQ / 64; item0 = s * 1024 + h; row0 = s * SEQ; tval = 64;
            sout = a.out + OFF_WKVP + ((size_t)(l * NB + s) * HB + h) * 4096;
#pragma unroll
            for (int kt = 0; kt < 4; ++kt) S[kt] = (f32x4){0.f, 0.f, 0.f, 0.f}; }
        else { const int d = slot - (slot >> 4) - 1; if (d >= DECB * HB * 4) continue; const int b = d >> 5; h = (d >> 2) & 7; vs = d & 3; nchunk = 1; item0 = NITEM_P + b * 8 + h; row0 = MP + DECS * b; tval = DECS;
            sout = a.out + OFF_WKVS + ((size_t)(l * DECB + b) * HB + h) * 4096;
            const float* sin = a.in[I_SWKV] + ((size_t)(l * DECB + b) * HB + h) * 4096 + (16 * vs + i) * 64 + 4 * q;
#pragma unroll
            for (int kt = 0; kt < 4; ++kt) S[kt] = *(const f32x4*)(sin + 16 * kt); }
        const int v = 16 * vs + i;
        R2St cur, nxt;
        r2_load(cur, ws, item0, i, q, v);
#pragma unroll 1
        for (int c = 0; c < nchunk; ++c) {
            const int it = item0 + 8 * c;
            if (c + 1 < nchunk) r2_load(nxt, ws, it + 8, i, q, v);
            const bf16* QT = (const bf16*)(ws + WS_QT) + (size_t)it * 4096;
            float* ob = OB + (size_t)(row0 + 64 * c) * 512 + h * 64 + v;
            u32x2 qa[4][2][2]; f32x4 oacc[4];
#pragma unroll
            for (int tt = 0; tt < 4; ++tt) if (16 * tt < tval) {
#pragma unroll
                for (int s = 0; s < 2; ++s) { qa[tt][s][0] = *(const u32x2*)(QT + (16 * tt + i) * 64 + 32 * s + 4 * q); qa[tt][s][1] = *(const u32x2*)(QT + (16 * tt + i) * 64 + 32 * s + 16 + 4 * q); }
#pragma unroll
                for (int r = 0; r < 4; ++r) oacc[tt][r] = ob[(size_t)(16 * tt + 4 * q + r) * 512]; }
            bf16x8 bs[2];
#pragma unroll
            for (int s = 0; s < 2; ++s) { v4u w; w.x = cvtpk(S[2 * s][0], S[2 * s][1]); w.y = cvtpk(S[2 * s][2], S[2 * s][3]); w.z = cvtpk(S[2 * s + 1][0], S[2 * s + 1][1]); w.w = cvtpk(S[2 * s + 1][2], S[2 * s + 1][3]); bs[s] = __builtin_bit_cast(bf16x8, w); }
#pragma unroll
            for (int kt = 0; kt < 4; ++kt) { f32x4 acc = cur.hh[kt];
#pragma unroll
                for (int s = 0; s < 2; ++s) { const v4u aw = (v4u){cur.pa[kt][s][0].x, cur.pa[kt][s][0].y, cur.pa[kt][s][1].x, cur.pa[kt][s][1].y}; acc = mfma16(__builtin_bit_cast(bf16x8, aw), bs[s], acc); }
                S[kt] = acc; }
#pragma unroll
            for (int tt = 0; tt < 4; ++tt) if (16 * tt < tval) {
                f32x4 acc = oacc[tt];
#pragma unroll
                for (int s = 0; s < 2; ++s) { const v4u aw = (v4u){qa[tt][s][0].x, qa[tt][s][0].y, qa[tt][s][1].x, qa[tt][s][1].y}; acc = mfma16(__builtin_bit_cast(bf16x8, aw), bs[s], acc); }
#pragma unroll
                for (int r = 0; r < 4; ++r) ob[(size_t)(16 * tt + 4 * q + r) * 512] = acc[r]; }
            cur = nxt;
        }
#pragma unroll
        for (int kt = 0; kt < 4; ++kt) *(f32x4*)(sout + (size_t)v * 64 + 16 * kt + 4 * q) = S[kt];
    }
}
__device__ __forceinline__ void ph_rwkv3(const Frame& F0, const Args& a, int l) {
    const Frame F = relaunder(F0);
    const float* OB = (const float*)(a.ws + WS_OB); const float* GG = (const float*)(a.ws + WS_GG); const float* BON = (const float*)(a.ws + WS_BON);
    bf16* YB = (bf16*)(a.ws + WS_YAB) + (size_t)M * 512; const float* lg = a.in[I_LNXG] + l * 512; const float* lb = a.in[I_LNXB] + l * 512;
    const int lane = F.lane;
    for (int m = F.vcu * NWAVES + F.wave; m < M; m += F.G * NWAVES) {
        const size_t off = (size_t)m * 512 + 8 * lane;
        const f32x4 o0 = *(const f32x4*)(OB + off), o1 = *(const f32x4*)(OB + off + 4);
        float s = (o0[0] + o0[1]) + (o0[2] + o0[3]) + (o1[0] + o1[1]) + (o1[2] + o1[3]);
        s += __shfl_xor(s, 1); s += __shfl_xor(s, 2); s += __shfl_xor(s, 4);
        const float mean = s * (1.f / 64.f);
        const f32x4 d0 = o0 - mean, d1 = o1 - mean;
        float s2 = (d0[0] * d0[0] + d0[1] * d0[1]) + (d0[2] * d0[2] + d0[3] * d0[3]) + (d1[0] * d1[0] + d1[1] * d1[1]) + (d1[2] * d1[2] + d1[3] * d1[3]);
        s2 += __shfl_xor(s2, 1); s2 += __shfl_xor(s2, 2); s2 += __shfl_xor(s2, 4);
        const float rstd = 1.0f / sqrtf(s2 * (1.f / 64.f) + GN_EPS);
        const f32x4 g0 = *(const f32x4*)(lg + 8 * lane), g1 = *(const f32x4*)(lg + 8 * lane + 4), b0 = *(const f32x4*)(lb + 8 * lane), b1 = *(const f32x4*)(lb + 8 * lane + 4);
        const f32x4 bn0 = *(const f32x4*)(BON + off), bn1 = *(const f32x4*)(BON + off + 4), gg0 = *(const f32x4*)(GG + off), gg1 = *(const f32x4*)(GG + off + 4);
        const f32x4 y0 = (d0 * rstd * g0 + b0 + bn0) * gg0, y1 = (d1 * rstd * g1 + b1 + bn1) * gg1;
        *(v4u*)(YB + off) = (v4u){cvtpk(y0[0], y0[1]), cvtpk(y0[2], y0[3]), cvtpk(y1[0], y1[1]), cvtpk(y1[2], y1[3])};
    }
}
constexpr int NPH_LAYER = 14, NPH = 2 + DEPTH * NPH_LAYER;
#ifndef MK_LAUNCH_PER_PHASE
#define MK_LAUNCH_PER_PHASE 0
#endif
typedef const __attribute__((address_space(4))) Args* KArgsPtr;
__device__ __forceinline__ const Args& kargs() { KArgsPtr p = (KArgsPtr)__builtin_amdgcn_kernarg_segment_ptr(); asm volatile("" : "+s"(p)); return *(const Args*)p; }
template <unsigned PHMASK> __global__ void __launch_bounds__(NTHR, 2) fwd(Args args_unused) {
    extern __shared__ __attribute__((aligned(16))) unsigned char lds_raw[];
    Frame F;
    F.lds = (LAS unsigned char*)lds_raw;
    F.tid = threadIdx.x; F.lane = F.tid & 63; F.wave = __builtin_amdgcn_readfirstlane(F.tid >> 6);
    F.G = gridDim.x; { const int bx = blockIdx.x; F.vcu = (F.G % 8 == 0) ? (bx % 8) * (F.G / 8) + bx / 8 : bx; }
    volatile LAS unsigned* MISC = (volatile LAS unsigned*)(F.lds + LDSCTL_OFF);
    for (int u = F.tid; u < (LDS_BYTES - LDSCTL_OFF) / 4; u += NTHR) ((LAS unsigned*)(F.lds + LDSCTL_OFF))[u] = 0u;
    __syncthreads();
    int lo, hi; { const Args& a = kargs(); lo = a.ph_lo; hi = a.ph_hi; }
    XcdBarrier bar; { const Args& a = kargs(); bar.bar = (unsigned*)(a.ws + WS_CTL) + CW_BAR; } bar.x = 0; bar.st = nullptr;
    if (hi - lo > 1) bar = xcd_barrier_post(bar.bar, MISC + 8);
#define IN(k) (lo <= (k) && (k) < hi)
#define ON(n, k) (((PHMASK >> (n)) & 1u) && IN(k))
#define SEAM(k) do { if (IN(k) && IN((k) + 1)) xcd_barrier(bar); } while (0)
#define WSP(T, off) ((T*)(a.ws + (off)))
    if (ON(14, 0)) { const Args& a = kargs(); ph_prologue(F, a); } SEAM(0);
    if (ON(15, 1)) { const Args& a = kargs(); ph_ln(F, a.in[I_XP], a.in[I_XS], nullptr, 0.f, nullptr, nullptr, nullptr, WSP(float, WS_MOD), nullptr, WSP(bf16, WS_U)); } SEAM(1);
#pragma unroll 1
    for (int l = 0; l < DEPTH; ++l) {
        const int pb = 2 + l * NPH_LAYER;
        const size_t wlo = WS_W + (size_t)l * WL_SIZE, modo = WS_MOD + (size_t)l * NSEQ * 9216 * 4;
        if (ON(0, pb + 0)) { const Args& a = kargs(); pg8::Gemm g{WSP(bf16, WS_U), WSP(const bf16, wlo + WL_GU0), M, NGU, D}; pg8::StaticOrder S; S.init(M, NGU, opq(F.G), opq((int)blockIdx.x)); pg8::EpiSwiglu E{WSP(bf16, WS_ACT), DFF};
            pg8::gemm_phase<pg8::EpiSwiglu, pg8::StaticOrder, true, true>(F.lds, g, S, E); } SEAM(pb + 0);
        if (ON(1, pb + 1)) { const Args& a = kargs(); pg8::Gemm g{WSP(bf16, WS_ACT), WSP(const bf16, wlo + WL_DN0), M, D, DFF}; pg8::StaticOrder S; S.init(M, D, opq(F.G), opq((int)blockIdx.x)); pg8::EpiF32 E{WSP(float, WS_F), D};
            pg8::gemm_phase<pg8::EpiF32, pg8::StaticOrder, true, true>(F.lds, g, S, E); } SEAM(pb + 1);
        if (ON(2, pb + 2)) { const Args& a = kargs(); const float* modl = WSP(float, modo);
            ph_ln(F, l == 0 ? a.in[I_XP] : a.out, l == 0 ? a.in[I_XS] : nullptr, WSP(float, WS_F), 0.5f, modl + 2 * D, a.in[I_LNG] + (l * 3 + 0) * D, a.in[I_LNB] + (l * 3 + 0) * D, modl + 3 * D, a.out, WSP(bf16, WS_U)); } SEAM(pb + 2);
        if (ON(3, pb + 3)) { const Args& a = kargs(); pg8::Gemm g{WSP(bf16, WS_U), WSP(const bf16, wlo + WL_IG), M, NIG, D}; pg8::StaticOrder S; S.init(M, NIG, opq(F.G), opq((int)blockIdx.x));
            pg8::EpiProj E{WSP(bf16, WS_Q), WSP(bf16, WS_KB), WSP(bf16, WS_VB), WSP(float, WS_PRW), WSP(bf16, WS_GATES), a.in[I_BGATE] + l * 2048,
                a.out + OFF_KP + (size_t)l * MP * 512, a.out + OFF_VP + (size_t)l * MP * 512, a.out + OFF_KS + (size_t)l * MD * 512, a.out + OFF_VS + (size_t)l * MD * 512,
                a.out + OFF_SHP + (size_t)l * NB * NRW, a.out + OFF_SHS + (size_t)l * DECB * NRW, QSCALE};
            pg8::gemm_phase<pg8::EpiProj, pg8::StaticOrder, true, true>(F.lds, g, S, E); } SEAM(pb + 3);
        if (ON(4, pb + 4)) { const Args& a = kargs(); ph_rwkv1(F, a, l); } SEAM(pb + 4);
        if (ON(5, pb + 5)) { const Args& a = kargs(); ph_rwkv2(F, a, l); } SEAM(pb + 5);
        if (ON(6, pb + 6)) { const Args& a = kargs();
            AttnP P{WSP(bf16, WS_Q), WSP(bf16, WS_KB), WSP(bf16, WS_VB), a.in[I_CK] + (size_t)l * DECB * PAST * 512, a.in[I_CV] + (size_t)l * DECB * PAST * 512, WSP(bf16, WS_YAB), a.in[I_RELB], a.in[I_SUBG] + l * 128,
                    WSP(float, WS_LAM)[l], 1.0f - (0.8f - 0.6f * expf(-0.3f * (float)l))};
            ph_attn(F, P); } SEAM(pb + 6);
        if (ON(7, pb + 7)) { const Args& a = kargs(); ph_rwkv3(F, a, l); } SEAM(pb + 7);
        if (ON(8, pb + 8)) { const Args& a = kargs(); pg8::Gemm g{WSP(bf16, WS_YAB), WSP(const bf16, wlo + WL_BR), 2 * M, 2048, 512}; pg8::PairOrder S{NPAN * 4, opq(F.G), opq((int)blockIdx.x), NPAN}; pg8::EpiMerge E{WSP(float, WS_F), WSP(bf16, WS_MERGED), WSP(bf16, WS_GATES), NPAN};
            pg8::gemm_phase<pg8::EpiMerge, pg8::PairOrder, true, true>(F.lds, g, S, E); } SEAM(pb + 8);
        if (ON(9, pb + 9)) { const Args& a = kargs(); pg8::Gemm g{WSP(bf16, WS_MERGED), WSP(const bf16, wlo + WL_O), M, D, D}; pg8::StaticOrder S; S.init(M, D, opq(F.G), opq((int)blockIdx.x)); pg8::EpiF32 E{WSP(float, WS_F), D};
            pg8::gemm_phase<pg8::EpiF32, pg8::StaticOrder, true, true>(F.lds, g, S, E); } SEAM(pb + 9);
        if (ON(10, pb + 10)) { const Args& a = kargs(); const float* modl = WSP(float, modo);
            ph_ln(F, a.out, nullptr, WSP(float, WS_F), 1.0f, modl + 5 * D, a.in[I_LNG] + (l * 3 + 1) * D, a.in[I_LNB] + (l * 3 + 1) * D, modl + 6 * D, a.out, WSP(bf16, WS_U)); } SEAM(pb + 10);
        if (ON(11, pb + 11)) { const Args& a = kargs(); pg8::Gemm g{WSP(bf16, WS_U), WSP(const bf16, wlo + WL_GU1), M, NGU, D}; pg8::StaticOrder S; S.init(M, NGU, opq(F.G), opq((int)blockIdx.x)); pg8::EpiSwiglu E{WSP(bf16, WS_ACT), DFF};
            pg8::gemm_phase<pg8::EpiSwiglu, pg8::StaticOrder, true, true>(F.lds, g, S, E); } SEAM(pb + 11);
        if (ON(12, pb + 12)) { const Args& a = kargs(); pg8::Gemm g{WSP(bf16, WS_ACT), WSP(const bf16, wlo + WL_DN1), M, D, DFF}; pg8::StaticOrder S; S.init(M, D, opq(F.G), opq((int)blockIdx.x)); pg8::EpiF32 E{WSP(float, WS_F), D};
            pg8::gemm_phase<pg8::EpiF32, pg8::StaticOrder, true, true>(F.lds, g, S, E); } SEAM(pb + 12);
        if (ON(13, pb + 13)) { const Args& a = kargs(); const float* modl = WSP(float, modo);
            ph_ln(F, a.out, nullptr, WSP(float, WS_F), 0.5f, modl + 8 * D, a.in[I_LNG] + (l * 3 + 2) * D, a.in[I_LNB] + (l * 3 + 2) * D, l + 1 < DEPTH ? modl + (size_t)NSEQ * 9216 : nullptr, a.out, WSP(bf16, WS_U)); } SEAM(pb + 13);
    }
#undef IN
#undef ON
#undef SEAM
#undef WSP
}

#if MK_LAUNCH_PER_PHASE
static const void* phase_fn(int k) {
    switch (k) { case 0: return (const void*)fwd<1u << 0>; case 1: return (const void*)fwd<1u << 1>; case 2: return (const void*)fwd<1u << 2>; case 3: return (const void*)fwd<1u << 3>;
        case 4: return (const void*)fwd<1u << 4>; case 5: return (const void*)fwd<1u << 5>; case 6: return (const void*)fwd<1u << 6>; case 7: return (const void*)fwd<1u << 7>;
        case 8: return (const void*)fwd<1u << 8>; case 9: return (const void*)fwd<1u << 9>; case 10: return (const void*)fwd<1u << 10>; case 11: return (const void*)fwd<1u << 11>;
        case 12: return (const void*)fwd<1u << 12>; case 13: return (const void*)fwd<1u << 13>; case 14: return (const void*)fwd<1u << 14>; default: return (const void*)fwd<1u << 15>; }
}
#else
#ifndef FULL_MASK
#define FULL_MASK 0xFFFFu
#endif
static const void* phase_fn(int) { return (const void*)fwd<FULL_MASK>; }
#endif

extern "C" void kernel_launch(void* const* d_in, const int* in_sizes, int n_in, void* d_out, int out_size, void* d_ws, size_t ws_size, hipStream_t stream) {
    static int grid = 0;
    if (grid == 0) {
        if (n_in != 34 || (size_t)out_size != OUT_TOTAL || ws_size < WS_END) { fprintf(stderr, "kernel_launch: unexpected shapes: n_in %d out %d ws %zu (need %zu)\n", n_in, out_size, ws_size, (size_t)WS_END); grid = -1; return; }
        int dev = 0, cus = 0, per_cu = 0;
        if (hipGetDevice(&dev) != hipSuccess || hipDeviceGetAttribute(&cus, hipDeviceAttributeMultiprocessorCount, dev) != hipSuccess) { grid = -1; return; }
        for (int k = 0; k < 16; ++k) if (hipFuncSetAttribute(phase_fn(k), hipFuncAttributeMaxDynamicSharedMemorySize, LDS_BYTES) != hipSuccess) { fprintf(stderr, "kernel_launch: hipFuncSetAttribute failed\n"); grid = -1; return; }
        if (hipOccupancyMaxActiveBlocksPerMultiprocessor(&per_cu, phase_fn(15), NTHR, LDS_BYTES) != hipSuccess || per_cu < 1) fprintf(stderr, "kernel_launch: occupancy query reports %d\n", per_cu);
        (void)hipGetLastError();
        grid = cus;
    }
    if (grid < 0) return;
    (void)hipMemsetAsync((char*)d_ws + WS_CTL, 0, CTL_ZERO_BYTES, stream);
    Args a{};
    for (int i = 0; i < 34; ++i) a.in[i] = (const float*)d_in[i];
    a.out = (float*)d_out; a.ws = (unsigned char*)d_ws;
#if MK_LAUNCH_PER_PHASE
#ifndef MAXPH
#define MAXPH NPH
#endif
    for (int p = 0; p < MAXPH; ++p) { a.ph_lo = p; a.ph_hi = p + 1; const int kind = p < 2 ? 14 + p : (p - 2) % NPH_LAYER; void* kargs[] = {&a}; (void)hipLaunchKernel(phase_fn(kind), dim3(grid), dim3(NTHR), kargs, LDS_BYTES, stream); }
#else
    a.ph_lo = 0; a.ph_hi = NPH; { void* kargs[] = {&a}; (void)hipLaunchKernel(phase_fn(15), dim3(grid), dim3(NTHR), kargs, LDS_BYTES, stream); }
#endif
}
```

```cpp
#include <hip/hip_runtime.h>
#include <hip/hip_bf16.h>
#include <cstdio>
#include <cstdint>
#include <cmath>
namespace pg8 {
#define PG8_LAS __attribute__((address_space(3)))
typedef unsigned short bf16_t;
typedef short bf16x8 __attribute__((ext_vector_type(8)));
typedef float f32x4 __attribute__((ext_vector_type(4)));
typedef unsigned u32x4 __attribute__((ext_vector_type(4)));
constexpr int BM = 256, BK = 64, HALF = 128, HTB = HALF * BK * 2  , STAGE_BYTES = 8 * HTB, NXCD = 8, WGM = 8;

__host__ __device__ __forceinline__ int lds_byte(int r, int c) { const int st = (r >> 4) * 2 + (c >> 5), rr = r & 15, cc = c & 31, ob = rr * 64 + cc * 2; return st * 1024 + (ob ^ (((ob >> 9) & 1) << 5)); }
__host__ __device__ __forceinline__ void stage_rc(int b, int& R, int& C) { const int st = b / 1024, sb = b % 1024, swz = sb ^ (((sb >> 9) & 1) << 5); R = (st >> 1) * 16 + swz / 64; C = (st & 1) * 32 + (swz % 64) / 2; }
__host__ __device__ __forceinline__ int perm32(int rho) { const int n = rho >> 4, i = rho & 15; return 8 * (i >> 2) + 4 * n + (i & 3); }

struct Unit { int pm, pn; };
struct Gemm { const bf16_t* A; const bf16_t* Bt; int M, N, K; };

struct StaticOrder {
    int nM, nN, nwg, G, c;
    __host__ __device__ void init(int M, int N, int G_, int c_) { nM = M / BM; nN = N / BM; nwg = nM * nN; G = G_; c = c_; }
    __host__ __device__ bool next(int i, Unit& u) const {
        const long L = (long)i * G + c; if (L >= nwg) return false;
        int wgid = (int)L; { const int q = nwg / NXCD, r = nwg % NXCD, xcd = wgid % NXCD, off = wgid / NXCD; wgid = (xcd < r ? xcd * (q + 1) : r * (q + 1) + (xcd - r) * q) + off; }
        const int nig = WGM * nN, gid = wgid / nig, fm = gid * WGM, gsz = (nM - fm) < WGM ? (nM - fm) : WGM;
        u.pm = fm + ((wgid % nig) % gsz); u.pn = (wgid % nig) / gsz; return true;
    }
    __device__ __forceinline__ void a_ready(const Unit&) const {}
    __device__ __forceinline__ void done(const Unit&) const {}
};

typedef float f32x2c_t __attribute__((ext_vector_type(2))); typedef __bf16 bf16x2c_t __attribute__((ext_vector_type(2)));
__device__ __forceinline__ unsigned cvt_pk_bf16(float lo, float hi) { f32x2c_t v = {lo, hi}; bf16x2c_t b = __builtin_convertvector(v, bf16x2c_t); return __builtin_bit_cast(unsigned, b); }
typedef float f32x2 __attribute__((ext_vector_type(2)));
__device__ __forceinline__ float fast_sigmoid(float x) { return __builtin_amdgcn_rcpf(1.0f + __expf(-x)); }
struct EpiSwiglu {
    static constexpr bool PERM = true, AFTER_DRAIN = false;
    bf16_t* O; int ldc;
    __device__ __forceinline__ void operator()(const f32x4 (&acc)[2][2][4][2], const Unit& u, int wr, int wc, int fr, int fq) const {
        const int row0 = u.pm * BM + wr * 64 + fr; const int col0 = u.pn * 128 + wc * 32 + 8 * fq;
#pragma unroll
        for (int ai = 0; ai < 2; ++ai)
#pragma unroll
            for (int m = 0; m < 4; ++m) { bf16_t* rowp = O + (size_t)(row0 + ai * HALF + m * 16) * ldc + col0;
                float v[8];
#pragma unroll
                for (int n = 0; n < 2; ++n)
#pragma unroll
                    for (int e = 0; e < 4; ++e) { const float g = acc[ai][0][m][n][e], up = acc[ai][1][m][n][e]; v[n * 4 + e] = g * fast_sigmoid(g) * up; }
                u32x4 w; w.x = cvt_pk_bf16(v[0], v[1]); w.y = cvt_pk_bf16(v[2], v[3]); w.z = cvt_pk_bf16(v[4], v[5]); w.w = cvt_pk_bf16(v[6], v[7]);
                *(u32x4*)rowp = w; }
    }
};
struct EpiF32 {
    static constexpr bool PERM = false, AFTER_DRAIN = false;
    float* O; int ldc;
    __device__ __forceinline__ void operator()(const f32x4 (&acc)[2][2][4][2], const Unit& u, int wr, int wc, int fr, int fq) const {
        const int row0 = u.pm * BM + wr * 64 + fr; const int col0 = u.pn * BM + wc * 32 + 4 * fq;
#pragma unroll
        for (int ai = 0; ai < 2; ++ai)
#pragma unroll
            for (int m = 0; m < 4; ++m) { float* rowp = O + (size_t)(row0 + ai * HALF + m * 16) * ldc + col0;
#pragma unroll
                for (int bj = 0; bj < 2; ++bj)
#pragma unroll
                    for (int n = 0; n < 2; ++n) *(f32x4*)(rowp + bj * HALF + n * 16) = acc[ai][bj][m][n]; }
    }
};
struct EpiProj {
    static constexpr bool PERM = false, AFTER_DRAIN = false;
    bf16_t* Q; bf16_t* Kb; bf16_t* Vb; float* PRW; bf16_t* PLB; bf16_t* GATES; const float* bgate;
    float* outKp; float* outVp; float* outKs; float* outVs; float* outShp; float* outShs;
    float qscale;
    __device__ __forceinline__ void operator()(const f32x4 (&acc)[2][2][4][2], const Unit& u, int wr, int wc, int fr, int fq) const {
        const int row0 = u.pm * BM + wr * 64 + fr; const int pn = u.pn; const int cw = wc * 32 + 4 * fq;
        const bool prompt = u.pm < 128;
#pragma unroll
        for (int ai = 0; ai < 2; ++ai)
#pragma unroll
            for (int m = 0; m < 4; ++m) { const int row = row0 + ai * HALF + m * 16;
#pragma unroll
                for (int bj = 0; bj < 2; ++bj)
#pragma unroll
                    for (int n = 0; n < 2; ++n) { const f32x4 v = acc[ai][bj][m][n]; const int ct = bj * HALF + n * 16 + cw;
                        if (pn < 2) { const int c = pn * 256 + ct; typedef unsigned u32x2v __attribute__((ext_vector_type(2))); u32x2v w; w.x = cvt_pk_bf16(v[0] * qscale, v[1] * qscale); w.y = cvt_pk_bf16(v[2] * qscale, v[3] * qscale);
                            *(u32x2v*)(Q + (size_t)row * 512 + c) = w; }
                        else if (pn < 6) { const bool isk = pn < 4; const int c = (pn - (isk ? 2 : 4)) * 256 + ct; typedef unsigned u32x2v __attribute__((ext_vector_type(2))); u32x2v w; w.x = cvt_pk_bf16(v[0], v[1]); w.y = cvt_pk_bf16(v[2], v[3]);
                            *(u32x2v*)((isk ? Kb : Vb) + (size_t)row * 512 + c) = w;
                            float* o = prompt ? (isk ? outKp : outVp) + (size_t)row * 512 + c : (isk ? outKs : outVs) + (size_t)(row - 32768) * 512 + c;
                            *(f32x4*)o = v; }
                        else if (pn < 13) { const int c = (pn - 6) * 256 + ct; *(f32x4*)(PRW + (size_t)row * 1792 + c) = v;
                            if (pn == 12) { typedef unsigned u32x2v __attribute__((ext_vector_type(2))); u32x2v w; w.x = cvt_pk_bf16(v[0], v[1]); w.y = cvt_pk_bf16(v[2], v[3]); *(u32x2v*)(PLB + (size_t)row * 256 + ct) = w; }
                            if (prompt) { if ((row & 8191) == 8191) *(f32x4*)(outShp + (size_t)(row >> 13) * 1792 + c) = v; }
                            else { const int rd = row - 32768; if ((rd & 31) == 31) *(f32x4*)(outShs + (size_t)(rd >> 5) * 1792 + c) = v; } }
                        else { const int c = (pn - 13) * 256 + ct; const f32x4 b = *(const f32x4*)(bgate + c); typedef unsigned u32x2v __attribute__((ext_vector_type(2))); u32x2v w;
                            w.x = cvt_pk_bf16(fast_sigmoid(v[0] + b[0]), fast_sigmoid(v[1] + b[1])); w.y = cvt_pk_bf16(fast_sigmoid(v[2] + b[2]), fast_sigmoid(v[3] + b[3]));
                            *(u32x2v*)(GATES + (size_t)row * 2048 + c) = w; }
                    } }
    }
};
struct EpiMerge {
    static constexpr bool PERM = false, AFTER_DRAIN = false;
    float* TMP; bf16_t* OUT; const bf16_t* GATES; int npan;
    __device__ __forceinline__ void operator()(const f32x4 (&acc)[2][2][4][2], const Unit& u, int wr, int wc, int fr, int fq) const {
        const int which = u.pm >= npan ? 1 : 0; const int pm = u.pm - which * npan, pn = u.pn - which * 4;
        const int row0 = pm * BM + wr * 64 + fr; const int col0 = pn * BM + wc * 32 + 4 * fq;
        typedef unsigned u32x2v __attribute__((ext_vector_type(2)));
#pragma unroll
        for (int ai = 0; ai < 2; ++ai)
#pragma unroll
            for (int m = 0; m < 4; ++m) { const int row = row0 + ai * HALF + m * 16;
#pragma unroll
                for (int bj = 0; bj < 2; ++bj)
#pragma unroll
                    for (int n = 0; n < 2; ++n) { const int c = col0 + bj * HALF + n * 16; const f32x4 v = acc[ai][bj][m][n];
                        const u32x2v gw = *(const u32x2v*)(GATES + (size_t)row * 2048 + which * 1024 + c);
                        f32x4 g; g[0] = __uint_as_float(gw.x << 16); g[1] = __uint_as_float(gw.x & 0xffff0000u); g[2] = __uint_as_float(gw.y << 16); g[3] = __uint_as_float(gw.y & 0xffff0000u);
                        float* tp = TMP + (size_t)row * 1024 + c;
                        if (which == 0) { *(f32x4*)tp = g * v; }
                        else { const f32x4 t = *(const f32x4*)tp + g * v; u32x2v w; w.x = cvt_pk_bf16(t[0], t[1]); w.y = cvt_pk_bf16(t[2], t[3]); *(u32x2v*)(OUT + (size_t)row * 1024 + c) = w; }
                    } }
    }
};
struct PairOrder {
    int ntile, G, c, npan;
    __device__ __forceinline__ bool next(int i, Unit& u) const { const int tile = (i >> 1) * G + c; if (tile >= ntile) return false; const int which = i & 1; u.pm = (tile >> 2) + which * npan; u.pn = (tile & 3) + which * 4; return true; }
    __device__ __forceinline__ void a_ready(const Unit&) const {}
    __device__ __forceinline__ void done(const Unit&) const {}
};
template <class Epi, class Sched, bool ALIGN_EPI = false, bool SP2 = false>
__device__ __forceinline__ void gemm_phase(PG8_LAS unsigned char* lds, const Gemm g, const Sched& S, const Epi& E, int wave_s) {
    int tid_ = wave_s * 64 + (int)__builtin_amdgcn_mbcnt_hi(~0u, __builtin_amdgcn_mbcnt_lo(~0u, 0u)); asm volatile("" : "+v"(tid_));
    const int tid = tid_, wid = __builtin_amdgcn_readfirstlane(tid >> 6), lane = tid & 63, wr = wid >> 2, wc = wid & 3, fr = lane & 15, fq = lane >> 4;
    const int K = g.K, nt = K / BK;
    unsigned voffA[2], voffB[2];
#pragma unroll
    for (int i = 0; i < 2; ++i) { int R, C; stage_rc(tid * 16 + i * 8192, R, C); const int Rb = Epi::PERM ? ((R & ~31) + perm32(R & 31)) : R;
        voffA[i] = (unsigned)(R * K + C) * 2u; voffB[i] = (unsigned)(Rb * K + C) * 2u; }
    const size_t kstep = (size_t)(BK * 2);
    const size_t hstep = (size_t)HALF * K * 2;
    const size_t tstep = 2 * hstep;
    const unsigned ldsw = (unsigned)wid * 1024u;
    const int aoff = lds_byte(wr * 64 + fr, fq * 8), boff = lds_byte(wc * 32 + fr, fq * 8);
#define PG8_SA(b, h) (((b) * 2 + (h)) * HTB)
#define PG8_SB(b, h) ((4 + (b) * 2 + (h)) * HTB)
#define PG8_STAGE(bufoff, gbase, voff) do { _Pragma("unroll") for (int _i = 0; _i < 2; ++_i) \
        __builtin_amdgcn_global_load_lds((const unsigned*)((const char*)(gbase) + (voff)[_i]), (PG8_LAS unsigned*)(lds + (bufoff) + ldsw + _i * 8192), 16, 0, 0); } while (0)
#define PG8_LDA(dst, b, h) do { _Pragma("unroll") for (int m = 0; m < 4; ++m) _Pragma("unroll") for (int k = 0; k < 2; ++k) dst[m][k] = *(const PG8_LAS bf16x8*)(lds + PG8_SA(b, h) + aoff + m * 2048 + k * 1024); } while (0)
#define PG8_LDB(dst, b, h) do { _Pragma("unroll") for (int n = 0; n < 2; ++n) _Pragma("unroll") for (int k = 0; k < 2; ++k) dst[n][k] = *(const PG8_LAS bf16x8*)(lds + PG8_SB(b, h) + boff + n * 2048 + k * 1024); } while (0)
#define PG8_MMA(ai, bj, At, Bt) do { __builtin_amdgcn_s_setprio(1); _Pragma("unroll") for (int m = 0; m < 4; ++m) _Pragma("unroll") for (int n = 0; n < 2; ++n) _Pragma("unroll") for (int k = 0; k < 2; ++k) \
        acc[ai][bj][m][n] = __builtin_amdgcn_mfma_f32_16x16x32_bf16(Bt[n][k], At[m][k], acc[ai][bj][m][n], 0, 0, 0); __builtin_amdgcn_s_setprio(0); } while (0)
#define PG8_WAIT_V(n) asm volatile("s_waitcnt vmcnt(" #n ")" ::: "memory")
#define PG8_WAIT_L(n) asm volatile("s_waitcnt lgkmcnt(" #n ")" ::: "memory")
#define PG8_BAR __builtin_amdgcn_s_barrier()
#define PG8_SCHED __builtin_amdgcn_sched_barrier(0)
    Unit cur, nxt; int ui = 0;
    if (!S.next(0, cur)) return;
    f32x4 acc[2][2][4][2];
#pragma unroll
    for (int a = 0; a < 2; ++a)
#pragma unroll
        for (int b = 0; b < 2; ++b)
#pragma unroll
            for (int m = 0; m < 4; ++m)
#pragma unroll
                for (int n = 0; n < 2; ++n) acc[a][b][m][n] = (f32x4){0.f, 0.f, 0.f, 0.f};
    bf16x8 At[4][2], B0[2][2], B1[2][2];
    const char* cA = (const char*)g.A + (size_t)cur.pm * tstep; const char* cB = (const char*)g.Bt + (size_t)cur.pn * tstep;
    S.a_ready(cur);
    if constexpr (SP2) {
        PG8_STAGE(PG8_SB(0, 0), cB, voffB); PG8_STAGE(PG8_SB(0, 1), cB + hstep, voffB); PG8_STAGE(PG8_SA(0, 0), cA, voffA); PG8_STAGE(PG8_SA(0, 1), cA + hstep, voffA);
        if (wr == 1) PG8_BAR;
        PG8_WAIT_V(2); PG8_BAR;
        PG8_STAGE(PG8_SB(1, 0), cB + kstep, voffB); PG8_STAGE(PG8_SA(1, 0), cA + kstep, voffA); PG8_STAGE(PG8_SB(1, 1), cB + hstep + kstep, voffB);
        PG8_WAIT_V(6); PG8_BAR;
    } else {
        PG8_STAGE(PG8_SB(0, 0), cB, voffB); PG8_STAGE(PG8_SA(0, 0), cA, voffA); PG8_STAGE(PG8_SB(0, 1), cB + hstep, voffB); PG8_STAGE(PG8_SA(0, 1), cA + hstep, voffA);
        if (wr == 1) PG8_BAR;
        PG8_WAIT_V(4); PG8_BAR;
        PG8_STAGE(PG8_SB(1, 0), cB + kstep, voffB); PG8_STAGE(PG8_SA(1, 0), cA + kstep, voffA); PG8_STAGE(PG8_SB(1, 1), cB + hstep + kstep, voffB);
        PG8_WAIT_V(6); PG8_BAR;
    }
    for (;;) {
        const bool has_next = S.next(ui + 1, nxt);
        const char* nA = has_next ? (const char*)g.A + (size_t)nxt.pm * tstep : cA; const char* nB = has_next ? (const char*)g.Bt + (size_t)nxt.pn * tstep : cB;
        for (int t = 0; t < nt; t += 2) {
            const bool last = (t == nt - 2);
            const char* a1 = cA + (size_t)(t + 1) * kstep;
            const char* a2 = last ? nA : cA + (size_t)(t + 2) * kstep; const char* b2 = last ? nB : cB + (size_t)(t + 2) * kstep;
            const char* a3 = a2 + kstep; const char* b3 = b2 + kstep;
            if (last && has_next) S.a_ready(nxt);
            if constexpr (SP2) {
            PG8_LDB(B0, 0, 0); PG8_LDB(B1, 0, 1); PG8_SCHED; PG8_LDA(At, 0, 0); PG8_STAGE(PG8_SA(1, 1), a1 + hstep, voffA);
            PG8_WAIT_V(8); PG8_WAIT_L(0); PG8_BAR; PG8_MMA(0, 0, At, B0); PG8_MMA(0, 1, At, B1); PG8_BAR; PG8_SCHED;
            PG8_LDA(At, 0, 1); PG8_STAGE(PG8_SB(0, 0), b2, voffB); PG8_STAGE(PG8_SB(0, 1), b2 + hstep, voffB); PG8_STAGE(PG8_SA(0, 0), a2, voffA);
            PG8_WAIT_V(8); PG8_WAIT_L(0); PG8_BAR; PG8_MMA(1, 0, At, B0); PG8_MMA(1, 1, At, B1); PG8_BAR; PG8_SCHED;
            PG8_LDB(B0, 1, 0); PG8_LDB(B1, 1, 1); PG8_SCHED; PG8_LDA(At, 1, 0); PG8_STAGE(PG8_SA(0, 1), a2 + hstep, voffA);
            PG8_WAIT_V(8); PG8_WAIT_L(0); PG8_BAR; PG8_MMA(0, 0, At, B0); PG8_MMA(0, 1, At, B1); PG8_BAR; PG8_SCHED;
            PG8_LDA(At, 1, 1); PG8_STAGE(PG8_SB(1, 0), b3, voffB); PG8_STAGE(PG8_SB(1, 1), b3 + hstep, voffB); PG8_STAGE(PG8_SA(1, 0), a3, voffA);
            PG8_WAIT_V(8); PG8_WAIT_L(0); PG8_BAR; PG8_MMA(1, 0, At, B0); PG8_MMA(1, 1, At, B1); PG8_BAR; PG8_SCHED;
            } else {
            PG8_LDB(B0, 0, 0); PG8_SCHED; PG8_LDA(At, 0, 0); PG8_STAGE(PG8_SA(1, 1), a1 + hstep, voffA);
            PG8_WAIT_L(8); PG8_BAR; PG8_WAIT_L(0); PG8_MMA(0, 0, At, B0); PG8_BAR; PG8_SCHED;
            PG8_LDB(B1, 0, 1); PG8_STAGE(PG8_SB(0, 0), b2, voffB);
            PG8_BAR; PG8_WAIT_L(0); PG8_MMA(0, 1, At, B1); PG8_BAR;
            PG8_LDA(At, 0, 1); PG8_STAGE(PG8_SA(0, 0), a2, voffA);
            PG8_BAR; PG8_WAIT_L(0); PG8_MMA(1, 0, At, B0); PG8_BAR; PG8_SCHED;
            PG8_STAGE(PG8_SB(0, 1), b2 + hstep, voffB);
            PG8_WAIT_V(6); PG8_BAR; PG8_MMA(1, 1, At, B1); PG8_BAR;
            PG8_LDB(B0, 1, 0); PG8_SCHED; PG8_LDA(At, 1, 0); PG8_STAGE(PG8_SA(0, 1), a2 + hstep, voffA);
            PG8_WAIT_L(8); PG8_BAR; PG8_WAIT_L(0); PG8_MMA(0, 0, At, B0); PG8_BAR; PG8_SCHED;
            PG8_LDB(B1, 1, 1); PG8_STAGE(PG8_SB(1, 0), b3, voffB);
            PG8_BAR; PG8_WAIT_L(0); PG8_MMA(0, 1, At, B1); PG8_BAR;
            PG8_LDA(At, 1, 1); PG8_STAGE(PG8_SA(1, 0), a3, voffA);
            PG8_BAR; PG8_WAIT_L(0); PG8_MMA(1, 0, At, B0); PG8_BAR; PG8_SCHED;
            PG8_STAGE(PG8_SB(1, 1), b3 + hstep, voffB);
            PG8_WAIT_V(6); PG8_BAR; PG8_MMA(1, 1, At, B1); PG8_BAR;
            }
        }
        if constexpr (ALIGN_EPI) { if (wr == 0) PG8_BAR; }
        if constexpr (!Epi::AFTER_DRAIN) { E(acc, cur, wr, wc, fr, fq); S.done(cur); }
        if (!has_next) break;
#pragma unroll
        for (int a = 0; a < 2; ++a)
#pragma unroll
            for (int b = 0; b < 2; ++b)
#pragma unroll
                for (int m = 0; m < 4; ++m)
#pragma unroll
                    for (int n = 0; n < 2; ++n) acc[a][b][m][n] = (f32x4){0.f, 0.f, 0.f, 0.f};
        cur = nxt; cA = nA; cB = nB; ++ui;
        if constexpr (ALIGN_EPI) { if (wr == 1) PG8_BAR; }
    }
    PG8_WAIT_V(0);
    if constexpr (!ALIGN_EPI) { if (wr == 0) PG8_BAR; }
    PG8_BAR;
    if constexpr (Epi::AFTER_DRAIN) { E.fused(acc, cur, wr, wc, fr, fq, lds, wid, lane); S.done(cur); }
#undef PG8_SA
#undef PG8_SB
#undef PG8_STAGE
#undef PG8_LDA
#undef PG8_LDB
#undef PG8_MMA
#undef PG8_WAIT_V
#undef PG8_WAIT_L
#undef PG8_BAR
#undef PG8_SCHED
}
}
using pg8::fast_sigmoid;
#define GAS __attribute__((address_space(1)))
#define LAS __attribute__((address_space(3)))
typedef unsigned short bf16;
typedef unsigned v4u __attribute__((ext_vector_type(4)));
typedef float f32x4 __attribute__((ext_vector_type(4)));
typedef short bf16x8 __attribute__((ext_vector_type(8)));
typedef GAS unsigned gu32;
typedef GAS unsigned long long gu64;
#define RLX_AGENT __ATOMIC_RELAXED, __HIP_MEMORY_SCOPE_AGENT
#define LDS_WAIT() asm volatile("s_waitcnt lgkmcnt(0)" ::: "memory")
#define VM_WAIT() asm volatile("s_waitcnt vmcnt(0)" ::: "memory")
__device__ __forceinline__ unsigned long long rt() { return __builtin_amdgcn_s_memrealtime(); }
__device__ __forceinline__ unsigned f2bf(float f) { unsigned u = __builtin_bit_cast(unsigned, f); return (u + 0x7fffu + ((u >> 16) & 1u)) >> 16; }
__device__ __forceinline__ unsigned pk2(float lo, float hi) { return f2bf(lo) | (f2bf(hi) << 16); }

#define XB_TMO      128
#define XB_XCNT(j)  (256  + 64 * (j))
#define XB_XSUB(j)  (1280 + 64 * (j))
#define XB_XGEN(j)  (2304 + 64 * (j))
#define XB_TOP      3328
#define XB_TOPGEN   3392
#define XCD_BAR_WORDS 3456
#define XB_SPIN_CAP (1u << 18)

__device__ __forceinline__ unsigned xb_ld(unsigned* p)              { return __hip_atomic_load(p, __ATOMIC_RELAXED, __HIP_MEMORY_SCOPE_AGENT); }
__device__ __forceinline__ unsigned xb_add(unsigned* p, unsigned v) { return __hip_atomic_fetch_add(p, v, __ATOMIC_RELAXED, __HIP_MEMORY_SCOPE_AGENT); }
__device__ __forceinline__ unsigned xb_xcc_id() { return (unsigned)__builtin_amdgcn_s_getreg((3 << 11) | 20) & 0xFu; }
#define XB_SPIN(cond, bar) do { unsigned _sp = 0; while (cond) { __builtin_amdgcn_s_sleep(1); \
    if ((++_sp & 255u) == 0u) { if (xb_ld(&(bar)[XB_TMO])) break; if (_sp > XB_SPIN_CAP) { atomicAdd(&(bar)[XB_TMO], 1u); break; } } } } while (0)

struct XcdBarrier {
    int wave;
    unsigned* bar; unsigned x;
    volatile LAS unsigned* st;
};

__device__ __forceinline__ XcdBarrier xcd_barrier_post(unsigned* bar, volatile LAS unsigned* st) {
    XcdBarrier b; b.bar = bar; b.x = xb_xcc_id(); b.st = st;
    if (threadIdx.x == 0) (void)xb_add(&bar[XB_XCNT(b.x)], 1u);
    return b;
}
__device__ __forceinline__ void xcd_barrier_complete(unsigned* bar, unsigned x, unsigned& nloc, unsigned& nx) {
    const unsigned G = gridDim.x * gridDim.y * gridDim.z;
    unsigned sum, cnt, mine, sp = 0u;
    for (;;) {
        sum = 0u; cnt = 0u; mine = 0u;
#pragma unroll
        for (unsigned j = 0; j < 16; ++j) { const unsigned c = xb_ld(&bar[XB_XCNT(j)]); sum += c; cnt += (c > 0u) ? 1u : 0u; mine = (j == x) ? c : mine; }
        if (sum == G) break;
        __builtin_amdgcn_s_sleep(1);
        if ((++sp & 255u) == 0u) { if (xb_ld(&bar[XB_TMO])) break; if (sp > XB_SPIN_CAP) { atomicAdd(&bar[XB_TMO], 1u); break; } }
    }
    nloc = mine > 0u ? mine : 1u; nx = cnt > 0u ? cnt : 1u;
}

__device__ __forceinline__ void xcd_barrier(const XcdBarrier& b) {
    asm volatile("s_waitcnt vmcnt(0)" ::: "memory");
    __syncthreads();
    if (b.wave == 0 && __builtin_amdgcn_mbcnt_hi(~0u, __builtin_amdgcn_mbcnt_lo(~0u, 0u)) == 0u) {
        unsigned* bar = b.bar;
        __builtin_amdgcn_s_waitcnt(0);
        unsigned nloc = b.st[0], nx = b.st[1];
        if (nloc == 0u) { xcd_barrier_complete(bar, b.x, nloc, nx); b.st[0] = nloc; b.st[1] = nx; }
        const unsigned old = xb_add(&bar[XB_XSUB(b.x)], 1u);
        const unsigned gen = old / nloc;
        if (old + 1u == (gen + 1u) * nloc) {
            __builtin_amdgcn_fence(__ATOMIC_RELEASE, "agent");
            asm volatile("s_waitcnt vmcnt(0)" ::: "memory");
            const unsigned og = xb_add(&bar[XB_TOP], 1u);
            const unsigned tg = og / nx;
            if (og + 1u == (tg + 1u) * nx) xb_add(&bar[XB_TOPGEN], 1u);
            else XB_SPIN(xb_ld(&bar[XB_TOPGEN]) == tg, bar);
            __builtin_amdgcn_fence(__ATOMIC_ACQUIRE, "agent");
            xb_add(&bar[XB_XGEN(b.x)], 1u);
            asm volatile("s_waitcnt vmcnt(0)" ::: "memory");
        } else {
            XB_SPIN(xb_ld(&bar[XB_XGEN(b.x)]) == gen, bar);
            __builtin_amdgcn_fence(__ATOMIC_ACQUIRE, "agent");
            asm volatile("s_waitcnt vmcnt(0)" ::: "memory");
        }
    }
    __syncthreads();
}
constexpr int NWAVES = 8, NTHR = 512;
constexpr int D = 1024, NB = 4, SEQ = 8192, DEPTH = 4, DECB = 32, DECS = 32, PAST = 2048;
constexpr int MP = NB * SEQ, MD = DECB * DECS, M = MP + MD, NPAN = M / 256, NSEQ = NB + DECB;
constexpr int DFF = 2816, NGU = 2 * DFF, NIN = 3328, NRW = 1792, NIG = NIN + 2 * D;
constexpr int HA = 4, HB = 8;
constexpr float LN_EPS = 1e-5f, GN_EPS = 64e-5f;
constexpr float ALPHA = 1.681792830507429f;
constexpr float QSCALE = 0.125f * 1.4426950408889634f;
constexpr float LOG2E = 1.4426950408889634f;
constexpr size_t OFF_Y = 0, OFF_KP = (size_t)M * D, OFF_VP = OFF_KP + (size_t)DEPTH * MP * 512, OFF_WKVP = OFF_VP + (size_t)DEPTH * MP * 512,
    OFF_SHP = OFF_WKVP + (size_t)DEPTH * NB * HB * 4096, OFF_KS = OFF_SHP + (size_t)DEPTH * NB * NRW, OFF_VS = OFF_KS + (size_t)DEPTH * MD * 512,
    OFF_WKVS = OFF_VS + (size_t)DEPTH * MD * 512, OFF_SHS = OFF_WKVS + (size_t)DEPTH * DECB * HB * 4096, OUT_TOTAL = OFF_SHS + (size_t)DEPTH * DECB * NRW;
static_assert(OUT_TOTAL == 177991680ull, "output size");
constexpr size_t al256(size_t x) { return (x + 255) & ~(size_t)255; }
constexpr size_t WS_CTL = 0, CTL_ZERO_BYTES = 1u << 20;
constexpr size_t WS_MOD = CTL_ZERO_BYTES;
constexpr size_t WS_LAM = WS_MOD + al256((size_t)DEPTH * NSEQ * 9 * D * 4);
constexpr size_t WS_W = WS_LAM + 256;
constexpr size_t WL_GU0 = 0, WL_GU1 = WL_GU0 + (size_t)NGU * D * 2, WL_DN0 = WL_GU1 + (size_t)NGU * D * 2, WL_DN1 = WL_DN0 + (size_t)D * DFF * 2,
    WL_IG = WL_DN1 + (size_t)D * DFF * 2, WL_BR = WL_IG + (size_t)NIG * D * 2, WL_O = WL_BR + (size_t)2048 * 512 * 2, WL_W2 = WL_O + (size_t)D * D * 2,
    WL_A2 = WL_W2 + 512 * 64 * 2, WL_G2 = WL_A2 + 512 * 64 * 2, WL_SIZE = WL_G2 + 512 * 128 * 2;
constexpr size_t WS_U = WS_W + (size_t)DEPTH * WL_SIZE;
constexpr size_t WS_ACT = WS_U + (size_t)M * D * 2;
constexpr size_t WS_F = WS_ACT + (size_t)M * DFF * 2;
constexpr size_t WS_Q = WS_F + (size_t)M * D * 4;
constexpr size_t WS_KB = WS_Q + (size_t)M * 512 * 2, WS_VB = WS_KB + (size_t)M * 512 * 2;
constexpr size_t WS_PRW = WS_VB + (size_t)M * 512 * 2;
constexpr size_t WS_GATES = WS_PRW + (size_t)M * NRW * 4;
constexpr size_t WS_YAB = WS_GATES + (size_t)M * 2048 * 2;
constexpr size_t WS_MERGED = WS_YAB + (size_t)2 * M * 512 * 2;
constexpr int NITEM_P = NB * (SEQ / 64) * HB, NITEM = NITEM_P + DECB * HB;
constexpr size_t WS_PT = WS_MERGED + (size_t)M * D * 2;
constexpr size_t WS_QT = WS_PT + (size_t)NITEM * 8192;
constexpr size_t WS_HT = WS_QT + (size_t)NITEM * 8192;
constexpr size_t WS_OT = WS_HT + (size_t)NITEM * 16384;
constexpr size_t WS_OB = WS_OT + (size_t)NITEM * 16384;
constexpr size_t WS_GG = WS_OB + (size_t)M * 512 * 4, WS_BON = WS_GG + (size_t)NITEM * 16384;
constexpr size_t WS_SC = WS_BON + (size_t)NITEM * 16384;
constexpr size_t WS_PLB = WS_SC + (size_t)NITEM * 8192;
constexpr size_t WS_SSB = WS_PLB + (size_t)M * 256 * 2;
constexpr size_t WS_END = WS_SSB + (size_t)DEPTH * DECB * 256 * 2;
constexpr int CW_TMO = 0, CW_BAR = 4096;
constexpr int RING_BYTES = 131072, EXTRA_OFF = 131072, LDSCTL_OFF = 146944, LDS_BYTES = 147456;

struct Args { const float* in[34]; float* out; unsigned char* ws; int ph_lo, ph_hi; };
static_assert(sizeof(Args) == 36 * 8 + 8, "Args has no padding");
enum { I_XP = 0, I_XS, I_CP, I_CS, I_CK, I_CV, I_SWKV, I_SSH, I_RELB, I_WADA, I_BADA, I_LNG, I_LNB, I_WGU, I_WDN, I_WIN, I_LAMQK, I_SUBG, I_MU, I_W0, I_W2, I_A0, I_A2, I_G2,
       I_KK, I_KA, I_RK, I_LNXG, I_LNXB, I_BRA, I_BRB, I_WGATE, I_BGATE, I_WO };

struct Frame { LAS unsigned char* lds; int tid, lane, wave, vcu, G; };

__device__ __forceinline__ int opq(int x) { asm volatile("" : "+s"(x)); return x; }
__device__ __forceinline__ Frame relaunder(const Frame& F) { Frame G = F; G.vcu = opq(G.vcu); G.G = opq(G.G); G.wave = opq(F.wave); G.lane = (int)__builtin_amdgcn_mbcnt_hi(~0u, __builtin_amdgcn_mbcnt_lo(~0u, 0u)); asm volatile("" : "+v"(G.lane)); G.tid = G.wave * 64 + G.lane; return G; }
__device__ __forceinline__ int row_seq(int row) { return row < MP ? (row >> 13) : NB + ((row - MP) >> 5); }
__device__ __forceinline__ int crow(int r, int hi) { return (r & 3) + 8 * (r >> 2) + 4 * hi; }
__device__ __forceinline__ float wave_sum(float v) {
#pragma unroll
    for (int o = 1; o < 64; o <<= 1) v += __shfl_xor(v, o);
    return v;
}
__device__ __forceinline__ unsigned cvtpk(float lo, float hi) { return pg8::cvt_pk_bf16(lo, hi); }
__device__ __forceinline__ float bf2f(bf16 b) { return __uint_as_float((unsigned)b << 16); }
typedef float f32x16 __attribute__((ext_vector_type(16)));
typedef unsigned u32x2 __attribute__((ext_vector_type(2)));
#define LP(T, p) ((LAS T*)(p))

__device__ __forceinline__ void p0_transpose_item(const float* W, int K, int N, bf16* WT, int k0, int n0, int drow0, LAS float* scr, int lane) {
#pragma unroll 8
    for (int i = 0; i < 32; ++i) { const int kk = 2 * i + (lane >> 5); scr[kk * 33 + (lane & 31)] = W[(size_t)(k0 + kk) * N + n0 + (lane & 31)]; }
    LDS_WAIT(); asm volatile("" ::: "memory");
    const int c = lane & 7;
#pragma unroll
    for (int j = 0; j < 4; ++j) { const int n = (lane >> 3) + 8 * j; const LAS float* s = scr + (8 * c) * 33 + n;
        v4u o; o.x = pk2(s[0 * 33], s[1 * 33]); o.y = pk2(s[2 * 33], s[3 * 33]); o.z = pk2(s[4 * 33], s[5 * 33]); o.w = pk2(s[6 * 33], s[7 * 33]);
        *(GAS v4u*)(WT + (size_t)(drow0 + n) * K + k0 + 8 * c) = o; }
    LDS_WAIT(); asm volatile("" ::: "memory");
}
__device__ __forceinline__ void conv_mat(const float* W, int K, int N, bf16* WT, int r, int row_off, bool gu, LAS float* scr, int lane) {
    const int nblk = N / 32, kb = r / nblk, nb = r % nblk, n0 = 32 * nb; int drow0 = row_off + n0;
    if (gu) { drow0 = n0 < DFF ? 256 * (n0 / 128) + (n0 % 128) : 256 * ((n0 - DFF) / 128) + 128 + ((n0 - DFF) % 128); }
    p0_transpose_item(W, K, N, WT, 64 * kb, n0, drow0, scr, lane);
}
__device__ __forceinline__ void ph_prologue(const Frame& F0, const Args& a) {
    const Frame F = relaunder(F0);
    unsigned char* ws = a.ws;
    LAS bf16* sc = LP(bf16, F.lds);
    for (int i = F.tid; i < NSEQ * D; i += NTHR) { const int s = i >> 10, k = i & 1023; const float c = s < NB ? a.in[I_CP][s * D + k] : a.in[I_CS][(s - NB) * D + k];
        sc[s * 1032 + k] = (bf16)f2bf(c * fast_sigmoid(c)); }
    __syncthreads();
    const int gw = F.vcu * NWAVES + F.wave, NGW = F.G * NWAVES; const int lane = F.lane, r32 = lane & 31, hi = lane >> 5;
    float* MOD = (float*)(ws + WS_MOD);
    for (int it = gw; it < DEPTH * 288; it += NGW) {
        const int l = it / 288, n0 = (it % 288) * 32;
        const float* W = a.in[I_WADA] + (size_t)l * D * 9216 + n0 + r32;
        f32x16 acc0 = {}, acc1 = {};
        const int rowB = (32 + r32) < NSEQ ? 32 + r32 : NSEQ - 1;
#pragma unroll 4
        for (int s = 0; s < 64; ++s) {
            const float* wp = W + (size_t)(16 * s + 8 * hi) * 9216;
            float w[8];
#pragma unroll
            for (int j = 0; j < 8; ++j) w[j] = wp[(size_t)j * 9216];
            v4u bw; bw.x = cvtpk(w[0], w[1]); bw.y = cvtpk(w[2], w[3]); bw.z = cvtpk(w[4], w[5]); bw.w = cvtpk(w[6], w[7]);
            const bf16x8 bfrag = __builtin_bit_cast(bf16x8, bw);
            const bf16x8 a0 = *LP(const bf16x8, sc + r32 * 1032 + 16 * s + 8 * hi);
            const bf16x8 a1 = *LP(const bf16x8, sc + rowB * 1032 + 16 * s + 8 * hi);
            acc0 = __builtin_amdgcn_mfma_f32_32x32x16_bf16(a0, bfrag, acc0, 0, 0, 0);
            acc1 = __builtin_amdgcn_mfma_f32_32x32x16_bf16(a1, bfrag, acc1, 0, 0, 0);
        }
        const float bias = a.in[I_BADA][(size_t)l * 9216 + n0 + r32];
#pragma unroll
        for (int r = 0; r < 16; ++r) { const int s0 = crow(r, hi); MOD[((size_t)l * NSEQ + s0) * 9216 + n0 + r32] = acc0[r] + bias;
            const int s1 = 32 + s0; if (s1 < NSEQ) MOD[((size_t)l * NSEQ + s1) * 9216 + n0 + r32] = acc1[r] + bias; }
    }
    LAS float* scr = LP(float, F.lds + 74304 + F.wave * 8448);
    constexpr int C0 = 16 * 176, C2 = 44 * 32, C4 = 16 * 104, C5 = 16 * 64, C6 = 8 * 32, C8 = 16 * 32, C9 = 16, C11 = 32;
    constexpr int PER_L = 2 * C0 + 2 * C2 + C4 + C5 + 2 * C6 + C8 + 2 * C9 + C11;
    for (int it = gw; it < DEPTH * PER_L; it += NGW) {
        const int l = it / PER_L; int r = it % PER_L; unsigned char* wl = ws + WS_W + (size_t)l * WL_SIZE;
        if (r < C0) { conv_mat(a.in[I_WGU] + (size_t)(l * 2 + 0) * D * NGU, D, NGU, (bf16*)(wl + WL_GU0), r, 0, true, scr, lane); continue; } r -= C0;
        if (r < C0) { conv_mat(a.in[I_WGU] + (size_t)(l * 2 + 1) * D * NGU, D, NGU, (bf16*)(wl + WL_GU1), r, 0, true, scr, lane); continue; } r -= C0;
        if (r < C2) { conv_mat(a.in[I_WDN] + (size_t)(l * 2 + 0) * DFF * D, DFF, D, (bf16*)(wl + WL_DN0), r, 0, false, scr, lane); continue; } r -= C2;
        if (r < C2) { conv_mat(a.in[I_WDN] + (size_t)(l * 2 + 1) * DFF * D, DFF, D, (bf16*)(wl + WL_DN1), r, 0, false, scr, lane); continue; } r -= C2;
        if (r < C4) { conv_mat(a.in[I_WIN] + (size_t)l * D * NIN, D, NIN, (bf16*)(wl + WL_IG), r, 0, false, scr, lane); continue; } r -= C4;
        if (r < C5) { conv_mat(a.in[I_WGATE] + (size_t)l * D * 2048, D, 2048, (bf16*)(wl + WL_IG), r, NIN, false, scr, lane); continue; } r -= C5;
        if (r < C6) { conv_mat(a.in[I_BRA] + (size_t)l * 512 * D, 512, D, (bf16*)(wl + WL_BR), r, 0, false, scr, lane); continue; } r -= C6;
        if (r < C6) { conv_mat(a.in[I_BRB] + (size_t)l * 512 * D, 512, D, (bf16*)(wl + WL_BR), r, 1024, false, scr, lane); continue; } r -= C6;
        if (r < C8) { conv_mat(a.in[I_WO] + (size_t)l * D * D, D, D, (bf16*)(wl + WL_O), r, 0, false, scr, lane); continue; } r -= C8;
        if (r < C9) { conv_mat(a.in[I_W2] + (size_t)l * 64 * 512, 64, 512, (bf16*)(wl + WL_W2), r, 0, false, scr, lane); continue; } r -= C9;
        if (r < C9) { conv_mat(a.in[I_A2] + (size_t)l * 64 * 512, 64, 512, (bf16*)(wl + WL_A2), r, 0, false, scr, lane); continue; } r -= C9;
        conv_mat(a.in[I_G2] + (size_t)l * 128 * 512, 128, 512, (bf16*)(wl + WL_G2), r, 0, false, scr, lane);
    }
    for (int z = gw * 64 + lane; z < DEPTH * DECB * 256; z += NGW * 64) ((bf16*)(ws + WS_SSB))[z] = (bf16)f2bf(a.in[I_SSH][(size_t)(z >> 8) * NRW + 1536 + (z & 255)]);
    if (blockIdx.x == 0 && F.wave == 0) {
        for (int l = 0; l < DEPTH; ++l) { const float* lq = a.in[I_LAMQK] + l * 256;
            const float s1 = wave_sum(lq[lane] * lq[64 + lane]), s2 = wave_sum(lq[128 + lane] * lq[192 + lane]);
            const float lam_init = 0.8f - 0.6f * expf(-0.3f * (float)l);
            if (lane == 0) ((float*)(ws + WS_LAM))[l] = expf(s1) - expf(s2) + lam_init; }
    }
}

__device__ __forceinline__ void ph_ln(const Frame& F0, const float* xin_p, const float* xin_s, const float* f, float gs, const float* gate_mod  ,
                                      const float* lng, const float* lnb, const float* modn  , float* xout, bf16* uout) {
    const Frame F = relaunder(F0);
    const int gw = F.vcu * NWAVES + F.wave, NGW = F.G * NWAVES, lane = F.lane;
    for (int m = gw; m < M; m += NGW) {
        const int seq = row_seq(m);
        const float* xr = (xin_s && m >= MP) ? xin_s + (size_t)(m - MP) * D : xin_p + (size_t)m * D;
        f32x4 v[4];
#pragma unroll
        for (int j = 0; j < 4; ++j) v[j] = *(const f32x4*)(xr + 4 * lane + 256 * j);
        if (f) {
            const float* fr = f + (size_t)m * D; const float* gm = gate_mod + (size_t)seq * 9216; float s = 0.f;
#pragma unroll
            for (int j = 0; j < 4; ++j) { const f32x4 fv = *(const f32x4*)(fr + 4 * lane + 256 * j); const f32x4 gv = *(const f32x4*)(gm + 4 * lane + 256 * j);
                v[j] = v[j] * ALPHA + (gv * gs) * fv; s += (v[j].x + v[j].y) + (v[j].z + v[j].w); }
            const float mean = wave_sum(s) * (1.f / D); float s2 = 0.f;
#pragma unroll
            for (int j = 0; j < 4; ++j) { v[j] = v[j] - mean; s2 += (v[j].x * v[j].x + v[j].y * v[j].y) + (v[j].z * v[j].z + v[j].w * v[j].w); }
            const float rstd = 1.0f / sqrtf(wave_sum(s2) * (1.f / D) + LN_EPS);
#pragma unroll
            for (int j = 0; j < 4; ++j) { const f32x4 g = *(const f32x4*)(lng + 4 * lane + 256 * j), b = *(const f32x4*)(lnb + 4 * lane + 256 * j); v[j] = v[j] * rstd * g + b;
                *(f32x4*)(xout + (size_t)m * D + 4 * lane + 256 * j) = v[j]; }
        }
        if (modn) {
            const float* mm = modn + (size_t)seq * 9216; float s = 0.f;
#pragma unroll
            for (int j = 0; j < 4; ++j) s += (v[j].x + v[j].y) + (v[j].z + v[j].w);
            const float mean = wave_sum(s) * (1.f / D); float s2 = 0.f;
#pragma unroll
            for (int j = 0; j < 4; ++j) { v[j] = v[j] - mean; s2 += (v[j].x * v[j].x + v[j].y * v[j].y) + (v[j].z * v[j].z + v[j].w * v[j].w); }
            const float rstd = 1.0f / sqrtf(wave_sum(s2) * (1.f / D) + LN_EPS);
#pragma unroll
            for (int j = 0; j < 4; ++j) { const f32x4 sh = *(const f32x4*)(mm + 4 * lane + 256 * j), scl = *(const f32x4*)(mm + D + 4 * lane + 256 * j);
                const f32x4 o = v[j] * rstd * (scl + 1.0f) + sh; u32x2 w; w.x = cvtpk(o.x, o.y); w.y = cvtpk(o.z, o.w);
                *(u32x2*)(uout + (size_t)m * D + 4 * lane + 256 * j) = w; }
        }
    }
}
__device__ __forceinline__ int t5_bucket(int rel) {
    const int n = rel < 0 ? -rel : rel; int b;
    if (n < 8) b = n; else if (n < 12) b = 8; else if (n < 16) b = 9; else if (n < 23) b = 10; else if (n < 32) b = 11; else if (n < 46) b = 12; else if (n < 64) b = 13; else if (n < 91) b = 14; else b = 15;
    return (rel > 0 ? 16 : 0) + b;
}
typedef short v4i16_t __attribute__((ext_vector_type(4)));
__device__ __forceinline__ v4i16_t vtr(LAS const unsigned char* p) { return __builtin_amdgcn_ds_read_tr16_b64_v4i16((LAS v4i16_t*)p); }
constexpr int ATT_SLOT = 32768;
constexpr int ATT_TAB = EXTRA_OFF;
struct AttnP { const bf16* Q; const bf16* Kb; const bf16* Vb; const float* ck; const float* cv; bf16* YA; const float* relb; const float* subg; float lam, oml; };

__device__ __forceinline__ void attn_scores(LAS const unsigned char* slot, LAS const float* tab, const bf16x8 (&qf)[4], f32x16 (&o)[4], bf16x8 (&pf)[4], float& mrun, float& lrun,
                                            int map, int lane, int k0, int qpos, bool constb, int nvalid) {
    const int r32 = lane & 31, hi = lane >> 5;
    LAS const unsigned char* kb = slot + map * 8192 + hi * 1024 + r32 * 16;
    f32x16 p0, p1;
    const float cb = constb ? tab[0] : 0.f;
#pragma unroll
    for (int r = 0; r < 16; ++r) { p0[r] = cb; p1[r] = cb; }
#pragma unroll
    for (int d0 = 0; d0 < 4; ++d0) {
        const bf16x8 k0f = *LP(const bf16x8, kb + d0 * 2048), k1f = *LP(const bf16x8, kb + d0 * 2048 + 512);
        p0 = __builtin_amdgcn_mfma_f32_32x32x16_bf16(k0f, qf[d0], p0, 0, 0, 0);
        p1 = __builtin_amdgcn_mfma_f32_32x32x16_bf16(k1f, qf[d0], p1, 0, 0, 0);
    }
    if (!constb) {
        const int base = k0 - qpos + 128;
#pragma unroll
        for (int r = 0; r < 16; ++r) { int i0 = base + crow(r, hi); int i1 = i0 + 32; i0 = i0 < 0 ? 0 : (i0 > 191 ? 191 : i0); i1 = i1 < 0 ? 0 : (i1 > 191 ? 191 : i1); p0[r] += tab[i0]; p1[r] += tab[i1]; }
    }
    if (nvalid < 64) {
#pragma unroll
        for (int r = 0; r < 16; ++r) { if (crow(r, hi) >= nvalid) p0[r] = -INFINITY; if (crow(r, hi) + 32 >= nvalid) p1[r] = -INFINITY; }
    }
    float mx = p0[0];
#pragma unroll
    for (int r = 1; r < 16; ++r) mx = fmaxf(mx, p0[r]);
#pragma unroll
    for (int r = 0; r < 16; ++r) mx = fmaxf(mx, p1[r]);
    mx = fmaxf(mx, __shfl_xor(mx, 32));
    const float mnew = fmaxf(mrun, mx);
    const float alpha = __builtin_amdgcn_exp2f(mrun - mnew);
    mrun = mnew;
    float ls = 0.f;
#pragma unroll
    for (int r = 0; r < 16; ++r) { p0[r] = __builtin_amdgcn_exp2f(p0[r] - mnew); p1[r] = __builtin_amdgcn_exp2f(p1[r] - mnew); ls += p0[r] + p1[r]; }
    lrun = lrun * alpha + ls;
    if (__any(alpha != 1.0f)) {
#pragma unroll
        for (int c = 0; c < 4; ++c)
#pragma unroll
            for (int r = 0; r < 16; ++r) o[c][r] *= alpha;
    }
#pragma unroll
    for (int ks = 0; ks < 4; ++ks) { v4u w;
        if (ks < 2) { const int b = 8 * ks; w.x = cvtpk(p0[b], p0[b + 1]); w.y = cvtpk(p0[b + 2], p0[b + 3]); w.z = cvtpk(p0[b + 4], p0[b + 5]); w.w = cvtpk(p0[b + 6], p0[b + 7]); }
        else { const int b = 8 * (ks - 2); w.x = cvtpk(p1[b], p1[b + 1]); w.y = cvtpk(p1[b + 2], p1[b + 3]); w.z = cvtpk(p1[b + 4], p1[b + 5]); w.w = cvtpk(p1[b + 6], p1[b + 7]); }
        pf[ks] = __builtin_bit_cast(bf16x8, w); }
}
__device__ __forceinline__ void attn_pv(LAS const unsigned char* slot, const bf16x8 (&pf)[4], f32x16 (&o)[4], int lane) {
    const int hi = lane >> 5;
    LAS const unsigned char* vb = slot + 16384 + ((lane >> 4) & 1) * 32 + (lane & 3) * 8 + (4 * hi + ((lane & 15) >> 2)) * 64;
#pragma unroll
    for (int c = 0; c < 4; ++c)
#pragma unroll
        for (int ks = 0; ks < 4; ++ks) {
            const v4i16_t lo = vtr(vb + c * 4096 + (2 * ks) * 512), hh = vtr(vb + c * 4096 + (2 * ks + 1) * 512);
            const bf16x8 vf = (bf16x8){lo[0], lo[1], lo[2], lo[3], hh[0], hh[1], hh[2], hh[3]};
            o[c] = __builtin_amdgcn_mfma_f32_32x32x16_bf16(vf, pf[ks], o[c], 0, 0, 0);
        }
}

__device__ __forceinline__ int att_koff(int key, int ch) { return (ch >> 3) * 8192 + ((ch & 7) >> 1) * 2048 + (ch & 1) * 1024 + (key >> 5) * 512 + (key & 31) * 16; }
__device__ __forceinline__ int att_voff(int key, int ch) { return 16384 + (ch >> 2) * 4096 + (key >> 3) * 512 + (key & 7) * 64 + (ch & 3) * 16; }

__device__ __forceinline__ void attn_unit(const Frame& F, const AttnP& P, bool dec, int bidx, int h, int qb) {
    const int tid = F.tid, lane = F.lane, wave = F.wave, r32 = lane & 31, hi = lane >> 5;
    const int map = wave & 1, qs = wave >> 1;
    LAS unsigned char* lds = F.lds;
    LAS float* tab = LP(float, lds + ATT_TAB);
    const int rowbase = dec ? MP + bidx * DECS : bidx * SEQ;
    const int q0 = dec ? 0 : qb * 128;
    const int qpos0 = dec ? PAST : q0;
    const bool active = dec ? (qs == 0) : true;
    const int NT = dec ? (PAST / 64 + 1) : (2 * qb + 2);
    const int myNT = dec ? NT : (2 * qb + 1 + (qs >> 1));
    if (tid < 192) tab[tid] = P.relb[t5_bucket(tid - 128) * HA + h] * LOG2E;
    bf16x8 qf[4];
    { const bf16* qp = P.Q + (size_t)(rowbase + q0 + (active ? qs * 32 : 0) + r32) * 512 + h * 128 + map * 64 + 8 * hi;
#pragma unroll
      for (int d0 = 0; d0 < 4; ++d0) qf[d0] = *(const bf16x8*)(qp + 16 * d0); }
    f32x16 o[4];
#pragma unroll
    for (int c = 0; c < 4; ++c)
#pragma unroll
        for (int r = 0; r < 16; ++r) o[c][r] = 0.f;
    float mrun = -INFINITY, lrun = 0.f;
    const int qposw = qpos0 + qs * 32;
    v4u kreg[2], vreg[2];
    auto load_tile = [&](int t) {
#pragma unroll
        for (int i = 0; i < 2; ++i) { const int id = tid + 512 * i;
            const int kk = (id & 7) | ((id >> 7) << 3), kc = (id >> 3) & 15;
            const int vk = ((id >> 2) & 7) | ((id >> 7) << 3), vc = (id & 3) | (((id >> 5) & 3) << 2);
            if (!dec) { kreg[i] = *(const v4u*)(P.Kb + (size_t)(rowbase + 64 * t + kk) * 512 + h * 128 + kc * 8); vreg[i] = *(const v4u*)(P.Vb + (size_t)(rowbase + 64 * t + vk) * 512 + h * 128 + vc * 8); }
            else if (t < PAST / 64) { const size_t gk = ((size_t)(bidx * PAST + 64 * t + kk) * HA + h) * 128 + kc * 8, gv = ((size_t)(bidx * PAST + 64 * t + vk) * HA + h) * 128 + vc * 8;
                const f32x4 a0 = *(const f32x4*)(P.ck + gk), a1 = *(const f32x4*)(P.ck + gk + 4), b0 = *(const f32x4*)(P.cv + gv), b1 = *(const f32x4*)(P.cv + gv + 4);
                kreg[i] = (v4u){cvtpk(a0[0], a0[1]), cvtpk(a0[2], a0[3]), cvtpk(a1[0], a1[1]), cvtpk(a1[2], a1[3])};
                vreg[i] = (v4u){cvtpk(b0[0], b0[1]), cvtpk(b0[2], b0[3]), cvtpk(b1[0], b1[1]), cvtpk(b1[2], b1[3])}; }
            else { kreg[i] = kk < DECS ? *(const v4u*)(P.Kb + (size_t)(rowbase + kk) * 512 + h * 128 + kc * 8) : (v4u){0u, 0u, 0u, 0u};
                   vreg[i] = vk < DECS ? *(const v4u*)(P.Vb + (size_t)(rowbase + vk) * 512 + h * 128 + vc * 8) : (v4u){0u, 0u, 0u, 0u}; }
        }
    };
    auto store_tile_at = [&](int sloff) {
        LAS unsigned char* sb = lds + sloff;
#pragma unroll
        for (int i = 0; i < 2; ++i) { const int id = tid + 512 * i;
            const int kk = (id & 7) | ((id >> 7) << 3), kc = (id >> 3) & 15, vk = ((id >> 2) & 7) | ((id >> 7) << 3), vc = (id & 3) | (((id >> 5) & 3) << 2);
            *LP(v4u, sb + att_koff(kk, kc)) = kreg[i]; *LP(v4u, sb + att_voff(vk, vc)) = vreg[i]; }
    };
    __syncthreads();
    load_tile(0); store_tile_at(0);
    __syncthreads();
    const bool late = wave >= 4;
    bf16x8 pf[4];
    bool pend = false;
    int sl_prev = 0, sl_cur = 0, sl_next = ATT_SLOT;
    for (int t = 0; t < NT; ++t) {
        if (t + 1 < NT) load_tile(t + 1);
        const bool mine = active && t < myNT;
        if (late) {
            if (pend) attn_pv(lds + sl_prev, pf, o, lane);
            pend = mine;
        }
        if (mine) {
            const int k0 = 64 * t;
            const bool constb = (k0 + 63 - qposw) <= -91;
            attn_scores(lds + sl_cur, tab, qf, o, pf, mrun, lrun, map, lane, k0, qposw + r32, constb, (dec && t == NT - 1) ? DECS : 64);
            if (!late) attn_pv(lds + sl_cur, pf, o, lane);
        }
        if (t + 1 < NT) store_tile_at(sl_next);
        __syncthreads();
        sl_prev = sl_cur; sl_cur = sl_next; sl_next = sl_next == 2 * ATT_SLOT ? 0 : sl_next + ATT_SLOT;
    }
    if (late && pend) attn_pv(lds + sl_prev, pf, o, lane);
    __syncthreads();
    lrun += __shfl_xor(lrun, 32);
    const float inv = 1.0f / lrun;
    LAS float* ex = LP(float, lds + (wave >> 1) * 16384);
    if (map == 1) {
#pragma unroll
        for (int c = 0; c < 4; ++c)
#pragma unroll
            for (int r = 0; r < 16; ++r) ex[(c * 16 + r) * 64 + lane] = o[c][r] * inv;
    }
    __syncthreads();
    LAS bf16* yst = LP(bf16, lds + 65536 + (wave >> 1) * 8448);
    if (map == 0) {
        float ss = 0.f;
#pragma unroll
        for (int c = 0; c < 4; ++c)
#pragma unroll
            for (int r = 0; r < 16; ++r) { const float v = o[c][r] * inv - P.lam * ex[(c * 16 + r) * 64 + lane]; o[c][r] = v; ss += v * v; }
        ss += __shfl_xor(ss, 32);
        const float rs = 1.0f / sqrtf(ss * (1.f / 128.f) + LN_EPS) * P.oml;
#pragma unroll
        for (int c = 0; c < 4; ++c)
#pragma unroll
            for (int r = 0; r < 16; ++r) { const int dv = 32 * c + crow(r, hi); yst[r32 * 132 + dv] = (bf16)f2bf(o[c][r] * rs * P.subg[dv]); }
    }
    __syncthreads();
    if (map == 0 && active) {
#pragma unroll
        for (int i = 0; i < 8; ++i) { const int row = i * 4 + (lane >> 4), ch = lane & 15;
            const u32x2 a = *LP(const u32x2, yst + row * 132 + ch * 8), b = *LP(const u32x2, yst + row * 132 + ch * 8 + 4);
            *(v4u*)(P.YA + (size_t)(rowbase + q0 + qs * 32 + row) * 512 + h * 128 + ch * 8) = (v4u){a.x, a.y, b.x, b.y}; }
    }
}
__device__ __forceinline__ void ph_attn(const Frame& F0, const AttnP& P) {
    const Frame F = relaunder(F0);
    for (int u = F.vcu; u < 1024 + DECB * HA; u += F.G) {
        if (u < 1024) { const int j = u >> 8, v = u & 255, bh = v >> 4, s = v & 15; const int qb = j == 0 ? s : j == 1 ? 31 - s : j == 2 ? 32 + s : 63 - s;
            attn_unit(F, P, false, bh >> 2, bh & 3, qb); }
        else { const int d = u - 1024; attn_unit(F, P, true, d >> 2, d & 3, 0); }
    }
}
constexpr int R1_RT = 0, R1_KH = 9216, R1_BH = 18432, R1_KAP = 27648, R1_KAPT = 36864, R1_VT = 46080, R1_BBT = 55296, R1_KBT = 64512;
constexpr int R1_ABKF = 73728, R1_AKK = 90368, R1_ABR = 99584, R1_AKR = 108800, R1_MB = 118016;
constexpr int R1_MF = R1_KH, R1_GT = R1_KAP, R1_WT = R1_ABKF, R1_UT = R1_KH;
constexpr int R1_LW = 73728, R1_LA = 82944, R1_LG = 92160;
constexpr int R1_RED = EXTRA_OFF, R1_CS = EXTRA_OFF + 1024, R1_GTV = EXTRA_OFF + 2048, R1_T16 = EXTRA_OFF + 2304, R1_MUL = EXTRA_OFF + 5632;
typedef unsigned short u16;
__device__ __forceinline__ f32x4 mfma16(bf16x8 a, bf16x8 b, f32x4 c) { return __builtin_amdgcn_mfma_f32_16x16x32_bf16(a, b, c, 0, 0, 0); }
__device__ __forceinline__ void mm64(f32x4 (&acc)[2], LAS const unsigned char* X, LAS const unsigned char* Y, int tm, int tn0, int lane) {
    const int i = lane & 15, q = lane >> 4;
#pragma unroll
    for (int s = 0; s < 2; ++s) {
        const bf16x8 af = *LP(const bf16x8, X + ((16 * tm + i) * 72 + 32 * s + 8 * q) * 2);
#pragma unroll
        for (int j = 0; j < 2; ++j) { const bf16x8 bfr = *LP(const bf16x8, Y + ((16 * (tn0 + j) + i) * 72 + 32 * s + 8 * q) * 2); acc[j] = mfma16(af, bfr, acc[j]); }
    }
}
__device__ __forceinline__ void st_tr(LAS unsigned char* arr, const f32x4& v, int n, int t0) {
    u32x2 w; w.x = cvtpk(v[0], v[1]); w.y = cvtpk(v[2], v[3]); *LP(u32x2, arr + (n * 72 + t0) * 2) = w;
}
__device__ __forceinline__ f32x4 prod16(f32x4 acc, LAS const float* X, int sx, LAS const float* Y, int sy, int lane) {
    const int i = lane & 15, q = lane >> 4;
#pragma unroll
    for (int s = 0; s < 4; ++s) acc = __builtin_amdgcn_mfma_f32_16x16x4f32(X[i * sx + 4 * s + q], Y[(4 * s + q) * sy + i], acc, 0, 0, 0);
    return acc;
}
__device__ __forceinline__ float tanh_fast(float x) { return 1.0f - 2.0f * __builtin_amdgcn_rcpf(1.0f + __expf(2.0f * x)); }

__device__ __forceinline__ int frag_a(int row, int k) { return ((row >> 4) * 2 + (k >> 5)) * 512 + (((k >> 2) & 3) * 16 + (row & 15)) * 8 + 4 * ((k >> 4) & 1) + (k & 3); }
__device__ __forceinline__ int frag_c(int c, int r0) { return (((c >> 4) * 4 + (r0 >> 4)) * 64 + ((r0 >> 2) & 3) * 16 + (c & 15)) * 4; }
__device__ __forceinline__ void ph_rwkv1(const Frame& F0, const Args& a, int l) {
    const Frame F = relaunder(F0);
    unsigned char* ws = a.ws; LAS unsigned char* lds = F.lds;
    int tid = F.tid, lane = F.lane, i = lane & 15, q = lane >> 4, t0 = 0; const int wave = F.wave, tm = wave >> 1, tnb = 2 * (wave & 1);
#define R1_RELANE() do { int l_ = F.lane; asm volatile("" : "+v"(l_)); lane = l_; i = lane & 15; q = lane >> 4; tid = wave * 64 + lane; t0 = 16 * tm + 4 * q; } while (0)
    const float* PRW = (const float*)(ws + WS_PRW); const bf16* PLB = (const bf16*)(ws + WS_PLB);
    const unsigned char* wl = ws + WS_W + (size_t)l * WL_SIZE;
    const bf16* W2t = (const bf16*)(wl + WL_W2); const bf16* A2t = (const bf16*)(wl + WL_A2); const bf16* G2t = (const bf16*)(wl + WL_G2);
    const float* mu = a.in[I_MU] + (size_t)l * NRW; const float* w0 = a.in[I_W0] + l * 512; const float* a0 = a.in[I_A0] + l * 512;
    const float* k_k = a.in[I_KK] + l * 512; const float* k_a = a.in[I_KA] + l * 512; const float* r_k = a.in[I_RK] + l * 512;
    float* OB = (float*)(ws + WS_OB); float* GG = (float*)(ws + WS_GG); float* BON = (float*)(ws + WS_BON);
    LAS float* RED = LP(float, lds + R1_RED); LAS float* CS = LP(float, lds + R1_CS); LAS float* GTV = LP(float, lds + R1_GTV);
    LAS float* ABKF = LP(float, lds + R1_ABKF); LAS float* MF = LP(float, lds + R1_MF);
    if (tid < 256) LP(float, lds + R1_MUL)[tid] = mu[1536 + tid];
    __syncthreads();
    for (int it = F.vcu; it < NITEM; it += F.G) {
        const bool dec = it >= NITEM_P; int h, row0, tval; const float* prev0;
        const bf16* prevb;
        if (!dec) { const int s = it >> 10, c = (it >> 3) & 127; h = it & 7; row0 = s * SEQ + 64 * c; tval = 64; prev0 = c > 0 ? PRW + (size_t)(row0 - 1) * NRW : nullptr; prevb = c > 0 ? PLB + (size_t)(row0 - 1) * 256 : nullptr; }
        else { const int b = (it - NITEM_P) >> 3; h = it & 7; row0 = MP + DECS * b; tval = DECS; prev0 = a.in[I_SSH] + (size_t)(l * DECB + b) * NRW; prevb = (const bf16*)(ws + WS_SSB) + (size_t)(l * DECB + b) * 256; }
        R1_RELANE();
        const int t0s = tid >> 3, part = tid & 7;
        const bool v0 = t0s < tval;
        const bf16* pl_ = PLB + (size_t)(row0 + (v0 ? t0s : 0)) * 256 + 32 * part;
        const bf16* pq_ = (v0 && t0s > 0) ? pl_ - 256 : (prevb ? prevb + 32 * part : pl_);
        const bool pqz = !(v0 && t0s > 0) && !prevb;
        v4u lp[4], lq[4];
#pragma unroll
        for (int e = 0; e < 4; ++e) { lp[e] = *(const v4u*)(pl_ + 8 * e); lq[e] = *(const v4u*)(pq_ + 8 * e); }
        float gp[2][4][3], gq[2][3], cst[2][8];
#pragma unroll
        for (int j = 0; j < 2; ++j) { const int col = h * 64 + 16 * (tnb + j) + i; const int tb = 16 * tm + 4 * q;
#pragma unroll
            for (int r = 0; r < 4; ++r) { const unsigned po = (unsigned)(row0 + min(tb + r, tval - 1)) * NRW + col; gp[j][r][0] = PRW[po]; gp[j][r][1] = PRW[po + 512]; gp[j][r][2] = PRW[po + 1024]; }
            const float* pb = tb > 0 ? PRW + (size_t)(row0 + min(tb, tval) - 1) * NRW : prev0;
            if (pb) { gq[j][0] = pb[col]; gq[j][1] = pb[512 + col]; gq[j][2] = pb[1024 + col]; } else { gq[j][0] = 0.f; gq[j][1] = 0.f; gq[j][2] = 0.f; }
            cst[j][0] = mu[col]; cst[j][1] = mu[512 + col]; cst[j][2] = mu[1024 + col]; cst[j][3] = w0[col]; cst[j][4] = a0[col]; cst[j][5] = k_k[col]; cst[j][6] = k_a[col]; cst[j][7] = r_k[col]; }
        { LAS unsigned char* dst = part < 2 ? lds + R1_LW + (t0s * 72 + 32 * part) * 2 : (part < 4 ? lds + R1_LA + (t0s * 72 + 32 * (part - 2)) * 2 : lds + R1_LG + (t0s * 136 + 32 * (part - 4)) * 2);
          LAS const float* mul = LP(const float, lds + R1_MUL) + 32 * part;
#pragma unroll
          for (int e8 = 0; e8 < 4; ++e8) { float x[8];
#pragma unroll
              for (int e = 0; e < 2; ++e) { const unsigned pa_ = e ? lp[e8].z : lp[e8].x, pb_ = e ? lp[e8].w : lp[e8].y, qa_ = e ? lq[e8].z : lq[e8].x, qb_ = e ? lq[e8].w : lq[e8].y;
                  const f32x4 pv = {__uint_as_float(pa_ << 16), __uint_as_float(pa_ & 0xffff0000u), __uint_as_float(pb_ << 16), __uint_as_float(pb_ & 0xffff0000u)};
                  const f32x4 qv = pqz ? (f32x4){0.f, 0.f, 0.f, 0.f} : (f32x4){__uint_as_float(qa_ << 16), __uint_as_float(qa_ & 0xffff0000u), __uint_as_float(qb_ << 16), __uint_as_float(qb_ & 0xffff0000u)};
                  const f32x4 m4 = *LP(const f32x4, mul + 8 * e8 + 4 * e);
                  const f32x4 xm = pv + (qv - pv) * m4;
#pragma unroll
                  for (int z = 0; z < 4; ++z) x[4 * e + z] = !v0 ? 0.f : (part < 2 ? tanh_fast(xm[z]) : (part < 4 ? xm[z] : fast_sigmoid(xm[z]))); }
              *LP(v4u, dst + e8 * 16) = (v4u){cvtpk(x[0], x[1]), cvtpk(x[2], x[3]), cvtpk(x[4], x[5]), cvtpk(x[6], x[7])}; }
        }
        bf16x8 bW[2][2], bA[2][2], bG[4][2];
#pragma unroll
        for (int j = 0; j < 2; ++j) { const int n = h * 64 + 16 * (tnb + j) + i;
#pragma unroll
            for (int s = 0; s < 2; ++s) { bW[s][j] = *(const bf16x8*)(W2t + (size_t)n * 64 + 32 * s + 8 * q); bA[s][j] = *(const bf16x8*)(A2t + (size_t)n * 64 + 32 * s + 8 * q); }
#pragma unroll
            for (int s = 0; s < 4; ++s) bG[s][j] = *(const bf16x8*)(G2t + (size_t)n * 128 + 32 * s + 8 * q); }
        __syncthreads();
        f32x4 aw[2], aa[2], ag[2];
#pragma unroll
        for (int j = 0; j < 2; ++j) { aw[j] = (f32x4){0.f, 0.f, 0.f, 0.f}; aa[j] = aw[j]; ag[j] = aw[j]; }
#pragma unroll
        for (int s = 0; s < 2; ++s) {
            const bf16x8 fw = *LP(const bf16x8, lds + R1_LW + ((16 * tm + i) * 72 + 32 * s + 8 * q) * 2), fa = *LP(const bf16x8, lds + R1_LA + ((16 * tm + i) * 72 + 32 * s + 8 * q) * 2);
#pragma unroll
            for (int j = 0; j < 2; ++j) { aw[j] = mfma16(fw, bW[s][j], aw[j]); aa[j] = mfma16(fa, bA[s][j], aa[j]); }
        }
#pragma unroll
        for (int s = 0; s < 4; ++s) {
            const bf16x8 fg = *LP(const bf16x8, lds + R1_LG + ((16 * tm + i) * 136 + 32 * s + 8 * q) * 2);
#pragma unroll
            for (int j = 0; j < 2; ++j) ag[j] = mfma16(fg, bG[s][j], ag[j]);
        }
        float xr[2][4], kp[2][4], xv[2][4], lw[2][4], av[2][4], kkr[2][4];
        float ssq[4] = {0.f, 0.f, 0.f, 0.f}, bsum[4] = {0.f, 0.f, 0.f, 0.f};
#pragma unroll
        for (int j = 0; j < 2; ++j) { const int n = 16 * (tnb + j) + i;
            const float mur = cst[j][0], muk = cst[j][1], muv = cst[j][2], w0c = cst[j][3], a0c = cst[j][4], kkc = cst[j][5], kac = cst[j][6], rkc = cst[j][7];
#pragma unroll
            for (int r = 0; r < 4; ++r) { const int t = 16 * tm + 4 * q + r; const bool valid = t < tval;
                const float pr = gp[j][r][0], pk = gp[j][r][1], pv = gp[j][r][2];
                const float qr = r ? gp[j][r - 1][0] : gq[j][0], qk = r ? gp[j][r - 1][1] : gq[j][1], qv = r ? gp[j][r - 1][2] : gq[j][2];
                const float r_ = pr + (qr - pr) * mur, k_ = pk + (qk - pk) * muk, v_ = pv + (qv - pv) * muv;
                const float wpre = w0c + aw[j][r];
                const float sp = fmaxf(-wpre, 0.f) + log1pf(__expf(-fabsf(wpre)));
                const float wlog = -sp - 0.5f;
                const float a_ = fast_sigmoid(a0c + aa[j][r]);
                const float kk_ = k_ * kkc, kp_ = k_ * (1.0f + (a_ - 1.0f) * kac);
                xr[j][r] = valid ? r_ : 0.f; kp[j][r] = valid ? kp_ : 0.f; xv[j][r] = valid ? v_ : 0.f; lw[j][r] = valid ? -__expf(wlog) : 0.f; av[j][r] = valid ? a_ : 0.f; kkr[j][r] = valid ? kk_ : 0.f;
                ssq[r] += kkr[j][r] * kkr[j][r]; bsum[r] += xr[j][r] * kp[j][r] * rkc;
            }
            *(f32x4*)(GG + (size_t)it * 4096 + frag_c(n, 16 * tm + 4 * q)) = ag[j]; }
#pragma unroll
        for (int r = 0; r < 4; ++r) {
#pragma unroll
            for (int o = 1; o < 16; o <<= 1) { ssq[r] += __shfl_xor(ssq[r], o); bsum[r] += __shfl_xor(bsum[r], o); }
            if (i == 0) { const int t = 16 * tm + 4 * q + r; RED[(t * 2 + (wave & 1)) * 2 + 0] = ssq[r]; RED[(t * 2 + (wave & 1)) * 2 + 1] = bsum[r]; } }
        float cin[2][4], exq[2];
#pragma unroll
        for (int j = 0; j < 2; ++j) { cin[j][0] = lw[j][0]; cin[j][1] = cin[j][0] + lw[j][1]; cin[j][2] = cin[j][1] + lw[j][2]; cin[j][3] = cin[j][2] + lw[j][3];
            const float tot = cin[j][3]; float ex = 0.f, wt = 0.f;
#pragma unroll
            for (int qq = 0; qq < 4; ++qq) { const float tq = __shfl(tot, i + 16 * qq); wt += tq; ex += qq < q ? tq : 0.f; }
            exq[j] = ex; if (q == 0) CS[tm * 64 + 16 * (tnb + j) + i] = wt; }
        for (int z = tid; z < 2304; z += NTHR) LP(unsigned, lds + R1_MB)[z] = 0u;
        __syncthreads();
        R1_RELANE();
#pragma unroll
        for (int j = 0; j < 2; ++j) { const int n = 16 * (tnb + j) + i, col = h * 64 + n; float tmex = 0.f, csT = 0.f;
#pragma unroll
            for (int z = 0; z < 4; ++z) { const float c_ = CS[z * 64 + n]; csT += c_; tmex += z < tm ? c_ : 0.f; }
            if (tm == 0 && q == 0) GTV[n] = __expf(csT);
            f32x4 vKapT, vVT, vBbT, vKbT, vBon;
#pragma unroll
            for (int r = 0; r < 4; ++r) { const int t = 16 * tm + 4 * q + r;
                const float cst = tmex + exq[j] + cin[j][r], csp = cst - lw[j][r];
                const float sq = RED[(t * 2 + 0) * 2 + 0] + RED[(t * 2 + 1) * 2 + 0], bt = RED[(t * 2 + 0) * 2 + 1] + RED[(t * 2 + 1) * 2 + 1];
                const float kk_ = kkr[j][r] * (1.0f / sqrtf(fmaxf(sq, 1e-24f))), b_ = kk_ * av[j][r];
                const float gt = __expf(cst), gi = __expf(-cst), gp = __expf(csp), ge = __expf(csT - cst);
                LP(u16, lds + R1_RT)[t * 72 + n] = (u16)f2bf(xr[j][r] * gt);
                LP(u16, lds + R1_KH)[t * 72 + n] = (u16)f2bf(kp[j][r] * gi);
                LP(u16, lds + R1_BH)[t * 72 + n] = (u16)f2bf(b_ * gi);
                LP(u16, lds + R1_KAP)[t * 72 + n] = (u16)f2bf(kk_ * gp);
                vKapT[r] = kk_ * gp; vVT[r] = xv[j][r]; vBbT[r] = b_ * ge; vKbT[r] = kp[j][r] * ge;
                vBon[r] = bt * xv[j][r];
                asm volatile("" ::: "memory");
            }
            const int t0 = 16 * tm + 4 * q;
            *(f32x4*)(BON + (size_t)it * 4096 + frag_c(n, t0)) = vBon;
            st_tr(lds + R1_KAPT, vKapT, n, t0); st_tr(lds + R1_VT, vVT, n, t0); st_tr(lds + R1_BBT, vBbT, n, t0); st_tr(lds + R1_KBT, vKbT, n, t0);
            asm volatile("" ::: "memory");
        }
        __syncthreads();
        R1_RELANE();
        { f32x4 c1[2], c2[2];
#pragma unroll
          for (int j = 0; j < 2; ++j) { c1[j] = (f32x4){0.f, 0.f, 0.f, 0.f}; c2[j] = c1[j]; }
          mm64(c1, lds + R1_KAP, lds + R1_BH, tm, tnb, lane); mm64(c2, lds + R1_KAP, lds + R1_KH, tm, tnb, lane);
#pragma unroll
          for (int j = 0; j < 2; ++j) { const int ic = 16 * (tnb + j) + i;
#pragma unroll
              for (int r = 0; r < 4; ++r) { const int t = 16 * tm + 4 * q + r;
                  ABKF[t * 65 + ic] = ic < t ? c1[j][r] : 0.f;
                  LP(u16, lds + R1_AKK)[t * 72 + ic] = (u16)f2bf(ic < t ? c2[j][r] : 0.f); } }
        }
        asm volatile("" ::: "memory");
        { f32x4 c3[2], c4[2];
#pragma unroll
          for (int j = 0; j < 2; ++j) { c3[j] = (f32x4){0.f, 0.f, 0.f, 0.f}; c4[j] = c3[j]; }
          mm64(c3, lds + R1_RT, lds + R1_BH, tm, tnb, lane);  mm64(c4, lds + R1_RT, lds + R1_KH, tm, tnb, lane);
#pragma unroll
          for (int j = 0; j < 2; ++j) { const int ic = 16 * (tnb + j) + i;
#pragma unroll
              for (int r = 0; r < 4; ++r) { const int t = 16 * tm + 4 * q + r;
                  LP(u16, lds + R1_ABR)[t * 72 + ic] = (u16)f2bf(ic <= t ? c3[j][r] : 0.f);
                  LP(u16, lds + R1_AKR)[t * 72 + ic] = (u16)f2bf(ic <= t ? c4[j][r] : 0.f); } }
        }
        __syncthreads();
#ifndef R1REP4
#define R1REP4 1
#endif
#pragma unroll 1
        for (int rep4 = 0; rep4 < R1REP4; ++rep4) {
        R1_RELANE();
        if (wave == 0) { const int g = q, c = i; float m[16];
#pragma unroll
            for (int ii = 0; ii < 16; ++ii) { float acc = ii == c ? 1.f : 0.f;
#pragma unroll
                for (int jj = 0; jj < ii; ++jj) acc -= ABKF[(16 * g + ii) * 65 + 16 * g + jj] * m[jj];
                m[ii] = acc; MF[(16 * g + ii) * 65 + 16 * g + c] = acc; LP(u16, lds + R1_MB)[(16 * g + ii) * 72 + 16 * g + c] = (u16)f2bf(acc); } }
        __syncthreads();
#define BLK(P, bi, bj) ((P) + (16 * (bi)) * 65 + 16 * (bj))
#define PUTM(bi, bj, acc) do { _Pragma("unroll") for (int r = 0; r < 4; ++r) { MF[(16 * (bi) + 4 * q + r) * 65 + 16 * (bj) + i] = -(acc)[r]; LP(u16, lds + R1_MB)[(16 * (bi) + 4 * q + r) * 72 + 16 * (bj) + i] = (u16)f2bf(-(acc)[r]); } } while (0)
        { LAS float* T = LP(float, lds + R1_T16) + wave * 272; const f32x4 z4 = {0.f, 0.f, 0.f, 0.f};
          if (wave < 3) { const int bi = wave + 1, bj = wave; f32x4 t = prod16(z4, BLK(ABKF, bi, bj), 65, BLK(MF, bj, bj), 65, lane);
#pragma unroll
              for (int r = 0; r < 4; ++r) T[(4 * q + r) * 17 + i] = t[r];
              f32x4 mres = prod16(z4, BLK(MF, bi, bi), 65, T, 17, lane); PUTM(bi, bj, mres); }
          __syncthreads();
          if (wave < 2) { const int bi = wave + 2, bj = wave; f32x4 t = prod16(z4, BLK(ABKF, bi, bj), 65, BLK(MF, bj, bj), 65, lane); t = prod16(t, BLK(ABKF, bi, bj + 1), 65, BLK(MF, bj + 1, bj), 65, lane);
#pragma unroll
              for (int r = 0; r < 4; ++r) T[(4 * q + r) * 17 + i] = t[r];
              f32x4 mres = prod16(z4, BLK(MF, bi, bi), 65, T, 17, lane); PUTM(bi, bj, mres); }
          __syncthreads();
          if (wave == 0) { f32x4 t = prod16(z4, BLK(ABKF, 3, 0), 65, BLK(MF, 0, 0), 65, lane); t = prod16(t, BLK(ABKF, 3, 1), 65, BLK(MF, 1, 0), 65, lane); t = prod16(t, BLK(ABKF, 3, 2), 65, BLK(MF, 2, 0), 65, lane);
#pragma unroll
              for (int r = 0; r < 4; ++r) T[(4 * q + r) * 17 + i] = t[r];
              f32x4 mres = prod16(z4, BLK(MF, 3, 3), 65, T, 17, lane); PUTM(3, 0, mres); }
          __syncthreads();
        }
#undef BLK
#undef PUTM
        }
#ifndef R1REP5
#define R1REP5 1
#endif
#pragma unroll 1
        for (int rep5 = 0; rep5 < R1REP5; ++rep5) {
            if (rep5) __syncthreads();
        R1_RELANE();
        { f32x4 cg[2], cw[2];
#pragma unroll
          for (int j = 0; j < 2; ++j) { cg[j] = (f32x4){0.f, 0.f, 0.f, 0.f}; cw[j] = cg[j]; }
          mm64(cg, lds + R1_AKK, lds + R1_VT, tm, tnb, lane); mm64(cw, lds + R1_MB, lds + R1_KAPT, tm, tnb, lane);
#pragma unroll
          for (int j = 0; j < 2; ++j) { const int n = 16 * (tnb + j) + i; st_tr(lds + R1_GT, cg[j], n, t0); st_tr(lds + R1_WT, cw[j], n, t0); } }
        __syncthreads();
        R1_RELANE();
        { f32x4 cu[2];
#pragma unroll
          for (int j = 0; j < 2; ++j) cu[j] = (f32x4){0.f, 0.f, 0.f, 0.f};
          mm64(cu, lds + R1_MB, lds + R1_GT, tm, tnb, lane);
#pragma unroll
          for (int j = 0; j < 2; ++j) st_tr(lds + R1_UT, cu[j], 16 * (tnb + j) + i, t0); }
        asm volatile("" ::: "memory");
        { f32x4 cq[2], cp[2];
#pragma unroll
          for (int j = 0; j < 2; ++j) { cq[j] = (f32x4){0.f, 0.f, 0.f, 0.f}; cp[j] = cq[j]; }
          mm64(cq, lds + R1_ABR, lds + R1_WT, tm, tnb, lane); mm64(cp, lds + R1_BBT, lds + R1_WT, tm, tnb, lane);
          bf16* QT = (bf16*)(ws + WS_QT) + (size_t)it * 4096; bf16* PT = (bf16*)(ws + WS_PT) + (size_t)it * 4096;
#pragma unroll
          for (int j = 0; j < 2; ++j) { const int n = 16 * (tnb + j) + i;
#pragma unroll
              for (int r = 0; r < 4; ++r) { const int t = t0 + r;
                  QT[frag_a(t, n)] = (bf16)f2bf(bf2f(LP(u16, lds + R1_RT)[t * 72 + n]) - cq[j][r]);
                  PT[frag_a(t, n)] = (bf16)f2bf((t == n ? GTV[n] : 0.f) - cp[j][r]); } } }
        __syncthreads();
        R1_RELANE();
        { f32x4 c1[2], c2[2];
#pragma unroll
          for (int j = 0; j < 2; ++j) { c1[j] = (f32x4){0.f, 0.f, 0.f, 0.f}; c2[j] = c1[j]; }
          mm64(c1, lds + R1_AKR, lds + R1_VT, tm, tnb, lane); mm64(c2, lds + R1_ABR, lds + R1_UT, tm, tnb, lane);
          float* OT = (float*)(ws + WS_OT) + (size_t)it * 4096;
#pragma unroll
          for (int j = 0; j < 2; ++j) { const int n = 16 * (tnb + j) + i;
              *(f32x4*)(OT + frag_c(n, t0)) = c1[j] - c2[j]; } }
        asm volatile("" ::: "memory");
        { f32x4 c3[2], c4[2];
#pragma unroll
          for (int j = 0; j < 2; ++j) { c3[j] = (f32x4){0.f, 0.f, 0.f, 0.f}; c4[j] = c3[j]; }
          mm64(c3, lds + R1_KBT, lds + R1_VT, tm, tnb, lane); mm64(c4, lds + R1_BBT, lds + R1_UT, tm, tnb, lane);
          float* HT = (float*)(ws + WS_HT) + (size_t)it * 4096;
#pragma unroll
          for (int j = 0; j < 2; ++j) { const int n = 16 * (tnb + j) + i;
              *(f32x4*)(HT + frag_c(n, t0)) = c3[j] - c4[j]; } }
        }
        __syncthreads();
    }
}

struct R2St { bf16x8 pa[4][2]; f32x4 hh[4]; };
__device__ __forceinline__ void r2_load(R2St& o, const unsigned char* ws, int it, int lane, int vs) {
    const bf16* PT = (const bf16*)(ws + WS_PT) + (size_t)it * 4096; const float* HT = (const float*)(ws + WS_HT) + (size_t)it * 4096;
#pragma unroll
    for (int tt = 0; tt < 4; ++tt) {
#pragma unroll
        for (int s = 0; s < 2; ++s) o.pa[tt][s] = *(const bf16x8*)(PT + ((tt * 2 + s) * 64 + lane) * 8);
        o.hh[tt] = *(const f32x4*)(HT + ((vs * 4 + tt) * 64 + lane) * 4);
    }
}
__device__ __forceinline__ void r2_step(const R2St& r, f32x4 (&S)[4], unsigned char* ws, int it, int vs, int lane) {
    bf16x8 bs[2];
#pragma unroll
    for (int s = 0; s < 2; ++s) { v4u w; w.x = cvtpk(S[2 * s][0], S[2 * s][1]); w.y = cvtpk(S[2 * s][2], S[2 * s][3]); w.z = cvtpk(S[2 * s + 1][0], S[2 * s + 1][1]); w.w = cvtpk(S[2 * s + 1][2], S[2 * s + 1][3]); bs[s] = __builtin_bit_cast(bf16x8, w);
        *(v4u*)(ws + WS_SC + (size_t)it * 8192 + (size_t)((vs * 2 + s) * 64 + lane) * 16) = w; }
#pragma unroll
    for (int kt = 0; kt < 4; ++kt) { f32x4 acc = r.hh[kt];
#pragma unroll
        for (int s = 0; s < 2; ++s) acc = mfma16(r.pa[kt][s], bs[s], acc);
        S[kt] = acc; }
}
__device__ __forceinline__ void ph_rwkv2(const Frame& F0, const Args& a, int l) {
    const Frame F = relaunder(F0);
    unsigned char* ws = a.ws;
    const int lane = F.lane, i = lane & 15, q = lane >> 4;
    for (int slot = F.vcu * NWAVES + F.wave; slot < 2048; slot += F.G * NWAVES) {
        int nchunk, item0, h, vs; float* sout; f32x4 S[4];
        if ((slot & 15) == 0) { const int pu = slot >> 4; const int s = pu >> 5; h = (pu >> 2) & 7; vs = pu & 3; nchunk = SEQ / 64; item0 = s * 1024 + h;
            sout = a.out + OFF_WKVP + ((size_t)(l * NB + s) * HB + h) * 4096;
#pragma unroll
            for (int kt = 0; kt < 4; ++kt) S[kt] = (f32x4){0.f, 0.f, 0.f, 0.f}; }
        else { const int d = slot - (slot >> 4) - 1; if (d >= DECB * HB * 4) continue; const int b = d >> 5; h = (d >> 2) & 7; vs = d & 3; nchunk = 1; item0 = NITEM_P + b * 8 + h;
            sout = a.out + OFF_WKVS + ((size_t)(l * DECB + b) * HB + h) * 4096;
            const float* sin = a.in[I_SWKV] + ((size_t)(l * DECB + b) * HB + h) * 4096 + (16 * vs + i) * 64 + 4 * q;
#pragma unroll
            for (int kt = 0; kt < 4; ++kt) S[kt] = *(const f32x4*)(sin + 16 * kt); }
        const int v = 16 * vs + i;
        const int itl = item0 + 8 * (nchunk - 1);
        R2St r0, r1, r2;
        r2_load(r0, ws, item0, lane, vs);
        r2_load(r1, ws, min(item0 + 8, itl), lane, vs);
        r2_load(r2, ws, min(item0 + 16, itl), lane, vs);
        int c = 0;
#pragma unroll 1
        for (; c + 3 <= nchunk; c += 3) {
            const int it = item0 + 8 * c;
            r2_step(r0, S, ws, it, vs, lane);      r2_load(r0, ws, min(it + 24, itl), lane, vs);
            r2_step(r1, S, ws, it + 8, vs, lane);  r2_load(r1, ws, min(it + 32, itl), lane, vs);
            r2_step(r2, S, ws, it + 16, vs, lane); r2_load(r2, ws, min(it + 40, itl), lane, vs);
        }
        if (c < nchunk) { r2_step(r0, S, ws, item0 + 8 * c, vs, lane); ++c; }
        if (c < nchunk) { r2_step(r1, S, ws, item0 + 8 * c, vs, lane); ++c; }
#pragma unroll
        for (int kt = 0; kt < 4; ++kt) *(f32x4*)(sout + (size_t)v * 64 + 16 * kt + 4 * q) = S[kt];
    }
}
__device__ __forceinline__ void ph_rwkv3(const Frame& F0, const Args& a, int l) {
    const Frame F = relaunder(F0);
    const unsigned char* ws = a.ws;
    bf16* YB = (bf16*)(a.ws + WS_YAB) + (size_t)M * 512; const float* lg = a.in[I_LNXG] + l * 512; const float* lb = a.in[I_LNXB] + l * 512;
    const int lane = F.lane, i = lane & 15, q = lane >> 4;
    LAS unsigned char* st = F.lds + F.wave * 9216;
    for (int it = F.vcu * NWAVES + F.wave; it < NITEM; it += F.G * NWAVES) {
        const bool dec = it >= NITEM_P; int h, row0, ntt;
        if (!dec) { const int s = it >> 10, c = (it >> 3) & 127; h = it & 7; row0 = s * SEQ + 64 * c; ntt = 4; }
        else { const int b = (it - NITEM_P) >> 3; h = it & 7; row0 = MP + DECS * b; ntt = 2; }
        const bf16* QT = (const bf16*)(ws + WS_QT) + (size_t)it * 4096; const float* OT = (const float*)(ws + WS_OT) + (size_t)it * 4096;
        const float* GG = (const float*)(ws + WS_GG) + (size_t)it * 4096; const float* BON = (const float*)(ws + WS_BON) + (size_t)it * 4096;
        bf16x8 bfr[4][2];
#pragma unroll
        for (int vs = 0; vs < 4; ++vs)
#pragma unroll
            for (int s = 0; s < 2; ++s) bfr[vs][s] = *(const bf16x8*)(ws + WS_SC + (size_t)it * 8192 + (size_t)((vs * 2 + s) * 64 + lane) * 16);
        float lgv[4], lbv[4];
#pragma unroll
        for (int vs = 0; vs < 4; ++vs) { lgv[vs] = lg[h * 64 + 16 * vs + i]; lbv[vs] = lb[h * 64 + 16 * vs + i]; }
#pragma unroll
        for (int tt = 0; tt < 4; ++tt) if (tt < ntt) {
            bf16x8 af[2];
#pragma unroll
            for (int s = 0; s < 2; ++s) af[s] = *(const bf16x8*)(QT + ((tt * 2 + s) * 64 + lane) * 8);
            f32x4 acc[4];
#pragma unroll
            for (int vs = 0; vs < 4; ++vs) { acc[vs] = *(const f32x4*)(OT + ((vs * 4 + tt) * 64 + lane) * 4); acc[vs] = mfma16(af[0], bfr[vs][0], acc[vs]); acc[vs] = mfma16(af[1], bfr[vs][1], acc[vs]); }
            f32x4 sm = (acc[0] + acc[1]) + (acc[2] + acc[3]);
#pragma unroll
            for (int o = 1; o < 16; o <<= 1) { sm[0] += __shfl_xor(sm[0], o); sm[1] += __shfl_xor(sm[1], o); sm[2] += __shfl_xor(sm[2], o); sm[3] += __shfl_xor(sm[3], o); }
            const f32x4 mean = sm * (1.f / 64.f);
            f32x4 s2 = {0.f, 0.f, 0.f, 0.f};
#pragma unroll
            for (int vs = 0; vs < 4; ++vs) { acc[vs] = acc[vs] - mean; s2 += acc[vs] * acc[vs]; }
#pragma unroll
            for (int o = 1; o < 16; o <<= 1) { s2[0] += __shfl_xor(s2[0], o); s2[1] += __shfl_xor(s2[1], o); s2[2] += __shfl_xor(s2[2], o); s2[3] += __shfl_xor(s2[3], o); }
            f32x4 rstd;
#pragma unroll
            for (int r = 0; r < 4; ++r) rstd[r] = 1.0f / sqrtf(s2[r] * (1.f / 64.f) + GN_EPS);
#pragma unroll
            for (int vs = 0; vs < 4; ++vs) { const int v = 16 * vs + i;
                const f32x4 bn = *(const f32x4*)(BON + ((vs * 4 + tt) * 64 + lane) * 4), gg = *(const f32x4*)(GG + ((vs * 4 + tt) * 64 + lane) * 4);
                const f32x4 y = (acc[vs] * rstd * lgv[vs] + lbv[vs] + bn) * gg;
#pragma unroll
                for (int r = 0; r < 4; ++r) LP(u16, st)[(16 * tt + 4 * q + r) * 72 + v] = (u16)f2bf(y[r]); }
        }
        if (lane < 16 * ntt) {
            bf16* yrow = YB + (size_t)(row0 + lane) * 512 + h * 64;
#pragma unroll
            for (int c8 = 0; c8 < 8; ++c8) *(v4u*)(yrow + 8 * c8) = *LP(const v4u, st + (lane * 72 + 8 * c8) * 2);
        }
    }
}
constexpr int NPH_LAYER = 14, NPH = 2 + DEPTH * NPH_LAYER;
#ifndef MK_LAUNCH_PER_PHASE
#define MK_LAUNCH_PER_PHASE 0
#endif
typedef const __attribute__((address_space(4))) Args* KArgsPtr;
__device__ __forceinline__ const Args& kargs() { KArgsPtr p = (KArgsPtr)__builtin_amdgcn_kernarg_segment_ptr(); asm volatile("" : "+s"(p)); return *(const Args*)p; }
template <unsigned PHMASK> __global__ void __launch_bounds__(NTHR, 2) fwd(Args args_unused) {
    extern __shared__ __attribute__((aligned(16))) unsigned char lds_raw[];
    Frame F;
    F.lds = (LAS unsigned char*)lds_raw;
    F.tid = 0; F.lane = 0; F.wave = __builtin_amdgcn_readfirstlane((int)threadIdx.x >> 6);
    F.G = gridDim.x; { const int bx = blockIdx.x; F.vcu = (F.G % 8 == 0) ? (bx % 8) * (F.G / 8) + bx / 8 : bx; }
    volatile LAS unsigned* MISC = (volatile LAS unsigned*)(F.lds + LDSCTL_OFF);
    for (int u = threadIdx.x; u < (LDS_BYTES - LDSCTL_OFF) / 4; u += NTHR) ((LAS unsigned*)(F.lds + LDSCTL_OFF))[u] = 0u;
    __syncthreads();
    int lo, hi; { const Args& a = kargs(); lo = a.ph_lo; hi = a.ph_hi; }
    XcdBarrier bar; { const Args& a = kargs(); bar.bar = (unsigned*)(a.ws + WS_CTL) + CW_BAR; } bar.x = 0; bar.st = nullptr;
    if (hi - lo > 1) bar = xcd_barrier_post(bar.bar, MISC + 8);
    bar.wave = F.wave;
#define IN(k) (lo <= (k) && (k) < hi)
#define ON(n, k) (((PHMASK >> (n)) & 1u) && IN(k))
#define SEAM(k) do { if (IN(k) && IN((k) + 1)) xcd_barrier(bar); } while (0)
#define WSP(T, off) ((T*)(a.ws + (off)))
#ifndef REP_MASK
#define REP_MASK 0u
#endif
#define REPS(n) ((((REP_MASK) >> (n)) & 1u) ? 2 : 1)
    if (ON(14, 0)) { const Args& a = kargs(); ph_prologue(F, a); } SEAM(0);
    if (ON(15, 1)) { const Args& a = kargs(); ph_ln(F, a.in[I_XP], a.in[I_XS], nullptr, 0.f, nullptr, nullptr, nullptr, WSP(float, WS_MOD), nullptr, WSP(bf16, WS_U)); } SEAM(1);
#pragma unroll 1
    for (int l = 0; l < DEPTH; ++l) {
        const int pb = 2 + l * NPH_LAYER;
        const size_t wlo = WS_W + (size_t)l * WL_SIZE, modo = WS_MOD + (size_t)l * NSEQ * 9216 * 4;
        for (int rep_ = 0; rep_ < REPS(0); ++rep_) if (ON(0, pb + 0)) { if (rep_) xcd_barrier(bar); const Args& a = kargs(); pg8::Gemm g{WSP(bf16, WS_U), WSP(const bf16, wlo + WL_GU0), M, NGU, D}; pg8::StaticOrder S; S.init(M, NGU, opq(F.G), opq((int)blockIdx.x)); pg8::EpiSwiglu E{WSP(bf16, WS_ACT), DFF};
            pg8::gemm_phase<pg8::EpiSwiglu, pg8::StaticOrder, true, true>(F.lds, g, S, E, opq(F.wave)); } SEAM(pb + 0);
        for (int rep_ = 0; rep_ < REPS(1); ++rep_) if (ON(1, pb + 1)) { if (rep_) xcd_barrier(bar); const Args& a = kargs(); pg8::Gemm g{WSP(bf16, WS_ACT), WSP(const bf16, wlo + WL_DN0), M, D, DFF}; pg8::StaticOrder S; S.init(M, D, opq(F.G), opq((int)blockIdx.x)); pg8::EpiF32 E{WSP(float, WS_F), D};
            pg8::gemm_phase<pg8::EpiF32, pg8::StaticOrder, true, true>(F.lds, g, S, E, opq(F.wave)); } SEAM(pb + 1);
        for (int rep_ = 0; rep_ < REPS(2); ++rep_) if (ON(2, pb + 2)) { if (rep_) xcd_barrier(bar); const Args& a = kargs(); const float* modl = WSP(float, modo);
            ph_ln(F, l == 0 ? a.in[I_XP] : a.out, l == 0 ? a.in[I_XS] : nullptr, WSP(float, WS_F), 0.5f, modl + 2 * D, a.in[I_LNG] + (l * 3 + 0) * D, a.in[I_LNB] + (l * 3 + 0) * D, modl + 3 * D, a.out, WSP(bf16, WS_U)); } SEAM(pb + 2);
        for (int rep_ = 0; rep_ < REPS(3); ++rep_) if (ON(3, pb + 3)) { if (rep_) xcd_barrier(bar); const Args& a = kargs(); pg8::Gemm g{WSP(bf16, WS_U), WSP(const bf16, wlo + WL_IG), M, NIG, D}; pg8::StaticOrder S; S.init(M, NIG, opq(F.G), opq((int)blockIdx.x));
            pg8::EpiProj E{WSP(bf16, WS_Q), WSP(bf16, WS_KB), WSP(bf16, WS_VB), WSP(float, WS_PRW), WSP(bf16, WS_PLB), WSP(bf16, WS_GATES), a.in[I_BGATE] + l * 2048,
                a.out + OFF_KP + (size_t)l * MP * 512, a.out + OFF_VP + (size_t)l * MP * 512, a.out + OFF_KS + (size_t)l * MD * 512, a.out + OFF_VS + (size_t)l * MD * 512,
                a.out + OFF_SHP + (size_t)l * NB * NRW, a.out + OFF_SHS + (size_t)l * DECB * NRW, QSCALE};
            pg8::gemm_phase<pg8::EpiProj, pg8::StaticOrder, true, true>(F.lds, g, S, E, opq(F.wave)); } SEAM(pb + 3);
        for (int rep_ = 0; rep_ < REPS(4); ++rep_) if (ON(4, pb + 4)) { if (rep_) xcd_barrier(bar); const Args& a = kargs(); ph_rwkv1(F, a, l); } SEAM(pb + 4);
        for (int rep_ = 0; rep_ < REPS(5); ++rep_) if (ON(5, pb + 5)) { if (rep_) xcd_barrier(bar); const Args& a = kargs(); ph_rwkv2(F, a, l); } SEAM(pb + 5);
        for (int rep_ = 0; rep_ < REPS(6); ++rep_) if (ON(6, pb + 6)) { if (rep_) xcd_barrier(bar); const Args& a = kargs();
            AttnP P{WSP(bf16, WS_Q), WSP(bf16, WS_KB), WSP(bf16, WS_VB), a.in[I_CK] + (size_t)l * DECB * PAST * 512, a.in[I_CV] + (size_t)l * DECB * PAST * 512, WSP(bf16, WS_YAB), a.in[I_RELB], a.in[I_SUBG] + l * 128,
                    WSP(float, WS_LAM)[l], 1.0f - (0.8f - 0.6f * expf(-0.3f * (float)l))};
            ph_attn(F, P); } SEAM(pb + 6);
        for (int rep_ = 0; rep_ < REPS(7); ++rep_) if (ON(7, pb + 7)) { if (rep_) xcd_barrier(bar); const Args& a = kargs(); ph_rwkv3(F, a, l); } SEAM(pb + 7);
        for (int rep_ = 0; rep_ < REPS(8); ++rep_) if (ON(8, pb + 8)) { if (rep_) xcd_barrier(bar); const Args& a = kargs(); pg8::Gemm g{WSP(bf16, WS_YAB), WSP(const bf16, wlo + WL_BR), 2 * M, 2048, 512}; pg8::PairOrder S{NPAN * 4, opq(F.G), opq((int)blockIdx.x), NPAN}; pg8::EpiMerge E{WSP(float, WS_F), WSP(bf16, WS_MERGED), WSP(bf16, WS_GATES), NPAN};
            pg8::gemm_phase<pg8::EpiMerge, pg8::PairOrder, true, true>(F.lds, g, S, E, opq(F.wave)); } SEAM(pb + 8);
        for (int rep_ = 0; rep_ < REPS(9); ++rep_) if (ON(9, pb + 9)) { if (rep_) xcd_barrier(bar); const Args& a = kargs(); pg8::Gemm g{WSP(bf16, WS_MERGED), WSP(const bf16, wlo + WL_O), M, D, D}; pg8::StaticOrder S; S.init(M, D, opq(F.G), opq((int)blockIdx.x)); pg8::EpiF32 E{WSP(float, WS_F), D};
            pg8::gemm_phase<pg8::EpiF32, pg8::StaticOrder, true, true>(F.lds, g, S, E, opq(F.wave)); } SEAM(pb + 9);
        for (int rep_ = 0; rep_ < REPS(10); ++rep_) if (ON(10, pb + 10)) { if (rep_) xcd_barrier(bar); const Args& a = kargs(); const float* modl = WSP(float, modo);
            ph_ln(F, a.out, nullptr, WSP(float, WS_F), 1.0f, modl + 5 * D, a.in[I_LNG] + (l * 3 + 1) * D, a.in[I_LNB] + (l * 3 + 1) * D, modl + 6 * D, a.out, WSP(bf16, WS_U)); } SEAM(pb + 10);
        for (int rep_ = 0; rep_ < REPS(11); ++rep_) if (ON(11, pb + 11)) { if (rep_) xcd_barrier(bar); const Args& a = kargs(); pg8::Gemm g{WSP(bf16, WS_U), WSP(const bf16, wlo + WL_GU1), M, NGU, D}; pg8::StaticOrder S; S.init(M, NGU, opq(F.G), opq((int)blockIdx.x)); pg8::EpiSwiglu E{WSP(bf16, WS_ACT), DFF};
            pg8::gemm_phase<pg8::EpiSwiglu, pg8::StaticOrder, true, true>(F.lds, g, S, E, opq(F.wave)); } SEAM(pb + 11);
        for (int rep_ = 0; rep_ < REPS(12); ++rep_) if (ON(12, pb + 12)) { if (rep_) xcd_barrier(bar); const Args& a = kargs(); pg8::Gemm g{WSP(bf16, WS_ACT), WSP(const bf16, wlo + WL_DN1), M, D, DFF}; pg8::StaticOrder S; S.init(M, D, opq(F.G), opq((int)blockIdx.x)); pg8::EpiF32 E{WSP(float, WS_F), D};
            pg8::gemm_phase<pg8::EpiF32, pg8::StaticOrder, true, true>(F.lds, g, S, E, opq(F.wave)); } SEAM(pb + 12);
        for (int rep_ = 0; rep_ < REPS(13); ++rep_) if (ON(13, pb + 13)) { if (rep_) xcd_barrier(bar); const Args& a = kargs(); const float* modl = WSP(float, modo);
            ph_ln(F, a.out, nullptr, WSP(float, WS_F), 0.5f, modl + 8 * D, a.in[I_LNG] + (l * 3 + 2) * D, a.in[I_LNB] + (l * 3 + 2) * D, l + 1 < DEPTH ? modl + (size_t)NSEQ * 9216 : nullptr, a.out, WSP(bf16, WS_U)); } SEAM(pb + 13);
    }
#undef IN
#undef ON
#undef SEAM
#undef WSP
}

#if MK_LAUNCH_PER_PHASE
static const void* phase_fn(int k) {
    switch (k) { case 0: return (const void*)fwd<1u << 0>; case 1: return (const void*)fwd<1u << 1>; case 2: return (const void*)fwd<1u << 2>; case 3: return (const void*)fwd<1u << 3>;
        case 4: return (const void*)fwd<1u << 4>; case 5: return (const void*)fwd<1u << 5>; case 6: return (const void*)fwd<1u << 6>; case 7: return (const void*)fwd<1u << 7>;
        case 8: return (const void*)fwd<1u << 8>; case 9: return (const void*)fwd<1u << 9>; case 10: return (const void*)fwd<1u << 10>; case 11: return (const void*)fwd<1u << 11>;
        case 12: return (const void*)fwd<1u << 12>; case 13: return (const void*)fwd<1u << 13>; case 14: return (const void*)fwd<1u << 14>; default: return (const void*)fwd<1u << 15>; }
}
#else
#ifndef FULL_MASK
#define FULL_MASK 0xFFFFu
#endif
static const void* phase_fn(int) { return (const void*)fwd<FULL_MASK>; }
#endif

extern "C" void kernel_launch(void* const* d_in, const int* in_sizes, int n_in, void* d_out, int out_size, void* d_ws, size_t ws_size, hipStream_t stream) {
    static int grid = 0;
    if (grid == 0) {
        if (n_in != 34 || (size_t)out_size != OUT_TOTAL || ws_size < WS_END) { fprintf(stderr, "kernel_launch: unexpected shapes: n_in %d out %d ws %zu (need %zu)\n", n_in, out_size, ws_size, (size_t)WS_END); grid = -1; return; }
        int dev = 0, cus = 0, per_cu = 0;
        if (hipGetDevice(&dev) != hipSuccess || hipDeviceGetAttribute(&cus, hipDeviceAttributeMultiprocessorCount, dev) != hipSuccess) { grid = -1; return; }
        for (int k = 0; k < 16; ++k) if (hipFuncSetAttribute(phase_fn(k), hipFuncAttributeMaxDynamicSharedMemorySize, LDS_BYTES) != hipSuccess) { fprintf(stderr, "kernel_launch: hipFuncSetAttribute failed\n"); grid = -1; return; }
        if (hipOccupancyMaxActiveBlocksPerMultiprocessor(&per_cu, phase_fn(15), NTHR, LDS_BYTES) != hipSuccess || per_cu < 1) fprintf(stderr, "kernel_launch: occupancy query reports %d\n", per_cu);
        (void)hipGetLastError();
        grid = cus;
    }
    if (grid < 0) return;
    (void)hipMemsetAsync((char*)d_ws + WS_CTL, 0, CTL_ZERO_BYTES, stream);
    Args a{};
    for (int i = 0; i < 34; ++i) a.in[i] = (const float*)d_in[i];
    a.out = (float*)d_out; a.ws = (unsigned char*)d_ws;
#if MK_LAUNCH_PER_PHASE
#ifndef MAXPH
#define MAXPH NPH
#endif
    for (int p = 0; p < MAXPH; ++p) { a.ph_lo = p; a.ph_hi = p + 1; const int kind = p < 2 ? 14 + p : (p - 2) % NPH_LAYER; void* kargs[] = {&a}; (void)hipLaunchKernel(phase_fn(kind), dim3(grid), dim3(NTHR), kargs, LDS_BYTES, stream); }
#else
    a.ph_lo = 0; a.ph_hi = NPH; { void* kargs[] = {&a}; (void)hipLaunchKernel(phase_fn(15), dim3(grid), dim3(NTHR), kargs, LDS_BYTES, stream); }
#endif
}
```

```cpp
#include <hip/hip_runtime.h>
#include <hip/hip_bf16.h>
#include <cstdio>
#include <cstdint>
#include <cmath>
namespace pg8 {
#define PG8_LAS __attribute__((address_space(3)))
typedef unsigned short bf16_t;
typedef short bf16x8 __attribute__((ext_vector_type(8)));
typedef float f32x4 __attribute__((ext_vector_type(4)));
typedef unsigned u32x4 __attribute__((ext_vector_type(4)));
constexpr int BM = 256, BK = 64, HALF = 128, HTB = HALF * BK * 2  , STAGE_BYTES = 8 * HTB, NXCD = 8, WGM = 8;

__host__ __device__ __forceinline__ int lds_byte(int r, int c) { const int st = (r >> 4) * 2 + (c >> 5), rr = r & 15, cc = c & 31, ob = rr * 64 + cc * 2; return st * 1024 + (ob ^ (((ob >> 9) & 1) << 5)); }
__host__ __device__ __forceinline__ void stage_rc(int b, int& R, int& C) { const int st = b / 1024, sb = b % 1024, swz = sb ^ (((sb >> 9) & 1) << 5); R = (st >> 1) * 16 + swz / 64; C = (st & 1) * 32 + (swz % 64) / 2; }
__host__ __device__ __forceinline__ int perm32(int rho) { const int n = rho >> 4, i = rho & 15; return 8 * (i >> 2) + 4 * n + (i & 3); }

struct Unit { int pm, pn, k0, ntk, ks; };
struct Gemm { const bf16_t* A; const bf16_t* Bt; int M, N, K; };

struct StaticOrder {
    int nM, nN, nwg, G, c;
    __host__ __device__ void init(int M, int N, int G_, int c_) { nM = M / BM; nN = N / BM; nwg = nM * nN; G = G_; c = c_; }
    __host__ __device__ bool next(int i, Unit& u) const {
        const long L = (long)i * G + c; if (L >= nwg) return false;
        int wgid = (int)L; { const int q = nwg / NXCD, r = nwg % NXCD, xcd = wgid % NXCD, off = wgid / NXCD; wgid = (xcd < r ? xcd * (q + 1) : r * (q + 1) + (xcd - r) * q) + off; }
        const int nig = WGM * nN, gid = wgid / nig, fm = gid * WGM, gsz = (nM - fm) < WGM ? (nM - fm) : WGM;
        u.pm = fm + ((wgid % nig) % gsz); u.pn = (wgid % nig) / gsz; u.k0 = 0; u.ntk = 0; u.ks = -1; return true;
    }
    __device__ __forceinline__ void a_ready(const Unit&) const {}
    __device__ __forceinline__ void done(const Unit&) const {}
};

typedef float f32x2c_t __attribute__((ext_vector_type(2))); typedef __bf16 bf16x2c_t __attribute__((ext_vector_type(2)));
__device__ __forceinline__ unsigned cvt_pk_bf16(float lo, float hi) { f32x2c_t v = {lo, hi}; bf16x2c_t b = __builtin_convertvector(v, bf16x2c_t); return __builtin_bit_cast(unsigned, b); }
typedef float f32x2 __attribute__((ext_vector_type(2)));
__device__ __forceinline__ float fast_sigmoid(float x) { return __builtin_amdgcn_rcpf(1.0f + __expf(-x)); }
struct EpiSwiglu {
    static constexpr bool PERM = true, AFTER_DRAIN = false;
    bf16_t* O; int ldc;
    __device__ __forceinline__ void operator()(const f32x4 (&acc)[2][2][4][2], const Unit& u, int wr, int wc, int fr, int fq) const {
        const int row0 = u.pm * BM + wr * 64 + fr; const int col0 = u.pn * 128 + wc * 32 + 8 * fq;
#pragma unroll
        for (int ai = 0; ai < 2; ++ai)
#pragma unroll
            for (int m = 0; m < 4; ++m) { bf16_t* rowp = O + (size_t)(row0 + ai * HALF + m * 16) * ldc + col0;
                float v[8];
#pragma unroll
                for (int n = 0; n < 2; ++n)
#pragma unroll
                    for (int e = 0; e < 4; ++e) { const float g = acc[ai][0][m][n][e], up = acc[ai][1][m][n][e]; v[n * 4 + e] = g * fast_sigmoid(g) * up; }
                u32x4 w; w.x = cvt_pk_bf16(v[0], v[1]); w.y = cvt_pk_bf16(v[2], v[3]); w.z = cvt_pk_bf16(v[4], v[5]); w.w = cvt_pk_bf16(v[6], v[7]);
                *(u32x4*)rowp = w; }
    }
};
struct EpiF32 {
    static constexpr bool PERM = false, AFTER_DRAIN = false;
    float* O; int ldc;
    __device__ __forceinline__ void operator()(const f32x4 (&acc)[2][2][4][2], const Unit& u, int wr, int wc, int fr, int fq) const {
        const int row0 = u.pm * BM + wr * 64 + fr; const int col0 = u.pn * BM + wc * 32 + 4 * fq;
#pragma unroll
        for (int ai = 0; ai < 2; ++ai)
#pragma unroll
            for (int m = 0; m < 4; ++m) { float* rowp = O + (size_t)(row0 + ai * HALF + m * 16) * ldc + col0;
#pragma unroll
                for (int bj = 0; bj < 2; ++bj)
#pragma unroll
                    for (int n = 0; n < 2; ++n) *(f32x4*)(rowp + bj * HALF + n * 16) = acc[ai][bj][m][n]; }
    }
};
struct EpiProj {
    static constexpr bool PERM = false, AFTER_DRAIN = false;
    bf16_t* Q; bf16_t* Kb; bf16_t* Vb; float* PRW; bf16_t* PLB; bf16_t* GATES; const float* bgate;
    float* outKp; float* outVp; float* outKs; float* outVs; float* outShp; float* outShs;
    float qscale;
    __device__ __forceinline__ void operator()(const f32x4 (&acc)[2][2][4][2], const Unit& u, int wr, int wc, int fr, int fq) const {
        const int row0 = u.pm * BM + wr * 64 + fr; const int pn = u.pn; const int cw = wc * 32 + 4 * fq;
        const bool prompt = u.pm < 128;
#pragma unroll
        for (int ai = 0; ai < 2; ++ai)
#pragma unroll
            for (int m = 0; m < 4; ++m) { const int row = row0 + ai * HALF + m * 16;
#pragma unroll
                for (int bj = 0; bj < 2; ++bj)
#pragma unroll
                    for (int n = 0; n < 2; ++n) { const f32x4 v = acc[ai][bj][m][n]; const int ct = bj * HALF + n * 16 + cw;
                        if (pn < 2) { const int c = pn * 256 + ct; typedef unsigned u32x2v __attribute__((ext_vector_type(2))); u32x2v w; w.x = cvt_pk_bf16(v[0] * qscale, v[1] * qscale); w.y = cvt_pk_bf16(v[2] * qscale, v[3] * qscale);
                            *(u32x2v*)(Q + (size_t)row * 512 + c) = w; }
                        else if (pn < 6) { const bool isk = pn < 4; const int c = (pn - (isk ? 2 : 4)) * 256 + ct; typedef unsigned u32x2v __attribute__((ext_vector_type(2))); u32x2v w; w.x = cvt_pk_bf16(v[0], v[1]); w.y = cvt_pk_bf16(v[2], v[3]);
                            *(u32x2v*)((isk ? Kb : Vb) + (size_t)row * 512 + c) = w;
                            float* o = prompt ? (isk ? outKp : outVp) + (size_t)row * 512 + c : (isk ? outKs : outVs) + (size_t)(row - 32768) * 512 + c;
                            *(f32x4*)o = v; }
                        else if (pn < 13) { const int c = (pn - 6) * 256 + ct; *(f32x4*)(PRW + (size_t)row * 1792 + c) = v;
                            if (pn == 12) { typedef unsigned u32x2v __attribute__((ext_vector_type(2))); u32x2v w; w.x = cvt_pk_bf16(v[0], v[1]); w.y = cvt_pk_bf16(v[2], v[3]); *(u32x2v*)(PLB + (size_t)row * 256 + ct) = w; }
                            if (prompt) { if ((row & 8191) == 8191) *(f32x4*)(outShp + (size_t)(row >> 13) * 1792 + c) = v; }
                            else { const int rd = row - 32768; if ((rd & 31) == 31) *(f32x4*)(outShs + (size_t)(rd >> 5) * 1792 + c) = v; } }
                        else { const int c = (pn - 13) * 256 + ct; const f32x4 b = *(const f32x4*)(bgate + c); typedef unsigned u32x2v __attribute__((ext_vector_type(2))); u32x2v w;
                            w.x = cvt_pk_bf16(fast_sigmoid(v[0] + b[0]), fast_sigmoid(v[1] + b[1])); w.y = cvt_pk_bf16(fast_sigmoid(v[2] + b[2]), fast_sigmoid(v[3] + b[3]));
                            *(u32x2v*)(GATES + (size_t)row * 2048 + c) = w; }
                    } }
    }
};
struct EpiMerge {
    static constexpr bool PERM = false, AFTER_DRAIN = false;
    float* TMP; bf16_t* OUT; const bf16_t* GATES; int npan;
    __device__ __forceinline__ void operator()(const f32x4 (&acc)[2][2][4][2], const Unit& u, int wr, int wc, int fr, int fq) const {
        const int which = u.pm >= npan ? 1 : 0; const int pm = u.pm - which * npan, pn = u.pn - which * 4;
        const int row0 = pm * BM + wr * 64 + fr; const int col0 = pn * BM + wc * 32 + 4 * fq;
        typedef unsigned u32x2v __attribute__((ext_vector_type(2)));
#pragma unroll
        for (int ai = 0; ai < 2; ++ai)
#pragma unroll
            for (int m = 0; m < 4; ++m) { const int row = row0 + ai * HALF + m * 16;
#pragma unroll
                for (int bj = 0; bj < 2; ++bj)
#pragma unroll
                    for (int n = 0; n < 2; ++n) { const int c = col0 + bj * HALF + n * 16; const f32x4 v = acc[ai][bj][m][n];
                        const u32x2v gw = *(const u32x2v*)(GATES + (size_t)row * 2048 + which * 1024 + c);
                        f32x4 g; g[0] = __uint_as_float(gw.x << 16); g[1] = __uint_as_float(gw.x & 0xffff0000u); g[2] = __uint_as_float(gw.y << 16); g[3] = __uint_as_float(gw.y & 0xffff0000u);
                        float* tp = TMP + (size_t)row * 1024 + c;
                        if (which == 0) { *(f32x4*)tp = g * v; }
                        else { const f32x4 t = *(const f32x4*)tp + g * v; u32x2v w; w.x = cvt_pk_bf16(t[0], t[1]); w.y = cvt_pk_bf16(t[2], t[3]); *(u32x2v*)(OUT + (size_t)row * 1024 + c) = w; }
                    } }
    }
};
struct SplitOrder {
    StaticOrder base; int G, c, nslice, nbase;
    __device__ __forceinline__ void init(int Mprompt, int N, int G_, int c_, int nslice_) { base.init(Mprompt, N, G_, c_); G = G_; c = c_; nslice = nslice_; nbase = c_ < base.nwg ? (base.nwg - c_ + G_ - 1) / G_ : 0; }
    __device__ __forceinline__ bool next(int i, Unit& u) const {
        if (i < nbase) return base.next(i, u);
        const int e = (i - nbase) * G + c; if (e >= 16 * nslice) return false;
        const int tile = e / nslice, sl = e - tile * nslice; u.pm = base.nM + (tile >> 2); u.pn = tile & 3; u.k0 = sl * 256; u.ntk = 4; u.ks = sl; return true;
    }
    __device__ __forceinline__ void a_ready(const Unit&) const {}
    __device__ __forceinline__ void done(const Unit&) const {}
};
struct EpiF32S {
    static constexpr bool PERM = true, AFTER_DRAIN = false;
    bf16_t* O; float* FP; int ldc, mprompt, mdec;
    __device__ __forceinline__ void operator()(const f32x4 (&acc)[2][2][4][2], const Unit& u, int wr, int wc, int fr, int fq) const {
        const int row0 = u.pm * BM + wr * 64 + fr; const int col0 = u.pn * BM + wc * 32 + 8 * fq;
        if (u.ks < 0) {
#pragma unroll
            for (int ai = 0; ai < 2; ++ai)
#pragma unroll
                for (int m = 0; m < 4; ++m) { bf16_t* rowp = O + (size_t)(row0 + ai * HALF + m * 16) * ldc + col0;
#pragma unroll
                    for (int bj = 0; bj < 2; ++bj) { const f32x4 v0 = acc[ai][bj][m][0], v1 = acc[ai][bj][m][1]; u32x4 w; w.x = cvt_pk_bf16(v0[0], v0[1]); w.y = cvt_pk_bf16(v0[2], v0[3]); w.z = cvt_pk_bf16(v1[0], v1[1]); w.w = cvt_pk_bf16(v1[2], v1[3]);
                        *(u32x4*)(rowp + bj * HALF) = w; } }
        } else {
            float* base = FP + ((size_t)u.ks * mdec + (row0 - mprompt)) * ldc;
#pragma unroll
            for (int ai = 0; ai < 2; ++ai)
#pragma unroll
                for (int m = 0; m < 4; ++m) { float* rowp = base + (size_t)(ai * HALF + m * 16) * ldc + col0;
#pragma unroll
                    for (int bj = 0; bj < 2; ++bj)
#pragma unroll
                        for (int n = 0; n < 2; ++n) *(f32x4*)(rowp + bj * HALF + n * 4) = acc[ai][bj][m][n]; }
        }
    }
};
struct PairOrder {
    int ntile, G, c, npan;
    __device__ __forceinline__ bool next(int i, Unit& u) const { const int tile = (i >> 1) * G + c; if (tile >= ntile) return false; const int which = i & 1; u.pm = (tile >> 2) + which * npan; u.pn = (tile & 3) + which * 4; u.k0 = 0; u.ntk = 0; u.ks = -1; return true; }
    __device__ __forceinline__ void a_ready(const Unit&) const {}
    __device__ __forceinline__ void done(const Unit&) const {}
};
template <class Epi, class Sched, bool ALIGN_EPI = false, bool SP2 = false>
__device__ __forceinline__ void gemm_phase(PG8_LAS unsigned char* lds, const Gemm g, const Sched& S, const Epi& E, int wave_s) {
    int tid_ = wave_s * 64 + (int)__builtin_amdgcn_mbcnt_hi(~0u, __builtin_amdgcn_mbcnt_lo(~0u, 0u)); asm volatile("" : "+v"(tid_));
    const int tid = tid_, wid = __builtin_amdgcn_readfirstlane(tid >> 6), lane = tid & 63, wr = wid >> 2, wc = wid & 3, fr = lane & 15, fq = lane >> 4;
    const int K = g.K, ntK = K / BK;
    unsigned voffA[2], voffB[2];
#pragma unroll
    for (int i = 0; i < 2; ++i) { int R, C; stage_rc(tid * 16 + i * 8192, R, C); const int Rb = Epi::PERM ? ((R & ~31) + perm32(R & 31)) : R;
        voffA[i] = (unsigned)(R * K + C) * 2u; voffB[i] = (unsigned)(Rb * K + C) * 2u; }
    const size_t kstep = (size_t)(BK * 2);
    const size_t hstep = (size_t)HALF * K * 2;
    const size_t tstep = 2 * hstep;
    const unsigned ldsw = (unsigned)wid * 1024u;
    const int aoff = lds_byte(wr * 64 + fr, fq * 8), boff = lds_byte(wc * 32 + fr, fq * 8);
#define PG8_SA(b, h) (((b) * 2 + (h)) * HTB)
#define PG8_SB(b, h) ((4 + (b) * 2 + (h)) * HTB)
#define PG8_STAGE(bufoff, gbase, voff) do { _Pragma("unroll") for (int _i = 0; _i < 2; ++_i) \
        __builtin_amdgcn_global_load_lds((const unsigned*)((const char*)(gbase) + (voff)[_i]), (PG8_LAS unsigned*)(lds + (bufoff) + ldsw + _i * 8192), 16, 0, 0); } while (0)
#define PG8_LDA(dst, b, h) do { _Pragma("unroll") for (int m = 0; m < 4; ++m) _Pragma("unroll") for (int k = 0; k < 2; ++k) dst[m][k] = *(const PG8_LAS bf16x8*)(lds + PG8_SA(b, h) + aoff + m * 2048 + k * 1024); } while (0)
#define PG8_LDB(dst, b, h) do { _Pragma("unroll") for (int n = 0; n < 2; ++n) _Pragma("unroll") for (int k = 0; k < 2; ++k) dst[n][k] = *(const PG8_LAS bf16x8*)(lds + PG8_SB(b, h) + boff + n * 2048 + k * 1024); } while (0)
#define PG8_MMA(ai, bj, At, Bt) do { __builtin_amdgcn_s_setprio(1); _Pragma("unroll") for (int m = 0; m < 4; ++m) _Pragma("unroll") for (int n = 0; n < 2; ++n) _Pragma("unroll") for (int k = 0; k < 2; ++k) \
        acc[ai][bj][m][n] = __builtin_amdgcn_mfma_f32_16x16x32_bf16(Bt[n][k], At[m][k], acc[ai][bj][m][n], 0, 0, 0); __builtin_amdgcn_s_setprio(0); } while (0)
#define PG8_WAIT_V(n) asm volatile("s_waitcnt vmcnt(" #n ")" ::: "memory")
#define PG8_WAIT_L(n) asm volatile("s_waitcnt lgkmcnt(" #n ")" ::: "memory")
#define PG8_BAR __builtin_amdgcn_s_barrier()
#define PG8_SCHED __builtin_amdgcn_sched_barrier(0)
    Unit cur, nxt; int ui = 0;
    if (!S.next(0, cur)) return;
    f32x4 acc[2][2][4][2];
#pragma unroll
    for (int a = 0; a < 2; ++a)
#pragma unroll
        for (int b = 0; b < 2; ++b)
#pragma unroll
            for (int m = 0; m < 4; ++m)
#pragma unroll
                for (int n = 0; n < 2; ++n) acc[a][b][m][n] = (f32x4){0.f, 0.f, 0.f, 0.f};
    bf16x8 At[4][2], B0[2][2], B1[2][2];
    const char* cA = (const char*)g.A + (size_t)cur.pm * tstep + (size_t)cur.k0 * 2; const char* cB = (const char*)g.Bt + (size_t)cur.pn * tstep + (size_t)cur.k0 * 2;
    S.a_ready(cur);
    if constexpr (SP2) {
        PG8_STAGE(PG8_SB(0, 0), cB, voffB); PG8_STAGE(PG8_SB(0, 1), cB + hstep, voffB); PG8_STAGE(PG8_SA(0, 0), cA, voffA); PG8_STAGE(PG8_SA(0, 1), cA + hstep, voffA);
        if (wr == 1) PG8_BAR;
        PG8_WAIT_V(2); PG8_BAR;
        PG8_STAGE(PG8_SB(1, 0), cB + kstep, voffB); PG8_STAGE(PG8_SA(1, 0), cA + kstep, voffA); PG8_STAGE(PG8_SB(1, 1), cB + hstep + kstep, voffB);
        PG8_WAIT_V(6); PG8_BAR;
    } else {
        PG8_STAGE(PG8_SB(0, 0), cB, voffB); PG8_STAGE(PG8_SA(0, 0), cA, voffA); PG8_STAGE(PG8_SB(0, 1), cB + hstep, voffB); PG8_STAGE(PG8_SA(0, 1), cA + hstep, voffA);
        if (wr == 1) PG8_BAR;
        PG8_WAIT_V(4); PG8_BAR;
        PG8_STAGE(PG8_SB(1, 0), cB + kstep, voffB); PG8_STAGE(PG8_SA(1, 0), cA + kstep, voffA); PG8_STAGE(PG8_SB(1, 1), cB + hstep + kstep, voffB);
        PG8_WAIT_V(6); PG8_BAR;
    }
    for (;;) {
        const bool has_next = S.next(ui + 1, nxt);
        const char* nA = has_next ? (const char*)g.A + (size_t)nxt.pm * tstep + (size_t)nxt.k0 * 2 : cA; const char* nB = has_next ? (const char*)g.Bt + (size_t)nxt.pn * tstep + (size_t)nxt.k0 * 2 : cB;
        const int nt = cur.ntk ? cur.ntk : ntK;
        for (int t = 0; t < nt; t += 2) {
            const bool last = (t == nt - 2);
            const char* a1 = cA + (size_t)(t + 1) * kstep;
            const char* a2 = last ? nA : cA + (size_t)(t + 2) * kstep; const char* b2 = last ? nB : cB + (size_t)(t + 2) * kstep;
            const char* a3 = a2 + kstep; const char* b3 = b2 + kstep;
            if (last && has_next) S.a_ready(nxt);
            if constexpr (SP2) {
            PG8_LDB(B0, 0, 0); PG8_LDB(B1, 0, 1); PG8_SCHED; PG8_LDA(At, 0, 0); PG8_STAGE(PG8_SA(1, 1), a1 + hstep, voffA);
            PG8_WAIT_V(8); PG8_WAIT_L(0); PG8_BAR; PG8_MMA(0, 0, At, B0); PG8_MMA(0, 1, At, B1); PG8_BAR; PG8_SCHED;
            PG8_LDA(At, 0, 1); PG8_STAGE(PG8_SB(0, 0), b2, voffB); PG8_STAGE(PG8_SB(0, 1), b2 + hstep, voffB); PG8_STAGE(PG8_SA(0, 0), a2, voffA);
            PG8_WAIT_V(8); PG8_WAIT_L(0); PG8_BAR; PG8_MMA(1, 0, At, B0); PG8_MMA(1, 1, At, B1); PG8_BAR; PG8_SCHED;
            PG8_LDB(B0, 1, 0); PG8_LDB(B1, 1, 1); PG8_SCHED; PG8_LDA(At, 1, 0); PG8_STAGE(PG8_SA(0, 1), a2 + hstep, voffA);
            PG8_WAIT_V(8); PG8_WAIT_L(0); PG8_BAR; PG8_MMA(0, 0, At, B0); PG8_MMA(0, 1, At, B1); PG8_BAR; PG8_SCHED;
            PG8_LDA(At, 1, 1); PG8_STAGE(PG8_SB(1, 0), b3, voffB); PG8_STAGE(PG8_SB(1, 1), b3 + hstep, voffB); PG8_STAGE(PG8_SA(1, 0), a3, voffA);
            PG8_WAIT_V(8); PG8_WAIT_L(0); PG8_BAR; PG8_MMA(1, 0, At, B0); PG8_MMA(1, 1, At, B1); PG8_BAR; PG8_SCHED;
            } else {
            PG8_LDB(B0, 0, 0); PG8_SCHED; PG8_LDA(At, 0, 0); PG8_STAGE(PG8_SA(1, 1), a1 + hstep, voffA);
            PG8_WAIT_L(8); PG8_BAR; PG8_WAIT_L(0); PG8_MMA(0, 0, At, B0); PG8_BAR; PG8_SCHED;
            PG8_LDB(B1, 0, 1); PG8_STAGE(PG8_SB(0, 0), b2, voffB);
            PG8_BAR; PG8_WAIT_L(0); PG8_MMA(0, 1, At, B1); PG8_BAR;
            PG8_LDA(At, 0, 1); PG8_STAGE(PG8_SA(0, 0), a2, voffA);
            PG8_BAR; PG8_WAIT_L(0); PG8_MMA(1, 0, At, B0); PG8_BAR; PG8_SCHED;
            PG8_STAGE(PG8_SB(0, 1), b2 + hstep, voffB);
            PG8_WAIT_V(6); PG8_BAR; PG8_MMA(1, 1, At, B1); PG8_BAR;
            PG8_LDB(B0, 1, 0); PG8_SCHED; PG8_LDA(At, 1, 0); PG8_STAGE(PG8_SA(0, 1), a2 + hstep, voffA);
            PG8_WAIT_L(8); PG8_BAR; PG8_WAIT_L(0); PG8_MMA(0, 0, At, B0); PG8_BAR; PG8_SCHED;
            PG8_LDB(B1, 1, 1); PG8_STAGE(PG8_SB(1, 0), b3, voffB);
            PG8_BAR; PG8_WAIT_L(0); PG8_MMA(0, 1, At, B1); PG8_BAR;
            PG8_LDA(At, 1, 1); PG8_STAGE(PG8_SA(1, 0), a3, voffA);
            PG8_BAR; PG8_WAIT_L(0); PG8_MMA(1, 0, At, B0); PG8_BAR; PG8_SCHED;
            PG8_STAGE(PG8_SB(1, 1), b3 + hstep, voffB);
            PG8_WAIT_V(6); PG8_BAR; PG8_MMA(1, 1, At, B1); PG8_BAR;
            }
        }
        if constexpr (ALIGN_EPI) { if (wr == 0) PG8_BAR; }
        if constexpr (!Epi::AFTER_DRAIN) { E(acc, cur, wr, wc, fr, fq); S.done(cur); }
        if (!has_next) break;
#pragma unroll
        for (int a = 0; a < 2; ++a)
#pragma unroll
            for (int b = 0; b < 2; ++b)
#pragma unroll
                for (int m = 0; m < 4; ++m)
#pragma unroll
                    for (int n = 0; n < 2; ++n) acc[a][b][m][n] = (f32x4){0.f, 0.f, 0.f, 0.f};
        cur = nxt; cA = nA; cB = nB; ++ui;
        if constexpr (ALIGN_EPI) { if (wr == 1) PG8_BAR; }
    }
    PG8_WAIT_V(0);
    if constexpr (!ALIGN_EPI) { if (wr == 0) PG8_BAR; }
    PG8_BAR;
    if constexpr (Epi::AFTER_DRAIN) { E.fused(acc, cur, wr, wc, fr, fq, lds, wid, lane); S.done(cur); }
#undef PG8_SA
#undef PG8_SB
#undef PG8_STAGE
#undef PG8_LDA
#undef PG8_LDB
#undef PG8_MMA
#undef PG8_WAIT_V
#undef PG8_WAIT_L
#undef PG8_BAR
#undef PG8_SCHED
}
}
using pg8::fast_sigmoid;
#define GAS __attribute__((address_space(1)))
#define LAS __attribute__((address_space(3)))
typedef unsigned short bf16;
typedef unsigned v4u __attribute__((ext_vector_type(4)));
typedef float f32x4 __attribute__((ext_vector_type(4)));
typedef short bf16x8 __attribute__((ext_vector_type(8)));
typedef GAS unsigned gu32;
typedef GAS unsigned long long gu64;
#define RLX_AGENT __ATOMIC_RELAXED, __HIP_MEMORY_SCOPE_AGENT
#define LDS_WAIT() asm volatile("s_waitcnt lgkmcnt(0)" ::: "memory")
#define VM_WAIT() asm volatile("s_waitcnt vmcnt(0)" ::: "memory")
__device__ __forceinline__ unsigned long long rt() { return __builtin_amdgcn_s_memrealtime(); }
__device__ __forceinline__ unsigned f2bf(float f) { unsigned u = __builtin_bit_cast(unsigned, f); return (u + 0x7fffu + ((u >> 16) & 1u)) >> 16; }
__device__ __forceinline__ unsigned pk2(float lo, float hi) { return f2bf(lo) | (f2bf(hi) << 16); }

#define XB_TMO      128
#define XB_XCNT(j)  (256  + 64 * (j))
#define XB_XSUB(j)  (1280 + 64 * (j))
#define XB_XGEN(j)  (2304 + 64 * (j))
#define XB_TOP      3328
#define XB_TOPGEN   3392
#define XCD_BAR_WORDS 3456
#define XB_SPIN_CAP (1u << 18)

__device__ __forceinline__ unsigned xb_ld(unsigned* p)              { return __hip_atomic_load(p, __ATOMIC_RELAXED, __HIP_MEMORY_SCOPE_AGENT); }
__device__ __forceinline__ unsigned xb_add(unsigned* p, unsigned v) { return __hip_atomic_fetch_add(p, v, __ATOMIC_RELAXED, __HIP_MEMORY_SCOPE_AGENT); }
__device__ __forceinline__ unsigned xb_xcc_id() { return (unsigned)__builtin_amdgcn_s_getreg((3 << 11) | 20) & 0xFu; }
#define XB_SPIN(cond, bar) do { unsigned _sp = 0; while (cond) { __builtin_amdgcn_s_sleep(1); \
    if ((++_sp & 255u) == 0u) { if (xb_ld(&(bar)[XB_TMO])) break; if (_sp > XB_SPIN_CAP) { atomicAdd(&(bar)[XB_TMO], 1u); break; } } } } while (0)

struct XcdBarrier {
    int wave;
    unsigned* bar; unsigned x;
    volatile LAS unsigned* st;
};

__device__ __forceinline__ XcdBarrier xcd_barrier_post(unsigned* bar, volatile LAS unsigned* st) {
    XcdBarrier b; b.bar = bar; b.x = xb_xcc_id(); b.st = st;
    if (threadIdx.x == 0) (void)xb_add(&bar[XB_XCNT(b.x)], 1u);
    return b;
}
__device__ __forceinline__ void xcd_barrier_complete(unsigned* bar, unsigned x, unsigned& nloc, unsigned& nx) {
    const unsigned G = gridDim.x * gridDim.y * gridDim.z;
    unsigned sum, cnt, mine, sp = 0u;
    for (;;) {
        sum = 0u; cnt = 0u; mine = 0u;
#pragma unroll
        for (unsigned j = 0; j < 16; ++j) { const unsigned c = xb_ld(&bar[XB_XCNT(j)]); sum += c; cnt += (c > 0u) ? 1u : 0u; mine = (j == x) ? c : mine; }
        if (sum == G) break;
        __builtin_amdgcn_s_sleep(1);
        if ((++sp & 255u) == 0u) { if (xb_ld(&bar[XB_TMO])) break; if (sp > XB_SPIN_CAP) { atomicAdd(&bar[XB_TMO], 1u); break; } }
    }
    nloc = mine > 0u ? mine : 1u; nx = cnt > 0u ? cnt : 1u;
}

__device__ __forceinline__ void xcd_barrier(const XcdBarrier& b) {
    asm volatile("s_waitcnt vmcnt(0)" ::: "memory");
    __syncthreads();
    if (b.wave == 0 && __builtin_amdgcn_mbcnt_hi(~0u, __builtin_amdgcn_mbcnt_lo(~0u, 0u)) == 0u) {
        unsigned* bar = b.bar;
        __builtin_amdgcn_s_waitcnt(0);
        unsigned nloc = b.st[0], nx = b.st[1];
        if (nloc == 0u) { xcd_barrier_complete(bar, b.x, nloc, nx); b.st[0] = nloc; b.st[1] = nx; }
        const unsigned old = xb_add(&bar[XB_XSUB(b.x)], 1u);
        const unsigned gen = old / nloc;
        if (old + 1u == (gen + 1u) * nloc) {
            __builtin_amdgcn_fence(__ATOMIC_RELEASE, "agent");
            asm volatile("s_waitcnt vmcnt(0)" ::: "memory");
            const unsigned og = xb_add(&bar[XB_TOP], 1u);
            const unsigned tg = og / nx;
            if (og + 1u == (tg + 1u) * nx) xb_add(&bar[XB_TOPGEN], 1u);
            else XB_SPIN(xb_ld(&bar[XB_TOPGEN]) == tg, bar);
            __builtin_amdgcn_fence(__ATOMIC_ACQUIRE, "agent");
            xb_add(&bar[XB_XGEN(b.x)], 1u);
            asm volatile("s_waitcnt vmcnt(0)" ::: "memory");
        } else {
            XB_SPIN(xb_ld(&bar[XB_XGEN(b.x)]) == gen, bar);
            __builtin_amdgcn_fence(__ATOMIC_ACQUIRE, "agent");
            asm volatile("s_waitcnt vmcnt(0)" ::: "memory");
        }
    }
    __syncthreads();
}
constexpr int NWAVES = 8, NTHR = 512;
constexpr int D = 1024, NB = 4, SEQ = 8192, DEPTH = 4, DECB = 32, DECS = 32, PAST = 2048;
constexpr int MP = NB * SEQ, MD = DECB * DECS, M = MP + MD, NPAN = M / 256, NSEQ = NB + DECB;
constexpr int DFF = 2816, NGU = 2 * DFF, NIN = 3328, NRW = 1792, NIG = NIN + 2 * D;
constexpr int HA = 4, HB = 8;
constexpr float LN_EPS = 1e-5f, GN_EPS = 64e-5f;
constexpr float ALPHA = 1.681792830507429f;
constexpr float QSCALE = 0.125f * 1.4426950408889634f;
constexpr float LOG2E = 1.4426950408889634f;
constexpr size_t OFF_Y = 0, OFF_KP = (size_t)M * D, OFF_VP = OFF_KP + (size_t)DEPTH * MP * 512, OFF_WKVP = OFF_VP + (size_t)DEPTH * MP * 512,
    OFF_SHP = OFF_WKVP + (size_t)DEPTH * NB * HB * 4096, OFF_KS = OFF_SHP + (size_t)DEPTH * NB * NRW, OFF_VS = OFF_KS + (size_t)DEPTH * MD * 512,
    OFF_WKVS = OFF_VS + (size_t)DEPTH * MD * 512, OFF_SHS = OFF_WKVS + (size_t)DEPTH * DECB * HB * 4096, OUT_TOTAL = OFF_SHS + (size_t)DEPTH * DECB * NRW;
static_assert(OUT_TOTAL == 177991680ull, "output size");
constexpr size_t al256(size_t x) { return (x + 255) & ~(size_t)255; }
constexpr size_t WS_CTL = 0, CTL_ZERO_BYTES = 1u << 20;
constexpr size_t WS_MOD = CTL_ZERO_BYTES;
constexpr size_t WS_LAM = WS_MOD + al256((size_t)DEPTH * NSEQ * 9 * D * 4);
constexpr size_t WS_W = WS_LAM + 256;
constexpr size_t WL_GU0 = 0, WL_GU1 = WL_GU0 + (size_t)NGU * D * 2, WL_DN0 = WL_GU1 + (size_t)NGU * D * 2, WL_DN1 = WL_DN0 + (size_t)D * DFF * 2,
    WL_IG = WL_DN1 + (size_t)D * DFF * 2, WL_BR = WL_IG + (size_t)NIG * D * 2, WL_O = WL_BR + (size_t)2048 * 512 * 2, WL_W2 = WL_O + (size_t)D * D * 2,
    WL_A2 = WL_W2 + 512 * 64 * 2, WL_G2 = WL_A2 + 512 * 64 * 2, WL_SIZE = WL_G2 + 512 * 128 * 2;
constexpr size_t WS_U = WS_W + (size_t)DEPTH * WL_SIZE;
constexpr size_t WS_ACT = WS_U + (size_t)M * D * 2;
constexpr size_t WS_F = WS_ACT + (size_t)M * DFF * 2;
constexpr size_t WS_Q = WS_F + (size_t)M * D * 4;
constexpr size_t WS_KB = WS_Q + (size_t)M * 512 * 2, WS_VB = WS_KB + (size_t)M * 512 * 2;
constexpr size_t WS_PRW = WS_VB + (size_t)M * 512 * 2;
constexpr size_t WS_GATES = WS_PRW + (size_t)M * NRW * 4;
constexpr size_t WS_YAB = WS_GATES + (size_t)M * 2048 * 2;
constexpr size_t WS_MERGED = WS_YAB + (size_t)2 * M * 512 * 2;
constexpr int NITEM_P = NB * (SEQ / 64) * HB, NITEM = NITEM_P + DECB * HB;
constexpr size_t WS_PT = WS_MERGED + (size_t)M * D * 2;
constexpr size_t WS_QT = WS_PT + (size_t)NITEM * 8192;
constexpr size_t WS_HT = WS_QT + (size_t)NITEM * 8192;
constexpr size_t WS_OT = WS_HT + (size_t)NITEM * 16384;
constexpr size_t WS_OB = WS_OT + (size_t)NITEM * 16384;
constexpr size_t WS_GG = WS_OB + (size_t)M * 512 * 4, WS_BON = WS_GG + (size_t)NITEM * 16384;
constexpr size_t WS_SC = WS_BON + (size_t)NITEM * 16384;
constexpr size_t WS_PLB = WS_SC + (size_t)NITEM * 8192;
constexpr size_t WS_SSB = WS_PLB + (size_t)M * 256 * 2;
constexpr size_t WS_FP = al256(WS_SSB + (size_t)DEPTH * DECB * 256 * 2);
constexpr size_t WS_END = WS_FP + (size_t)11 * MD * D * 4;
constexpr int CW_TMO = 0, CW_BAR = 4096, CW_QUEUE = 8192;
constexpr int RING_BYTES = 131072, EXTRA_OFF = 131072, LDSCTL_OFF = 146944, LDS_BYTES = 147456;

struct Args { const float* in[34]; float* out; unsigned char* ws; int ph_lo, ph_hi; };
static_assert(sizeof(Args) == 36 * 8 + 8, "Args has no padding");
enum { I_XP = 0, I_XS, I_CP, I_CS, I_CK, I_CV, I_SWKV, I_SSH, I_RELB, I_WADA, I_BADA, I_LNG, I_LNB, I_WGU, I_WDN, I_WIN, I_LAMQK, I_SUBG, I_MU, I_W0, I_W2, I_A0, I_A2, I_G2,
       I_KK, I_KA, I_RK, I_LNXG, I_LNXB, I_BRA, I_BRB, I_WGATE, I_BGATE, I_WO };

struct Frame { LAS unsigned char* lds; int tid, lane, wave, vcu, G; };

__device__ __forceinline__ int opq(int x) { asm volatile("" : "+s"(x)); return x; }
__device__ __forceinline__ Frame relaunder(const Frame& F) { Frame G = F; G.vcu = opq(G.vcu); G.G = opq(G.G); G.wave = opq(F.wave); G.lane = (int)__builtin_amdgcn_mbcnt_hi(~0u, __builtin_amdgcn_mbcnt_lo(~0u, 0u)); asm volatile("" : "+v"(G.lane)); G.tid = G.wave * 64 + G.lane; return G; }
__device__ __forceinline__ int row_seq(int row) { return row < MP ? (row >> 13) : NB + ((row - MP) >> 5); }
__device__ __forceinline__ int crow(int r, int hi) { return (r & 3) + 8 * (r >> 2) + 4 * hi; }
__device__ __forceinline__ float wave_sum(float v) {
#pragma unroll
    for (int o = 1; o < 64; o <<= 1) v += __shfl_xor(v, o);
    return v;
}
__device__ __forceinline__ unsigned cvtpk(float lo, float hi) { return pg8::cvt_pk_bf16(lo, hi); }
__device__ __forceinline__ unsigned short f2bf1(float x) { return (unsigned short)(pg8::cvt_pk_bf16(x, 0.f) & 0xffffu); }
__device__ __forceinline__ float bf2f(bf16 b) { return __uint_as_float((unsigned)b << 16); }
typedef float f32x16 __attribute__((ext_vector_type(16)));
typedef unsigned u32x2 __attribute__((ext_vector_type(2)));
#define LP(T, p) ((LAS T*)(p))

__device__ __forceinline__ void p0_transpose_item(const float* W, int K, int N, bf16* WT, int k0, int n0, int drow0, LAS float* scr, int lane) {
#pragma unroll 8
    for (int i = 0; i < 32; ++i) { const int kk = 2 * i + (lane >> 5); scr[kk * 33 + (lane & 31)] = W[(size_t)(k0 + kk) * N + n0 + (lane & 31)]; }
    LDS_WAIT(); asm volatile("" ::: "memory");
    const int c = lane & 7;
#pragma unroll
    for (int j = 0; j < 4; ++j) { const int n = (lane >> 3) + 8 * j; const LAS float* s = scr + (8 * c) * 33 + n;
        v4u o; o.x = pk2(s[0 * 33], s[1 * 33]); o.y = pk2(s[2 * 33], s[3 * 33]); o.z = pk2(s[4 * 33], s[5 * 33]); o.w = pk2(s[6 * 33], s[7 * 33]);
        *(GAS v4u*)(WT + (size_t)(drow0 + n) * K + k0 + 8 * c) = o; }
    LDS_WAIT(); asm volatile("" ::: "memory");
}
__device__ __forceinline__ void conv_mat(const float* W, int K, int N, bf16* WT, int r, int row_off, bool gu, LAS float* scr, int lane) {
    const int nblk = N / 32, kb = r / nblk, nb = r % nblk, n0 = 32 * nb; int drow0 = row_off + n0;
    if (gu) { drow0 = n0 < DFF ? 256 * (n0 / 128) + (n0 % 128) : 256 * ((n0 - DFF) / 128) + 128 + ((n0 - DFF) % 128); }
    p0_transpose_item(W, K, N, WT, 64 * kb, n0, drow0, scr, lane);
}
__device__ __forceinline__ void ph_prologue(const Frame& F0, const Args& a) {
    const Frame F = relaunder(F0);
    unsigned char* ws = a.ws;
    LAS bf16* sc = LP(bf16, F.lds);
    for (int i = F.tid; i < NSEQ * D; i += NTHR) { const int s = i >> 10, k = i & 1023; const float c = s < NB ? a.in[I_CP][s * D + k] : a.in[I_CS][(s - NB) * D + k];
        sc[s * 1032 + k] = (bf16)f2bf(c * fast_sigmoid(c)); }
    __syncthreads();
    const int gw = F.vcu * NWAVES + F.wave, NGW = F.G * NWAVES; const int lane = F.lane, r32 = lane & 31, hi = lane >> 5;
    float* MOD = (float*)(ws + WS_MOD);
    for (int it = gw; it < DEPTH * 288; it += NGW) {
        const int l = it / 288, n0 = (it % 288) * 32;
        const float* W = a.in[I_WADA] + (size_t)l * D * 9216 + n0 + r32;
        f32x16 acc0 = {}, acc1 = {};
        const int rowB = (32 + r32) < NSEQ ? 32 + r32 : NSEQ - 1;
#pragma unroll 4
        for (int s = 0; s < 64; ++s) {
            const float* wp = W + (size_t)(16 * s + 8 * hi) * 9216;
            float w[8];
#pragma unroll
            for (int j = 0; j < 8; ++j) w[j] = wp[(size_t)j * 9216];
            v4u bw; bw.x = cvtpk(w[0], w[1]); bw.y = cvtpk(w[2], w[3]); bw.z = cvtpk(w[4], w[5]); bw.w = cvtpk(w[6], w[7]);
            const bf16x8 bfrag = __builtin_bit_cast(bf16x8, bw);
            const bf16x8 a0 = *LP(const bf16x8, sc + r32 * 1032 + 16 * s + 8 * hi);
            const bf16x8 a1 = *LP(const bf16x8, sc + rowB * 1032 + 16 * s + 8 * hi);
            acc0 = __builtin_amdgcn_mfma_f32_32x32x16_bf16(a0, bfrag, acc0, 0, 0, 0);
            acc1 = __builtin_amdgcn_mfma_f32_32x32x16_bf16(a1, bfrag, acc1, 0, 0, 0);
        }
        const float bias = a.in[I_BADA][(size_t)l * 9216 + n0 + r32];
#pragma unroll
        for (int r = 0; r < 16; ++r) { const int s0 = crow(r, hi); MOD[((size_t)l * NSEQ + s0) * 9216 + n0 + r32] = acc0[r] + bias;
            const int s1 = 32 + s0; if (s1 < NSEQ) MOD[((size_t)l * NSEQ + s1) * 9216 + n0 + r32] = acc1[r] + bias; }
    }
    LAS float* scr = LP(float, F.lds + 74304 + F.wave * 8448);
    constexpr int C0 = 16 * 176, C2 = 44 * 32, C4 = 16 * 104, C5 = 16 * 64, C6 = 8 * 32, C8 = 16 * 32, C9 = 16, C11 = 32;
    constexpr int PER_L = 2 * C0 + 2 * C2 + C4 + C5 + 2 * C6 + C8 + 2 * C9 + C11;
    for (int it = gw; it < DEPTH * PER_L; it += NGW) {
        const int l = it / PER_L; int r = it % PER_L; unsigned char* wl = ws + WS_W + (size_t)l * WL_SIZE;
        if (r < C0) { conv_mat(a.in[I_WGU] + (size_t)(l * 2 + 0) * D * NGU, D, NGU, (bf16*)(wl + WL_GU0), r, 0, true, scr, lane); continue; } r -= C0;
        if (r < C0) { conv_mat(a.in[I_WGU] + (size_t)(l * 2 + 1) * D * NGU, D, NGU, (bf16*)(wl + WL_GU1), r, 0, true, scr, lane); continue; } r -= C0;
        if (r < C2) { conv_mat(a.in[I_WDN] + (size_t)(l * 2 + 0) * DFF * D, DFF, D, (bf16*)(wl + WL_DN0), r, 0, false, scr, lane); continue; } r -= C2;
        if (r < C2) { conv_mat(a.in[I_WDN] + (size_t)(l * 2 + 1) * DFF * D, DFF, D, (bf16*)(wl + WL_DN1), r, 0, false, scr, lane); continue; } r -= C2;
        if (r < C4) { conv_mat(a.in[I_WIN] + (size_t)l * D * NIN, D, NIN, (bf16*)(wl + WL_IG), r, 0, false, scr, lane); continue; } r -= C4;
        if (r < C5) { conv_mat(a.in[I_WGATE] + (size_t)l * D * 2048, D, 2048, (bf16*)(wl + WL_IG), r, NIN, false, scr, lane); continue; } r -= C5;
        if (r < C6) { conv_mat(a.in[I_BRA] + (size_t)l * 512 * D, 512, D, (bf16*)(wl + WL_BR), r, 0, false, scr, lane); continue; } r -= C6;
        if (r < C6) { conv_mat(a.in[I_BRB] + (size_t)l * 512 * D, 512, D, (bf16*)(wl + WL_BR), r, 1024, false, scr, lane); continue; } r -= C6;
        if (r < C8) { conv_mat(a.in[I_WO] + (size_t)l * D * D, D, D, (bf16*)(wl + WL_O), r, 0, false, scr, lane); continue; } r -= C8;
        if (r < C9) { conv_mat(a.in[I_W2] + (size_t)l * 64 * 512, 64, 512, (bf16*)(wl + WL_W2), r, 0, false, scr, lane); continue; } r -= C9;
        if (r < C9) { conv_mat(a.in[I_A2] + (size_t)l * 64 * 512, 64, 512, (bf16*)(wl + WL_A2), r, 0, false, scr, lane); continue; } r -= C9;
        conv_mat(a.in[I_G2] + (size_t)l * 128 * 512, 128, 512, (bf16*)(wl + WL_G2), r, 0, false, scr, lane);
    }
    for (int z = gw * 64 + lane; z < DEPTH * DECB * 256; z += NGW * 64) ((bf16*)(ws + WS_SSB))[z] = (bf16)f2bf(a.in[I_SSH][(size_t)(z >> 8) * NRW + 1536 + (z & 255)]);
    if (blockIdx.x == 0 && F.wave == 0) {
        for (int l = 0; l < DEPTH; ++l) { const float* lq = a.in[I_LAMQK] + l * 256;
            const float s1 = wave_sum(lq[lane] * lq[64 + lane]), s2 = wave_sum(lq[128 + lane] * lq[192 + lane]);
            const float lam_init = 0.8f - 0.6f * expf(-0.3f * (float)l);
            if (lane == 0) ((float*)(ws + WS_LAM))[l] = expf(s1) - expf(s2) + lam_init; }
    }
}

__device__ __forceinline__ void ph_ln(const Frame& F0, const float* xin_p, const float* xin_s, const bf16* f, float gs, const float* gate_mod  ,
                                      const float* lng, const float* lnb, const float* modn  , float* xout, bf16* uout,
                                      const float* fparts = nullptr, int nparts = 0  ) {
    const Frame F = relaunder(F0);
    const int gw = F.vcu * NWAVES + F.wave, NGW = F.G * NWAVES, lane = F.lane;
    for (int m = gw; m < M; m += NGW) {
        const int seq = row_seq(m);
        const float* xr = (xin_s && m >= MP) ? xin_s + (size_t)(m - MP) * D : xin_p + (size_t)m * D;
        f32x4 v[4];
#pragma unroll
        for (int j = 0; j < 4; ++j) v[j] = *(const f32x4*)(xr + 4 * lane + 256 * j);
        if (f) {
            const bf16* fr = f + (size_t)m * D; const float* gm = gate_mod + (size_t)seq * 9216; float s = 0.f;
#pragma unroll
            for (int j = 0; j < 4; ++j) { f32x4 fv;
                if (fparts && m >= MP) { fv = (f32x4){0.f, 0.f, 0.f, 0.f}; for (int sp = 0; sp < nparts; ++sp) fv += *(const f32x4*)(fparts + ((size_t)sp * MD + (m - MP)) * D + 4 * lane + 256 * j); }
                else { const u32x2 fw = *(const u32x2*)(fr + 4 * lane + 256 * j); fv = (f32x4){__uint_as_float(fw.x << 16), __uint_as_float(fw.x & 0xffff0000u), __uint_as_float(fw.y << 16), __uint_as_float(fw.y & 0xffff0000u)}; }
                const f32x4 gv = *(const f32x4*)(gm + 4 * lane + 256 * j);
                v[j] = v[j] * ALPHA + (gv * gs) * fv; s += (v[j].x + v[j].y) + (v[j].z + v[j].w); }
            const float mean = wave_sum(s) * (1.f / D); float s2 = 0.f;
#pragma unroll
            for (int j = 0; j < 4; ++j) { v[j] = v[j] - mean; s2 += (v[j].x * v[j].x + v[j].y * v[j].y) + (v[j].z * v[j].z + v[j].w * v[j].w); }
            const float rstd = 1.0f / sqrtf(wave_sum(s2) * (1.f / D) + LN_EPS);
#pragma unroll
            for (int j = 0; j < 4; ++j) { const f32x4 g = *(const f32x4*)(lng + 4 * lane + 256 * j), b = *(const f32x4*)(lnb + 4 * lane + 256 * j); v[j] = v[j] * rstd * g + b;
                *(f32x4*)(xout + (size_t)m * D + 4 * lane + 256 * j) = v[j]; }
        }
        if (modn) {
            const float* mm = modn + (size_t)seq * 9216; float s = 0.f;
#pragma unroll
            for (int j = 0; j < 4; ++j) s += (v[j].x + v[j].y) + (v[j].z + v[j].w);
            const float mean = wave_sum(s) * (1.f / D); float s2 = 0.f;
#pragma unroll
            for (int j = 0; j < 4; ++j) { v[j] = v[j] - mean; s2 += (v[j].x * v[j].x + v[j].y * v[j].y) + (v[j].z * v[j].z + v[j].w * v[j].w); }
            const float rstd = 1.0f / sqrtf(wave_sum(s2) * (1.f / D) + LN_EPS);
#pragma unroll
            for (int j = 0; j < 4; ++j) { const f32x4 sh = *(const f32x4*)(mm + 4 * lane + 256 * j), scl = *(const f32x4*)(mm + D + 4 * lane + 256 * j);
                const f32x4 o = v[j] * rstd * (scl + 1.0f) + sh; u32x2 w; w.x = cvtpk(o.x, o.y); w.y = cvtpk(o.z, o.w);
                *(u32x2*)(uout + (size_t)m * D + 4 * lane + 256 * j) = w; }
        }
    }
}
__device__ __forceinline__ int t5_bucket(int rel) {
    const int n = rel < 0 ? -rel : rel; int b;
    if (n < 8) b = n; else if (n < 12) b = 8; else if (n < 16) b = 9; else if (n < 23) b = 10; else if (n < 32) b = 11; else if (n < 46) b = 12; else if (n < 64) b = 13; else if (n < 91) b = 14; else b = 15;
    return (rel > 0 ? 16 : 0) + b;
}
typedef short v4i16_t __attribute__((ext_vector_type(4)));
__device__ __forceinline__ v4i16_t vtr(LAS const unsigned char* p) { return __builtin_amdgcn_ds_read_tr16_b64_v4i16((LAS v4i16_t*)p); }
constexpr int ATT_SLOT = 32768;
constexpr int ATT_TAB = EXTRA_OFF;
struct AttnP { const bf16* Q; const bf16* Kb; const bf16* Vb; const float* ck; const float* cv; bf16* YA; const float* relb; const float* subg; float lam, oml; };

__device__ __forceinline__ void attn_scores(LAS const unsigned char* slot, LAS const float* tab, const bf16x8 (&qf)[4], f32x16 (&o)[4], bf16x8 (&pf)[4], float& mrun, float& lrun,
                                            int map, int lane, int k0, int qpos, bool constb, int nvalid, bool first  ) {
    const int r32 = lane & 31, hi = lane >> 5;
    LAS const unsigned char* kb = slot + map * 8192 + hi * 1024 + r32 * 16;
    f32x16 p0, p1;
    const float cb = (constb ? tab[0] : 0.f) - (first ? 0.f : mrun);
#pragma unroll
    for (int r = 0; r < 16; ++r) { p0[r] = cb; p1[r] = cb; }
#pragma unroll
    for (int d0 = 0; d0 < 4; ++d0) {
        const bf16x8 k0f = *LP(const bf16x8, kb + d0 * 2048), k1f = *LP(const bf16x8, kb + d0 * 2048 + 512);
        p0 = __builtin_amdgcn_mfma_f32_32x32x16_bf16(k0f, qf[d0], p0, 0, 0, 0);
        p1 = __builtin_amdgcn_mfma_f32_32x32x16_bf16(k1f, qf[d0], p1, 0, 0, 0);
    }
    if (!constb) {
        const int base = k0 - qpos + 128;
#pragma unroll
        for (int r = 0; r < 16; ++r) { int i0 = base + crow(r, hi); int i1 = i0 + 32; i0 = i0 < 0 ? 0 : (i0 > 191 ? 191 : i0); i1 = i1 < 0 ? 0 : (i1 > 191 ? 191 : i1); p0[r] += tab[i0]; p1[r] += tab[i1]; }
    }
    if (nvalid < 64) {
#pragma unroll
        for (int r = 0; r < 16; ++r) { if (crow(r, hi) >= nvalid) p0[r] = -INFINITY; if (crow(r, hi) + 32 >= nvalid) p1[r] = -INFINITY; }
    }
    float ma = fmaxf(fmaxf(p0[0], p0[1]), p1[0]), mb = fmaxf(fmaxf(p0[2], p0[3]), p1[1]); ma = fmaxf(fmaxf(ma, p1[2]), p1[3]);
#pragma unroll
    for (int r = 4; r < 16; r += 4) { ma = fmaxf(fmaxf(ma, p0[r]), p0[r + 1]); mb = fmaxf(fmaxf(mb, p0[r + 2]), p0[r + 3]); ma = fmaxf(fmaxf(ma, p1[r]), p1[r + 1]); mb = fmaxf(fmaxf(mb, p1[r + 2]), p1[r + 3]); }
    float mx = fmaxf(ma, mb);
    mx = fmaxf(mx, __shfl_xor(mx, 32));
    if (first || __any(mx > 8.0f)) {
        const float delta = first ? mx : (mx > 8.0f ? mx : 0.f);
        const float alpha = first ? 0.f : __builtin_amdgcn_exp2f(-delta);
        mrun = first ? mx : mrun + delta;
        lrun *= alpha;
#pragma unroll
        for (int r = 0; r < 16; ++r) { p0[r] -= delta; p1[r] -= delta; }
#pragma unroll
        for (int c = 0; c < 4; ++c)
#pragma unroll
            for (int r = 0; r < 16; ++r) o[c][r] *= alpha;
    }
    float ls = 0.f;
#pragma unroll
    for (int r = 0; r < 16; ++r) { p0[r] = __builtin_amdgcn_exp2f(p0[r]); p1[r] = __builtin_amdgcn_exp2f(p1[r]); ls += p0[r] + p1[r]; }
    lrun += ls;
#pragma unroll
    for (int ks = 0; ks < 4; ++ks) { v4u w;
        if (ks < 2) { const int b = 8 * ks; w.x = cvtpk(p0[b], p0[b + 1]); w.y = cvtpk(p0[b + 2], p0[b + 3]); w.z = cvtpk(p0[b + 4], p0[b + 5]); w.w = cvtpk(p0[b + 6], p0[b + 7]); }
        else { const int b = 8 * (ks - 2); w.x = cvtpk(p1[b], p1[b + 1]); w.y = cvtpk(p1[b + 2], p1[b + 3]); w.z = cvtpk(p1[b + 4], p1[b + 5]); w.w = cvtpk(p1[b + 6], p1[b + 7]); }
        pf[ks] = __builtin_bit_cast(bf16x8, w); }
}
__device__ __forceinline__ void attn_pv(LAS const unsigned char* slot, const bf16x8 (&pf)[4], f32x16 (&o)[4], int lane) {
    const int hi = lane >> 5;
    LAS const unsigned char* vb = slot + 16384 + ((lane >> 4) & 1) * 32 + (lane & 3) * 8 + (4 * hi + ((lane & 15) >> 2)) * 64;
#pragma unroll
    for (int c = 0; c < 4; ++c)
#pragma unroll
        for (int ks = 0; ks < 4; ++ks) {
            const v4i16_t lo = vtr(vb + c * 4096 + (2 * ks) * 512), hh = vtr(vb + c * 4096 + (2 * ks + 1) * 512);
            const bf16x8 vf = (bf16x8){lo[0], lo[1], lo[2], lo[3], hh[0], hh[1], hh[2], hh[3]};
            o[c] = __builtin_amdgcn_mfma_f32_32x32x16_bf16(vf, pf[ks], o[c], 0, 0, 0);
        }
}

__device__ __forceinline__ int att_koff(int key, int ch) { return (ch >> 3) * 8192 + ((ch & 7) >> 1) * 2048 + (ch & 1) * 1024 + (key >> 5) * 512 + (key & 31) * 16; }
__device__ __forceinline__ int att_voff(int key, int ch) { return 16384 + (ch >> 2) * 4096 + (key >> 3) * 512 + (key & 7) * 64 + (ch & 3) * 16; }

__device__ __forceinline__ void attn_unit(const Frame& F, const AttnP& P, bool dec, int bidx, int h, int qb) {
    const int tid = F.tid, lane = F.lane, wave = F.wave, r32 = lane & 31, hi = lane >> 5;
    const int map = wave & 1, qs = wave >> 1;
    LAS unsigned char* lds = F.lds;
    LAS float* tab = LP(float, lds + ATT_TAB);
    const int rowbase = dec ? MP + bidx * DECS : bidx * SEQ;
    const int q0 = dec ? 0 : qb * 128;
    const int qpos0 = dec ? PAST : q0;
    const bool active = dec ? (qs == 0) : true;
    const int NT = dec ? (PAST / 64 + 1) : (2 * qb + 2);
    const int myNT = dec ? NT : (2 * qb + 1 + (qs >> 1));
    if (tid < 192) tab[tid] = P.relb[t5_bucket(tid - 128) * HA + h] * LOG2E;
    bf16x8 qf[4];
    { const bf16* qp = P.Q + (size_t)(rowbase + q0 + (active ? qs * 32 : 0) + r32) * 512 + h * 128 + map * 64 + 8 * hi;
#pragma unroll
      for (int d0 = 0; d0 < 4; ++d0) qf[d0] = *(const bf16x8*)(qp + 16 * d0); }
    f32x16 o[4];
#pragma unroll
    for (int c = 0; c < 4; ++c)
#pragma unroll
        for (int r = 0; r < 16; ++r) o[c][r] = 0.f;
    float mrun = -INFINITY, lrun = 0.f;
    const int qposw = qpos0 + qs * 32;
    v4u kreg[2], vreg[2];
    auto load_tile = [&](int t) {
#pragma unroll
        for (int i = 0; i < 2; ++i) { const int id = tid + 512 * i;
            const int kk = (id & 7) | ((id >> 7) << 3), kc = (id >> 3) & 15;
            const int vk = ((id >> 2) & 7) | ((id >> 7) << 3), vc = (id & 3) | (((id >> 5) & 3) << 2);
            if (!dec) { kreg[i] = *(const v4u*)(P.Kb + (size_t)(rowbase + 64 * t + kk) * 512 + h * 128 + kc * 8); vreg[i] = *(const v4u*)(P.Vb + (size_t)(rowbase + 64 * t + vk) * 512 + h * 128 + vc * 8); }
            else if (t < PAST / 64) { const size_t gk = ((size_t)(bidx * PAST + 64 * t + kk) * HA + h) * 128 + kc * 8, gv = ((size_t)(bidx * PAST + 64 * t + vk) * HA + h) * 128 + vc * 8;
                const f32x4 a0 = *(const f32x4*)(P.ck + gk), a1 = *(const f32x4*)(P.ck + gk + 4), b0 = *(const f32x4*)(P.cv + gv), b1 = *(const f32x4*)(P.cv + gv + 4);
                kreg[i] = (v4u){cvtpk(a0[0], a0[1]), cvtpk(a0[2], a0[3]), cvtpk(a1[0], a1[1]), cvtpk(a1[2], a1[3])};
                vreg[i] = (v4u){cvtpk(b0[0], b0[1]), cvtpk(b0[2], b0[3]), cvtpk(b1[0], b1[1]), cvtpk(b1[2], b1[3])}; }
            else { kreg[i] = kk < DECS ? *(const v4u*)(P.Kb + (size_t)(rowbase + kk) * 512 + h * 128 + kc * 8) : (v4u){0u, 0u, 0u, 0u};
                   vreg[i] = vk < DECS ? *(const v4u*)(P.Vb + (size_t)(rowbase + vk) * 512 + h * 128 + vc * 8) : (v4u){0u, 0u, 0u, 0u}; }
        }
    };
    auto store_tile_at = [&](int sloff) {
        LAS unsigned char* sb = lds + sloff;
#pragma unroll
        for (int i = 0; i < 2; ++i) { const int id = tid + 512 * i;
            const int kk = (id & 7) | ((id >> 7) << 3), kc = (id >> 3) & 15, vk = ((id >> 2) & 7) | ((id >> 7) << 3), vc = (id & 3) | (((id >> 5) & 3) << 2);
            *LP(v4u, sb + att_koff(kk, kc)) = kreg[i]; *LP(v4u, sb + att_voff(vk, vc)) = vreg[i]; }
    };
    __syncthreads();
    load_tile(0); store_tile_at(0);
    __syncthreads();
    const bool late = wave >= 4;
    bf16x8 pf[4];
    bool pend = false;
    int sl_prev = 0, sl_cur = 0, sl_next = ATT_SLOT;
    for (int t = 0; t < NT; ++t) {
        if (t + 1 < NT) load_tile(t + 1);
        const bool mine = active && t < myNT;
        if (late) {
            if (pend) attn_pv(lds + sl_prev, pf, o, lane);
            pend = mine;
        }
        if (mine) {
            const int k0 = 64 * t;
            const bool constb = (k0 + 63 - qposw) <= -91;
            attn_scores(lds + sl_cur, tab, qf, o, pf, mrun, lrun, map, lane, k0, qposw + r32, constb, (dec && t == NT - 1) ? DECS : 64, t == 0);
            if (!late) attn_pv(lds + sl_cur, pf, o, lane);
        }
        if (t + 1 < NT) store_tile_at(sl_next);
        __syncthreads();
        sl_prev = sl_cur; sl_cur = sl_next; sl_next = sl_next == 2 * ATT_SLOT ? 0 : sl_next + ATT_SLOT;
    }
    if (late && pend) attn_pv(lds + sl_prev, pf, o, lane);
    __syncthreads();
    lrun += __shfl_xor(lrun, 32);
    const float inv = 1.0f / lrun;
    LAS float* ex = LP(float, lds + (wave >> 1) * 16384);
    if (map == 1) {
#pragma unroll
        for (int c = 0; c < 4; ++c)
#pragma unroll
            for (int r = 0; r < 16; ++r) ex[(c * 16 + r) * 64 + lane] = o[c][r] * inv;
    }
    __syncthreads();
    LAS bf16* yst = LP(bf16, lds + 65536 + (wave >> 1) * 8448);
    if (map == 0) {
        float ss = 0.f;
#pragma unroll
        for (int c = 0; c < 4; ++c)
#pragma unroll
            for (int r = 0; r < 16; ++r) { const float v = o[c][r] * inv - P.lam * ex[(c * 16 + r) * 64 + lane]; o[c][r] = v; ss += v * v; }
        ss += __shfl_xor(ss, 32);
        const float rs = 1.0f / sqrtf(ss * (1.f / 128.f) + LN_EPS) * P.oml;
#pragma unroll
        for (int c = 0; c < 4; ++c)
#pragma unroll
            for (int r = 0; r < 16; ++r) { const int dv = 32 * c + crow(r, hi); yst[r32 * 132 + dv] = (bf16)f2bf(o[c][r] * rs * P.subg[dv]); }
    }
    __syncthreads();
    if (map == 0 && active) {
#pragma unroll
        for (int i = 0; i < 8; ++i) { const int row = i * 4 + (lane >> 4), ch = lane & 15;
            const u32x2 a = *LP(const u32x2, yst + row * 132 + ch * 8), b = *LP(const u32x2, yst + row * 132 + ch * 8 + 4);
            *(v4u*)(P.YA + (size_t)(rowbase + q0 + qs * 32 + row) * 512 + h * 128 + ch * 8) = (v4u){a.x, a.y, b.x, b.y}; }
    }
}
__device__ __forceinline__ void ph_attn(const Frame& F0, const AttnP& P, unsigned* qcount) {
    const Frame F = relaunder(F0);
    LAS unsigned* qslot = LP(unsigned, F.lds + LDSCTL_OFF + 64);
    for (;;) {
        __syncthreads();
        if (F.tid == 0) *qslot = __hip_atomic_fetch_add(qcount, 1u, __ATOMIC_RELAXED, __HIP_MEMORY_SCOPE_AGENT);
        __syncthreads();
        const int u = __builtin_amdgcn_readfirstlane((int)*qslot);
        if (u >= 1024 + DECB * HA) break;
        if (u < 1024) { const int bh = u & 15, qb = 63 - (u >> 4); attn_unit(F, P, false, bh >> 2, bh & 3, qb); }
        else { const int d = u - 1024; attn_unit(F, P, true, d >> 2, d & 3, 0); }
    }
}
constexpr int R1_RT = 0, R1_KH = 9216, R1_BH = 18432, R1_KAP = 27648, R1_KAPT = 36864, R1_VT = 46080, R1_BBT = 55296, R1_KBT = 64512;
constexpr int R1_ABKF = 73728, R1_AKK = 90368, R1_ABR = 99584, R1_AKR = 108800, R1_MB = 118016;
constexpr int R1_MF = R1_KH, R1_GT = R1_KAP, R1_WT = R1_ABKF, R1_UT = R1_KH;
constexpr int R1_LW = 73728, R1_LA = 82944, R1_LG = 92160;
constexpr int R1_RED = EXTRA_OFF, R1_CS = EXTRA_OFF + 1024, R1_GTV = EXTRA_OFF + 2048, R1_T16 = EXTRA_OFF + 2304, R1_MUL = EXTRA_OFF + 5632;
typedef unsigned short u16;
__device__ __forceinline__ f32x4 mfma16(bf16x8 a, bf16x8 b, f32x4 c) { return __builtin_amdgcn_mfma_f32_16x16x32_bf16(a, b, c, 0, 0, 0); }
__device__ __forceinline__ void mm64(f32x4 (&acc)[2], LAS const unsigned char* X, LAS const unsigned char* Y, int tm, int tn0, int lane) {
    const int i = lane & 15, q = lane >> 4;
#pragma unroll
    for (int s = 0; s < 2; ++s) {
        const bf16x8 af = *LP(const bf16x8, X + ((16 * tm + i) * 72 + 32 * s + 8 * q) * 2);
#pragma unroll
        for (int j = 0; j < 2; ++j) { const bf16x8 bfr = *LP(const bf16x8, Y + ((16 * (tn0 + j) + i) * 72 + 32 * s + 8 * q) * 2); acc[j] = mfma16(af, bfr, acc[j]); }
    }
}
__device__ __forceinline__ void st_tr(LAS unsigned char* arr, const f32x4& v, int n, int t0) {
    u32x2 w; w.x = cvtpk(v[0], v[1]); w.y = cvtpk(v[2], v[3]); *LP(u32x2, arr + (n * 72 + t0) * 2) = w;
}
__device__ __forceinline__ f32x4 prod16(f32x4 acc, LAS const float* X, int sx, LAS const float* Y, int sy, int lane) {
    const int i = lane & 15, q = lane >> 4;
#pragma unroll
    for (int s = 0; s < 4; ++s) acc = __builtin_amdgcn_mfma_f32_16x16x4f32(X[i * sx + 4 * s + q], Y[(4 * s + q) * sy + i], acc, 0, 0, 0);
    return acc;
}
__device__ __forceinline__ float tanh_fast(float x) { return 1.0f - 2.0f * __builtin_amdgcn_rcpf(1.0f + __expf(2.0f * x)); }

__device__ __forceinline__ int frag_a(int row, int k) { return ((row >> 4) * 2 + (k >> 5)) * 512 + (((k >> 2) & 3) * 16 + (row & 15)) * 8 + 4 * ((k >> 4) & 1) + (k & 3); }
__device__ __forceinline__ int frag_c(int c, int r0) { return (((c >> 4) * 4 + (r0 >> 4)) * 64 + ((r0 >> 2) & 3) * 16 + (c & 15)) * 4; }
__device__ __forceinline__ void ph_rwkv1(const Frame& F0, const Args& a, int l) {
    const Frame F = relaunder(F0);
    unsigned char* ws = a.ws; LAS unsigned char* lds = F.lds;
    int tid = F.tid, lane = F.lane, i = lane & 15, q = lane >> 4, t0 = 0; const int wave = F.wave, tm = wave >> 1, tnb = 2 * (wave & 1);
#define R1_RELANE() do { int l_ = F.lane; asm volatile("" : "+v"(l_)); lane = l_; i = lane & 15; q = lane >> 4; tid = wave * 64 + lane; t0 = 16 * tm + 4 * q; } while (0)
    const float* PRW = (const float*)(ws + WS_PRW); const bf16* PLB = (const bf16*)(ws + WS_PLB);
    const unsigned char* wl = ws + WS_W + (size_t)l * WL_SIZE;
    const bf16* W2t = (const bf16*)(wl + WL_W2); const bf16* A2t = (const bf16*)(wl + WL_A2); const bf16* G2t = (const bf16*)(wl + WL_G2);
    const float* mu = a.in[I_MU] + (size_t)l * NRW; const float* w0 = a.in[I_W0] + l * 512; const float* a0 = a.in[I_A0] + l * 512;
    const float* k_k = a.in[I_KK] + l * 512; const float* k_a = a.in[I_KA] + l * 512; const float* r_k = a.in[I_RK] + l * 512;
    float* OB = (float*)(ws + WS_OB); float* GG = (float*)(ws + WS_GG); float* BON = (float*)(ws + WS_BON);
    LAS float* RED = LP(float, lds + R1_RED); LAS float* CS = LP(float, lds + R1_CS); LAS float* GTV = LP(float, lds + R1_GTV);
    LAS float* ABKF = LP(float, lds + R1_ABKF); LAS float* MF = LP(float, lds + R1_MF);
    if (tid < 256) LP(float, lds + R1_MUL)[tid] = mu[1536 + tid];
    __syncthreads();
    struct R1Item { int h, row0, tval; const float* prev0; const bf16* prevb; };
    auto item_info = [&](int it) -> R1Item { R1Item I;
        if (it < NITEM_P) { const int s = it >> 10, c = (it >> 3) & 127; I.h = it & 7; I.row0 = s * SEQ + 64 * c; I.tval = 64; I.prev0 = c > 0 ? PRW + (size_t)(I.row0 - 1) * NRW : nullptr; I.prevb = c > 0 ? PLB + (size_t)(I.row0 - 1) * 256 : nullptr; }
        else { const int b = (it - NITEM_P) >> 3; I.h = it & 7; I.row0 = MP + DECS * b; I.tval = DECS; I.prev0 = a.in[I_SSH] + (size_t)(l * DECB + b) * NRW; I.prevb = (const bf16*)(ws + WS_SSB) + (size_t)(l * DECB + b) * 256; }
        return I; };
    v4u lp[4], lq[4];
    float gp[2][4][3], gq[2][3], cst[2][8]; bool pqz = false;
    auto load_top = [&](const R1Item& I) {
        const int t0s = tid >> 3, part = tid & 7; const bool v0 = t0s < I.tval;
        const bf16* pl_ = PLB + (size_t)(I.row0 + (v0 ? t0s : 0)) * 256 + 32 * part;
        const bf16* pq_ = (v0 && t0s > 0) ? pl_ - 256 : (I.prevb ? I.prevb + 32 * part : pl_);
        pqz = !(v0 && t0s > 0) && !I.prevb;
#pragma unroll
        for (int e = 0; e < 4; ++e) { lp[e] = *(const v4u*)(pl_ + 8 * e); lq[e] = *(const v4u*)(pq_ + 8 * e); }
#pragma unroll
        for (int j = 0; j < 2; ++j) { const int col = I.h * 64 + 16 * (tnb + j) + i; const int tb = 16 * tm + 4 * q;
#pragma unroll
            for (int r = 0; r < 4; ++r) { const unsigned po = (unsigned)(I.row0 + min(tb + r, I.tval - 1)) * NRW + col; gp[j][r][0] = PRW[po]; gp[j][r][1] = PRW[po + 512]; gp[j][r][2] = PRW[po + 1024]; }
            const float* pb = tb > 0 ? PRW + (size_t)(I.row0 + min(tb, I.tval) - 1) * NRW : I.prev0;
            if (pb) { gq[j][0] = pb[col]; gq[j][1] = pb[512 + col]; gq[j][2] = pb[1024 + col]; } else { gq[j][0] = 0.f; gq[j][1] = 0.f; gq[j][2] = 0.f; }
            cst[j][0] = mu[col]; cst[j][1] = mu[512 + col]; cst[j][2] = mu[1024 + col]; cst[j][3] = w0[col]; cst[j][4] = a0[col]; cst[j][5] = k_k[col]; cst[j][6] = k_a[col]; cst[j][7] = r_k[col]; }
    };
    R1Item cur = item_info(F.vcu < NITEM ? F.vcu : 0), nxt = cur;
    if (F.vcu < NITEM) { R1_RELANE(); load_top(cur); }
    for (int it = F.vcu; it < NITEM; it += F.G) {
        const int h = cur.h, row0 = cur.row0, tval = cur.tval;
        R1_RELANE();
        const int t0s = tid >> 3, part = tid & 7;
        const bool v0 = t0s < tval;
        { LAS unsigned char* dst = part < 2 ? lds + R1_LW + (t0s * 72 + 32 * part) * 2 : (part < 4 ? lds + R1_LA + (t0s * 72 + 32 * (part - 2)) * 2 : lds + R1_LG + (t0s * 136 + 32 * (part - 4)) * 2);
          LAS const float* mul = LP(const float, lds + R1_MUL) + 32 * part;
#pragma unroll
          for (int e8 = 0; e8 < 4; ++e8) { float x[8];
#pragma unroll
              for (int e = 0; e < 2; ++e) { const unsigned pa_ = e ? lp[e8].z : lp[e8].x, pb_ = e ? lp[e8].w : lp[e8].y, qa_ = e ? lq[e8].z : lq[e8].x, qb_ = e ? lq[e8].w : lq[e8].y;
                  const f32x4 pv = {__uint_as_float(pa_ << 16), __uint_as_float(pa_ & 0xffff0000u), __uint_as_float(pb_ << 16), __uint_as_float(pb_ & 0xffff0000u)};
                  const f32x4 qv = pqz ? (f32x4){0.f, 0.f, 0.f, 0.f} : (f32x4){__uint_as_float(qa_ << 16), __uint_as_float(qa_ & 0xffff0000u), __uint_as_float(qb_ << 16), __uint_as_float(qb_ & 0xffff0000u)};
                  const f32x4 m4 = *LP(const f32x4, mul + 8 * e8 + 4 * e);
                  const f32x4 xm = pv + (qv - pv) * m4;
#pragma unroll
                  for (int z = 0; z < 4; ++z) x[4 * e + z] = !v0 ? 0.f : (part < 2 ? tanh_fast(xm[z]) : (part < 4 ? xm[z] : fast_sigmoid(xm[z]))); }
              *LP(v4u, dst + e8 * 16) = (v4u){cvtpk(x[0], x[1]), cvtpk(x[2], x[3]), cvtpk(x[4], x[5]), cvtpk(x[6], x[7])}; }
        }
        bf16x8 bW[2][2], bA[2][2], bG[4][2];
#pragma unroll
        for (int j = 0; j < 2; ++j) { const int n = h * 64 + 16 * (tnb + j) + i;
#pragma unroll
            for (int s = 0; s < 2; ++s) { bW[s][j] = *(const bf16x8*)(W2t + (size_t)n * 64 + 32 * s + 8 * q); bA[s][j] = *(const bf16x8*)(A2t + (size_t)n * 64 + 32 * s + 8 * q); }
#pragma unroll
            for (int s = 0; s < 4; ++s) bG[s][j] = *(const bf16x8*)(G2t + (size_t)n * 128 + 32 * s + 8 * q); }
        __syncthreads();
        f32x4 aw[2], aa[2], ag[2];
#pragma unroll
        for (int j = 0; j < 2; ++j) { aw[j] = (f32x4){0.f, 0.f, 0.f, 0.f}; aa[j] = aw[j]; ag[j] = aw[j]; }
#pragma unroll
        for (int s = 0; s < 2; ++s) {
            const bf16x8 fw = *LP(const bf16x8, lds + R1_LW + ((16 * tm + i) * 72 + 32 * s + 8 * q) * 2), fa = *LP(const bf16x8, lds + R1_LA + ((16 * tm + i) * 72 + 32 * s + 8 * q) * 2);
#pragma unroll
            for (int j = 0; j < 2; ++j) { aw[j] = mfma16(fw, bW[s][j], aw[j]); aa[j] = mfma16(fa, bA[s][j], aa[j]); }
        }
#pragma unroll
        for (int s = 0; s < 4; ++s) {
            const bf16x8 fg = *LP(const bf16x8, lds + R1_LG + ((16 * tm + i) * 136 + 32 * s + 8 * q) * 2);
#pragma unroll
            for (int j = 0; j < 2; ++j) ag[j] = mfma16(fg, bG[s][j], ag[j]);
        }
        float xr[2][4], kp[2][4], xv[2][4], lw[2][4], av[2][4], kkr[2][4];
        float ssq[4] = {0.f, 0.f, 0.f, 0.f}, bsum[4] = {0.f, 0.f, 0.f, 0.f};
#pragma unroll
        for (int j = 0; j < 2; ++j) { const int n = 16 * (tnb + j) + i;
            const float mur = cst[j][0], muk = cst[j][1], muv = cst[j][2], w0c = cst[j][3], a0c = cst[j][4], kkc = cst[j][5], kac = cst[j][6], rkc = cst[j][7];
#pragma unroll
            for (int r = 0; r < 4; ++r) { const int t = 16 * tm + 4 * q + r; const bool valid = t < tval;
                const float pr = gp[j][r][0], pk = gp[j][r][1], pv = gp[j][r][2];
                const float qr = r ? gp[j][r - 1][0] : gq[j][0], qk = r ? gp[j][r - 1][1] : gq[j][1], qv = r ? gp[j][r - 1][2] : gq[j][2];
                const float r_ = pr + (qr - pr) * mur, k_ = pk + (qk - pk) * muk, v_ = pv + (qv - pv) * muv;
                const float wpre = w0c + aw[j][r];
                const float sp = fmaxf(-wpre, 0.f) + __logf(1.0f + __expf(-fabsf(wpre)));
                const float wlog = -sp - 0.5f;
                const float a_ = fast_sigmoid(a0c + aa[j][r]);
                const float kk_ = k_ * kkc, kp_ = k_ * (1.0f + (a_ - 1.0f) * kac);
                xr[j][r] = valid ? r_ : 0.f; kp[j][r] = valid ? kp_ : 0.f; xv[j][r] = valid ? v_ : 0.f; lw[j][r] = valid ? -__expf(wlog) : 0.f; av[j][r] = valid ? a_ : 0.f; kkr[j][r] = valid ? kk_ : 0.f;
                ssq[r] += kkr[j][r] * kkr[j][r]; bsum[r] += xr[j][r] * kp[j][r] * rkc;
            }
            *(f32x4*)(GG + (size_t)it * 4096 + frag_c(n, 16 * tm + 4 * q)) = ag[j]; }
#pragma unroll
        for (int r = 0; r < 4; ++r) {
#pragma unroll
            for (int o = 1; o < 16; o <<= 1) { ssq[r] += __shfl_xor(ssq[r], o); bsum[r] += __shfl_xor(bsum[r], o); }
            if (i == 0) { const int t = 16 * tm + 4 * q + r; RED[(t * 2 + (wave & 1)) * 2 + 0] = ssq[r]; RED[(t * 2 + (wave & 1)) * 2 + 1] = bsum[r]; } }
        { const int itn = it + F.G < NITEM ? it + F.G : it; nxt = item_info(itn); R1_RELANE(); load_top(nxt); }
        float cin[2][4], exq[2];
#pragma unroll
        for (int j = 0; j < 2; ++j) { cin[j][0] = lw[j][0]; cin[j][1] = cin[j][0] + lw[j][1]; cin[j][2] = cin[j][1] + lw[j][2]; cin[j][3] = cin[j][2] + lw[j][3];
            const float tot = cin[j][3]; float ex = 0.f, wt = 0.f;
#pragma unroll
            for (int qq = 0; qq < 4; ++qq) { const float tq = __shfl(tot, i + 16 * qq); wt += tq; ex += qq < q ? tq : 0.f; }
            exq[j] = ex; if (q == 0) CS[tm * 64 + 16 * (tnb + j) + i] = wt; }
        for (int z = tid; z < 2304; z += NTHR) LP(unsigned, lds + R1_MB)[z] = 0u;
        __syncthreads();
        R1_RELANE();
#pragma unroll
        for (int j = 0; j < 2; ++j) { const int n = 16 * (tnb + j) + i, col = h * 64 + n; float tmex = 0.f, csT = 0.f;
#pragma unroll
            for (int z = 0; z < 4; ++z) { const float c_ = CS[z * 64 + n]; csT += c_; tmex += z < tm ? c_ : 0.f; }
            const float gTj = __expf(csT);
            if (tm == 0 && q == 0) GTV[n] = gTj;
            f32x4 vKapT, vVT, vBbT, vKbT, vBon;
#pragma unroll
            for (int r = 0; r < 4; ++r) { const int t = 16 * tm + 4 * q + r;
                const float cst = tmex + exq[j] + cin[j][r], csp = cst - lw[j][r];
                const float sq = RED[(t * 2 + 0) * 2 + 0] + RED[(t * 2 + 1) * 2 + 0], bt = RED[(t * 2 + 0) * 2 + 1] + RED[(t * 2 + 1) * 2 + 1];
                const float kk_ = kkr[j][r] * __builtin_amdgcn_rsqf(fmaxf(sq, 1e-24f)), b_ = kk_ * av[j][r];
                const float gt = __expf(cst), gi = __builtin_amdgcn_rcpf(gt), gp = __expf(csp), ge = gTj * gi;
                LP(u16, lds + R1_RT)[t * 72 + n] = f2bf1(xr[j][r] * gt);
                LP(u16, lds + R1_KH)[t * 72 + n] = f2bf1(kp[j][r] * gi);
                LP(u16, lds + R1_BH)[t * 72 + n] = f2bf1(b_ * gi);
                LP(u16, lds + R1_KAP)[t * 72 + n] = f2bf1(kk_ * gp);
                vKapT[r] = kk_ * gp; vVT[r] = xv[j][r]; vBbT[r] = b_ * ge; vKbT[r] = kp[j][r] * ge;
                vBon[r] = bt * xv[j][r];
                asm volatile("" ::: "memory");
            }
            const int t0 = 16 * tm + 4 * q;
            *(f32x4*)(BON + (size_t)it * 4096 + frag_c(n, t0)) = vBon;
            st_tr(lds + R1_KAPT, vKapT, n, t0); st_tr(lds + R1_VT, vVT, n, t0); st_tr(lds + R1_BBT, vBbT, n, t0); st_tr(lds + R1_KBT, vKbT, n, t0);
            asm volatile("" ::: "memory");
        }
        __syncthreads();
        R1_RELANE();
        { f32x4 c1[2], c2[2];
#pragma unroll
          for (int j = 0; j < 2; ++j) { c1[j] = (f32x4){0.f, 0.f, 0.f, 0.f}; c2[j] = c1[j]; }
          mm64(c1, lds + R1_KAP, lds + R1_BH, tm, tnb, lane); mm64(c2, lds + R1_KAP, lds + R1_KH, tm, tnb, lane);
#pragma unroll
          for (int j = 0; j < 2; ++j) { const int ic = 16 * (tnb + j) + i;
#pragma unroll
              for (int r = 0; r < 4; ++r) { const int t = 16 * tm + 4 * q + r;
                  ABKF[t * 65 + ic] = ic < t ? c1[j][r] : 0.f;
                  LP(u16, lds + R1_AKK)[t * 72 + ic] = f2bf1(ic < t ? c2[j][r] : 0.f); } }
        }
        asm volatile("" ::: "memory");
        { f32x4 c3[2], c4[2];
#pragma unroll
          for (int j = 0; j < 2; ++j) { c3[j] = (f32x4){0.f, 0.f, 0.f, 0.f}; c4[j] = c3[j]; }
          mm64(c3, lds + R1_RT, lds + R1_BH, tm, tnb, lane);  mm64(c4, lds + R1_RT, lds + R1_KH, tm, tnb, lane);
#pragma unroll
          for (int j = 0; j < 2; ++j) { const int ic = 16 * (tnb + j) + i;
#pragma unroll
              for (int r = 0; r < 4; ++r) { const int t = 16 * tm + 4 * q + r;
                  LP(u16, lds + R1_ABR)[t * 72 + ic] = f2bf1(ic <= t ? c3[j][r] : 0.f);
                  LP(u16, lds + R1_AKR)[t * 72 + ic] = f2bf1(ic <= t ? c4[j][r] : 0.f); } }
        }
        __syncthreads();
#ifndef R1REP4
#define R1REP4 1
#endif
#pragma unroll 1
        for (int rep4 = 0; rep4 < R1REP4; ++rep4) {
        R1_RELANE();
        if (wave == 0) { const int g = q, c = i; float m[16];
#pragma unroll
            for (int ii = 0; ii < 16; ++ii) { float acc = ii == c ? 1.f : 0.f;
#pragma unroll
                for (int jj = 0; jj < ii; ++jj) acc -= ABKF[(16 * g + ii) * 65 + 16 * g + jj] * m[jj];
                m[ii] = acc; MF[(16 * g + ii) * 65 + 16 * g + c] = acc; LP(u16, lds + R1_MB)[(16 * g + ii) * 72 + 16 * g + c] = (u16)f2bf(acc); } }
        __syncthreads();
#define BLK(P, bi, bj) ((P) + (16 * (bi)) * 65 + 16 * (bj))
#define PUTM(bi, bj, acc) do { _Pragma("unroll") for (int r = 0; r < 4; ++r) { MF[(16 * (bi) + 4 * q + r) * 65 + 16 * (bj) + i] = -(acc)[r]; LP(u16, lds + R1_MB)[(16 * (bi) + 4 * q + r) * 72 + 16 * (bj) + i] = (u16)f2bf(-(acc)[r]); } } while (0)
        { LAS float* T = LP(float, lds + R1_T16) + wave * 272; const f32x4 z4 = {0.f, 0.f, 0.f, 0.f};
          if (wave < 3) { const int bi = wave + 1, bj = wave; f32x4 t = prod16(z4, BLK(ABKF, bi, bj), 65, BLK(MF, bj, bj), 65, lane);
#pragma unroll
              for (int r = 0; r < 4; ++r) T[(4 * q + r) * 17 + i] = t[r];
              f32x4 mres = prod16(z4, BLK(MF, bi, bi), 65, T, 17, lane); PUTM(bi, bj, mres); }
          __syncthreads();
          if (wave < 2) { const int bi = wave + 2, bj = wave; f32x4 t = prod16(z4, BLK(ABKF, bi, bj), 65, BLK(MF, bj, bj), 65, lane); t = prod16(t, BLK(ABKF, bi, bj + 1), 65, BLK(MF, bj + 1, bj), 65, lane);
#pragma unroll
              for (int r = 0; r < 4; ++r) T[(4 * q + r) * 17 + i] = t[r];
              f32x4 mres = prod16(z4, BLK(MF, bi, bi), 65, T, 17, lane); PUTM(bi, bj, mres); }
          __syncthreads();
          if (wave == 0) { f32x4 t = prod16(z4, BLK(ABKF, 3, 0), 65, BLK(MF, 0, 0), 65, lane); t = prod16(t, BLK(ABKF, 3, 1), 65, BLK(MF, 1, 0), 65, lane); t = prod16(t, BLK(ABKF, 3, 2), 65, BLK(MF, 2, 0), 65, lane);
#pragma unroll
              for (int r = 0; r < 4; ++r) T[(4 * q + r) * 17 + i] = t[r];
              f32x4 mres = prod16(z4, BLK(MF, 3, 3), 65, T, 17, lane); PUTM(3, 0, mres); }
          __syncthreads();
        }
#undef BLK
#undef PUTM
        }
        R1_RELANE();
        {
            const int sl = wave & 3, nb = 16 * sl + i;
            auto afrag = [&](int arr, int rt, int st) -> bf16x8 { return *LP(const bf16x8, lds + arr + ((16 * rt + i) * 72 + 32 * st + 8 * q) * 2); };
            auto afragp = [&](int arr, int rt, int st) -> bf16x8 { const u32x2 a0 = *LP(const u32x2, lds + arr + ((16 * rt + i) * 72 + 32 * st + 4 * q) * 2), a1 = *LP(const u32x2, lds + arr + ((16 * rt + i) * 72 + 32 * st + 16 + 4 * q) * 2);
                                                                  return __builtin_bit_cast(bf16x8, (v4u){a0.x, a0.y, a1.x, a1.y}); };
            auto packb = [&](const f32x4& lo, const f32x4& hi2) -> bf16x8 { return __builtin_bit_cast(bf16x8, (v4u){cvtpk(lo[0], lo[1]), cvtpk(lo[2], lo[3]), cvtpk(hi2[0], hi2[1]), cvtpk(hi2[2], hi2[3])}); };
            const f32x4 z4 = {0.f, 0.f, 0.f, 0.f};
            if (wave < 4) {
                bf16x8 vfr[2];
#pragma unroll
                for (int st = 0; st < 2; ++st) vfr[st] = *LP(const bf16x8, lds + R1_VT + (nb * 72 + 32 * st + 8 * q) * 2);
                f32x4 g[4], u[4];
#pragma unroll
                for (int rt = 0; rt < 4; ++rt) { g[rt] = mfma16(afrag(R1_AKK, rt, 0), vfr[0], z4); g[rt] = mfma16(afrag(R1_AKK, rt, 1), vfr[1], g[rt]); }
                bf16x8 gb[2] = {packb(g[0], g[1]), packb(g[2], g[3])};
#pragma unroll
                for (int rt = 0; rt < 4; ++rt) { u[rt] = mfma16(afragp(R1_MB, rt, 0), gb[0], z4); u[rt] = mfma16(afragp(R1_MB, rt, 1), gb[1], u[rt]); }
                bf16x8 ub[2] = {packb(u[0], u[1]), packb(u[2], u[3])};
                float* OT = (float*)(ws + WS_OT) + (size_t)it * 4096; float* HT = (float*)(ws + WS_HT) + (size_t)it * 4096;
#pragma unroll
                for (int rt = 0; rt < 4; ++rt) {
                    f32x4 o1 = mfma16(afrag(R1_AKR, rt, 0), vfr[0], z4); o1 = mfma16(afrag(R1_AKR, rt, 1), vfr[1], o1);
                    f32x4 o2 = mfma16(afragp(R1_ABR, rt, 0), ub[0], z4); o2 = mfma16(afragp(R1_ABR, rt, 1), ub[1], o2);
                    *(f32x4*)(OT + ((sl * 4 + rt) * 64 + lane) * 4) = o1 - o2;
                    f32x4 h1 = mfma16(afrag(R1_KBT, rt, 0), vfr[0], z4); h1 = mfma16(afrag(R1_KBT, rt, 1), vfr[1], h1);
                    f32x4 h2 = mfma16(afragp(R1_BBT, rt, 0), ub[0], z4); h2 = mfma16(afragp(R1_BBT, rt, 1), ub[1], h2);
                    *(f32x4*)(HT + ((sl * 4 + rt) * 64 + lane) * 4) = h1 - h2;
                }
            } else {
                bf16x8 kfr[2];
#pragma unroll
                for (int st = 0; st < 2; ++st) kfr[st] = *LP(const bf16x8, lds + R1_KAPT + (nb * 72 + 32 * st + 8 * q) * 2);
                f32x4 w[4];
#pragma unroll
                for (int rt = 0; rt < 4; ++rt) { w[rt] = mfma16(afrag(R1_MB, rt, 0), kfr[0], z4); w[rt] = mfma16(afrag(R1_MB, rt, 1), kfr[1], w[rt]); }
                bf16x8 wb[2] = {packb(w[0], w[1]), packb(w[2], w[3])};
                bf16* QT = (bf16*)(ws + WS_QT) + (size_t)it * 4096; bf16* PT = (bf16*)(ws + WS_PT) + (size_t)it * 4096;
                const float gtv = GTV[nb];
#pragma unroll
                for (int rt = 0; rt < 4; ++rt) {
                    f32x4 cq = mfma16(afragp(R1_ABR, rt, 0), wb[0], z4); cq = mfma16(afragp(R1_ABR, rt, 1), wb[1], cq);
                    f32x4 cp = mfma16(afragp(R1_BBT, rt, 0), wb[0], z4); cp = mfma16(afragp(R1_BBT, rt, 1), wb[1], cp);
#pragma unroll
                    for (int r = 0; r < 4; ++r) { const int t = 16 * rt + 4 * q + r;
                        QT[frag_a(t, nb)] = f2bf1(bf2f(LP(u16, lds + R1_RT)[t * 72 + nb]) - cq[r]);
                        PT[frag_a(t, nb)] = f2bf1((t == nb ? gtv : 0.f) - cp[r]); }
                }
            }
        }
        cur = nxt;
        __syncthreads();
    }
}

struct R2St { bf16x8 pa[4][2]; f32x4 hh[4]; };
__device__ __forceinline__ void r2_load(R2St& o, const unsigned char* ws, int it, int lane, int vs) {
    const bf16* PT = (const bf16*)(ws + WS_PT) + (size_t)it * 4096; const float* HT = (const float*)(ws + WS_HT) + (size_t)it * 4096;
#pragma unroll
    for (int tt = 0; tt < 4; ++tt) {
#pragma unroll
        for (int s = 0; s < 2; ++s) o.pa[tt][s] = *(const bf16x8*)(PT + ((tt * 2 + s) * 64 + lane) * 8);
        o.hh[tt] = *(const f32x4*)(HT + ((vs * 4 + tt) * 64 + lane) * 4);
    }
}
__device__ __forceinline__ void r2_step(const R2St& r, f32x4 (&S)[4], unsigned char* ws, int it, int vs, int lane) {
    bf16x8 bs[2];
#pragma unroll
    for (int s = 0; s < 2; ++s) { v4u w; w.x = cvtpk(S[2 * s][0], S[2 * s][1]); w.y = cvtpk(S[2 * s][2], S[2 * s][3]); w.z = cvtpk(S[2 * s + 1][0], S[2 * s + 1][1]); w.w = cvtpk(S[2 * s + 1][2], S[2 * s + 1][3]); bs[s] = __builtin_bit_cast(bf16x8, w);
        *(v4u*)(ws + WS_SC + (size_t)it * 8192 + (size_t)((vs * 2 + s) * 64 + lane) * 16) = w; }
#pragma unroll
    for (int kt = 0; kt < 4; ++kt) { f32x4 acc = r.hh[kt];
#pragma unroll
        for (int s = 0; s < 2; ++s) acc = mfma16(r.pa[kt][s], bs[s], acc);
        S[kt] = acc; }
}
__device__ __forceinline__ void ph_rwkv2(const Frame& F0, const Args& a, int l) {
    const Frame F = relaunder(F0);
    unsigned char* ws = a.ws;
    const int lane = F.lane, i = lane & 15, q = lane >> 4;
    for (int slot = F.vcu * NWAVES + F.wave; slot < 2048; slot += F.G * NWAVES) {
        int nchunk, item0, h, vs; float* sout; f32x4 S[4];
        if ((slot & 15) == 0) { const int pu = slot >> 4; const int s = pu >> 5; h = (pu >> 2) & 7; vs = pu & 3; nchunk = SEQ / 64; item0 = s * 1024 + h;
            sout = a.out + OFF_WKVP + ((size_t)(l * NB + s) * HB + h) * 4096;
#pragma unroll
            for (int kt = 0; kt < 4; ++kt) S[kt] = (f32x4){0.f, 0.f, 0.f, 0.f}; }
        else { const int d = slot - (slot >> 4) - 1; if (d >= DECB * HB * 4) continue; const int b = d >> 5; h = (d >> 2) & 7; vs = d & 3; nchunk = 1; item0 = NITEM_P + b * 8 + h;
            sout = a.out + OFF_WKVS + ((size_t)(l * DECB + b) * HB + h) * 4096;
            const float* sin = a.in[I_SWKV] + ((size_t)(l * DECB + b) * HB + h) * 4096 + (16 * vs + i) * 64 + 4 * q;
#pragma unroll
            for (int kt = 0; kt < 4; ++kt) S[kt] = *(const f32x4*)(sin + 16 * kt); }
        const int v = 16 * vs + i;
        const int itl = item0 + 8 * (nchunk - 1);
        R2St r0, r1, r2;
        r2_load(r0, ws, item0, lane, vs);
        r2_load(r1, ws, min(item0 + 8, itl), lane, vs);
        r2_load(r2, ws, min(item0 + 16, itl), lane, vs);
        int c = 0;
#pragma unroll 1
        for (; c + 3 <= nchunk; c += 3) {
            const int it = item0 + 8 * c;
            r2_step(r0, S, ws, it, vs, lane);      r2_load(r0, ws, min(it + 24, itl), lane, vs);
            r2_step(r1, S, ws, it + 8, vs, lane);  r2_load(r1, ws, min(it + 32, itl), lane, vs);
            r2_step(r2, S, ws, it + 16, vs, lane); r2_load(r2, ws, min(it + 40, itl), lane, vs);
        }
        if (c < nchunk) { r2_step(r0, S, ws, item0 + 8 * c, vs, lane); ++c; }
        if (c < nchunk) { r2_step(r1, S, ws, item0 + 8 * c, vs, lane); ++c; }
#pragma unroll
        for (int kt = 0; kt < 4; ++kt) *(f32x4*)(sout + (size_t)v * 64 + 16 * kt + 4 * q) = S[kt];
    }
}
__device__ __forceinline__ void ph_rwkv3(const Frame& F0, const Args& a, int l) {
    const Frame F = relaunder(F0);
    const unsigned char* ws = a.ws;
    bf16* YB = (bf16*)(a.ws + WS_YAB) + (size_t)M * 512; const float* lg = a.in[I_LNXG] + l * 512; const float* lb = a.in[I_LNXB] + l * 512;
    const int lane = F.lane, i = lane & 15, q = lane >> 4;
    LAS unsigned char* st = F.lds + F.wave * 9216;
    for (int it = F.vcu * NWAVES + F.wave; it < NITEM; it += F.G * NWAVES) {
        const bool dec = it >= NITEM_P; int h, row0, ntt;
        if (!dec) { const int s = it >> 10, c = (it >> 3) & 127; h = it & 7; row0 = s * SEQ + 64 * c; ntt = 4; }
        else { const int b = (it - NITEM_P) >> 3; h = it & 7; row0 = MP + DECS * b; ntt = 2; }
        const bf16* QT = (const bf16*)(ws + WS_QT) + (size_t)it * 4096; const float* OT = (const float*)(ws + WS_OT) + (size_t)it * 4096;
        const float* GG = (const float*)(ws + WS_GG) + (size_t)it * 4096; const float* BON = (const float*)(ws + WS_BON) + (size_t)it * 4096;
        bf16x8 bfr[4][2];
#pragma unroll
        for (int vs = 0; vs < 4; ++vs)
#pragma unroll
            for (int s = 0; s < 2; ++s) bfr[vs][s] = *(const bf16x8*)(ws + WS_SC + (size_t)it * 8192 + (size_t)((vs * 2 + s) * 64 + lane) * 16);
        float lgv[4], lbv[4];
#pragma unroll
        for (int vs = 0; vs < 4; ++vs) { lgv[vs] = lg[h * 64 + 16 * vs + i]; lbv[vs] = lb[h * 64 + 16 * vs + i]; }
#pragma unroll
        for (int tt = 0; tt < 4; ++tt) if (tt < ntt) {
            bf16x8 af[2];
#pragma unroll
            for (int s = 0; s < 2; ++s) af[s] = *(const bf16x8*)(QT + ((tt * 2 + s) * 64 + lane) * 8);
            f32x4 acc[4];
#pragma unroll
            for (int vs = 0; vs < 4; ++vs) { acc[vs] = *(const f32x4*)(OT + ((vs * 4 + tt) * 64 + lane) * 4); acc[vs] = mfma16(af[0], bfr[vs][0], acc[vs]); acc[vs] = mfma16(af[1], bfr[vs][1], acc[vs]); }
            f32x4 sm = (acc[0] + acc[1]) + (acc[2] + acc[3]);
#pragma unroll
            for (int o = 1; o < 16; o <<= 1) { sm[0] += __shfl_xor(sm[0], o); sm[1] += __shfl_xor(sm[1], o); sm[2] += __shfl_xor(sm[2], o); sm[3] += __shfl_xor(sm[3], o); }
            const f32x4 mean = sm * (1.f / 64.f);
            f32x4 s2 = {0.f, 0.f, 0.f, 0.f};
#pragma unroll
            for (int vs = 0; vs < 4; ++vs) { acc[vs] = acc[vs] - mean; s2 += acc[vs] * acc[vs]; }
#pragma unroll
            for (int o = 1; o < 16; o <<= 1) { s2[0] += __shfl_xor(s2[0], o); s2[1] += __shfl_xor(s2[1], o); s2[2] += __shfl_xor(s2[2], o); s2[3] += __shfl_xor(s2[3], o); }
            f32x4 rstd;
#pragma unroll
            for (int r = 0; r < 4; ++r) rstd[r] = 1.0f / sqrtf(s2[r] * (1.f / 64.f) + GN_EPS);
#pragma unroll
            for (int vs = 0; vs < 4; ++vs) { const int v = 16 * vs + i;
                const f32x4 bn = *(const f32x4*)(BON + ((vs * 4 + tt) * 64 + lane) * 4), gg = *(const f32x4*)(GG + ((vs * 4 + tt) * 64 + lane) * 4);
                const f32x4 y = (acc[vs] * rstd * lgv[vs] + lbv[vs] + bn) * gg;
#pragma unroll
                for (int r = 0; r < 4; ++r) LP(u16, st)[(16 * tt + 4 * q + r) * 72 + v] = (u16)f2bf(y[r]); }
        }
        if (lane < 16 * ntt) {
            bf16* yrow = YB + (size_t)(row0 + lane) * 512 + h * 64;
#pragma unroll
            for (int c8 = 0; c8 < 8; ++c8) *(v4u*)(yrow + 8 * c8) = *LP(const v4u, st + (lane * 72 + 8 * c8) * 2);
        }
    }
}
constexpr int NPH_LAYER = 13, NPH = 2 + DEPTH * NPH_LAYER;
#ifndef MK_LAUNCH_PER_PHASE
#define MK_LAUNCH_PER_PHASE 0
#endif
typedef const __attribute__((address_space(4))) Args* KArgsPtr;
__device__ __forceinline__ const Args& kargs() { KArgsPtr p = (KArgsPtr)__builtin_amdgcn_kernarg_segment_ptr(); asm volatile("" : "+s"(p)); return *(const Args*)p; }
template <unsigned PHMASK> __global__ void __launch_bounds__(NTHR, 2) fwd(Args args_unused) {
    extern __shared__ __attribute__((aligned(16))) unsigned char lds_raw[];
    Frame F;
    F.lds = (LAS unsigned char*)lds_raw;
    F.tid = 0; F.lane = 0; F.wave = __builtin_amdgcn_readfirstlane((int)threadIdx.x >> 6);
    F.G = gridDim.x; { const int bx = blockIdx.x; F.vcu = (F.G % 8 == 0) ? (bx % 8) * (F.G / 8) + bx / 8 : bx; }
    volatile LAS unsigned* MISC = (volatile LAS unsigned*)(F.lds + LDSCTL_OFF);
    for (int u = threadIdx.x; u < (LDS_BYTES - LDSCTL_OFF) / 4; u += NTHR) ((LAS unsigned*)(F.lds + LDSCTL_OFF))[u] = 0u;
    __syncthreads();
    int lo, hi; { const Args& a = kargs(); lo = a.ph_lo; hi = a.ph_hi; }
    XcdBarrier bar; { const Args& a = kargs(); bar.bar = (unsigned*)(a.ws + WS_CTL) + CW_BAR; } bar.x = 0; bar.st = nullptr;
    if (hi - lo > 1) bar = xcd_barrier_post(bar.bar, MISC + 8);
    bar.wave = F.wave;
#define IN(k) (lo <= (k) && (k) < hi)
#define ON(n, k) (((PHMASK >> (n)) & 1u) && IN(k))
#define SEAM(k) do { if (IN(k) && IN((k) + 1)) xcd_barrier(bar); } while (0)
#define WSP(T, off) ((T*)(a.ws + (off)))
#ifndef REP_MASK
#define REP_MASK 0u
#endif
#define REPS(n) ((((REP_MASK) >> (n)) & 1u) ? 2 : 1)
    if (ON(13, 0)) { const Args& a = kargs(); ph_prologue(F, a); } SEAM(0);
    if (ON(14, 1)) { const Args& a = kargs(); ph_ln(F, a.in[I_XP], a.in[I_XS], nullptr, 0.f, nullptr, nullptr, nullptr, WSP(float, WS_MOD), nullptr, WSP(bf16, WS_U)); } SEAM(1);
#pragma unroll 1
    for (int l = 0; l < DEPTH; ++l) {
        const int pb = 2 + l * NPH_LAYER;
        const size_t wlo = WS_W + (size_t)l * WL_SIZE, modo = WS_MOD + (size_t)l * NSEQ * 9216 * 4;
        for (int rep_ = 0; rep_ < REPS(0); ++rep_) if (ON(0, pb + 0)) { if (rep_) xcd_barrier(bar); const Args& a = kargs(); pg8::Gemm g{WSP(bf16, WS_U), WSP(const bf16, wlo + WL_GU0), M, NGU, D}; pg8::StaticOrder S; S.init(M, NGU, opq(F.G), opq((int)blockIdx.x)); pg8::EpiSwiglu E{WSP(bf16, WS_ACT), DFF};
            pg8::gemm_phase<pg8::EpiSwiglu, pg8::StaticOrder, true, true>(F.lds, g, S, E, opq(F.wave)); } SEAM(pb + 0);
        for (int rep_ = 0; rep_ < REPS(1); ++rep_) if (ON(1, pb + 1)) { if (rep_) xcd_barrier(bar); const Args& a = kargs(); pg8::Gemm g{WSP(bf16, WS_ACT), WSP(const bf16, wlo + WL_DN0), M, D, DFF}; pg8::SplitOrder S; S.init(MP, D, opq(F.G), opq((int)blockIdx.x), DFF / 256); pg8::EpiF32S E{WSP(bf16, WS_F), WSP(float, WS_FP), D, MP, MD};
            pg8::gemm_phase<pg8::EpiF32S, pg8::SplitOrder, true, true>(F.lds, g, S, E, opq(F.wave)); } SEAM(pb + 1);
        for (int rep_ = 0; rep_ < REPS(2); ++rep_) if (ON(2, pb + 2)) { if (rep_) xcd_barrier(bar); const Args& a = kargs(); const float* modl = WSP(float, modo);
            ph_ln(F, l == 0 ? a.in[I_XP] : a.out, l == 0 ? a.in[I_XS] : nullptr, WSP(bf16, WS_F), 0.5f, modl + 2 * D, a.in[I_LNG] + (l * 3 + 0) * D, a.in[I_LNB] + (l * 3 + 0) * D, modl + 3 * D, a.out, WSP(bf16, WS_U), WSP(float, WS_FP), DFF / 256); } SEAM(pb + 2);
        for (int rep_ = 0; rep_ < REPS(3); ++rep_) if (ON(3, pb + 3)) { if (rep_) xcd_barrier(bar); const Args& a = kargs(); pg8::Gemm g{WSP(bf16, WS_U), WSP(const bf16, wlo + WL_IG), M, NIG, D}; pg8::StaticOrder S; S.init(M, NIG, opq(F.G), opq((int)blockIdx.x));
            pg8::EpiProj E{WSP(bf16, WS_Q), WSP(bf16, WS_KB), WSP(bf16, WS_VB), WSP(float, WS_PRW), WSP(bf16, WS_PLB), WSP(bf16, WS_GATES), a.in[I_BGATE] + l * 2048,
                a.out + OFF_KP + (size_t)l * MP * 512, a.out + OFF_VP + (size_t)l * MP * 512, a.out + OFF_KS + (size_t)l * MD * 512, a.out + OFF_VS + (size_t)l * MD * 512,
                a.out + OFF_SHP + (size_t)l * NB * NRW, a.out + OFF_SHS + (size_t)l * DECB * NRW, QSCALE};
            pg8::gemm_phase<pg8::EpiProj, pg8::StaticOrder, true, true>(F.lds, g, S, E, opq(F.wave)); } SEAM(pb + 3);
        for (int rep_ = 0; rep_ < REPS(4); ++rep_) if (ON(4, pb + 4)) { if (rep_) xcd_barrier(bar); const Args& a = kargs(); ph_rwkv1(F, a, l); } SEAM(pb + 4);
        if (ON(5, pb + 5)) { const Args& a = kargs(); ph_rwkv2(F, a, l); }
        if (ON(5, pb + 5)) { const Args& a = kargs();
            AttnP P{WSP(bf16, WS_Q), WSP(bf16, WS_KB), WSP(bf16, WS_VB), a.in[I_CK] + (size_t)l * DECB * PAST * 512, a.in[I_CV] + (size_t)l * DECB * PAST * 512, WSP(bf16, WS_YAB), a.in[I_RELB], a.in[I_SUBG] + l * 128,
                    WSP(float, WS_LAM)[l], 1.0f - (0.8f - 0.6f * expf(-0.3f * (float)l))};
            ph_attn(F, P, (unsigned*)(a.ws + WS_CTL) + CW_QUEUE + 64 * l); } SEAM(pb + 5);
        for (int rep_ = 0; rep_ < REPS(6); ++rep_) if (ON(6, pb + 6)) { if (rep_) xcd_barrier(bar); const Args& a = kargs(); ph_rwkv3(F, a, l); } SEAM(pb + 6);
        for (int rep_ = 0; rep_ < REPS(7); ++rep_) if (ON(7, pb + 7)) { if (rep_) xcd_barrier(bar); const Args& a = kargs(); pg8::Gemm g{WSP(bf16, WS_YAB), WSP(const bf16, wlo + WL_BR), 2 * M, 2048, 512}; pg8::PairOrder S{NPAN * 4, opq(F.G), opq((int)blockIdx.x), NPAN}; pg8::EpiMerge E{WSP(float, WS_F), WSP(bf16, WS_MERGED), WSP(bf16, WS_GATES), NPAN};
            pg8::gemm_phase<pg8::EpiMerge, pg8::PairOrder, true, true>(F.lds, g, S, E, opq(F.wave)); } SEAM(pb + 7);
        for (int rep_ = 0; rep_ < REPS(8); ++rep_) if (ON(8, pb + 8)) { if (rep_) xcd_barrier(bar); const Args& a = kargs(); pg8::Gemm g{WSP(bf16, WS_MERGED), WSP(const bf16, wlo + WL_O), M, D, D}; pg8::SplitOrder S; S.init(MP, D, opq(F.G), opq((int)blockIdx.x), D / 256); pg8::EpiF32S E{WSP(bf16, WS_F), WSP(float, WS_FP), D, MP, MD};
            pg8::gemm_phase<pg8::EpiF32S, pg8::SplitOrder, true, true>(F.lds, g, S, E, opq(F.wave)); } SEAM(pb + 8);
        for (int rep_ = 0; rep_ < REPS(9); ++rep_) if (ON(9, pb + 9)) { if (rep_) xcd_barrier(bar); const Args& a = kargs(); const float* modl = WSP(float, modo);
            ph_ln(F, a.out, nullptr, WSP(bf16, WS_F), 1.0f, modl + 5 * D, a.in[I_LNG] + (l * 3 + 1) * D, a.in[I_LNB] + (l * 3 + 1) * D, modl + 6 * D, a.out, WSP(bf16, WS_U), WSP(float, WS_FP), D / 256); } SEAM(pb + 9);
        for (int rep_ = 0; rep_ < REPS(10); ++rep_) if (ON(10, pb + 10)) { if (rep_) xcd_barrier(bar); const Args& a = kargs(); pg8::Gemm g{WSP(bf16, WS_U), WSP(const bf16, wlo + WL_GU1), M, NGU, D}; pg8::StaticOrder S; S.init(M, NGU, opq(F.G), opq((int)blockIdx.x)); pg8::EpiSwiglu E{WSP(bf16, WS_ACT), DFF};
            pg8::gemm_phase<pg8::EpiSwiglu, pg8::StaticOrder, true, true>(F.lds, g, S, E, opq(F.wave)); } SEAM(pb + 10);
        for (int rep_ = 0; rep_ < REPS(11); ++rep_) if (ON(11, pb + 11)) { if (rep_) xcd_barrier(bar); const Args& a = kargs(); pg8::Gemm g{WSP(bf16, WS_ACT), WSP(const bf16, wlo + WL_DN1), M, D, DFF}; pg8::SplitOrder S; S.init(MP, D, opq(F.G), opq((int)blockIdx.x), DFF / 256); pg8::EpiF32S E{WSP(bf16, WS_F), WSP(float, WS_FP), D, MP, MD};
            pg8::gemm_phase<pg8::EpiF32S, pg8::SplitOrder, true, true>(F.lds, g, S, E, opq(F.wave)); } SEAM(pb + 11);
        for (int rep_ = 0; rep_ < REPS(12); ++rep_) if (ON(12, pb + 12)) { if (rep_) xcd_barrier(bar); const Args& a = kargs(); const float* modl = WSP(float, modo);
            ph_ln(F, a.out, nullptr, WSP(bf16, WS_F), 0.5f, modl + 8 * D, a.in[I_LNG] + (l * 3 + 2) * D, a.in[I_LNB] + (l * 3 + 2) * D, l + 1 < DEPTH ? modl + (size_t)NSEQ * 9216 : nullptr, a.out, WSP(bf16, WS_U), WSP(float, WS_FP), DFF / 256); } SEAM(pb + 12);
    }
#undef IN
#undef ON
#undef SEAM
#undef WSP
}

#if MK_LAUNCH_PER_PHASE
static const void* phase_fn(int k) {
    switch (k) { case 0: return (const void*)fwd<1u << 0>; case 1: return (const void*)fwd<1u << 1>; case 2: return (const void*)fwd<1u << 2>; case 3: return (const void*)fwd<1u << 3>;
        case 4: return (const void*)fwd<1u << 4>; case 5: return (const void*)fwd<1u << 5>; case 6: return (const void*)fwd<1u << 6>; case 7: return (const void*)fwd<1u << 7>;
        case 8: return (const void*)fwd<1u << 8>; case 9: return (const void*)fwd<1u << 9>; case 10: return (const void*)fwd<1u << 10>; case 11: return (const void*)fwd<1u << 11>;
        case 12: return (const void*)fwd<1u << 12>; case 13: return (const void*)fwd<1u << 13>; case 14: return (const void*)fwd<1u << 14>; default: return (const void*)fwd<1u << 15>; }
}
#else
#ifndef FULL_MASK
#define FULL_MASK 0xFFFFu
#endif
static const void* phase_fn(int) { return (const void*)fwd<FULL_MASK>; }
#endif

extern "C" void kernel_launch(void* const* d_in, const int* in_sizes, int n_in, void* d_out, int out_size, void* d_ws, size_t ws_size, hipStream_t stream) {
    static int grid = 0;
    if (grid == 0) {
        if (n_in != 34 || (size_t)out_size != OUT_TOTAL || ws_size < WS_END) { fprintf(stderr, "kernel_launch: unexpected shapes: n_in %d out %d ws %zu (need %zu)\n", n_in, out_size, ws_size, (size_t)WS_END); grid = -1; return; }
        int dev = 0, cus = 0, per_cu = 0;
        if (hipGetDevice(&dev) != hipSuccess || hipDeviceGetAttribute(&cus, hipDeviceAttributeMultiprocessorCount, dev) != hipSuccess) { grid = -1; return; }
        for (int k = 0; k < 16; ++k) if (hipFuncSetAttribute(phase_fn(k), hipFuncAttributeMaxDynamicSharedMemorySize, LDS_BYTES) != hipSuccess) { fprintf(stderr, "kernel_launch: hipFuncSetAttribute failed\n"); grid = -1; return; }
        if (hipOccupancyMaxActiveBlocksPerMultiprocessor(&per_cu, phase_fn(15), NTHR, LDS_BYTES) != hipSuccess || per_cu < 1) fprintf(stderr, "kernel_launch: occupancy query reports %d\n", per_cu);
        (void)hipGetLastError();
        grid = cus;
    }
    if (grid < 0) return;
    (void)hipMemsetAsync((char*)d_ws + WS_CTL, 0, CTL_ZERO_BYTES, stream);
    Args a{};
    for (int i = 0; i < 34; ++i) a.in[i] = (const float*)d_in[i];
    a.out = (float*)d_out; a.ws = (unsigned char*)d_ws;
#if MK_LAUNCH_PER_PHASE
#ifndef MAXPH
#define MAXPH NPH
#endif
    for (int p = 0; p < MAXPH; ++p) { a.ph_lo = p; a.ph_hi = p + 1; const int kind = p < 2 ? 13 + p : (p - 2) % NPH_LAYER; void* kargs[] = {&a}; (void)hipLaunchKernel(phase_fn(kind), dim3(grid), dim3(NTHR), kargs, LDS_BYTES, stream); }
#else
    a.ph_lo = 0; a.ph_hi = NPH; { void* kargs[] = {&a}; (void)hipLaunchKernel(phase_fn(15), dim3(grid), dim3(NTHR), kargs, LDS_BYTES, stream); }
#endif
}
```

```cpp
#include <hip/hip_runtime.h>
#include <hip/hip_bf16.h>
#include <cstdio>
#include <cstdint>
#include <cmath>
namespace pg8 {
#define PG8_LAS __attribute__((address_space(3)))
typedef unsigned short bf16_t;
typedef short bf16x8 __attribute__((ext_vector_type(8)));
typedef float f32x4 __attribute__((ext_vector_type(4)));
typedef unsigned u32x4 __attribute__((ext_vector_type(4)));
constexpr int BM = 256, BK = 64, HALF = 128, HTB = HALF * BK * 2  , STAGE_BYTES = 8 * HTB, NXCD = 8, WGM = 8;

__host__ __device__ __forceinline__ int lds_byte(int r, int c) { const int st = (r >> 4) * 2 + (c >> 5), rr = r & 15, cc = c & 31, ob = rr * 64 + cc * 2; return st * 1024 + (ob ^ (((ob >> 9) & 1) << 5)); }
__host__ __device__ __forceinline__ void stage_rc(int b, int& R, int& C) { const int st = b / 1024, sb = b % 1024, swz = sb ^ (((sb >> 9) & 1) << 5); R = (st >> 1) * 16 + swz / 64; C = (st & 1) * 32 + (swz % 64) / 2; }
__host__ __device__ __forceinline__ int perm32(int rho) { const int n = rho >> 4, i = rho & 15; return 8 * (i >> 2) + 4 * n + (i & 3); }

struct Unit { int pm, pn, k0, ntk, ks; };
struct Gemm { const bf16_t* A; const bf16_t* Bt; int M, N, K; };

struct StaticOrder {
    int nM, nN, nwg, G, c;
    __host__ __device__ void init(int M, int N, int G_, int c_) { nM = M / BM; nN = N / BM; nwg = nM * nN; G = G_; c = c_; }
    __host__ __device__ bool next(int i, Unit& u) const {
        const long L = (long)i * G + c; if (L >= nwg) return false;
        int wgid = (int)L; { const int q = nwg / NXCD, r = nwg % NXCD, xcd = wgid % NXCD, off = wgid / NXCD; wgid = (xcd < r ? xcd * (q + 1) : r * (q + 1) + (xcd - r) * q) + off; }
        const int nig = WGM * nN, gid = wgid / nig, fm = gid * WGM, gsz = (nM - fm) < WGM ? (nM - fm) : WGM;
        u.pm = fm + ((wgid % nig) % gsz); u.pn = (wgid % nig) / gsz; u.k0 = 0; u.ntk = 0; u.ks = -1; return true;
    }
    __device__ __forceinline__ void a_ready(const Unit&) const {}
    __device__ __forceinline__ void done(const Unit&) const {}
};

typedef float f32x2c_t __attribute__((ext_vector_type(2))); typedef __bf16 bf16x2c_t __attribute__((ext_vector_type(2)));
__device__ __forceinline__ unsigned cvt_pk_bf16(float lo, float hi) { f32x2c_t v = {lo, hi}; bf16x2c_t b = __builtin_convertvector(v, bf16x2c_t); return __builtin_bit_cast(unsigned, b); }
typedef float f32x2 __attribute__((ext_vector_type(2)));
__device__ __forceinline__ float fast_sigmoid(float x) { return __builtin_amdgcn_rcpf(1.0f + __expf(-x)); }
struct EpiSwiglu {
    static constexpr bool PERM = true, AFTER_DRAIN = false, KEEPS = false;
    bf16_t* O; int ldc;
    __device__ __forceinline__ void operator()(const f32x4 (&acc)[2][2][4][2], const Unit& u, int wr, int wc, int fr, int fq) const {
        const int row0 = u.pm * BM + wr * 64 + fr; const int col0 = u.pn * 128 + wc * 32 + 8 * fq;
#pragma unroll
        for (int ai = 0; ai < 2; ++ai)
#pragma unroll
            for (int m = 0; m < 4; ++m) { bf16_t* rowp = O + (size_t)(row0 + ai * HALF + m * 16) * ldc + col0;
                float v[8];
#pragma unroll
                for (int n = 0; n < 2; ++n)
#pragma unroll
                    for (int e = 0; e < 4; ++e) { const float g = acc[ai][0][m][n][e], up = acc[ai][1][m][n][e]; v[n * 4 + e] = g * fast_sigmoid(g) * up; }
                u32x4 w; w.x = cvt_pk_bf16(v[0], v[1]); w.y = cvt_pk_bf16(v[2], v[3]); w.z = cvt_pk_bf16(v[4], v[5]); w.w = cvt_pk_bf16(v[6], v[7]);
                *(u32x4*)rowp = w; }
    }
};
struct EpiF32 {
    static constexpr bool PERM = false, AFTER_DRAIN = false, KEEPS = false;
    float* O; int ldc;
    __device__ __forceinline__ void operator()(const f32x4 (&acc)[2][2][4][2], const Unit& u, int wr, int wc, int fr, int fq) const {
        const int row0 = u.pm * BM + wr * 64 + fr; const int col0 = u.pn * BM + wc * 32 + 4 * fq;
#pragma unroll
        for (int ai = 0; ai < 2; ++ai)
#pragma unroll
            for (int m = 0; m < 4; ++m) { float* rowp = O + (size_t)(row0 + ai * HALF + m * 16) * ldc + col0;
#pragma unroll
                for (int bj = 0; bj < 2; ++bj)
#pragma unroll
                    for (int n = 0; n < 2; ++n) *(f32x4*)(rowp + bj * HALF + n * 16) = acc[ai][bj][m][n]; }
    }
};
struct EpiProj {
    static constexpr bool PERM = true, AFTER_DRAIN = false, KEEPS = false;
    bf16_t* Q; bf16_t* Kb; bf16_t* Vb; float* PRW; bf16_t* PLB; bf16_t* GATES; const float* bgate;
    float* outKp; float* outVp; float* outKs; float* outVs; float* outShp; float* outShs;
    float qscale;
    __device__ __forceinline__ void operator()(const f32x4 (&acc)[2][2][4][2], const Unit& u, int wr, int wc, int fr, int fq) const {
        const int row0 = u.pm * BM + wr * 64 + fr; const int pn = u.pn; const int cw = wc * 32 + 8 * fq;
        const bool prompt = u.pm < 128;
        auto pack8 = [](const f32x4& a, const f32x4& b) -> u32x4 { u32x4 w; w.x = cvt_pk_bf16(a[0], a[1]); w.y = cvt_pk_bf16(a[2], a[3]); w.z = cvt_pk_bf16(b[0], b[1]); w.w = cvt_pk_bf16(b[2], b[3]); return w; };
#pragma unroll
        for (int ai = 0; ai < 2; ++ai)
#pragma unroll
            for (int m = 0; m < 4; ++m) { const int row = row0 + ai * HALF + m * 16;
#pragma unroll
                for (int bj = 0; bj < 2; ++bj) { const f32x4 v0 = acc[ai][bj][m][0], v1 = acc[ai][bj][m][1]; const int ct = bj * HALF + cw;
                    if (pn < 2) { const int c = pn * 256 + ct; *(u32x4*)(Q + (size_t)row * 512 + c) = pack8(v0 * qscale, v1 * qscale); }
                    else if (pn < 6) { const bool isk = pn < 4; const int c = (pn - (isk ? 2 : 4)) * 256 + ct;
                        *(u32x4*)((isk ? Kb : Vb) + (size_t)row * 512 + c) = pack8(v0, v1);
                        float* o = prompt ? (isk ? outKp : outVp) + (size_t)row * 512 + c : (isk ? outKs : outVs) + (size_t)(row - 32768) * 512 + c;
                        *(f32x4*)o = v0; *(f32x4*)(o + 4) = v1; }
                    else if (pn < 13) { const int c = (pn - 6) * 256 + ct; float* o = PRW + (size_t)row * 1792 + c; *(f32x4*)o = v0; *(f32x4*)(o + 4) = v1;
                        if (pn == 12) *(u32x4*)(PLB + (size_t)row * 256 + ct) = pack8(v0, v1);
                        if (prompt) { if ((row & 8191) == 8191) { float* so = outShp + (size_t)(row >> 13) * 1792 + c; *(f32x4*)so = v0; *(f32x4*)(so + 4) = v1; } }
                        else { const int rd = row - 32768; if ((rd & 31) == 31) { float* so = outShs + (size_t)(rd >> 5) * 1792 + c; *(f32x4*)so = v0; *(f32x4*)(so + 4) = v1; } } }
                    else { const int c = (pn - 13) * 256 + ct; const f32x4 b0 = *(const f32x4*)(bgate + c), b1 = *(const f32x4*)(bgate + c + 4);
                        f32x4 s0, s1;
#pragma unroll
                        for (int e = 0; e < 4; ++e) { s0[e] = fast_sigmoid(v0[e] + b0[e]); s1[e] = fast_sigmoid(v1[e] + b1[e]); }
                        *(u32x4*)(GATES + (size_t)row * 2048 + c) = pack8(s0, s1); }
                } }
    }
};
struct EpiMerge {
    static constexpr bool PERM = true, AFTER_DRAIN = false, KEEPS = true;
    bf16_t* OUT; const bf16_t* GATES; int npan;
    __device__ __forceinline__ bool apply(f32x4 (&acc)[2][2][4][2], const Unit& u, int wr, int wc, int fr, int fq) const {
        const int which = u.pm >= npan ? 1 : 0; const int pm = u.pm - which * npan, pn = u.pn - which * 4;
        const int row0 = pm * BM + wr * 64 + fr; const int col0 = pn * BM + wc * 32 + 8 * fq;
        auto lo4 = [](const u32x4& w) -> f32x4 { f32x4 g; g[0] = __uint_as_float(w.x << 16); g[1] = __uint_as_float(w.x & 0xffff0000u); g[2] = __uint_as_float(w.y << 16); g[3] = __uint_as_float(w.y & 0xffff0000u); return g; };
        auto hi4 = [](const u32x4& w) -> f32x4 { f32x4 g; g[0] = __uint_as_float(w.z << 16); g[1] = __uint_as_float(w.z & 0xffff0000u); g[2] = __uint_as_float(w.w << 16); g[3] = __uint_as_float(w.w & 0xffff0000u); return g; };
        auto clampg = [](f32x4 g) -> f32x4 { g[0] = fmaxf(g[0], 1e-30f); g[1] = fmaxf(g[1], 1e-30f); g[2] = fmaxf(g[2], 1e-30f); g[3] = fmaxf(g[3], 1e-30f); return g; };
        auto rcp4 = [](const f32x4& g) -> f32x4 { f32x4 r; r[0] = __builtin_amdgcn_rcpf(g[0]); r[1] = __builtin_amdgcn_rcpf(g[1]); r[2] = __builtin_amdgcn_rcpf(g[2]); r[3] = __builtin_amdgcn_rcpf(g[3]); return r; };
        u32x4 ac[2], an[2], bc[2], bn[2];
        auto issue = [&](int g) { const int r = row0 + (g >> 2) * HALF + (g & 3) * 16;
#pragma unroll
            for (int bj = 0; bj < 2; ++bj) { bn[bj] = *(const u32x4*)(GATES + (size_t)r * 2048 + 1024 + col0 + bj * HALF); if (!which) an[bj] = *(const u32x4*)(GATES + (size_t)r * 2048 + col0 + bj * HALF); } };
        issue(0);
#pragma unroll
        for (int g = 0; g < 8; ++g) { const int ai = g >> 2, m = g & 3;
#pragma unroll
            for (int bj = 0; bj < 2; ++bj) { ac[bj] = an[bj]; bc[bj] = bn[bj]; }
            if (g < 7) issue(g + 1);
            const size_t ro = (size_t)(row0 + ai * HALF + m * 16) * 1024 + col0;
#pragma unroll
            for (int bj = 0; bj < 2; ++bj) { const f32x4 gb0 = clampg(lo4(bc[bj])), gb1 = clampg(hi4(bc[bj]));
                if (which == 0) { acc[ai][bj][m][0] = acc[ai][bj][m][0] * (lo4(ac[bj]) * rcp4(gb0)); acc[ai][bj][m][1] = acc[ai][bj][m][1] * (hi4(ac[bj]) * rcp4(gb1)); }
                else { const f32x4 t0 = acc[ai][bj][m][0] * gb0, t1 = acc[ai][bj][m][1] * gb1; u32x4 w; w.x = cvt_pk_bf16(t0[0], t0[1]); w.y = cvt_pk_bf16(t0[2], t0[3]); w.z = cvt_pk_bf16(t1[0], t1[1]); w.w = cvt_pk_bf16(t1[2], t1[3]);
                    *(u32x4*)(OUT + ro + bj * HALF) = w; } }
        }
        return which == 0;
    }
};
struct SplitOrder {
    StaticOrder base; int G, c, nslice, nbase;
    __device__ __forceinline__ void init(int Mprompt, int N, int G_, int c_, int nslice_) { base.init(Mprompt, N, G_, c_); G = G_; c = c_; nslice = nslice_; nbase = c_ < base.nwg ? (base.nwg - c_ + G_ - 1) / G_ : 0; }
    __device__ __forceinline__ bool next(int i, Unit& u) const {
        if (i < nbase) return base.next(i, u);
        const int e = (i - nbase) * G + c; if (e >= 16 * nslice) return false;
        const int tile = e / nslice, sl = e - tile * nslice; u.pm = base.nM + (tile >> 2); u.pn = tile & 3; u.k0 = sl * 256; u.ntk = 4; u.ks = sl; return true;
    }
    __device__ __forceinline__ void a_ready(const Unit&) const {}
    __device__ __forceinline__ void done(const Unit&) const {}
};
struct EpiF32S {
    static constexpr bool PERM = true, AFTER_DRAIN = false, KEEPS = false;
    bf16_t* O; float* FP; int ldc, mprompt, mdec;
    __device__ __forceinline__ void operator()(const f32x4 (&acc)[2][2][4][2], const Unit& u, int wr, int wc, int fr, int fq) const {
        const int row0 = u.pm * BM + wr * 64 + fr; const int col0 = u.pn * BM + wc * 32 + 8 * fq;
        if (u.ks < 0) {
#pragma unroll
            for (int ai = 0; ai < 2; ++ai)
#pragma unroll
                for (int m = 0; m < 4; ++m) { bf16_t* rowp = O + (size_t)(row0 + ai * HALF + m * 16) * ldc + col0;
#pragma unroll
                    for (int bj = 0; bj < 2; ++bj) { const f32x4 v0 = acc[ai][bj][m][0], v1 = acc[ai][bj][m][1]; u32x4 w; w.x = cvt_pk_bf16(v0[0], v0[1]); w.y = cvt_pk_bf16(v0[2], v0[3]); w.z = cvt_pk_bf16(v1[0], v1[1]); w.w = cvt_pk_bf16(v1[2], v1[3]);
                        *(u32x4*)(rowp + bj * HALF) = w; } }
        } else {
            float* base = FP + ((size_t)u.ks * mdec + (row0 - mprompt)) * ldc;
#pragma unroll
            for (int ai = 0; ai < 2; ++ai)
#pragma unroll
                for (int m = 0; m < 4; ++m) { float* rowp = base + (size_t)(ai * HALF + m * 16) * ldc + col0;
#pragma unroll
                    for (int bj = 0; bj < 2; ++bj)
#pragma unroll
                        for (int n = 0; n < 2; ++n) *(f32x4*)(rowp + bj * HALF + n * 4) = acc[ai][bj][m][n]; }
        }
    }
};
struct PairOrder {
    int ntile, G, c, npan;
    __device__ __forceinline__ bool next(int i, Unit& u) const { const int tile = (i >> 1) * G + c; if (tile >= ntile) return false; const int which = i & 1; u.pm = (tile >> 2) + which * npan; u.pn = (tile & 3) + which * 4; u.k0 = 0; u.ntk = 0; u.ks = -1; return true; }
    __device__ __forceinline__ void a_ready(const Unit&) const {}
    __device__ __forceinline__ void done(const Unit&) const {}
};
template <class Epi, class Sched, bool ALIGN_EPI = false, bool SP2 = false>
__device__ __forceinline__ void gemm_phase(PG8_LAS unsigned char* lds, const Gemm g, const Sched& S, const Epi& E, int wave_s) {
    int tid_ = wave_s * 64 + (int)__builtin_amdgcn_mbcnt_hi(~0u, __builtin_amdgcn_mbcnt_lo(~0u, 0u)); asm volatile("" : "+v"(tid_));
    const int tid = tid_, wid = __builtin_amdgcn_readfirstlane(tid >> 6), lane = tid & 63, wr = wid >> 2, wc = wid & 3, fr = lane & 15, fq = lane >> 4;
    const int K = g.K, ntK = K / BK;
    unsigned voffA[2], voffB[2];
#pragma unroll
    for (int i = 0; i < 2; ++i) { int R, C; stage_rc(tid * 16 + i * 8192, R, C); const int Rb = Epi::PERM ? ((R & ~31) + perm32(R & 31)) : R;
        voffA[i] = (unsigned)(R * K + C) * 2u; voffB[i] = (unsigned)(Rb * K + C) * 2u; }
    const size_t kstep = (size_t)(BK * 2);
    const size_t hstep = (size_t)HALF * K * 2;
    const size_t tstep = 2 * hstep;
    const unsigned ldsw = (unsigned)wid * 1024u;
    const int aoff = lds_byte(wr * 64 + fr, fq * 8), boff = lds_byte(wc * 32 + fr, fq * 8);
#define PG8_SA(b, h) (((b) * 2 + (h)) * HTB)
#define PG8_SB(b, h) ((4 + (b) * 2 + (h)) * HTB)
#define PG8_STAGE(bufoff, gbase, voff) do { _Pragma("unroll") for (int _i = 0; _i < 2; ++_i) \
        __builtin_amdgcn_global_load_lds((const unsigned*)((const char*)(gbase) + (voff)[_i]), (PG8_LAS unsigned*)(lds + (bufoff) + ldsw + _i * 8192), 16, 0, 0); } while (0)
#define PG8_LDA(dst, b, h) do { _Pragma("unroll") for (int m = 0; m < 4; ++m) _Pragma("unroll") for (int k = 0; k < 2; ++k) dst[m][k] = *(const PG8_LAS bf16x8*)(lds + PG8_SA(b, h) + aoff + m * 2048 + k * 1024); } while (0)
#define PG8_LDB(dst, b, h) do { _Pragma("unroll") for (int n = 0; n < 2; ++n) _Pragma("unroll") for (int k = 0; k < 2; ++k) dst[n][k] = *(const PG8_LAS bf16x8*)(lds + PG8_SB(b, h) + boff + n * 2048 + k * 1024); } while (0)
#define PG8_MMA(ai, bj, At, Bt) do { __builtin_amdgcn_s_setprio(1); _Pragma("unroll") for (int m = 0; m < 4; ++m) _Pragma("unroll") for (int n = 0; n < 2; ++n) _Pragma("unroll") for (int k = 0; k < 2; ++k) \
        acc[ai][bj][m][n] = __builtin_amdgcn_mfma_f32_16x16x32_bf16(Bt[n][k], At[m][k], acc[ai][bj][m][n], 0, 0, 0); __builtin_amdgcn_s_setprio(0); } while (0)
#define PG8_WAIT_V(n) asm volatile("s_waitcnt vmcnt(" #n ")" ::: "memory")
#define PG8_WAIT_L(n) asm volatile("s_waitcnt lgkmcnt(" #n ")" ::: "memory")
#define PG8_BAR __builtin_amdgcn_s_barrier()
#define PG8_SCHED __builtin_amdgcn_sched_barrier(0)
    Unit cur, nxt; int ui = 0;
    if (!S.next(0, cur)) return;
    f32x4 acc[2][2][4][2];
#pragma unroll
    for (int a = 0; a < 2; ++a)
#pragma unroll
        for (int b = 0; b < 2; ++b)
#pragma unroll
            for (int m = 0; m < 4; ++m)
#pragma unroll
                for (int n = 0; n < 2; ++n) acc[a][b][m][n] = (f32x4){0.f, 0.f, 0.f, 0.f};
    bf16x8 At[4][2], B0[2][2], B1[2][2];
    const char* cA = (const char*)g.A + (size_t)cur.pm * tstep + (size_t)cur.k0 * 2; const char* cB = (const char*)g.Bt + (size_t)cur.pn * tstep + (size_t)cur.k0 * 2;
    S.a_ready(cur);
    if constexpr (SP2) {
        PG8_STAGE(PG8_SB(0, 0), cB, voffB); PG8_STAGE(PG8_SB(0, 1), cB + hstep, voffB); PG8_STAGE(PG8_SA(0, 0), cA, voffA); PG8_STAGE(PG8_SA(0, 1), cA + hstep, voffA);
        if (wr == 1) PG8_BAR;
        PG8_WAIT_V(2); PG8_BAR;
        PG8_STAGE(PG8_SB(1, 0), cB + kstep, voffB); PG8_STAGE(PG8_SA(1, 0), cA + kstep, voffA); PG8_STAGE(PG8_SB(1, 1), cB + hstep + kstep, voffB);
        PG8_WAIT_V(6); PG8_BAR;
    } else {
        PG8_STAGE(PG8_SB(0, 0), cB, voffB); PG8_STAGE(PG8_SA(0, 0), cA, voffA); PG8_STAGE(PG8_SB(0, 1), cB + hstep, voffB); PG8_STAGE(PG8_SA(0, 1), cA + hstep, voffA);
        if (wr == 1) PG8_BAR;
        PG8_WAIT_V(4); PG8_BAR;
        PG8_STAGE(PG8_SB(1, 0), cB + kstep, voffB); PG8_STAGE(PG8_SA(1, 0), cA + kstep, voffA); PG8_STAGE(PG8_SB(1, 1), cB + hstep + kstep, voffB);
        PG8_WAIT_V(6); PG8_BAR;
    }
    for (;;) {
        const bool has_next = S.next(ui + 1, nxt);
        const char* nA = has_next ? (const char*)g.A + (size_t)nxt.pm * tstep + (size_t)nxt.k0 * 2 : cA; const char* nB = has_next ? (const char*)g.Bt + (size_t)nxt.pn * tstep + (size_t)nxt.k0 * 2 : cB;
        const int nt = cur.ntk ? cur.ntk : ntK;
        for (int t = 0; t < nt; t += 2) {
            const bool last = (t == nt - 2);
            const char* a1 = cA + (size_t)(t + 1) * kstep;
            const char* a2 = last ? nA : cA + (size_t)(t + 2) * kstep; const char* b2 = last ? nB : cB + (size_t)(t + 2) * kstep;
            const char* a3 = a2 + kstep; const char* b3 = b2 + kstep;
            if (last && has_next) S.a_ready(nxt);
            if constexpr (SP2) {
            PG8_LDB(B0, 0, 0); PG8_LDB(B1, 0, 1); PG8_SCHED; PG8_LDA(At, 0, 0); PG8_STAGE(PG8_SA(1, 1), a1 + hstep, voffA);
            PG8_WAIT_V(8); PG8_WAIT_L(0); PG8_BAR; PG8_MMA(0, 0, At, B0); PG8_MMA(0, 1, At, B1); PG8_BAR; PG8_SCHED;
            PG8_LDA(At, 0, 1); PG8_STAGE(PG8_SB(0, 0), b2, voffB); PG8_STAGE(PG8_SB(0, 1), b2 + hstep, voffB); PG8_STAGE(PG8_SA(0, 0), a2, voffA);
            PG8_WAIT_V(8); PG8_WAIT_L(0); PG8_BAR; PG8_MMA(1, 0, At, B0); PG8_MMA(1, 1, At, B1); PG8_BAR; PG8_SCHED;
            PG8_LDB(B0, 1, 0); PG8_LDB(B1, 1, 1); PG8_SCHED; PG8_LDA(At, 1, 0); PG8_STAGE(PG8_SA(0, 1), a2 + hstep, voffA);
            PG8_WAIT_V(8); PG8_WAIT_L(0); PG8_BAR; PG8_MMA(0, 0, At, B0); PG8_MMA(0, 1, At, B1); PG8_BAR; PG8_SCHED;
            PG8_LDA(At, 1, 1); PG8_STAGE(PG8_SB(1, 0), b3, voffB); PG8_STAGE(PG8_SB(1, 1), b3 + hstep, voffB); PG8_STAGE(PG8_SA(1, 0), a3, voffA);
            PG8_WAIT_V(8); PG8_WAIT_L(0); PG8_BAR; PG8_MMA(1, 0, At, B0); PG8_MMA(1, 1, At, B1); PG8_BAR; PG8_SCHED;
            } else {
            PG8_LDB(B0, 0, 0); PG8_SCHED; PG8_LDA(At, 0, 0); PG8_STAGE(PG8_SA(1, 1), a1 + hstep, voffA);
            PG8_WAIT_L(8); PG8_BAR; PG8_WAIT_L(0); PG8_MMA(0, 0, At, B0); PG8_BAR; PG8_SCHED;
            PG8_LDB(B1, 0, 1); PG8_STAGE(PG8_SB(0, 0), b2, voffB);
            PG8_BAR; PG8_WAIT_L(0); PG8_MMA(0, 1, At, B1); PG8_BAR;
            PG8_LDA(At, 0, 1); PG8_STAGE(PG8_SA(0, 0), a2, voffA);
            PG8_BAR; PG8_WAIT_L(0); PG8_MMA(1, 0, At, B0); PG8_BAR; PG8_SCHED;
            PG8_STAGE(PG8_SB(0, 1), b2 + hstep, voffB);
            PG8_WAIT_V(6); PG8_BAR; PG8_MMA(1, 1, At, B1); PG8_BAR;
            PG8_LDB(B0, 1, 0); PG8_SCHED; PG8_LDA(At, 1, 0); PG8_STAGE(PG8_SA(0, 1), a2 + hstep, voffA);
            PG8_WAIT_L(8); PG8_BAR; PG8_WAIT_L(0); PG8_MMA(0, 0, At, B0); PG8_BAR; PG8_SCHED;
            PG8_LDB(B1, 1, 1); PG8_STAGE(PG8_SB(1, 0), b3, voffB);
            PG8_BAR; PG8_WAIT_L(0); PG8_MMA(0, 1, At, B1); PG8_BAR;
            PG8_LDA(At, 1, 1); PG8_STAGE(PG8_SA(1, 0), a3, voffA);
            PG8_BAR; PG8_WAIT_L(0); PG8_MMA(1, 0, At, B0); PG8_BAR; PG8_SCHED;
            PG8_STAGE(PG8_SB(1, 1), b3 + hstep, voffB);
            PG8_WAIT_V(6); PG8_BAR; PG8_MMA(1, 1, At, B1); PG8_BAR;
            }
        }
        if constexpr (ALIGN_EPI) { if (wr == 0) PG8_BAR; }
        bool keep_acc = false;
        if constexpr (!Epi::AFTER_DRAIN) { if constexpr (Epi::KEEPS) keep_acc = E.apply(acc, cur, wr, wc, fr, fq); else E(acc, cur, wr, wc, fr, fq); S.done(cur); }
        if (!has_next) break;
        if (!keep_acc)
#pragma unroll
        for (int a = 0; a < 2; ++a)
#pragma unroll
            for (int b = 0; b < 2; ++b)
#pragma unroll
                for (int m = 0; m < 4; ++m)
#pragma unroll
                    for (int n = 0; n < 2; ++n) acc[a][b][m][n] = (f32x4){0.f, 0.f, 0.f, 0.f};
        cur = nxt; cA = nA; cB = nB; ++ui;
        if constexpr (ALIGN_EPI) { if (wr == 1) PG8_BAR; }
    }
    PG8_WAIT_V(0);
    if constexpr (!ALIGN_EPI) { if (wr == 0) PG8_BAR; }
    PG8_BAR;
    if constexpr (Epi::AFTER_DRAIN) { E.fused(acc, cur, wr, wc, fr, fq, lds, wid, lane); S.done(cur); }
#undef PG8_SA
#undef PG8_SB
#undef PG8_STAGE
#undef PG8_LDA
#undef PG8_LDB
#undef PG8_MMA
#undef PG8_WAIT_V
#undef PG8_WAIT_L
#undef PG8_BAR
#undef PG8_SCHED
}
}
using pg8::fast_sigmoid;
#define GAS __attribute__((address_space(1)))
#define LAS __attribute__((address_space(3)))
typedef unsigned short bf16;
typedef unsigned v4u __attribute__((ext_vector_type(4)));
typedef float f32x4 __attribute__((ext_vector_type(4)));
typedef short bf16x8 __attribute__((ext_vector_type(8)));
typedef GAS unsigned gu32;
typedef GAS unsigned long long gu64;
#define RLX_AGENT __ATOMIC_RELAXED, __HIP_MEMORY_SCOPE_AGENT
#define LDS_WAIT() asm volatile("s_waitcnt lgkmcnt(0)" ::: "memory")
#define VM_WAIT() asm volatile("s_waitcnt vmcnt(0)" ::: "memory")
__device__ __forceinline__ unsigned long long rt() { return __builtin_amdgcn_s_memrealtime(); }
__device__ __forceinline__ unsigned f2bf(float f) { unsigned u = __builtin_bit_cast(unsigned, f); return (u + 0x7fffu + ((u >> 16) & 1u)) >> 16; }
__device__ __forceinline__ unsigned pk2(float lo, float hi) { return f2bf(lo) | (f2bf(hi) << 16); }

#define XB_TMO      128
#define XB_XCNT(j)  (256  + 64 * (j))
#define XB_XSUB(j)  (1280 + 64 * (j))
#define XB_XGEN(j)  (2304 + 64 * (j))
#define XB_TOP      3328
#define XB_TOPGEN   3392
#define XCD_BAR_WORDS 3456
#define XB_SPIN_CAP (1u << 18)

__device__ __forceinline__ unsigned xb_ld(unsigned* p)              { return __hip_atomic_load(p, __ATOMIC_RELAXED, __HIP_MEMORY_SCOPE_AGENT); }
__device__ __forceinline__ unsigned xb_add(unsigned* p, unsigned v) { return __hip_atomic_fetch_add(p, v, __ATOMIC_RELAXED, __HIP_MEMORY_SCOPE_AGENT); }
__device__ __forceinline__ unsigned xb_xcc_id() { return (unsigned)__builtin_amdgcn_s_getreg((3 << 11) | 20) & 0xFu; }
#define XB_SPIN(cond, bar) do { unsigned _sp = 0; while (cond) { __builtin_amdgcn_s_sleep(1); \
    if ((++_sp & 255u) == 0u) { if (xb_ld(&(bar)[XB_TMO])) break; if (_sp > XB_SPIN_CAP) { atomicAdd(&(bar)[XB_TMO], 1u); break; } } } } while (0)

struct XcdBarrier {
    int wave;
    unsigned* bar; unsigned x;
    volatile LAS unsigned* st;
};

__device__ __forceinline__ XcdBarrier xcd_barrier_post(unsigned* bar, volatile LAS unsigned* st) {
    XcdBarrier b; b.bar = bar; b.x = xb_xcc_id(); b.st = st;
    if (threadIdx.x == 0) (void)xb_add(&bar[XB_XCNT(b.x)], 1u);
    return b;
}
__device__ __forceinline__ void xcd_barrier_complete(unsigned* bar, unsigned x, unsigned& nloc, unsigned& nx) {
    const unsigned G = gridDim.x * gridDim.y * gridDim.z;
    unsigned sum, cnt, mine, sp = 0u;
    for (;;) {
        sum = 0u; cnt = 0u; mine = 0u;
#pragma unroll
        for (unsigned j = 0; j < 16; ++j) { const unsigned c = xb_ld(&bar[XB_XCNT(j)]); sum += c; cnt += (c > 0u) ? 1u : 0u; mine = (j == x) ? c : mine; }
        if (sum == G) break;
        __builtin_amdgcn_s_sleep(1);
        if ((++sp & 255u) == 0u) { if (xb_ld(&bar[XB_TMO])) break; if (sp > XB_SPIN_CAP) { atomicAdd(&bar[XB_TMO], 1u); break; } }
    }
    nloc = mine > 0u ? mine : 1u; nx = cnt > 0u ? cnt : 1u;
}

__device__ __forceinline__ void xcd_barrier(const XcdBarrier& b) {
    asm volatile("s_waitcnt vmcnt(0)" ::: "memory");
    __syncthreads();
    if (b.wave == 0 && __builtin_amdgcn_mbcnt_hi(~0u, __builtin_amdgcn_mbcnt_lo(~0u, 0u)) == 0u) {
        unsigned* bar = b.bar;
        __builtin_amdgcn_s_waitcnt(0);
        unsigned nloc = b.st[0], nx = b.st[1];
        if (nloc == 0u) { xcd_barrier_complete(bar, b.x, nloc, nx); b.st[0] = nloc; b.st[1] = nx; }
        const unsigned old = xb_add(&bar[XB_XSUB(b.x)], 1u);
        const unsigned gen = old / nloc;
        if (old + 1u == (gen + 1u) * nloc) {
            __builtin_amdgcn_fence(__ATOMIC_RELEASE, "agent");
            asm volatile("s_waitcnt vmcnt(0)" ::: "memory");
            const unsigned og = xb_add(&bar[XB_TOP], 1u);
            const unsigned tg = og / nx;
            if (og + 1u == (tg + 1u) * nx) xb_add(&bar[XB_TOPGEN], 1u);
            else XB_SPIN(xb_ld(&bar[XB_TOPGEN]) == tg, bar);
            __builtin_amdgcn_fence(__ATOMIC_ACQUIRE, "agent");
            xb_add(&bar[XB_XGEN(b.x)], 1u);
            asm volatile("s_waitcnt vmcnt(0)" ::: "memory");
        } else {
            XB_SPIN(xb_ld(&bar[XB_XGEN(b.x)]) == gen, bar);
            __builtin_amdgcn_fence(__ATOMIC_ACQUIRE, "agent");
            asm volatile("s_waitcnt vmcnt(0)" ::: "memory");
        }
    }
    __syncthreads();
}
constexpr int NWAVES = 8, NTHR = 512;
constexpr int D = 1024, NB = 4, SEQ = 8192, DEPTH = 4, DECB = 32, DECS = 32, PAST = 2048;
constexpr int MP = NB * SEQ, MD = DECB * DECS, M = MP + MD, NPAN = M / 256, NSEQ = NB + DECB;
constexpr int DFF = 2816, NGU = 2 * DFF, NIN = 3328, NRW = 1792, NIG = NIN + 2 * D;
constexpr int HA = 4, HB = 8;
constexpr float LN_EPS = 1e-5f, GN_EPS = 64e-5f;
constexpr float ALPHA = 1.681792830507429f;
constexpr float QSCALE = 0.125f * 1.4426950408889634f;
constexpr float LOG2E = 1.4426950408889634f;
constexpr size_t OFF_Y = 0, OFF_KP = (size_t)M * D, OFF_VP = OFF_KP + (size_t)DEPTH * MP * 512, OFF_WKVP = OFF_VP + (size_t)DEPTH * MP * 512,
    OFF_SHP = OFF_WKVP + (size_t)DEPTH * NB * HB * 4096, OFF_KS = OFF_SHP + (size_t)DEPTH * NB * NRW, OFF_VS = OFF_KS + (size_t)DEPTH * MD * 512,
    OFF_WKVS = OFF_VS + (size_t)DEPTH * MD * 512, OFF_SHS = OFF_WKVS + (size_t)DEPTH * DECB * HB * 4096, OUT_TOTAL = OFF_SHS + (size_t)DEPTH * DECB * NRW;
static_assert(OUT_TOTAL == 177991680ull, "output size");
constexpr size_t al256(size_t x) { return (x + 255) & ~(size_t)255; }
constexpr size_t WS_CTL = 0, CTL_ZERO_BYTES = 1u << 20;
constexpr size_t WS_MOD = CTL_ZERO_BYTES;
constexpr size_t WS_LAM = WS_MOD + al256((size_t)DEPTH * NSEQ * 9 * D * 4);
constexpr size_t WS_W = WS_LAM + 256;
constexpr size_t WL_GU0 = 0, WL_GU1 = WL_GU0 + (size_t)NGU * D * 2, WL_DN0 = WL_GU1 + (size_t)NGU * D * 2, WL_DN1 = WL_DN0 + (size_t)D * DFF * 2,
    WL_IG = WL_DN1 + (size_t)D * DFF * 2, WL_BR = WL_IG + (size_t)NIG * D * 2, WL_O = WL_BR + (size_t)2048 * 512 * 2, WL_W2 = WL_O + (size_t)D * D * 2,
    WL_A2 = WL_W2 + 512 * 64 * 2, WL_G2 = WL_A2 + 512 * 64 * 2, WL_SIZE = WL_G2 + 512 * 128 * 2;
constexpr size_t WS_U = WS_W + (size_t)DEPTH * WL_SIZE;
constexpr size_t WS_ACT = WS_U + (size_t)M * D * 2;
constexpr size_t WS_F = WS_ACT + (size_t)M * DFF * 2;
constexpr size_t WS_Q = WS_F + (size_t)M * D * 4;
constexpr size_t WS_KB = WS_Q + (size_t)M * 512 * 2, WS_VB = WS_KB + (size_t)M * 512 * 2;
constexpr size_t WS_PRW = WS_VB + (size_t)M * 512 * 2;
constexpr size_t WS_GATES = WS_PRW + (size_t)M * NRW * 4;
constexpr size_t WS_YAB = WS_GATES + (size_t)M * 2048 * 2;
constexpr size_t WS_MERGED = WS_YAB + (size_t)2 * M * 512 * 2;
constexpr int NITEM_P = NB * (SEQ / 64) * HB, NITEM = NITEM_P + DECB * HB;
constexpr size_t WS_PT = WS_MERGED + (size_t)M * D * 2;
constexpr size_t WS_QT = WS_PT + (size_t)NITEM * 8192;
constexpr size_t WS_HT = WS_QT + (size_t)NITEM * 8192;
constexpr size_t WS_OT = WS_HT + (size_t)NITEM * 16384;
constexpr size_t WS_OB = WS_OT + (size_t)NITEM * 16384;
constexpr size_t WS_GG = WS_OB + (size_t)M * 512 * 4, WS_BON = WS_GG + (size_t)NITEM * 16384;
constexpr size_t WS_SC = WS_BON + (size_t)NITEM * 16384;
constexpr size_t WS_PLB = WS_SC + (size_t)NITEM * 8192;
constexpr size_t WS_SSB = WS_PLB + (size_t)M * 256 * 2;
constexpr size_t WS_FP = al256(WS_SSB + (size_t)DEPTH * DECB * 256 * 2);
constexpr size_t WS_END = WS_FP + (size_t)11 * MD * D * 4;
constexpr int CW_TMO = 0, CW_BAR = 4096, CW_QUEUE = 8192;
constexpr int RING_BYTES = 131072, EXTRA_OFF = 131072, LDSCTL_OFF = 146944, LDS_BYTES = 147456;

struct Args { const float* in[34]; float* out; unsigned char* ws; int ph_lo, ph_hi; };
static_assert(sizeof(Args) == 36 * 8 + 8, "Args has no padding");
enum { I_XP = 0, I_XS, I_CP, I_CS, I_CK, I_CV, I_SWKV, I_SSH, I_RELB, I_WADA, I_BADA, I_LNG, I_LNB, I_WGU, I_WDN, I_WIN, I_LAMQK, I_SUBG, I_MU, I_W0, I_W2, I_A0, I_A2, I_G2,
       I_KK, I_KA, I_RK, I_LNXG, I_LNXB, I_BRA, I_BRB, I_WGATE, I_BGATE, I_WO };

struct Frame { LAS unsigned char* lds; int tid, lane, wave, vcu, G; };

__device__ __forceinline__ int opq(int x) { asm volatile("" : "+s"(x)); return x; }
__device__ __forceinline__ Frame relaunder(const Frame& F) { Frame G = F; G.vcu = opq(G.vcu); G.G = opq(G.G); G.wave = opq(F.wave); G.lane = (int)__builtin_amdgcn_mbcnt_hi(~0u, __builtin_amdgcn_mbcnt_lo(~0u, 0u)); asm volatile("" : "+v"(G.lane)); G.tid = G.wave * 64 + G.lane; return G; }
__device__ __forceinline__ int row_seq(int row) { return row < MP ? (row >> 13) : NB + ((row - MP) >> 5); }
__device__ __forceinline__ int crow(int r, int hi) { return (r & 3) + 8 * (r >> 2) + 4 * hi; }
__device__ __forceinline__ float wave_sum(float v) {
#pragma unroll
    for (int o = 1; o < 64; o <<= 1) v += __shfl_xor(v, o);
    return v;
}
__device__ __forceinline__ unsigned cvtpk(float lo, float hi) { return pg8::cvt_pk_bf16(lo, hi); }
__device__ __forceinline__ unsigned short f2bf1(float x) { return (unsigned short)(pg8::cvt_pk_bf16(x, 0.f) & 0xffffu); }
__device__ __forceinline__ float bf2f(bf16 b) { return __uint_as_float((unsigned)b << 16); }
typedef float f32x16 __attribute__((ext_vector_type(16)));
typedef unsigned u32x2 __attribute__((ext_vector_type(2)));
#define LP(T, p) ((LAS T*)(p))

__device__ __forceinline__ void p0_transpose_item(const float* W, int K, int N, bf16* WT, int k0, int n0, int drow0, LAS float* scr, int lane) {
    float wv[32];
#pragma unroll
    for (int i = 0; i < 32; ++i) wv[i] = W[(size_t)(k0 + 2 * i + (lane >> 5)) * N + n0 + (lane & 31)];
#pragma unroll
    for (int i = 0; i < 32; ++i) scr[(2 * i + (lane >> 5)) * 33 + (lane & 31)] = wv[i];
    LDS_WAIT(); asm volatile("" ::: "memory");
    const int c = lane & 7;
#pragma unroll
    for (int j = 0; j < 4; ++j) { const int n = (lane >> 3) + 8 * j; const LAS float* s = scr + (8 * c) * 33 + n;
        v4u o; o.x = pk2(s[0 * 33], s[1 * 33]); o.y = pk2(s[2 * 33], s[3 * 33]); o.z = pk2(s[4 * 33], s[5 * 33]); o.w = pk2(s[6 * 33], s[7 * 33]);
        *(GAS v4u*)(WT + (size_t)(drow0 + n) * K + k0 + 8 * c) = o; }
    LDS_WAIT(); asm volatile("" ::: "memory");
}
__device__ __forceinline__ void conv_mat(const float* W, int K, int N, bf16* WT, int r, int row_off, bool gu, LAS float* scr, int lane) {
    const int nblk = N / 32, kb = r / nblk, nb = r % nblk, n0 = 32 * nb; int drow0 = row_off + n0;
    if (gu) { drow0 = n0 < DFF ? 256 * (n0 / 128) + (n0 % 128) : 256 * ((n0 - DFF) / 128) + 128 + ((n0 - DFF) % 128); }
    p0_transpose_item(W, K, N, WT, 64 * kb, n0, drow0, scr, lane);
}
__device__ __forceinline__ void ph_prologue(const Frame& F0, const Args& a) {
    const Frame F = relaunder(F0);
    unsigned char* ws = a.ws;
    LAS bf16* sc = LP(bf16, F.lds);
    for (int i = F.tid; i < NSEQ * D; i += NTHR) { const int s = i >> 10, k = i & 1023; const float c = s < NB ? a.in[I_CP][s * D + k] : a.in[I_CS][(s - NB) * D + k];
        sc[s * 1032 + k] = (bf16)f2bf(c * fast_sigmoid(c)); }
    __syncthreads();
    const int gw = F.vcu * NWAVES + F.wave, NGW = F.G * NWAVES; const int lane = F.lane, r32 = lane & 31, hi = lane >> 5;
    float* MOD = (float*)(ws + WS_MOD);
    for (int it = gw; it < DEPTH * 288; it += NGW) {
        const int l = it / 288, n0 = (it % 288) * 32;
        const float* W = a.in[I_WADA] + (size_t)l * D * 9216 + n0 + r32;
        f32x16 acc0 = {}, acc1 = {};
        const int rowB = (32 + r32) < NSEQ ? 32 + r32 : NSEQ - 1;
#pragma unroll 4
        for (int s = 0; s < 64; ++s) {
            const float* wp = W + (size_t)(16 * s + 8 * hi) * 9216;
            float w[8];
#pragma unroll
            for (int j = 0; j < 8; ++j) w[j] = wp[(size_t)j * 9216];
            v4u bw; bw.x = cvtpk(w[0], w[1]); bw.y = cvtpk(w[2], w[3]); bw.z = cvtpk(w[4], w[5]); bw.w = cvtpk(w[6], w[7]);
            const bf16x8 bfrag = __builtin_bit_cast(bf16x8, bw);
            const bf16x8 a0 = *LP(const bf16x8, sc + r32 * 1032 + 16 * s + 8 * hi);
            const bf16x8 a1 = *LP(const bf16x8, sc + rowB * 1032 + 16 * s + 8 * hi);
            acc0 = __builtin_amdgcn_mfma_f32_32x32x16_bf16(a0, bfrag, acc0, 0, 0, 0);
            acc1 = __builtin_amdgcn_mfma_f32_32x32x16_bf16(a1, bfrag, acc1, 0, 0, 0);
        }
        const float bias = a.in[I_BADA][(size_t)l * 9216 + n0 + r32];
#pragma unroll
        for (int r = 0; r < 16; ++r) { const int s0 = crow(r, hi); MOD[((size_t)l * NSEQ + s0) * 9216 + n0 + r32] = acc0[r] + bias;
            const int s1 = 32 + s0; if (s1 < NSEQ) MOD[((size_t)l * NSEQ + s1) * 9216 + n0 + r32] = acc1[r] + bias; }
    }
    LAS float* scr = LP(float, F.lds + 74304 + F.wave * 8448);
    constexpr int C0 = 16 * 176, C2 = 44 * 32, C4 = 16 * 104, C5 = 16 * 64, C6 = 8 * 32, C8 = 16 * 32, C9 = 16, C11 = 32;
    constexpr int PER_L = 2 * C0 + 2 * C2 + C4 + C5 + 2 * C6 + C8 + 2 * C9 + C11;
    for (int it = gw; it < DEPTH * PER_L; it += NGW) {
        const int l = it / PER_L; int r = it % PER_L; unsigned char* wl = ws + WS_W + (size_t)l * WL_SIZE;
        if (r < C0) { conv_mat(a.in[I_WGU] + (size_t)(l * 2 + 0) * D * NGU, D, NGU, (bf16*)(wl + WL_GU0), r, 0, true, scr, lane); continue; } r -= C0;
        if (r < C0) { conv_mat(a.in[I_WGU] + (size_t)(l * 2 + 1) * D * NGU, D, NGU, (bf16*)(wl + WL_GU1), r, 0, true, scr, lane); continue; } r -= C0;
        if (r < C2) { conv_mat(a.in[I_WDN] + (size_t)(l * 2 + 0) * DFF * D, DFF, D, (bf16*)(wl + WL_DN0), r, 0, false, scr, lane); continue; } r -= C2;
        if (r < C2) { conv_mat(a.in[I_WDN] + (size_t)(l * 2 + 1) * DFF * D, DFF, D, (bf16*)(wl + WL_DN1), r, 0, false, scr, lane); continue; } r -= C2;
        if (r < C4) { conv_mat(a.in[I_WIN] + (size_t)l * D * NIN, D, NIN, (bf16*)(wl + WL_IG), r, 0, false, scr, lane); continue; } r -= C4;
        if (r < C5) { conv_mat(a.in[I_WGATE] + (size_t)l * D * 2048, D, 2048, (bf16*)(wl + WL_IG), r, NIN, false, scr, lane); continue; } r -= C5;
        if (r < C6) { conv_mat(a.in[I_BRA] + (size_t)l * 512 * D, 512, D, (bf16*)(wl + WL_BR), r, 0, false, scr, lane); continue; } r -= C6;
        if (r < C6) { conv_mat(a.in[I_BRB] + (size_t)l * 512 * D, 512, D, (bf16*)(wl + WL_BR), r, 1024, false, scr, lane); continue; } r -= C6;
        if (r < C8) { conv_mat(a.in[I_WO] + (size_t)l * D * D, D, D, (bf16*)(wl + WL_O), r, 0, false, scr, lane); continue; } r -= C8;
        if (r < C9) { conv_mat(a.in[I_W2] + (size_t)l * 64 * 512, 64, 512, (bf16*)(wl + WL_W2), r, 0, false, scr, lane); continue; } r -= C9;
        if (r < C9) { conv_mat(a.in[I_A2] + (size_t)l * 64 * 512, 64, 512, (bf16*)(wl + WL_A2), r, 0, false, scr, lane); continue; } r -= C9;
        conv_mat(a.in[I_G2] + (size_t)l * 128 * 512, 128, 512, (bf16*)(wl + WL_G2), r, 0, false, scr, lane);
    }
    for (int z = gw * 64 + lane; z < DEPTH * DECB * 256; z += NGW * 64) ((bf16*)(ws + WS_SSB))[z] = (bf16)f2bf(a.in[I_SSH][(size_t)(z >> 8) * NRW + 1536 + (z & 255)]);
    if (blockIdx.x == 0 && F.wave == 0) {
        for (int l = 0; l < DEPTH; ++l) { const float* lq = a.in[I_LAMQK] + l * 256;
            const float s1 = wave_sum(lq[lane] * lq[64 + lane]), s2 = wave_sum(lq[128 + lane] * lq[192 + lane]);
            const float lam_init = 0.8f - 0.6f * expf(-0.3f * (float)l);
            if (lane == 0) ((float*)(ws + WS_LAM))[l] = expf(s1) - expf(s2) + lam_init; }
    }
}

__device__ __forceinline__ void ph_ln(const Frame& F0, const float* xin_p, const float* xin_s, const bf16* f, float gs, const float* gate_mod  ,
                                      const float* lng, const float* lnb, const float* modn  , float* xout, bf16* uout,
                                      const float* fparts = nullptr, int nparts = 0  ) {
    const Frame F = relaunder(F0);
    const int gw = F.vcu * NWAVES + F.wave, NGW = F.G * NWAVES, lane = F.lane;
    const int m0 = gw; if (m0 >= M) return;
    f32x4 cg[4], cb[4], cgate[4], csh[4], cscl[4]; int cseq = -1;
#pragma unroll
    for (int j = 0; j < 4; ++j) { cg[j] = f ? *(const f32x4*)(lng + 4 * lane + 256 * j) : (f32x4){0.f, 0.f, 0.f, 0.f}; cb[j] = f ? *(const f32x4*)(lnb + 4 * lane + 256 * j) : (f32x4){0.f, 0.f, 0.f, 0.f}; }
    auto xrow = [&](int m) -> const float* { return (xin_s && m >= MP) ? xin_s + (size_t)(m - MP) * D : xin_p + (size_t)m * D; };
    f32x4 v[4], vn[4]; u32x2 fw[4], fwn[4];
#pragma unroll
    for (int j = 0; j < 4; ++j) { vn[j] = *(const f32x4*)(xrow(m0) + 4 * lane + 256 * j); fwn[j] = (f && !(fparts && m0 >= MP)) ? *(const u32x2*)(f + (size_t)m0 * D + 4 * lane + 256 * j) : (u32x2){0u, 0u}; }
    for (int m = m0; m < M; m += NGW) {
        const int seq = row_seq(m);
#pragma unroll
        for (int j = 0; j < 4; ++j) { v[j] = vn[j]; fw[j] = fwn[j]; }
        { const int mn = m + NGW < M ? m + NGW : m;
#pragma unroll
          for (int j = 0; j < 4; ++j) { vn[j] = *(const f32x4*)(xrow(mn) + 4 * lane + 256 * j); fwn[j] = (f && !(fparts && mn >= MP)) ? *(const u32x2*)(f + (size_t)mn * D + 4 * lane + 256 * j) : (u32x2){0u, 0u}; } }
        if (seq != cseq) { cseq = seq;
#pragma unroll
            for (int j = 0; j < 4; ++j) { if (f) cgate[j] = *(const f32x4*)(gate_mod + (size_t)seq * 9216 + 4 * lane + 256 * j) * gs;
                if (modn) { csh[j] = *(const f32x4*)(modn + (size_t)seq * 9216 + 4 * lane + 256 * j); cscl[j] = *(const f32x4*)(modn + (size_t)seq * 9216 + D + 4 * lane + 256 * j) + 1.0f; } } }
        if (f) {
            float s = 0.f;
#pragma unroll
            for (int j = 0; j < 4; ++j) { f32x4 fv;
                if (fparts && m >= MP) { fv = (f32x4){0.f, 0.f, 0.f, 0.f}; for (int sp = 0; sp < nparts; ++sp) fv += *(const f32x4*)(fparts + ((size_t)sp * MD + (m - MP)) * D + 4 * lane + 256 * j); }
                else fv = (f32x4){__uint_as_float(fw[j].x << 16), __uint_as_float(fw[j].x & 0xffff0000u), __uint_as_float(fw[j].y << 16), __uint_as_float(fw[j].y & 0xffff0000u)};
                v[j] = v[j] * ALPHA + cgate[j] * fv; s += (v[j].x + v[j].y) + (v[j].z + v[j].w); }
            const float mean = wave_sum(s) * (1.f / D); float s2 = 0.f;
#pragma unroll
            for (int j = 0; j < 4; ++j) { v[j] = v[j] - mean; s2 += (v[j].x * v[j].x + v[j].y * v[j].y) + (v[j].z * v[j].z + v[j].w * v[j].w); }
            const float rstd = 1.0f / sqrtf(wave_sum(s2) * (1.f / D) + LN_EPS);
#pragma unroll
            for (int j = 0; j < 4; ++j) { v[j] = v[j] * rstd * cg[j] + cb[j]; *(f32x4*)(xout + (size_t)m * D + 4 * lane + 256 * j) = v[j]; }
        }
        if (modn) {
            float s = 0.f;
#pragma unroll
            for (int j = 0; j < 4; ++j) s += (v[j].x + v[j].y) + (v[j].z + v[j].w);
            const float mean = wave_sum(s) * (1.f / D); float s2 = 0.f;
#pragma unroll
            for (int j = 0; j < 4; ++j) { v[j] = v[j] - mean; s2 += (v[j].x * v[j].x + v[j].y * v[j].y) + (v[j].z * v[j].z + v[j].w * v[j].w); }
            const float rstd = 1.0f / sqrtf(wave_sum(s2) * (1.f / D) + LN_EPS);
#pragma unroll
            for (int j = 0; j < 4; ++j) { const f32x4 o = v[j] * rstd * cscl[j] + csh[j]; u32x2 w; w.x = cvtpk(o.x, o.y); w.y = cvtpk(o.z, o.w);
                *(u32x2*)(uout + (size_t)m * D + 4 * lane + 256 * j) = w; }
        }
    }
}
__device__ __forceinline__ int t5_bucket(int rel) {
    const int n = rel < 0 ? -rel : rel; int b;
    if (n < 8) b = n; else if (n < 12) b = 8; else if (n < 16) b = 9; else if (n < 23) b = 10; else if (n < 32) b = 11; else if (n < 46) b = 12; else if (n < 64) b = 13; else if (n < 91) b = 14; else b = 15;
    return (rel > 0 ? 16 : 0) + b;
}
typedef short v4i16_t __attribute__((ext_vector_type(4)));
__device__ __forceinline__ v4i16_t vtr(LAS const unsigned char* p) { return __builtin_amdgcn_ds_read_tr16_b64_v4i16((LAS v4i16_t*)p); }
constexpr int ATT_SLOT = 32768;
constexpr int ATT_TAB = EXTRA_OFF;
struct AttnP { const bf16* Q; const bf16* Kb; const bf16* Vb; const float* ck; const float* cv; bf16* YA; const float* relb; const float* subg; float lam, oml; };

__device__ __forceinline__ void attn_scores(LAS const unsigned char* slot, LAS const float* tab, const bf16x8 (&qf)[4], f32x16 (&o)[4], bf16x8 (&pf)[4], float& mrun, float& lrun,
                                            int map, int lane, int k0, int qpos, bool constb, int nvalid, bool first  ) {
    const int r32 = lane & 31, hi = lane >> 5;
    LAS const unsigned char* kb = slot + map * 8192 + hi * 1024 + r32 * 16;
    f32x16 p0, p1;
    const float cb = (constb ? tab[0] : 0.f) - (first ? 0.f : mrun);
#pragma unroll
    for (int r = 0; r < 16; ++r) { p0[r] = cb; p1[r] = cb; }
#pragma unroll
    for (int d0 = 0; d0 < 4; ++d0) {
        const bf16x8 k0f = *LP(const bf16x8, kb + d0 * 2048), k1f = *LP(const bf16x8, kb + d0 * 2048 + 512);
        p0 = __builtin_amdgcn_mfma_f32_32x32x16_bf16(k0f, qf[d0], p0, 0, 0, 0);
        p1 = __builtin_amdgcn_mfma_f32_32x32x16_bf16(k1f, qf[d0], p1, 0, 0, 0);
    }
    if (!constb) {
        const int base = k0 - qpos + 128;
#pragma unroll
        for (int r = 0; r < 16; ++r) { int i0 = base + crow(r, hi); int i1 = i0 + 32; i0 = i0 < 0 ? 0 : (i0 > 191 ? 191 : i0); i1 = i1 < 0 ? 0 : (i1 > 191 ? 191 : i1); p0[r] += tab[i0]; p1[r] += tab[i1]; }
    }
    if (nvalid < 64) {
#pragma unroll
        for (int r = 0; r < 16; ++r) { if (crow(r, hi) >= nvalid) p0[r] = -INFINITY; if (crow(r, hi) + 32 >= nvalid) p1[r] = -INFINITY; }
    }
    float ma = fmaxf(fmaxf(p0[0], p0[1]), p1[0]), mb = fmaxf(fmaxf(p0[2], p0[3]), p1[1]); ma = fmaxf(fmaxf(ma, p1[2]), p1[3]);
#pragma unroll
    for (int r = 4; r < 16; r += 4) { ma = fmaxf(fmaxf(ma, p0[r]), p0[r + 1]); mb = fmaxf(fmaxf(mb, p0[r + 2]), p0[r + 3]); ma = fmaxf(fmaxf(ma, p1[r]), p1[r + 1]); mb = fmaxf(fmaxf(mb, p1[r + 2]), p1[r + 3]); }
    float mx = fmaxf(ma, mb);
    mx = fmaxf(mx, __shfl_xor(mx, 32));
    if (first || __any(mx > 8.0f)) {
        const float delta = first ? mx : (mx > 8.0f ? mx : 0.f);
        const float alpha = first ? 0.f : __builtin_amdgcn_exp2f(-delta);
        mrun = first ? mx : mrun + delta;
        lrun *= alpha;
#pragma unroll
        for (int r = 0; r < 16; ++r) { p0[r] -= delta; p1[r] -= delta; }
#pragma unroll
        for (int c = 0; c < 4; ++c)
#pragma unroll
            for (int r = 0; r < 16; ++r) o[c][r] *= alpha;
    }
    float ls = 0.f;
#pragma unroll
    for (int r = 0; r < 16; ++r) { p0[r] = __builtin_amdgcn_exp2f(p0[r]); p1[r] = __builtin_amdgcn_exp2f(p1[r]); ls += p0[r] + p1[r]; }
    lrun += ls;
#pragma unroll
    for (int ks = 0; ks < 4; ++ks) { v4u w;
        if (ks < 2) { const int b = 8 * ks; w.x = cvtpk(p0[b], p0[b + 1]); w.y = cvtpk(p0[b + 2], p0[b + 3]); w.z = cvtpk(p0[b + 4], p0[b + 5]); w.w = cvtpk(p0[b + 6], p0[b + 7]); }
        else { const int b = 8 * (ks - 2); w.x = cvtpk(p1[b], p1[b + 1]); w.y = cvtpk(p1[b + 2], p1[b + 3]); w.z = cvtpk(p1[b + 4], p1[b + 5]); w.w = cvtpk(p1[b + 6], p1[b + 7]); }
        pf[ks] = __builtin_bit_cast(bf16x8, w); }
}
__device__ __forceinline__ void attn_pv(LAS const unsigned char* slot, const bf16x8 (&pf)[4], f32x16 (&o)[4], int lane) {
    const int hi = lane >> 5;
    LAS const unsigned char* vb = slot + 16384 + ((lane >> 4) & 1) * 32 + (lane & 3) * 8 + (4 * hi + ((lane & 15) >> 2)) * 64;
#pragma unroll
    for (int c = 0; c < 4; ++c)
#pragma unroll
        for (int ks = 0; ks < 4; ++ks) {
            const v4i16_t lo = vtr(vb + c * 4096 + (2 * ks) * 512), hh = vtr(vb + c * 4096 + (2 * ks + 1) * 512);
            const bf16x8 vf = (bf16x8){lo[0], lo[1], lo[2], lo[3], hh[0], hh[1], hh[2], hh[3]};
            o[c] = __builtin_amdgcn_mfma_f32_32x32x16_bf16(vf, pf[ks], o[c], 0, 0, 0);
        }
}

__device__ __forceinline__ int att_koff(int key, int ch) { return (ch >> 3) * 8192 + ((ch & 7) >> 1) * 2048 + (ch & 1) * 1024 + (key >> 5) * 512 + (key & 31) * 16; }
__device__ __forceinline__ int att_voff(int key, int ch) { return 16384 + (ch >> 2) * 4096 + (key >> 3) * 512 + (key & 7) * 64 + (ch & 3) * 16; }

__device__ __forceinline__ void attn_unit(const Frame& F, const AttnP& P, bool dec, int bidx, int h, int qb) {
    const int tid = F.tid, lane = F.lane, wave = F.wave, r32 = lane & 31, hi = lane >> 5;
    const int map = wave & 1, qs = wave >> 1;
    LAS unsigned char* lds = F.lds;
    LAS float* tab = LP(float, lds + ATT_TAB);
    const int rowbase = dec ? MP + bidx * DECS : bidx * SEQ;
    const int q0 = dec ? 0 : qb * 128;
    const int qpos0 = dec ? PAST : q0;
    const bool active = dec ? (qs == 0) : true;
    const int NT = dec ? (PAST / 64 + 1) : (2 * qb + 2);
    const int myNT = dec ? NT : (2 * qb + 1 + (qs >> 1));
    if (tid < 192) tab[tid] = P.relb[t5_bucket(tid - 128) * HA + h] * LOG2E;
    bf16x8 qf[4];
    { const bf16* qp = P.Q + (size_t)(rowbase + q0 + (active ? qs * 32 : 0) + r32) * 512 + h * 128 + map * 64 + 8 * hi;
#pragma unroll
      for (int d0 = 0; d0 < 4; ++d0) qf[d0] = *(const bf16x8*)(qp + 16 * d0); }
    f32x16 o[4];
#pragma unroll
    for (int c = 0; c < 4; ++c)
#pragma unroll
        for (int r = 0; r < 16; ++r) o[c][r] = 0.f;
    float mrun = -INFINITY, lrun = 0.f;
    const int qposw = qpos0 + qs * 32;
    v4u kreg[2], vreg[2];
    auto load_tile = [&](int t) {
#pragma unroll
        for (int i = 0; i < 2; ++i) { const int id = tid + 512 * i;
            const int kk = (id & 7) | ((id >> 7) << 3), kc = (id >> 3) & 15;
            const int vk = ((id >> 2) & 7) | ((id >> 7) << 3), vc = (id & 3) | (((id >> 5) & 3) << 2);
            if (!dec) { kreg[i] = *(const v4u*)(P.Kb + (size_t)(rowbase + 64 * t + kk) * 512 + h * 128 + kc * 8); vreg[i] = *(const v4u*)(P.Vb + (size_t)(rowbase + 64 * t + vk) * 512 + h * 128 + vc * 8); }
            else if (t < PAST / 64) { const size_t gk = ((size_t)(bidx * PAST + 64 * t + kk) * HA + h) * 128 + kc * 8, gv = ((size_t)(bidx * PAST + 64 * t + vk) * HA + h) * 128 + vc * 8;
                const f32x4 a0 = *(const f32x4*)(P.ck + gk), a1 = *(const f32x4*)(P.ck + gk + 4), b0 = *(const f32x4*)(P.cv + gv), b1 = *(const f32x4*)(P.cv + gv + 4);
                kreg[i] = (v4u){cvtpk(a0[0], a0[1]), cvtpk(a0[2], a0[3]), cvtpk(a1[0], a1[1]), cvtpk(a1[2], a1[3])};
                vreg[i] = (v4u){cvtpk(b0[0], b0[1]), cvtpk(b0[2], b0[3]), cvtpk(b1[0], b1[1]), cvtpk(b1[2], b1[3])}; }
            else { kreg[i] = kk < DECS ? *(const v4u*)(P.Kb + (size_t)(rowbase + kk) * 512 + h * 128 + kc * 8) : (v4u){0u, 0u, 0u, 0u};
                   vreg[i] = vk < DECS ? *(const v4u*)(P.Vb + (size_t)(rowbase + vk) * 512 + h * 128 + vc * 8) : (v4u){0u, 0u, 0u, 0u}; }
        }
    };
    auto store_tile_at = [&](int sloff) {
        LAS unsigned char* sb = lds + sloff;
#pragma unroll
        for (int i = 0; i < 2; ++i) { const int id = tid + 512 * i;
            const int kk = (id & 7) | ((id >> 7) << 3), kc = (id >> 3) & 15, vk = ((id >> 2) & 7) | ((id >> 7) << 3), vc = (id & 3) | (((id >> 5) & 3) << 2);
            *LP(v4u, sb + att_koff(kk, kc)) = kreg[i]; *LP(v4u, sb + att_voff(vk, vc)) = vreg[i]; }
    };
    __syncthreads();
    load_tile(0); store_tile_at(0);
    __syncthreads();
    const bool late = wave >= 4;
    bf16x8 pf[4];
    bool pend = false;
    int sl_prev = 0, sl_cur = 0, sl_next = ATT_SLOT;
    for (int t = 0; t < NT; ++t) {
        if (t + 1 < NT) load_tile(t + 1);
        const bool mine = active && t < myNT;
        if (late) {
            if (pend) attn_pv(lds + sl_prev, pf, o, lane);
            pend = mine;
        }
        if (mine) {
            const int k0 = 64 * t;
            const bool constb = (k0 + 63 - qposw) <= -91;
            attn_scores(lds + sl_cur, tab, qf, o, pf, mrun, lrun, map, lane, k0, qposw + r32, constb, (dec && t == NT - 1) ? DECS : 64, t == 0);
            if (!late) attn_pv(lds + sl_cur, pf, o, lane);
        }
        if (t + 1 < NT) store_tile_at(sl_next);
        __syncthreads();
        sl_prev = sl_cur; sl_cur = sl_next; sl_next = sl_next == 2 * ATT_SLOT ? 0 : sl_next + ATT_SLOT;
    }
    if (late && pend) attn_pv(lds + sl_prev, pf, o, lane);
    __syncthreads();
    lrun += __shfl_xor(lrun, 32);
    const float inv = 1.0f / lrun;
    LAS float* ex = LP(float, lds + (wave >> 1) * 16384);
    if (map == 1) {
#pragma unroll
        for (int c = 0; c < 4; ++c)
#pragma unroll
            for (int r = 0; r < 16; ++r) ex[(c * 16 + r) * 64 + lane] = o[c][r] * inv;
    }
    __syncthreads();
    LAS bf16* yst = LP(bf16, lds + 65536 + (wave >> 1) * 8448);
    if (map == 0) {
        float ss = 0.f;
#pragma unroll
        for (int c = 0; c < 4; ++c)
#pragma unroll
            for (int r = 0; r < 16; ++r) { const float v = o[c][r] * inv - P.lam * ex[(c * 16 + r) * 64 + lane]; o[c][r] = v; ss += v * v; }
        ss += __shfl_xor(ss, 32);
        const float rs = 1.0f / sqrtf(ss * (1.f / 128.f) + LN_EPS) * P.oml;
#pragma unroll
        for (int c = 0; c < 4; ++c)
#pragma unroll
            for (int r = 0; r < 16; ++r) { const int dv = 32 * c + crow(r, hi); yst[r32 * 132 + dv] = (bf16)f2bf(o[c][r] * rs * P.subg[dv]); }
    }
    __syncthreads();
    if (map == 0 && active) {
#pragma unroll
        for (int i = 0; i < 8; ++i) { const int row = i * 4 + (lane >> 4), ch = lane & 15;
            const u32x2 a = *LP(const u32x2, yst + row * 132 + ch * 8), b = *LP(const u32x2, yst + row * 132 + ch * 8 + 4);
            *(v4u*)(P.YA + (size_t)(rowbase + q0 + qs * 32 + row) * 512 + h * 128 + ch * 8) = (v4u){a.x, a.y, b.x, b.y}; }
    }
}
__device__ __forceinline__ void ph_attn(const Frame& F0, const AttnP& P, unsigned* qcount) {
    const Frame F = relaunder(F0);
    LAS unsigned* qslot = LP(unsigned, F.lds + LDSCTL_OFF + 64);
    for (;;) {
        __syncthreads();
        if (F.tid == 0) *qslot = __hip_atomic_fetch_add(qcount, 1u, __ATOMIC_RELAXED, __HIP_MEMORY_SCOPE_AGENT);
        __syncthreads();
        const int u = __builtin_amdgcn_readfirstlane((int)*qslot);
        if (u >= 1024 + DECB * HA) break;
        if (u < 1024) { const int bh = u & 15, qb = 63 - (u >> 4); attn_unit(F, P, false, bh >> 2, bh & 3, qb); }
        else { const int d = u - 1024; attn_unit(F, P, true, d >> 2, d & 3, 0); }
    }
}
constexpr int R1_RT = 0, R1_KH = 9216, R1_BH = 18432, R1_KAP = 27648, R1_KAPT = 36864, R1_VT = 46080, R1_BBT = 55296, R1_KBT = 64512;
constexpr int R1_ABKF = 73728, R1_AKK = 90368, R1_ABR = 99584, R1_AKR = 108800, R1_MB = 118016;
constexpr int R1_MF = R1_KH, R1_GT = R1_KAP, R1_WT = R1_ABKF, R1_UT = R1_KH;
constexpr int R1_LW = 73728, R1_LA = 82944, R1_LG = 92160;
constexpr int R1_RED = EXTRA_OFF, R1_CS = EXTRA_OFF + 1024, R1_GTV = EXTRA_OFF + 2048, R1_T16 = EXTRA_OFF + 2304, R1_MUL = EXTRA_OFF + 5632;
typedef unsigned short u16;
__device__ __forceinline__ f32x4 mfma16(bf16x8 a, bf16x8 b, f32x4 c) { return __builtin_amdgcn_mfma_f32_16x16x32_bf16(a, b, c, 0, 0, 0); }
__device__ __forceinline__ void mm64(f32x4 (&acc)[2], LAS const unsigned char* X, LAS const unsigned char* Y, int tm, int tn0, int lane) {
    const int i = lane & 15, q = lane >> 4;
#pragma unroll
    for (int s = 0; s < 2; ++s) {
        const bf16x8 af = *LP(const bf16x8, X + ((16 * tm + i) * 72 + 32 * s + 8 * q) * 2);
#pragma unroll
        for (int j = 0; j < 2; ++j) { const bf16x8 bfr = *LP(const bf16x8, Y + ((16 * (tn0 + j) + i) * 72 + 32 * s + 8 * q) * 2); acc[j] = mfma16(af, bfr, acc[j]); }
    }
}
__device__ __forceinline__ void st_tr(LAS unsigned char* arr, const f32x4& v, int n, int t0) {
    u32x2 w; w.x = cvtpk(v[0], v[1]); w.y = cvtpk(v[2], v[3]); *LP(u32x2, arr + (n * 72 + t0) * 2) = w;
}
__device__ __forceinline__ f32x4 prod16(f32x4 acc, LAS const float* X, int sx, LAS const float* Y, int sy, int lane) {
    const int i = lane & 15, q = lane >> 4;
#pragma unroll
    for (int s = 0; s < 4; ++s) acc = __builtin_amdgcn_mfma_f32_16x16x4f32(X[i * sx + 4 * s + q], Y[(4 * s + q) * sy + i], acc, 0, 0, 0);
    return acc;
}
__device__ __forceinline__ float tanh_fast(float x) { return 1.0f - 2.0f * __builtin_amdgcn_rcpf(1.0f + __expf(2.0f * x)); }

__device__ __forceinline__ int frag_a(int row, int k) { return ((row >> 4) * 2 + (k >> 5)) * 512 + (((k >> 2) & 3) * 16 + (row & 15)) * 8 + 4 * ((k >> 4) & 1) + (k & 3); }
__device__ __forceinline__ int frag_c(int c, int r0) { return (((c >> 4) * 4 + (r0 >> 4)) * 64 + ((r0 >> 2) & 3) * 16 + (c & 15)) * 4; }
__device__ __forceinline__ void ph_rwkv1(const Frame& F0, const Args& a, int l) {
    const Frame F = relaunder(F0);
    unsigned char* ws = a.ws; LAS unsigned char* lds = F.lds;
    int tid = F.tid, lane = F.lane, i = lane & 15, q = lane >> 4, t0 = 0; const int wave = F.wave, tm = wave >> 1, tnb = 2 * (wave & 1);
#define R1_RELANE() do { int l_ = F.lane; asm volatile("" : "+v"(l_)); lane = l_; i = lane & 15; q = lane >> 4; tid = wave * 64 + lane; t0 = 16 * tm + 4 * q; } while (0)
    const float* PRW = (const float*)(ws + WS_PRW); const bf16* PLB = (const bf16*)(ws + WS_PLB);
    const unsigned char* wl = ws + WS_W + (size_t)l * WL_SIZE;
    const bf16* W2t = (const bf16*)(wl + WL_W2); const bf16* A2t = (const bf16*)(wl + WL_A2); const bf16* G2t = (const bf16*)(wl + WL_G2);
    const float* mu = a.in[I_MU] + (size_t)l * NRW; const float* w0 = a.in[I_W0] + l * 512; const float* a0 = a.in[I_A0] + l * 512;
    const float* k_k = a.in[I_KK] + l * 512; const float* k_a = a.in[I_KA] + l * 512; const float* r_k = a.in[I_RK] + l * 512;
    bf16* GG = (bf16*)(ws + WS_GG); bf16* BON = (bf16*)(ws + WS_BON);
    LAS float* RED = LP(float, lds + R1_RED); LAS float* CS = LP(float, lds + R1_CS); LAS float* GTV = LP(float, lds + R1_GTV);
    LAS float* ABKF = LP(float, lds + R1_ABKF); LAS float* MF = LP(float, lds + R1_MF);
    if (tid < 256) LP(float, lds + R1_MUL)[tid] = mu[1536 + tid];
    __syncthreads();
    struct R1Item { int h, row0, tval; const float* prev0; const bf16* prevb; };
    auto item_info = [&](int it) -> R1Item { R1Item I;
        if (it < NITEM_P) { const int s = it >> 10, c = (it >> 3) & 127; I.h = it & 7; I.row0 = s * SEQ + 64 * c; I.tval = 64; I.prev0 = c > 0 ? PRW + (size_t)(I.row0 - 1) * NRW : nullptr; I.prevb = c > 0 ? PLB + (size_t)(I.row0 - 1) * 256 : nullptr; }
        else { const int b = (it - NITEM_P) >> 3; I.h = it & 7; I.row0 = MP + DECS * b; I.tval = DECS; I.prev0 = a.in[I_SSH] + (size_t)(l * DECB + b) * NRW; I.prevb = (const bf16*)(ws + WS_SSB) + (size_t)(l * DECB + b) * 256; }
        return I; };
    v4u lp[4], lq[4];
    float gp[2][4][3], gq[2][3], cst[2][8]; bool pqz = false;
    auto load_top = [&](const R1Item& I) {
        const int t0s = tid >> 3, part = tid & 7; const bool v0 = t0s < I.tval;
        const bf16* pl_ = PLB + (size_t)(I.row0 + (v0 ? t0s : 0)) * 256 + 32 * part;
        const bf16* pq_ = (v0 && t0s > 0) ? pl_ - 256 : (I.prevb ? I.prevb + 32 * part : pl_);
        pqz = !(v0 && t0s > 0) && !I.prevb;
#pragma unroll
        for (int e = 0; e < 4; ++e) { lp[e] = *(const v4u*)(pl_ + 8 * e); lq[e] = *(const v4u*)(pq_ + 8 * e); }
#pragma unroll
        for (int j = 0; j < 2; ++j) { const int col = I.h * 64 + 16 * (tnb + j) + i; const int tb = 16 * tm + 4 * q;
#pragma unroll
            for (int r = 0; r < 4; ++r) { const unsigned po = (unsigned)(I.row0 + min(tb + r, I.tval - 1)) * NRW + col; gp[j][r][0] = PRW[po]; gp[j][r][1] = PRW[po + 512]; gp[j][r][2] = PRW[po + 1024]; }
            const float* pb = tb > 0 ? PRW + (size_t)(I.row0 + min(tb, I.tval) - 1) * NRW : I.prev0;
            if (pb) { gq[j][0] = pb[col]; gq[j][1] = pb[512 + col]; gq[j][2] = pb[1024 + col]; } else { gq[j][0] = 0.f; gq[j][1] = 0.f; gq[j][2] = 0.f; }
            cst[j][0] = mu[col]; cst[j][1] = mu[512 + col]; cst[j][2] = mu[1024 + col]; cst[j][3] = w0[col]; cst[j][4] = a0[col]; cst[j][5] = k_k[col]; cst[j][6] = k_a[col]; cst[j][7] = r_k[col]; }
    };
    R1Item cur = item_info(F.vcu < NITEM ? F.vcu : 0), nxt = cur;
    if (F.vcu < NITEM) { R1_RELANE(); load_top(cur); }
    for (int it = F.vcu; it < NITEM; it += F.G) {
        const int h = cur.h, row0 = cur.row0, tval = cur.tval;
        R1_RELANE();
        const int t0s = tid >> 3, part = tid & 7;
        const bool v0 = t0s < tval;
        { LAS unsigned char* dst = part < 2 ? lds + R1_LW + (t0s * 72 + 32 * part) * 2 : (part < 4 ? lds + R1_LA + (t0s * 72 + 32 * (part - 2)) * 2 : lds + R1_LG + (t0s * 136 + 32 * (part - 4)) * 2);
          LAS const float* mul = LP(const float, lds + R1_MUL) + 32 * part;
#pragma unroll
          for (int e8 = 0; e8 < 4; ++e8) { float x[8];
#pragma unroll
              for (int e = 0; e < 2; ++e) { const unsigned pa_ = e ? lp[e8].z : lp[e8].x, pb_ = e ? lp[e8].w : lp[e8].y, qa_ = e ? lq[e8].z : lq[e8].x, qb_ = e ? lq[e8].w : lq[e8].y;
                  const f32x4 pv = {__uint_as_float(pa_ << 16), __uint_as_float(pa_ & 0xffff0000u), __uint_as_float(pb_ << 16), __uint_as_float(pb_ & 0xffff0000u)};
                  const f32x4 qv = pqz ? (f32x4){0.f, 0.f, 0.f, 0.f} : (f32x4){__uint_as_float(qa_ << 16), __uint_as_float(qa_ & 0xffff0000u), __uint_as_float(qb_ << 16), __uint_as_float(qb_ & 0xffff0000u)};
                  const f32x4 m4 = *LP(const f32x4, mul + 8 * e8 + 4 * e);
                  const f32x4 xm = pv + (qv - pv) * m4;
#pragma unroll
                  for (int z = 0; z < 4; ++z) x[4 * e + z] = !v0 ? 0.f : (part < 2 ? tanh_fast(xm[z]) : (part < 4 ? xm[z] : fast_sigmoid(xm[z]))); }
              *LP(v4u, dst + e8 * 16) = (v4u){cvtpk(x[0], x[1]), cvtpk(x[2], x[3]), cvtpk(x[4], x[5]), cvtpk(x[6], x[7])}; }
        }
        bf16x8 bW[2][2], bA[2][2], bG[4][2];
#pragma unroll
        for (int j = 0; j < 2; ++j) { const int n = h * 64 + 16 * (tnb + j) + i;
#pragma unroll
            for (int s = 0; s < 2; ++s) { bW[s][j] = *(const bf16x8*)(W2t + (size_t)n * 64 + 32 * s + 8 * q); bA[s][j] = *(const bf16x8*)(A2t + (size_t)n * 64 + 32 * s + 8 * q); }
#pragma unroll
            for (int s = 0; s < 4; ++s) bG[s][j] = *(const bf16x8*)(G2t + (size_t)n * 128 + 32 * s + 8 * q); }
        __syncthreads();
        f32x4 aw[2], aa[2], ag[2];
#pragma unroll
        for (int j = 0; j < 2; ++j) { aw[j] = (f32x4){0.f, 0.f, 0.f, 0.f}; aa[j] = aw[j]; ag[j] = aw[j]; }
#pragma unroll
        for (int s = 0; s < 2; ++s) {
            const bf16x8 fw = *LP(const bf16x8, lds + R1_LW + ((16 * tm + i) * 72 + 32 * s + 8 * q) * 2), fa = *LP(const bf16x8, lds + R1_LA + ((16 * tm + i) * 72 + 32 * s + 8 * q) * 2);
#pragma unroll
            for (int j = 0; j < 2; ++j) { aw[j] = mfma16(fw, bW[s][j], aw[j]); aa[j] = mfma16(fa, bA[s][j], aa[j]); }
        }
#pragma unroll
        for (int s = 0; s < 4; ++s) {
            const bf16x8 fg = *LP(const bf16x8, lds + R1_LG + ((16 * tm + i) * 136 + 32 * s + 8 * q) * 2);
#pragma unroll
            for (int j = 0; j < 2; ++j) ag[j] = mfma16(fg, bG[s][j], ag[j]);
        }
        float xr[2][4], kp[2][4], xv[2][4], lw[2][4], av[2][4], kkr[2][4];
        float ssq[4] = {0.f, 0.f, 0.f, 0.f}, bsum[4] = {0.f, 0.f, 0.f, 0.f};
#pragma unroll
        for (int j = 0; j < 2; ++j) { const int n = 16 * (tnb + j) + i;
            const float mur = cst[j][0], muk = cst[j][1], muv = cst[j][2], w0c = cst[j][3], a0c = cst[j][4], kkc = cst[j][5], kac = cst[j][6], rkc = cst[j][7];
#pragma unroll
            for (int r = 0; r < 4; ++r) { const int t = 16 * tm + 4 * q + r; const bool valid = t < tval;
                const float pr = gp[j][r][0], pk = gp[j][r][1], pv = gp[j][r][2];
                const float qr = r ? gp[j][r - 1][0] : gq[j][0], qk = r ? gp[j][r - 1][1] : gq[j][1], qv = r ? gp[j][r - 1][2] : gq[j][2];
                const float r_ = pr + (qr - pr) * mur, k_ = pk + (qk - pk) * muk, v_ = pv + (qv - pv) * muv;
                const float wpre = w0c + aw[j][r];
                const float sp = fmaxf(-wpre, 0.f) + __logf(1.0f + __expf(-fabsf(wpre)));
                const float wlog = -sp - 0.5f;
                const float a_ = fast_sigmoid(a0c + aa[j][r]);
                const float kk_ = k_ * kkc, kp_ = k_ * (1.0f + (a_ - 1.0f) * kac);
                xr[j][r] = valid ? r_ : 0.f; kp[j][r] = valid ? kp_ : 0.f; xv[j][r] = valid ? v_ : 0.f; lw[j][r] = valid ? -__expf(wlog) : 0.f; av[j][r] = valid ? a_ : 0.f; kkr[j][r] = valid ? kk_ : 0.f;
                ssq[r] += kkr[j][r] * kkr[j][r]; bsum[r] += xr[j][r] * kp[j][r] * rkc;
            }
            *(u32x2*)(GG + (size_t)it * 4096 + frag_c(n, 16 * tm + 4 * q)) = (u32x2){cvtpk(ag[j][0], ag[j][1]), cvtpk(ag[j][2], ag[j][3])}; }
#pragma unroll
        for (int r = 0; r < 4; ++r) {
#pragma unroll
            for (int o = 1; o < 16; o <<= 1) { ssq[r] += __shfl_xor(ssq[r], o); bsum[r] += __shfl_xor(bsum[r], o); }
            if (i == 0) { const int t = 16 * tm + 4 * q + r; RED[(t * 2 + (wave & 1)) * 2 + 0] = ssq[r]; RED[(t * 2 + (wave & 1)) * 2 + 1] = bsum[r]; } }
        { const int itn = it + F.G < NITEM ? it + F.G : it; nxt = item_info(itn); R1_RELANE(); load_top(nxt); }
        float cin[2][4], exq[2];
#pragma unroll
        for (int j = 0; j < 2; ++j) { cin[j][0] = lw[j][0]; cin[j][1] = cin[j][0] + lw[j][1]; cin[j][2] = cin[j][1] + lw[j][2]; cin[j][3] = cin[j][2] + lw[j][3];
            const float tot = cin[j][3]; float ex = 0.f, wt = 0.f;
#pragma unroll
            for (int qq = 0; qq < 4; ++qq) { const float tq = __shfl(tot, i + 16 * qq); wt += tq; ex += qq < q ? tq : 0.f; }
            exq[j] = ex; if (q == 0) CS[tm * 64 + 16 * (tnb + j) + i] = wt; }
        for (int z = tid; z < 2304; z += NTHR) LP(unsigned, lds + R1_MB)[z] = 0u;
        __syncthreads();
        R1_RELANE();
#pragma unroll
        for (int j = 0; j < 2; ++j) { const int n = 16 * (tnb + j) + i, col = h * 64 + n; float tmex = 0.f, csT = 0.f;
#pragma unroll
            for (int z = 0; z < 4; ++z) { const float c_ = CS[z * 64 + n]; csT += c_; tmex += z < tm ? c_ : 0.f; }
            const float gTj = __expf(csT);
            if (tm == 0 && q == 0) GTV[n] = gTj;
            f32x4 vKapT, vVT, vBbT, vKbT, vBon;
#pragma unroll
            for (int r = 0; r < 4; ++r) { const int t = 16 * tm + 4 * q + r;
                const float cst = tmex + exq[j] + cin[j][r], csp = cst - lw[j][r];
                const float sq = RED[(t * 2 + 0) * 2 + 0] + RED[(t * 2 + 1) * 2 + 0], bt = RED[(t * 2 + 0) * 2 + 1] + RED[(t * 2 + 1) * 2 + 1];
                const float kk_ = kkr[j][r] * __builtin_amdgcn_rsqf(fmaxf(sq, 1e-24f)), b_ = kk_ * av[j][r];
                const float gt = __expf(cst), gi = __builtin_amdgcn_rcpf(gt), gp = __expf(csp), ge = gTj * gi;
                LP(u16, lds + R1_RT)[t * 72 + n] = f2bf1(xr[j][r] * gt);
                LP(u16, lds + R1_KH)[t * 72 + n] = f2bf1(kp[j][r] * gi);
                LP(u16, lds + R1_BH)[t * 72 + n] = f2bf1(b_ * gi);
                LP(u16, lds + R1_KAP)[t * 72 + n] = f2bf1(kk_ * gp);
                vKapT[r] = kk_ * gp; vVT[r] = xv[j][r]; vBbT[r] = b_ * ge; vKbT[r] = kp[j][r] * ge;
                vBon[r] = bt * xv[j][r];
                asm volatile("" ::: "memory");
            }
            const int t0 = 16 * tm + 4 * q;
            *(u32x2*)(BON + (size_t)it * 4096 + frag_c(n, t0)) = (u32x2){cvtpk(vBon[0], vBon[1]), cvtpk(vBon[2], vBon[3])};
            st_tr(lds + R1_KAPT, vKapT, n, t0); st_tr(lds + R1_VT, vVT, n, t0); st_tr(lds + R1_BBT, vBbT, n, t0); st_tr(lds + R1_KBT, vKbT, n, t0);
            asm volatile("" ::: "memory");
        }
        __syncthreads();
        R1_RELANE();
        { f32x4 c1[2], c2[2];
#pragma unroll
          for (int j = 0; j < 2; ++j) { c1[j] = (f32x4){0.f, 0.f, 0.f, 0.f}; c2[j] = c1[j]; }
          mm64(c1, lds + R1_KAP, lds + R1_BH, tm, tnb, lane); mm64(c2, lds + R1_KAP, lds + R1_KH, tm, tnb, lane);
#pragma unroll
          for (int j = 0; j < 2; ++j) { const int ic = 16 * (tnb + j) + i;
#pragma unroll
              for (int r = 0; r < 4; ++r) { const int t = 16 * tm + 4 * q + r;
                  ABKF[t * 65 + ic] = ic < t ? c1[j][r] : 0.f;
                  LP(u16, lds + R1_AKK)[t * 72 + ic] = f2bf1(ic < t ? c2[j][r] : 0.f); } }
        }
        asm volatile("" ::: "memory");
        { f32x4 c3[2], c4[2];
#pragma unroll
          for (int j = 0; j < 2; ++j) { c3[j] = (f32x4){0.f, 0.f, 0.f, 0.f}; c4[j] = c3[j]; }
          mm64(c3, lds + R1_RT, lds + R1_BH, tm, tnb, lane);  mm64(c4, lds + R1_RT, lds + R1_KH, tm, tnb, lane);
#pragma unroll
          for (int j = 0; j < 2; ++j) { const int ic = 16 * (tnb + j) + i;
#pragma unroll
              for (int r = 0; r < 4; ++r) { const int t = 16 * tm + 4 * q + r;
                  LP(u16, lds + R1_ABR)[t * 72 + ic] = f2bf1(ic <= t ? c3[j][r] : 0.f);
                  LP(u16, lds + R1_AKR)[t * 72 + ic] = f2bf1(ic <= t ? c4[j][r] : 0.f); } }
        }
        __syncthreads();
#ifndef R1REP4
#define R1REP4 1
#endif
#pragma unroll 1
        for (int rep4 = 0; rep4 < R1REP4; ++rep4) {
        R1_RELANE();
        if (wave == 0) { const int g = q, c = i; float m[16];
#pragma unroll
            for (int ii = 0; ii < 16; ++ii) { float acc = ii == c ? 1.f : 0.f;
#pragma unroll
                for (int jj = 0; jj < ii; ++jj) acc -= ABKF[(16 * g + ii) * 65 + 16 * g + jj] * m[jj];
                m[ii] = acc; MF[(16 * g + ii) * 65 + 16 * g + c] = acc; LP(u16, lds + R1_MB)[(16 * g + ii) * 72 + 16 * g + c] = (u16)f2bf(acc); } }
        __syncthreads();
#define BLK(P, bi, bj) ((P) + (16 * (bi)) * 65 + 16 * (bj))
#define PUTM(bi, bj, acc) do { _Pragma("unroll") for (int r = 0; r < 4; ++r) { MF[(16 * (bi) + 4 * q + r) * 65 + 16 * (bj) + i] = -(acc)[r]; LP(u16, lds + R1_MB)[(16 * (bi) + 4 * q + r) * 72 + 16 * (bj) + i] = (u16)f2bf(-(acc)[r]); } } while (0)
        { LAS float* T = LP(float, lds + R1_T16) + wave * 272; const f32x4 z4 = {0.f, 0.f, 0.f, 0.f};
          if (wave < 3) { const int bi = wave + 1, bj = wave; f32x4 t = prod16(z4, BLK(ABKF, bi, bj), 65, BLK(MF, bj, bj), 65, lane);
#pragma unroll
              for (int r = 0; r < 4; ++r) T[(4 * q + r) * 17 + i] = t[r];
              f32x4 mres = prod16(z4, BLK(MF, bi, bi), 65, T, 17, lane); PUTM(bi, bj, mres); }
          __syncthreads();
          if (wave < 2) { const int bi = wave + 2, bj = wave; f32x4 t = prod16(z4, BLK(ABKF, bi, bj), 65, BLK(MF, bj, bj), 65, lane); t = prod16(t, BLK(ABKF, bi, bj + 1), 65, BLK(MF, bj + 1, bj), 65, lane);
#pragma unroll
              for (int r = 0; r < 4; ++r) T[(4 * q + r) * 17 + i] = t[r];
              f32x4 mres = prod16(z4, BLK(MF, bi, bi), 65, T, 17, lane); PUTM(bi, bj, mres); }
          __syncthreads();
          if (wave == 0) { f32x4 t = prod16(z4, BLK(ABKF, 3, 0), 65, BLK(MF, 0, 0), 65, lane); t = prod16(t, BLK(ABKF, 3, 1), 65, BLK(MF, 1, 0), 65, lane); t = prod16(t, BLK(ABKF, 3, 2), 65, BLK(MF, 2, 0), 65, lane);
#pragma unroll
              for (int r = 0; r < 4; ++r) T[(4 * q + r) * 17 + i] = t[r];
              f32x4 mres = prod16(z4, BLK(MF, 3, 3), 65, T, 17, lane); PUTM(3, 0, mres); }
          __syncthreads();
        }
#undef BLK
#undef PUTM
        }
        R1_RELANE();
        {
            const int sl = wave & 3, nb = 16 * sl + i;
            auto afrag = [&](int arr, int rt, int st) -> bf16x8 { return *LP(const bf16x8, lds + arr + ((16 * rt + i) * 72 + 32 * st + 8 * q) * 2); };
            auto afragp = [&](int arr, int rt, int st) -> bf16x8 { const u32x2 a0 = *LP(const u32x2, lds + arr + ((16 * rt + i) * 72 + 32 * st + 4 * q) * 2), a1 = *LP(const u32x2, lds + arr + ((16 * rt + i) * 72 + 32 * st + 16 + 4 * q) * 2);
                                                                  return __builtin_bit_cast(bf16x8, (v4u){a0.x, a0.y, a1.x, a1.y}); };
            auto packb = [&](const f32x4& lo, const f32x4& hi2) -> bf16x8 { return __builtin_bit_cast(bf16x8, (v4u){cvtpk(lo[0], lo[1]), cvtpk(lo[2], lo[3]), cvtpk(hi2[0], hi2[1]), cvtpk(hi2[2], hi2[3])}); };
            const f32x4 z4 = {0.f, 0.f, 0.f, 0.f};
            if (wave < 4) {
                bf16x8 vfr[2];
#pragma unroll
                for (int st = 0; st < 2; ++st) vfr[st] = *LP(const bf16x8, lds + R1_VT + (nb * 72 + 32 * st + 8 * q) * 2);
                f32x4 g[4], u[4];
#pragma unroll
                for (int rt = 0; rt < 4; ++rt) { g[rt] = mfma16(afrag(R1_AKK, rt, 0), vfr[0], z4); g[rt] = mfma16(afrag(R1_AKK, rt, 1), vfr[1], g[rt]); }
                bf16x8 gb[2] = {packb(g[0], g[1]), packb(g[2], g[3])};
#pragma unroll
                for (int rt = 0; rt < 4; ++rt) { u[rt] = mfma16(afragp(R1_MB, rt, 0), gb[0], z4); u[rt] = mfma16(afragp(R1_MB, rt, 1), gb[1], u[rt]); }
                bf16x8 ub[2] = {packb(u[0], u[1]), packb(u[2], u[3])};
                bf16* OT = (bf16*)(ws + WS_OT) + (size_t)it * 4096; float* HT = (float*)(ws + WS_HT) + (size_t)it * 4096;
#pragma unroll
                for (int rt = 0; rt < 4; ++rt) {
                    f32x4 o1 = mfma16(afrag(R1_AKR, rt, 0), vfr[0], z4); o1 = mfma16(afrag(R1_AKR, rt, 1), vfr[1], o1);
                    f32x4 o2 = mfma16(afragp(R1_ABR, rt, 0), ub[0], z4); o2 = mfma16(afragp(R1_ABR, rt, 1), ub[1], o2);
                    { const f32x4 od = o1 - o2; *(u32x2*)(OT + ((sl * 4 + rt) * 64 + lane) * 4) = (u32x2){cvtpk(od[0], od[1]), cvtpk(od[2], od[3])}; }
                    f32x4 h1 = mfma16(afrag(R1_KBT, rt, 0), vfr[0], z4); h1 = mfma16(afrag(R1_KBT, rt, 1), vfr[1], h1);
                    f32x4 h2 = mfma16(afragp(R1_BBT, rt, 0), ub[0], z4); h2 = mfma16(afragp(R1_BBT, rt, 1), ub[1], h2);
                    *(f32x4*)(HT + ((sl * 4 + rt) * 64 + lane) * 4) = h1 - h2;
                }
            } else {
                bf16x8 kfr[2];
#pragma unroll
                for (int st = 0; st < 2; ++st) kfr[st] = *LP(const bf16x8, lds + R1_KAPT + (nb * 72 + 32 * st + 8 * q) * 2);
                f32x4 w[4];
#pragma unroll
                for (int rt = 0; rt < 4; ++rt) { w[rt] = mfma16(afrag(R1_MB, rt, 0), kfr[0], z4); w[rt] = mfma16(afrag(R1_MB, rt, 1), kfr[1], w[rt]); }
                bf16x8 wb[2] = {packb(w[0], w[1]), packb(w[2], w[3])};
                LAS u16* QTs = LP(u16, lds + R1_KH); LAS u16* PTs = LP(u16, lds + R1_BH);
                const float gtv = GTV[nb];
#pragma unroll
                for (int rt = 0; rt < 4; ++rt) {
                    f32x4 cq = mfma16(afragp(R1_ABR, rt, 0), wb[0], z4); cq = mfma16(afragp(R1_ABR, rt, 1), wb[1], cq);
                    f32x4 cp = mfma16(afragp(R1_BBT, rt, 0), wb[0], z4); cp = mfma16(afragp(R1_BBT, rt, 1), wb[1], cp);
#pragma unroll
                    for (int r = 0; r < 4; ++r) { const int t = 16 * rt + 4 * q + r;
                        QTs[frag_a(t, nb)] = f2bf1(bf2f(LP(u16, lds + R1_RT)[t * 72 + nb]) - cq[r]);
                        PTs[frag_a(t, nb)] = f2bf1((t == nb ? gtv : 0.f) - cp[r]); }
                }
            }
        }
        cur = nxt;
        __syncthreads();
        { R1_RELANE();
          v4u* QTg = (v4u*)((bf16*)(ws + WS_QT) + (size_t)it * 4096); v4u* PTg = (v4u*)((bf16*)(ws + WS_PT) + (size_t)it * 4096);
          QTg[tid] = *LP(const v4u, lds + R1_KH + tid * 16); PTg[tid] = *LP(const v4u, lds + R1_BH + tid * 16); }
    }
}

struct R2St { bf16x8 pa[4][2]; f32x4 hh[4]; };
__device__ __forceinline__ void r2_load(R2St& o, const unsigned char* ws, int it, int lane, int vs) {
    const bf16* PT = (const bf16*)(ws + WS_PT) + (size_t)it * 4096; const float* HT = (const float*)(ws + WS_HT) + (size_t)it * 4096;
#pragma unroll
    for (int tt = 0; tt < 4; ++tt) {
#pragma unroll
        for (int s = 0; s < 2; ++s) o.pa[tt][s] = *(const bf16x8*)(PT + ((tt * 2 + s) * 64 + lane) * 8);
        o.hh[tt] = *(const f32x4*)(HT + ((vs * 4 + tt) * 64 + lane) * 4);
    }
}
__device__ __forceinline__ void r2_step(const R2St& r, f32x4 (&S)[4], unsigned char* ws, int it, int vs, int lane) {
    bf16x8 bs[2];
#pragma unroll
    for (int s = 0; s < 2; ++s) { v4u w; w.x = cvtpk(S[2 * s][0], S[2 * s][1]); w.y = cvtpk(S[2 * s][2], S[2 * s][3]); w.z = cvtpk(S[2 * s + 1][0], S[2 * s + 1][1]); w.w = cvtpk(S[2 * s + 1][2], S[2 * s + 1][3]); bs[s] = __builtin_bit_cast(bf16x8, w);
        *(v4u*)(ws + WS_SC + (size_t)it * 8192 + (size_t)((vs * 2 + s) * 64 + lane) * 16) = w; }
#pragma unroll
    for (int kt = 0; kt < 4; ++kt) { f32x4 acc = r.hh[kt];
#pragma unroll
        for (int s = 0; s < 2; ++s) acc = mfma16(r.pa[kt][s], bs[s], acc);
        S[kt] = acc; }
}
__device__ __forceinline__ void ph_rwkv2(const Frame& F0, const Args& a, int l) {
    const Frame F = relaunder(F0);
    unsigned char* ws = a.ws;
    const int lane = F.lane, i = lane & 15, q = lane >> 4;
    for (int slot = F.vcu * NWAVES + F.wave; slot < 2048; slot += F.G * NWAVES) {
        int nchunk, item0, h, vs; float* sout; f32x4 S[4];
        if ((slot & 15) == 0) { const int pu = slot >> 4; const int s = pu >> 5; h = (pu >> 2) & 7; vs = pu & 3; nchunk = SEQ / 64; item0 = s * 1024 + h;
            sout = a.out + OFF_WKVP + ((size_t)(l * NB + s) * HB + h) * 4096;
#pragma unroll
            for (int kt = 0; kt < 4; ++kt) S[kt] = (f32x4){0.f, 0.f, 0.f, 0.f}; }
        else { const int d = slot - (slot >> 4) - 1; if (d >= DECB * HB * 4) continue; const int b = d >> 5; h = (d >> 2) & 7; vs = d & 3; nchunk = 1; item0 = NITEM_P + b * 8 + h;
            sout = a.out + OFF_WKVS + ((size_t)(l * DECB + b) * HB + h) * 4096;
            const float* sin = a.in[I_SWKV] + ((size_t)(l * DECB + b) * HB + h) * 4096 + (16 * vs + i) * 64 + 4 * q;
#pragma unroll
            for (int kt = 0; kt < 4; ++kt) S[kt] = *(const f32x4*)(sin + 16 * kt); }
        const int v = 16 * vs + i;
        const int itl = item0 + 8 * (nchunk - 1);
        R2St r0, r1, r2;
        r2_load(r0, ws, item0, lane, vs);
        r2_load(r1, ws, min(item0 + 8, itl), lane, vs);
        r2_load(r2, ws, min(item0 + 16, itl), lane, vs);
        int c = 0;
#pragma unroll 1
        for (; c + 3 <= nchunk; c += 3) {
            const int it = item0 + 8 * c;
            r2_step(r0, S, ws, it, vs, lane);      r2_load(r0, ws, min(it + 24, itl), lane, vs);
            r2_step(r1, S, ws, it + 8, vs, lane);  r2_load(r1, ws, min(it + 32, itl), lane, vs);
            r2_step(r2, S, ws, it + 16, vs, lane); r2_load(r2, ws, min(it + 40, itl), lane, vs);
        }
        if (c < nchunk) { r2_step(r0, S, ws, item0 + 8 * c, vs, lane); ++c; }
        if (c < nchunk) { r2_step(r1, S, ws, item0 + 8 * c, vs, lane); ++c; }
#pragma unroll
        for (int kt = 0; kt < 4; ++kt) *(f32x4*)(sout + (size_t)v * 64 + 16 * kt + 4 * q) = S[kt];
    }
}
__device__ __forceinline__ void ph_rwkv3(const Frame& F0, const Args& a, int l) {
    const Frame F = relaunder(F0);
    const unsigned char* ws = a.ws;
    bf16* YB = (bf16*)(a.ws + WS_YAB) + (size_t)M * 512; const float* lg = a.in[I_LNXG] + l * 512; const float* lb = a.in[I_LNXB] + l * 512;
    const int lane = F.lane, i = lane & 15, q = lane >> 4;
    LAS unsigned char* st = F.lds + F.wave * 9216;
    for (int it = F.vcu * NWAVES + F.wave; it < NITEM; it += F.G * NWAVES) {
        const bool dec = it >= NITEM_P; int h, row0, ntt;
        if (!dec) { const int s = it >> 10, c = (it >> 3) & 127; h = it & 7; row0 = s * SEQ + 64 * c; ntt = 4; }
        else { const int b = (it - NITEM_P) >> 3; h = it & 7; row0 = MP + DECS * b; ntt = 2; }
        const bf16* QT = (const bf16*)(ws + WS_QT) + (size_t)it * 4096; const bf16* OT = (const bf16*)(ws + WS_OT) + (size_t)it * 4096;
        const bf16* GG = (const bf16*)(ws + WS_GG) + (size_t)it * 4096; const bf16* BON = (const bf16*)(ws + WS_BON) + (size_t)it * 4096;
        auto ld4 = [](const bf16* p) -> f32x4 { const u32x2 w = *(const u32x2*)p; return (f32x4){__uint_as_float(w.x << 16), __uint_as_float(w.x & 0xffff0000u), __uint_as_float(w.y << 16), __uint_as_float(w.y & 0xffff0000u)}; };
        bf16x8 bfr[4][2];
#pragma unroll
        for (int vs = 0; vs < 4; ++vs)
#pragma unroll
            for (int s = 0; s < 2; ++s) bfr[vs][s] = *(const bf16x8*)(ws + WS_SC + (size_t)it * 8192 + (size_t)((vs * 2 + s) * 64 + lane) * 16);
        float lgv[4], lbv[4];
#pragma unroll
        for (int vs = 0; vs < 4; ++vs) { lgv[vs] = lg[h * 64 + 16 * vs + i]; lbv[vs] = lb[h * 64 + 16 * vs + i]; }
#pragma unroll
        for (int tt = 0; tt < 4; ++tt) if (tt < ntt) {
            bf16x8 af[2];
#pragma unroll
            for (int s = 0; s < 2; ++s) af[s] = *(const bf16x8*)(QT + ((tt * 2 + s) * 64 + lane) * 8);
            f32x4 acc[4];
#pragma unroll
            for (int vs = 0; vs < 4; ++vs) { acc[vs] = ld4(OT + ((vs * 4 + tt) * 64 + lane) * 4); acc[vs] = mfma16(af[0], bfr[vs][0], acc[vs]); acc[vs] = mfma16(af[1], bfr[vs][1], acc[vs]); }
            f32x4 sm = (acc[0] + acc[1]) + (acc[2] + acc[3]);
#pragma unroll
            for (int o = 1; o < 16; o <<= 1) { sm[0] += __shfl_xor(sm[0], o); sm[1] += __shfl_xor(sm[1], o); sm[2] += __shfl_xor(sm[2], o); sm[3] += __shfl_xor(sm[3], o); }
            const f32x4 mean = sm * (1.f / 64.f);
            f32x4 s2 = {0.f, 0.f, 0.f, 0.f};
#pragma unroll
            for (int vs = 0; vs < 4; ++vs) { acc[vs] = acc[vs] - mean; s2 += acc[vs] * acc[vs]; }
#pragma unroll
            for (int o = 1; o < 16; o <<= 1) { s2[0] += __shfl_xor(s2[0], o); s2[1] += __shfl_xor(s2[1], o); s2[2] += __shfl_xor(s2[2], o); s2[3] += __shfl_xor(s2[3], o); }
            f32x4 rstd;
#pragma unroll
            for (int r = 0; r < 4; ++r) rstd[r] = 1.0f / sqrtf(s2[r] * (1.f / 64.f) + GN_EPS);
#pragma unroll
            for (int vs = 0; vs < 4; ++vs) { const int v = 16 * vs + i;
                const f32x4 bn = ld4(BON + ((vs * 4 + tt) * 64 + lane) * 4), gg = ld4(GG + ((vs * 4 + tt) * 64 + lane) * 4);
                const f32x4 y = (acc[vs] * rstd * lgv[vs] + lbv[vs] + bn) * gg;
#pragma unroll
                for (int r = 0; r < 4; ++r) LP(u16, st)[(16 * tt + 4 * q + r) * 72 + v] = (u16)f2bf(y[r]); }
        }
#pragma unroll
        for (int rr = 0; rr < 8; ++rr) { const int trow = rr * 8 + (lane >> 3), c8 = lane & 7;
            if (trow < 16 * ntt) *(v4u*)(YB + (size_t)(row0 + trow) * 512 + h * 64 + 8 * c8) = *LP(const v4u, st + (trow * 72 + 8 * c8) * 2); }
    }
}
constexpr int NPH_LAYER = 13, NPH = 2 + DEPTH * NPH_LAYER;
#ifndef MK_LAUNCH_PER_PHASE
#define MK_LAUNCH_PER_PHASE 0
#endif
typedef const __attribute__((address_space(4))) Args* KArgsPtr;
__device__ __forceinline__ const Args& kargs() { KArgsPtr p = (KArgsPtr)__builtin_amdgcn_kernarg_segment_ptr(); asm volatile("" : "+s"(p)); return *(const Args*)p; }
template <unsigned PHMASK> __global__ void __launch_bounds__(NTHR, 2) fwd(Args args_unused) {
    extern __shared__ __attribute__((aligned(16))) unsigned char lds_raw[];
    Frame F;
    F.lds = (LAS unsigned char*)lds_raw;
    F.tid = 0; F.lane = 0; F.wave = __builtin_amdgcn_readfirstlane((int)threadIdx.x >> 6);
    F.G = gridDim.x; { const int bx = blockIdx.x; F.vcu = (F.G % 8 == 0) ? (bx % 8) * (F.G / 8) + bx / 8 : bx; }
    volatile LAS unsigned* MISC = (volatile LAS unsigned*)(F.lds + LDSCTL_OFF);
    for (int u = threadIdx.x; u < (LDS_BYTES - LDSCTL_OFF) / 4; u += NTHR) ((LAS unsigned*)(F.lds + LDSCTL_OFF))[u] = 0u;
    __syncthreads();
    int lo, hi; { const Args& a = kargs(); lo = a.ph_lo; hi = a.ph_hi; }
    XcdBarrier bar; { const Args& a = kargs(); bar.bar = (unsigned*)(a.ws + WS_CTL) + CW_BAR; } bar.x = 0; bar.st = nullptr;
    if (hi - lo > 1) bar = xcd_barrier_post(bar.bar, MISC + 8);
    bar.wave = F.wave;
#define IN(k) (lo <= (k) && (k) < hi)
#define ON(n, k) (((PHMASK >> (n)) & 1u) && IN(k))
#define SEAM(k) do { if (IN(k) && IN((k) + 1)) xcd_barrier(bar); } while (0)
#define WSP(T, off) ((T*)(a.ws + (off)))
#ifndef REP_MASK
#define REP_MASK 0u
#endif
#define REPS(n) ((((REP_MASK) >> (n)) & 1u) ? 2 : 1)
    if (ON(13, 0)) { const Args& a = kargs(); ph_prologue(F, a); } SEAM(0);
    if (ON(14, 1)) { const Args& a = kargs(); ph_ln(F, a.in[I_XP], a.in[I_XS], nullptr, 0.f, nullptr, nullptr, nullptr, WSP(float, WS_MOD), nullptr, WSP(bf16, WS_U)); } SEAM(1);
#pragma unroll 1
    for (int l = 0; l < DEPTH; ++l) {
        const int pb = 2 + l * NPH_LAYER;
        const size_t wlo = WS_W + (size_t)l * WL_SIZE, modo = WS_MOD + (size_t)l * NSEQ * 9216 * 4;
        for (int rep_ = 0; rep_ < REPS(0); ++rep_) if (ON(0, pb + 0)) { if (rep_) xcd_barrier(bar); const Args& a = kargs(); pg8::Gemm g{WSP(bf16, WS_U), WSP(const bf16, wlo + WL_GU0), M, NGU, D}; pg8::StaticOrder S; S.init(M, NGU, opq(F.G), opq((int)blockIdx.x)); pg8::EpiSwiglu E{WSP(bf16, WS_ACT), DFF};
            pg8::gemm_phase<pg8::EpiSwiglu, pg8::StaticOrder, true, true>(F.lds, g, S, E, opq(F.wave)); } SEAM(pb + 0);
        for (int rep_ = 0; rep_ < REPS(1); ++rep_) if (ON(1, pb + 1)) { if (rep_) xcd_barrier(bar); const Args& a = kargs(); pg8::Gemm g{WSP(bf16, WS_ACT), WSP(const bf16, wlo + WL_DN0), M, D, DFF}; pg8::SplitOrder S; S.init(MP, D, opq(F.G), opq((int)blockIdx.x), DFF / 256); pg8::EpiF32S E{WSP(bf16, WS_F), WSP(float, WS_FP), D, MP, MD};
            pg8::gemm_phase<pg8::EpiF32S, pg8::SplitOrder, true, true>(F.lds, g, S, E, opq(F.wave)); } SEAM(pb + 1);
        for (int rep_ = 0; rep_ < REPS(2); ++rep_) if (ON(2, pb + 2)) { if (rep_) xcd_barrier(bar); const Args& a = kargs(); const float* modl = WSP(float, modo);
            ph_ln(F, l == 0 ? a.in[I_XP] : a.out, l == 0 ? a.in[I_XS] : nullptr, WSP(bf16, WS_F), 0.5f, modl + 2 * D, a.in[I_LNG] + (l * 3 + 0) * D, a.in[I_LNB] + (l * 3 + 0) * D, modl + 3 * D, a.out, WSP(bf16, WS_U), WSP(float, WS_FP), DFF / 256); } SEAM(pb + 2);
        for (int rep_ = 0; rep_ < REPS(3); ++rep_) if (ON(3, pb + 3)) { if (rep_) xcd_barrier(bar); const Args& a = kargs(); pg8::Gemm g{WSP(bf16, WS_U), WSP(const bf16, wlo + WL_IG), M, NIG, D}; pg8::StaticOrder S; S.init(M, NIG, opq(F.G), opq((int)blockIdx.x));
            pg8::EpiProj E{WSP(bf16, WS_Q), WSP(bf16, WS_KB), WSP(bf16, WS_VB), WSP(float, WS_PRW), WSP(bf16, WS_PLB), WSP(bf16, WS_GATES), a.in[I_BGATE] + l * 2048,
                a.out + OFF_KP + (size_t)l * MP * 512, a.out + OFF_VP + (size_t)l * MP * 512, a.out + OFF_KS + (size_t)l * MD * 512, a.out + OFF_VS + (size_t)l * MD * 512,
                a.out + OFF_SHP + (size_t)l * NB * NRW, a.out + OFF_SHS + (size_t)l * DECB * NRW, QSCALE};
            pg8::gemm_phase<pg8::EpiProj, pg8::StaticOrder, true, true>(F.lds, g, S, E, opq(F.wave)); } SEAM(pb + 3);
        for (int rep_ = 0; rep_ < REPS(4); ++rep_) if (ON(4, pb + 4)) { if (rep_) xcd_barrier(bar); const Args& a = kargs(); ph_rwkv1(F, a, l); } SEAM(pb + 4);
        if (ON(5, pb + 5)) { const Args& a = kargs(); ph_rwkv2(F, a, l); }
        if (ON(5, pb + 5)) { const Args& a = kargs();
            AttnP P{WSP(bf16, WS_Q), WSP(bf16, WS_KB), WSP(bf16, WS_VB), a.in[I_CK] + (size_t)l * DECB * PAST * 512, a.in[I_CV] + (size_t)l * DECB * PAST * 512, WSP(bf16, WS_YAB), a.in[I_RELB], a.in[I_SUBG] + l * 128,
                    WSP(float, WS_LAM)[l], 1.0f - (0.8f - 0.6f * expf(-0.3f * (float)l))};
            ph_attn(F, P, (unsigned*)(a.ws + WS_CTL) + CW_QUEUE + 64 * l); } SEAM(pb + 5);
        for (int rep_ = 0; rep_ < REPS(6); ++rep_) if (ON(6, pb + 6)) { if (rep_) xcd_barrier(bar); const Args& a = kargs(); ph_rwkv3(F, a, l); } SEAM(pb + 6);
        for (int rep_ = 0; rep_ < REPS(7); ++rep_) if (ON(7, pb + 7)) { if (rep_) xcd_barrier(bar); const Args& a = kargs(); pg8::Gemm g{WSP(bf16, WS_YAB), WSP(const bf16, wlo + WL_BR), 2 * M, 2048, 512}; pg8::PairOrder S{NPAN * 4, opq(F.G), opq((int)blockIdx.x), NPAN}; pg8::EpiMerge E{WSP(bf16, WS_MERGED), WSP(bf16, WS_GATES), NPAN};
            pg8::gemm_phase<pg8::EpiMerge, pg8::PairOrder, true, true>(F.lds, g, S, E, opq(F.wave)); } SEAM(pb + 7);
        for (int rep_ = 0; rep_ < REPS(8); ++rep_) if (ON(8, pb + 8)) { if (rep_) xcd_barrier(bar); const Args& a = kargs(); pg8::Gemm g{WSP(bf16, WS_MERGED), WSP(const bf16, wlo + WL_O), M, D, D}; pg8::SplitOrder S; S.init(MP, D, opq(F.G), opq((int)blockIdx.x), D / 256); pg8::EpiF32S E{WSP(bf16, WS_F), WSP(float, WS_FP), D, MP, MD};
            pg8::gemm_phase<pg8::EpiF32S, pg8::SplitOrder, true, true>(F.lds, g, S, E, opq(F.wave)); } SEAM(pb + 8);
        for (int rep_ = 0; rep_ < REPS(9); ++rep_) if (ON(9, pb + 9)) { if (rep_) xcd_barrier(bar); const Args& a = kargs(); const float* modl = WSP(float, modo);
            ph_ln(F, a.out, nullptr, WSP(bf16, WS_F), 1.0f, modl + 5 * D, a.in[I_LNG] + (l * 3 + 1) * D, a.in[I_LNB] + (l * 3 + 1) * D, modl + 6 * D, a.out, WSP(bf16, WS_U), WSP(float, WS_FP), D / 256); } SEAM(pb + 9);
        for (int rep_ = 0; rep_ < REPS(10); ++rep_) if (ON(10, pb + 10)) { if (rep_) xcd_barrier(bar); const Args& a = kargs(); pg8::Gemm g{WSP(bf16, WS_U), WSP(const bf16, wlo + WL_GU1), M, NGU, D}; pg8::StaticOrder S; S.init(M, NGU, opq(F.G), opq((int)blockIdx.x)); pg8::EpiSwiglu E{WSP(bf16, WS_ACT), DFF};
            pg8::gemm_phase<pg8::EpiSwiglu, pg8::StaticOrder, true, true>(F.lds, g, S, E, opq(F.wave)); } SEAM(pb + 10);
        for (int rep_ = 0; rep_ < REPS(11); ++rep_) if (ON(11, pb + 11)) { if (rep_) xcd_barrier(bar); const Args& a = kargs(); pg8::Gemm g{WSP(bf16, WS_ACT), WSP(const bf16, wlo + WL_DN1), M, D, DFF}; pg8::SplitOrder S; S.init(MP, D, opq(F.G), opq((int)blockIdx.x), DFF / 256); pg8::EpiF32S E{WSP(bf16, WS_F), WSP(float, WS_FP), D, MP, MD};
            pg8::gemm_phase<pg8::EpiF32S, pg8::SplitOrder, true, true>(F.lds, g, S, E, opq(F.wave)); } SEAM(pb + 11);
        for (int rep_ = 0; rep_ < REPS(12); ++rep_) if (ON(12, pb + 12)) { if (rep_) xcd_barrier(bar); const Args& a = kargs(); const float* modl = WSP(float, modo);
            ph_ln(F, a.out, nullptr, WSP(bf16, WS_F), 0.5f, modl + 8 * D, a.in[I_LNG] + (l * 3 + 2) * D, a.in[I_LNB] + (l * 3 + 2) * D, l + 1 < DEPTH ? modl + (size_t)NSEQ * 9216 : nullptr, a.out, WSP(bf16, WS_U), WSP(float, WS_FP), DFF / 256); } SEAM(pb + 12);
    }
#undef IN
#undef ON
#undef SEAM
#undef WSP
}

#if MK_LAUNCH_PER_PHASE
static const void* phase_fn(int k) {
    switch (k) { case 0: return (const void*)fwd<1u << 0>; case 1: return (const void*)fwd<1u << 1>; case 2: return (const void*)fwd<1u << 2>; case 3: return (const void*)fwd<1u << 3>;
        case 4: return (const void*)fwd<1u << 4>; case 5: return (const void*)fwd<1u << 5>; case 6: return (const void*)fwd<1u << 6>; case 7: return (const void*)fwd<1u << 7>;
        case 8: return (const void*)fwd<1u << 8>; case 9: return (const void*)fwd<1u << 9>; case 10: return (const void*)fwd<1u << 10>; case 11: return (const void*)fwd<1u << 11>;
        case 12: return (const void*)fwd<1u << 12>; case 13: return (const void*)fwd<1u << 13>; case 14: return (const void*)fwd<1u << 14>; default: return (const void*)fwd<1u << 15>; }
}
#else
#ifndef FULL_MASK
#define FULL_MASK 0xFFFFu
#endif
static const void* phase_fn(int) { return (const void*)fwd<FULL_MASK>; }
#endif

extern "C" void kernel_launch(void* const* d_in, const int* in_sizes, int n_in, void* d_out, int out_size, void* d_ws, size_t ws_size, hipStream_t stream) {
    static int grid = 0;
    if (grid == 0) {
        if (n_in != 34 || (size_t)out_size != OUT_TOTAL || ws_size < WS_END) { fprintf(stderr, "kernel_launch: unexpected shapes: n_in %d out %d ws %zu (need %zu)\n", n_in, out_size, ws_size, (size_t)WS_END); grid = -1; return; }
        int dev = 0, cus = 0, per_cu = 0;
        if (hipGetDevice(&dev) != hipSuccess || hipDeviceGetAttribute(&cus, hipDeviceAttributeMultiprocessorCount, dev) != hipSuccess) { grid = -1; return; }
        for (int k = 0; k < 16; ++k) if (hipFuncSetAttribute(phase_fn(k), hipFuncAttributeMaxDynamicSharedMemorySize, LDS_BYTES) != hipSuccess) { fprintf(stderr, "kernel_launch: hipFuncSetAttribute failed\n"); grid = -1; return; }
        if (hipOccupancyMaxActiveBlocksPerMultiprocessor(&per_cu, phase_fn(15), NTHR, LDS_BYTES) != hipSuccess || per_cu < 1) fprintf(stderr, "kernel_launch: occupancy query reports %d\n", per_cu);
        (void)hipGetLastError();
        grid = cus;
    }
    if (grid < 0) return;
    (void)hipMemsetAsync((char*)d_ws + WS_CTL, 0, CTL_ZERO_BYTES, stream);
    Args a{};
    for (int i = 0; i < 34; ++i) a.in[i] = (const float*)d_in[i];
    a.out = (float*)d_out; a.ws = (unsigned char*)d_ws;
#if MK_LAUNCH_PER_PHASE
#ifndef MAXPH
#define MAXPH NPH
#endif
    for (int p = 0; p < MAXPH; ++p) { a.ph_lo = p; a.ph_hi = p + 1; const int kind = p < 2 ? 13 + p : (p - 2) % NPH_LAYER; void* kargs[] = {&a}; (void)hipLaunchKernel(phase_fn(kind), dim3(grid), dim3(NTHR), kargs, LDS_BYTES, stream); }
#else
    a.ph_lo = 0; a.ph_hi = NPH; { void* kargs[] = {&a}; (void)hipLaunchKernel(phase_fn(15), dim3(grid), dim3(NTHR), kargs, LDS_BYTES, stream); }
#endif
}
```

```cpp
#include <hip/hip_runtime.h>
#include <hip/hip_bf16.h>
#include <cstdio>
#include <cstdint>
#include <cmath>
namespace pg8 {
#define PG8_LAS __attribute__((address_space(3)))
typedef unsigned short bf16_t;
typedef short bf16x8 __attribute__((ext_vector_type(8)));
typedef float f32x4 __attribute__((ext_vector_type(4)));
typedef unsigned u32x4 __attribute__((ext_vector_type(4)));
constexpr int BM = 256, BK = 64, HALF = 128, HTB = HALF * BK * 2  , STAGE_BYTES = 8 * HTB, NXCD = 8, WGM = 8;

__host__ __device__ __forceinline__ int lds_byte(int r, int c) { const int st = (r >> 4) * 2 + (c >> 5), rr = r & 15, cc = c & 31, ob = rr * 64 + cc * 2; return st * 1024 + (ob ^ (((ob >> 9) & 1) << 5)); }
__host__ __device__ __forceinline__ void stage_rc(int b, int& R, int& C) { const int st = b / 1024, sb = b % 1024, swz = sb ^ (((sb >> 9) & 1) << 5); R = (st >> 1) * 16 + swz / 64; C = (st & 1) * 32 + (swz % 64) / 2; }
__host__ __device__ __forceinline__ int perm32(int rho) { const int n = rho >> 4, i = rho & 15; return 8 * (i >> 2) + 4 * n + (i & 3); }

struct Unit { int pm, pn, k0, ntk, ks; };
struct Gemm { const bf16_t* A; const bf16_t* Bt; int M, N, K; };

struct StaticOrder {
    int nM, nN, nwg, G, c;
    __host__ __device__ void init(int M, int N, int G_, int c_) { nM = M / BM; nN = N / BM; nwg = nM * nN; G = G_; c = c_; }
    __host__ __device__ bool next(int i, Unit& u) const {
        const long L = (long)i * G + c; if (L >= nwg) return false;
        int wgid = (int)L; { const int q = nwg / NXCD, r = nwg % NXCD, xcd = wgid % NXCD, off = wgid / NXCD; wgid = (xcd < r ? xcd * (q + 1) : r * (q + 1) + (xcd - r) * q) + off; }
        const int nig = WGM * nN, gid = wgid / nig, fm = gid * WGM, gsz = (nM - fm) < WGM ? (nM - fm) : WGM;
        u.pm = fm + ((wgid % nig) % gsz); u.pn = (wgid % nig) / gsz; u.k0 = 0; u.ntk = 0; u.ks = -1; return true;
    }
    __device__ __forceinline__ void a_ready(const Unit&) const {}
    __device__ __forceinline__ void done(const Unit&) const {}
};

typedef float f32x2c_t __attribute__((ext_vector_type(2))); typedef __bf16 bf16x2c_t __attribute__((ext_vector_type(2)));
__device__ __forceinline__ unsigned cvt_pk_bf16(float lo, float hi) { f32x2c_t v = {lo, hi}; bf16x2c_t b = __builtin_convertvector(v, bf16x2c_t); return __builtin_bit_cast(unsigned, b); }
typedef float f32x2 __attribute__((ext_vector_type(2)));
__device__ __forceinline__ float fast_sigmoid(float x) { return __builtin_amdgcn_rcpf(1.0f + __expf(-x)); }
struct EpiSwiglu {
    static constexpr bool PERM = true, AFTER_DRAIN = false, KEEPS = false;
    bf16_t* O; int ldc;
    __device__ __forceinline__ void operator()(const f32x4 (&acc)[2][2][4][2], const Unit& u, int wr, int wc, int fr, int fq) const {
        const int row0 = u.pm * BM + wr * 64 + fr; const int col0 = u.pn * 128 + wc * 32 + 8 * fq;
#pragma unroll
        for (int ai = 0; ai < 2; ++ai)
#pragma unroll
            for (int m = 0; m < 4; ++m) { bf16_t* rowp = O + (size_t)(row0 + ai * HALF + m * 16) * ldc + col0;
                float v[8];
#pragma unroll
                for (int n = 0; n < 2; ++n)
#pragma unroll
                    for (int e = 0; e < 4; ++e) { const float g = acc[ai][0][m][n][e], up = acc[ai][1][m][n][e]; v[n * 4 + e] = g * fast_sigmoid(g) * up; }
                u32x4 w; w.x = cvt_pk_bf16(v[0], v[1]); w.y = cvt_pk_bf16(v[2], v[3]); w.z = cvt_pk_bf16(v[4], v[5]); w.w = cvt_pk_bf16(v[6], v[7]);
                *(u32x4*)rowp = w; }
    }
};
struct EpiF32 {
    static constexpr bool PERM = false, AFTER_DRAIN = false, KEEPS = false;
    float* O; int ldc;
    __device__ __forceinline__ void operator()(const f32x4 (&acc)[2][2][4][2], const Unit& u, int wr, int wc, int fr, int fq) const {
        const int row0 = u.pm * BM + wr * 64 + fr; const int col0 = u.pn * BM + wc * 32 + 4 * fq;
#pragma unroll
        for (int ai = 0; ai < 2; ++ai)
#pragma unroll
            for (int m = 0; m < 4; ++m) { float* rowp = O + (size_t)(row0 + ai * HALF + m * 16) * ldc + col0;
#pragma unroll
                for (int bj = 0; bj < 2; ++bj)
#pragma unroll
                    for (int n = 0; n < 2; ++n) *(f32x4*)(rowp + bj * HALF + n * 16) = acc[ai][bj][m][n]; }
    }
};
struct EpiProj {
    static constexpr bool PERM = true, AFTER_DRAIN = false, KEEPS = false;
    bf16_t* Q; bf16_t* Kb; bf16_t* Vb; bf16_t* PRW; bf16_t* GATES; const float* bgate;
    float* outKp; float* outVp; float* outKs; float* outVs; float* outShp; float* outShs;
    float qscale;
    __device__ __forceinline__ void operator()(const f32x4 (&acc)[2][2][4][2], const Unit& u, int wr, int wc, int fr, int fq) const {
        const int row0 = u.pm * BM + wr * 64 + fr; const int pn = u.pn; const int cw = wc * 32 + 8 * fq;
        const bool prompt = u.pm < 128;
        auto pack8 = [](const f32x4& a, const f32x4& b) -> u32x4 { u32x4 w; w.x = cvt_pk_bf16(a[0], a[1]); w.y = cvt_pk_bf16(a[2], a[3]); w.z = cvt_pk_bf16(b[0], b[1]); w.w = cvt_pk_bf16(b[2], b[3]); return w; };
#pragma unroll
        for (int ai = 0; ai < 2; ++ai)
#pragma unroll
            for (int m = 0; m < 4; ++m) { const int row = row0 + ai * HALF + m * 16;
#pragma unroll
                for (int bj = 0; bj < 2; ++bj) { const f32x4 v0 = acc[ai][bj][m][0], v1 = acc[ai][bj][m][1]; const int ct = bj * HALF + cw;
                    if (pn < 2) { const int c = pn * 256 + ct; *(u32x4*)(Q + (size_t)row * 512 + c) = pack8(v0 * qscale, v1 * qscale); }
                    else if (pn < 6) { const bool isk = pn < 4; const int c = (pn - (isk ? 2 : 4)) * 256 + ct;
                        *(u32x4*)((isk ? Kb : Vb) + (size_t)row * 512 + c) = pack8(v0, v1);
                        float* o = prompt ? (isk ? outKp : outVp) + (size_t)row * 512 + c : (isk ? outKs : outVs) + (size_t)(row - 32768) * 512 + c;
                        __builtin_nontemporal_store(v0, (f32x4*)o); __builtin_nontemporal_store(v1, (f32x4*)(o + 4)); }
                    else if (pn < 13) { const int c = (pn - 6) * 256 + ct; *(u32x4*)(PRW + (size_t)row * 1792 + c) = pack8(v0, v1);
                        if (prompt) { if ((row & 8191) == 8191) { float* so = outShp + (size_t)(row >> 13) * 1792 + c; *(f32x4*)so = v0; *(f32x4*)(so + 4) = v1; } }
                        else { const int rd = row - 32768; if ((rd & 31) == 31) { float* so = outShs + (size_t)(rd >> 5) * 1792 + c; *(f32x4*)so = v0; *(f32x4*)(so + 4) = v1; } } }
                    else { const int c = (pn - 13) * 256 + ct; const f32x4 b0 = *(const f32x4*)(bgate + c), b1 = *(const f32x4*)(bgate + c + 4);
                        f32x4 s0, s1;
#pragma unroll
                        for (int e = 0; e < 4; ++e) { s0[e] = fast_sigmoid(v0[e] + b0[e]); s1[e] = fast_sigmoid(v1[e] + b1[e]); }
                        *(u32x4*)(GATES + (size_t)row * 2048 + c) = pack8(s0, s1); }
                } }
    }
};
struct EpiMerge {
    static constexpr bool PERM = true, AFTER_DRAIN = false, KEEPS = true;
    bf16_t* OUT; const bf16_t* GATES; int npan;
    __device__ __forceinline__ bool apply(f32x4 (&acc)[2][2][4][2], const Unit& u, int wr, int wc, int fr, int fq) const {
        const int which = u.pm >= npan ? 1 : 0; const int pm = u.pm - which * npan, pn = u.pn - which * 4;
        const int row0 = pm * BM + wr * 64 + fr; const int col0 = pn * BM + wc * 32 + 8 * fq;
        auto lo4 = [](const u32x4& w) -> f32x4 { f32x4 g; g[0] = __uint_as_float(w.x << 16); g[1] = __uint_as_float(w.x & 0xffff0000u); g[2] = __uint_as_float(w.y << 16); g[3] = __uint_as_float(w.y & 0xffff0000u); return g; };
        auto hi4 = [](const u32x4& w) -> f32x4 { f32x4 g; g[0] = __uint_as_float(w.z << 16); g[1] = __uint_as_float(w.z & 0xffff0000u); g[2] = __uint_as_float(w.w << 16); g[3] = __uint_as_float(w.w & 0xffff0000u); return g; };
        auto clampg = [](f32x4 g) -> f32x4 { g[0] = fmaxf(g[0], 1e-30f); g[1] = fmaxf(g[1], 1e-30f); g[2] = fmaxf(g[2], 1e-30f); g[3] = fmaxf(g[3], 1e-30f); return g; };
        auto rcp4 = [](const f32x4& g) -> f32x4 { f32x4 r; r[0] = __builtin_amdgcn_rcpf(g[0]); r[1] = __builtin_amdgcn_rcpf(g[1]); r[2] = __builtin_amdgcn_rcpf(g[2]); r[3] = __builtin_amdgcn_rcpf(g[3]); return r; };
        u32x4 ac[2], an[2], bc[2], bn[2];
        auto issue = [&](int g) { const int r = row0 + (g >> 2) * HALF + (g & 3) * 16;
#pragma unroll
            for (int bj = 0; bj < 2; ++bj) { bn[bj] = *(const u32x4*)(GATES + (size_t)r * 2048 + 1024 + col0 + bj * HALF); if (!which) an[bj] = *(const u32x4*)(GATES + (size_t)r * 2048 + col0 + bj * HALF); } };
        issue(0);
#pragma unroll
        for (int g = 0; g < 8; ++g) { const int ai = g >> 2, m = g & 3;
#pragma unroll
            for (int bj = 0; bj < 2; ++bj) { ac[bj] = an[bj]; bc[bj] = bn[bj]; }
            if (g < 7) issue(g + 1);
            const size_t ro = (size_t)(row0 + ai * HALF + m * 16) * 1024 + col0;
#pragma unroll
            for (int bj = 0; bj < 2; ++bj) { const f32x4 gb0 = clampg(lo4(bc[bj])), gb1 = clampg(hi4(bc[bj]));
                if (which == 0) { acc[ai][bj][m][0] = acc[ai][bj][m][0] * (lo4(ac[bj]) * rcp4(gb0)); acc[ai][bj][m][1] = acc[ai][bj][m][1] * (hi4(ac[bj]) * rcp4(gb1)); }
                else { const f32x4 t0 = acc[ai][bj][m][0] * gb0, t1 = acc[ai][bj][m][1] * gb1; u32x4 w; w.x = cvt_pk_bf16(t0[0], t0[1]); w.y = cvt_pk_bf16(t0[2], t0[3]); w.z = cvt_pk_bf16(t1[0], t1[1]); w.w = cvt_pk_bf16(t1[2], t1[3]);
                    *(u32x4*)(OUT + ro + bj * HALF) = w; } }
        }
        return which == 0;
    }
};
struct SplitOrder {
    StaticOrder base; int G, c, nslice, nbase;
    __device__ __forceinline__ void init(int Mprompt, int N, int G_, int c_, int nslice_) { base.init(Mprompt, N, G_, c_); G = G_; c = c_; nslice = nslice_; nbase = c_ < base.nwg ? (base.nwg - c_ + G_ - 1) / G_ : 0; }
    __device__ __forceinline__ bool next(int i, Unit& u) const {
        if (i < nbase) return base.next(i, u);
        const int e = (i - nbase) * G + c; if (e >= 16 * nslice) return false;
        const int tile = e / nslice, sl = e - tile * nslice; u.pm = base.nM + (tile >> 2); u.pn = tile & 3; u.k0 = sl * 256; u.ntk = 4; u.ks = sl; return true;
    }
    __device__ __forceinline__ void a_ready(const Unit&) const {}
    __device__ __forceinline__ void done(const Unit&) const {}
};
struct EpiF32S {
    static constexpr bool PERM = true, AFTER_DRAIN = false, KEEPS = false;
    bf16_t* O; float* FP; int ldc, mprompt, mdec;
    __device__ __forceinline__ void operator()(const f32x4 (&acc)[2][2][4][2], const Unit& u, int wr, int wc, int fr, int fq) const {
        const int row0 = u.pm * BM + wr * 64 + fr; const int col0 = u.pn * BM + wc * 32 + 8 * fq;
        if (u.ks < 0) {
#pragma unroll
            for (int ai = 0; ai < 2; ++ai)
#pragma unroll
                for (int m = 0; m < 4; ++m) { bf16_t* rowp = O + (size_t)(row0 + ai * HALF + m * 16) * ldc + col0;
#pragma unroll
                    for (int bj = 0; bj < 2; ++bj) { const f32x4 v0 = acc[ai][bj][m][0], v1 = acc[ai][bj][m][1]; u32x4 w; w.x = cvt_pk_bf16(v0[0], v0[1]); w.y = cvt_pk_bf16(v0[2], v0[3]); w.z = cvt_pk_bf16(v1[0], v1[1]); w.w = cvt_pk_bf16(v1[2], v1[3]);
                        *(u32x4*)(rowp + bj * HALF) = w; } }
        } else {
            float* base = FP + ((size_t)u.ks * mdec + (row0 - mprompt)) * ldc;
#pragma unroll
            for (int ai = 0; ai < 2; ++ai)
#pragma unroll
                for (int m = 0; m < 4; ++m) { float* rowp = base + (size_t)(ai * HALF + m * 16) * ldc + col0;
#pragma unroll
                    for (int bj = 0; bj < 2; ++bj)
#pragma unroll
                        for (int n = 0; n < 2; ++n) *(f32x4*)(rowp + bj * HALF + n * 4) = acc[ai][bj][m][n]; }
        }
    }
};
struct PairOrder {
    int ntile, G, c, npan;
    __device__ __forceinline__ bool next(int i, Unit& u) const { const int tile = (i >> 1) * G + c; if (tile >= ntile) return false; const int which = i & 1; u.pm = (tile >> 2) + which * npan; u.pn = (tile & 3) + which * 4; u.k0 = 0; u.ntk = 0; u.ks = -1; return true; }
    __device__ __forceinline__ void a_ready(const Unit&) const {}
    __device__ __forceinline__ void done(const Unit&) const {}
};
template <class Epi, class Sched, bool ALIGN_EPI = false, bool SP2 = false>
__device__ __forceinline__ void gemm_phase(PG8_LAS unsigned char* lds, const Gemm g, const Sched& S, const Epi& E, int wave_s) {
    unsigned z_ = 0u; asm volatile("" : "+v"(z_));
    int tid_ = wave_s * 64 + (int)__builtin_amdgcn_mbcnt_hi(~0u, __builtin_amdgcn_mbcnt_lo(~0u, z_));
    const int tid = tid_, wid = __builtin_amdgcn_readfirstlane(tid >> 6), lane = tid & 63, wr = wid >> 2, wc = wid & 3, fr = lane & 15, fq = lane >> 4;
    const int K = g.K, ntK = K / BK;
    unsigned voffA[2], voffB[2];
#pragma unroll
    for (int i = 0; i < 2; ++i) { int R, C; stage_rc(tid * 16 + i * 8192, R, C); const int Rb = Epi::PERM ? ((R & ~31) + perm32(R & 31)) : R;
        voffA[i] = (unsigned)(R * K + C) * 2u; voffB[i] = (unsigned)(Rb * K + C) * 2u; }
    const size_t kstep = (size_t)(BK * 2);
    const size_t hstep = (size_t)HALF * K * 2;
    const size_t tstep = 2 * hstep;
    const unsigned ldsw = (unsigned)wid * 1024u;
    const int aoff = lds_byte(wr * 64 + fr, fq * 8), boff = lds_byte(wc * 32 + fr, fq * 8);
#define PG8_SA(b, h) (((b) * 2 + (h)) * HTB)
#define PG8_SB(b, h) ((4 + (b) * 2 + (h)) * HTB)
#define PG8_STAGE(bufoff, gbase, voff) do { _Pragma("unroll") for (int _i = 0; _i < 2; ++_i) \
        __builtin_amdgcn_global_load_lds((const unsigned*)((const char*)(gbase) + (voff)[_i]), (PG8_LAS unsigned*)(lds + (bufoff) + ldsw + _i * 8192), 16, 0, 0); } while (0)
#define PG8_LDA(dst, b, h) do { _Pragma("unroll") for (int m = 0; m < 4; ++m) _Pragma("unroll") for (int k = 0; k < 2; ++k) dst[m][k] = *(const PG8_LAS bf16x8*)(lds + PG8_SA(b, h) + aoff + m * 2048 + k * 1024); } while (0)
#define PG8_LDB(dst, b, h) do { _Pragma("unroll") for (int n = 0; n < 2; ++n) _Pragma("unroll") for (int k = 0; k < 2; ++k) dst[n][k] = *(const PG8_LAS bf16x8*)(lds + PG8_SB(b, h) + boff + n * 2048 + k * 1024); } while (0)
#define PG8_MMA(ai, bj, At, Bt) do { __builtin_amdgcn_s_setprio(1); _Pragma("unroll") for (int m = 0; m < 4; ++m) _Pragma("unroll") for (int n = 0; n < 2; ++n) _Pragma("unroll") for (int k = 0; k < 2; ++k) \
        acc[ai][bj][m][n] = __builtin_amdgcn_mfma_f32_16x16x32_bf16(Bt[n][k], At[m][k], acc[ai][bj][m][n], 0, 0, 0); __builtin_amdgcn_s_setprio(0); } while (0)
#define PG8_WAIT_V(n) asm volatile("s_waitcnt vmcnt(" #n ")" ::: "memory")
#define PG8_WAIT_L(n) asm volatile("s_waitcnt lgkmcnt(" #n ")" ::: "memory")
#define PG8_BAR __builtin_amdgcn_s_barrier()
#define PG8_SCHED __builtin_amdgcn_sched_barrier(0)
    Unit cur, nxt; int ui = 0;
    if (!S.next(0, cur)) return;
    f32x4 acc[2][2][4][2];
#pragma unroll
    for (int a = 0; a < 2; ++a)
#pragma unroll
        for (int b = 0; b < 2; ++b)
#pragma unroll
            for (int m = 0; m < 4; ++m)
#pragma unroll
                for (int n = 0; n < 2; ++n) acc[a][b][m][n] = (f32x4){0.f, 0.f, 0.f, 0.f};
    bf16x8 At[4][2], B0[2][2], B1[2][2];
    const char* cA = (const char*)g.A + (size_t)cur.pm * tstep + (size_t)cur.k0 * 2; const char* cB = (const char*)g.Bt + (size_t)cur.pn * tstep + (size_t)cur.k0 * 2;
    S.a_ready(cur);
    if constexpr (SP2) {
        PG8_STAGE(PG8_SB(0, 0), cB, voffB); PG8_STAGE(PG8_SB(0, 1), cB + hstep, voffB); PG8_STAGE(PG8_SA(0, 0), cA, voffA); PG8_STAGE(PG8_SA(0, 1), cA + hstep, voffA);
        if (wr == 1) PG8_BAR;
        PG8_WAIT_V(2); PG8_BAR;
        PG8_STAGE(PG8_SB(1, 0), cB + kstep, voffB); PG8_STAGE(PG8_SA(1, 0), cA + kstep, voffA); PG8_STAGE(PG8_SB(1, 1), cB + hstep + kstep, voffB);
        PG8_WAIT_V(6); PG8_BAR;
    } else {
        PG8_STAGE(PG8_SB(0, 0), cB, voffB); PG8_STAGE(PG8_SA(0, 0), cA, voffA); PG8_STAGE(PG8_SB(0, 1), cB + hstep, voffB); PG8_STAGE(PG8_SA(0, 1), cA + hstep, voffA);
        if (wr == 1) PG8_BAR;
        PG8_WAIT_V(4); PG8_BAR;
        PG8_STAGE(PG8_SB(1, 0), cB + kstep, voffB); PG8_STAGE(PG8_SA(1, 0), cA + kstep, voffA); PG8_STAGE(PG8_SB(1, 1), cB + hstep + kstep, voffB);
        PG8_WAIT_V(6); PG8_BAR;
    }
    for (;;) {
        const bool has_next = S.next(ui + 1, nxt);
        const char* nA = has_next ? (const char*)g.A + (size_t)nxt.pm * tstep + (size_t)nxt.k0 * 2 : cA; const char* nB = has_next ? (const char*)g.Bt + (size_t)nxt.pn * tstep + (size_t)nxt.k0 * 2 : cB;
        const int nt = cur.ntk ? cur.ntk : ntK;
        for (int t = 0; t < nt; t += 2) {
            const bool last = (t == nt - 2);
            const char* a1 = cA + (size_t)(t + 1) * kstep;
            const char* a2 = last ? nA : cA + (size_t)(t + 2) * kstep; const char* b2 = last ? nB : cB + (size_t)(t + 2) * kstep;
            const char* a3 = a2 + kstep; const char* b3 = b2 + kstep;
            if (last && has_next) S.a_ready(nxt);
            if constexpr (SP2) {
            PG8_LDB(B0, 0, 0); PG8_LDB(B1, 0, 1); PG8_SCHED; PG8_LDA(At, 0, 0); PG8_STAGE(PG8_SA(1, 1), a1 + hstep, voffA);
            PG8_WAIT_V(8); PG8_WAIT_L(0); PG8_BAR; PG8_MMA(0, 0, At, B0); PG8_MMA(0, 1, At, B1); PG8_BAR; PG8_SCHED;
            PG8_LDA(At, 0, 1); PG8_STAGE(PG8_SB(0, 0), b2, voffB); PG8_STAGE(PG8_SB(0, 1), b2 + hstep, voffB); PG8_STAGE(PG8_SA(0, 0), a2, voffA);
            PG8_WAIT_V(8); PG8_WAIT_L(0); PG8_BAR; PG8_MMA(1, 0, At, B0); PG8_MMA(1, 1, At, B1); PG8_BAR; PG8_SCHED;
            PG8_LDB(B0, 1, 0); PG8_LDB(B1, 1, 1); PG8_SCHED; PG8_LDA(At, 1, 0); PG8_STAGE(PG8_SA(0, 1), a2 + hstep, voffA);
            PG8_WAIT_V(8); PG8_WAIT_L(0); PG8_BAR; PG8_MMA(0, 0, At, B0); PG8_MMA(0, 1, At, B1); PG8_BAR; PG8_SCHED;
            PG8_LDA(At, 1, 1); PG8_STAGE(PG8_SB(1, 0), b3, voffB); PG8_STAGE(PG8_SB(1, 1), b3 + hstep, voffB); PG8_STAGE(PG8_SA(1, 0), a3, voffA);
            PG8_WAIT_V(8); PG8_WAIT_L(0); PG8_BAR; PG8_MMA(1, 0, At, B0); PG8_MMA(1, 1, At, B1); PG8_BAR; PG8_SCHED;
            } else {
            PG8_LDB(B0, 0, 0); PG8_SCHED; PG8_LDA(At, 0, 0); PG8_STAGE(PG8_SA(1, 1), a1 + hstep, voffA);
            PG8_WAIT_L(8); PG8_BAR; PG8_WAIT_L(0); PG8_MMA(0, 0, At, B0); PG8_BAR; PG8_SCHED;
            PG8_LDB(B1, 0, 1); PG8_STAGE(PG8_SB(0, 0), b2, voffB);
            PG8_BAR; PG8_WAIT_L(0); PG8_MMA(0, 1, At, B1); PG8_BAR;
            PG8_LDA(At, 0, 1); PG8_STAGE(PG8_SA(0, 0), a2, voffA);
            PG8_BAR; PG8_WAIT_L(0); PG8_MMA(1, 0, At, B0); PG8_BAR; PG8_SCHED;
            PG8_STAGE(PG8_SB(0, 1), b2 + hstep, voffB);
            PG8_WAIT_V(6); PG8_BAR; PG8_MMA(1, 1, At, B1); PG8_BAR;
            PG8_LDB(B0, 1, 0); PG8_SCHED; PG8_LDA(At, 1, 0); PG8_STAGE(PG8_SA(0, 1), a2 + hstep, voffA);
            PG8_WAIT_L(8); PG8_BAR; PG8_WAIT_L(0); PG8_MMA(0, 0, At, B0); PG8_BAR; PG8_SCHED;
            PG8_LDB(B1, 1, 1); PG8_STAGE(PG8_SB(1, 0), b3, voffB);
            PG8_BAR; PG8_WAIT_L(0); PG8_MMA(0, 1, At, B1); PG8_BAR;
            PG8_LDA(At, 1, 1); PG8_STAGE(PG8_SA(1, 0), a3, voffA);
            PG8_BAR; PG8_WAIT_L(0); PG8_MMA(1, 0, At, B0); PG8_BAR; PG8_SCHED;
            PG8_STAGE(PG8_SB(1, 1), b3 + hstep, voffB);
            PG8_WAIT_V(6); PG8_BAR; PG8_MMA(1, 1, At, B1); PG8_BAR;
            }
        }
        if constexpr (ALIGN_EPI) { if (wr == 0) PG8_BAR; }
        bool keep_acc = false;
        if constexpr (!Epi::AFTER_DRAIN) { if constexpr (Epi::KEEPS) keep_acc = E.apply(acc, cur, wr, wc, fr, fq); else E(acc, cur, wr, wc, fr, fq); S.done(cur); }
        if (!has_next) break;
        if (!keep_acc)
#pragma unroll
        for (int a = 0; a < 2; ++a)
#pragma unroll
            for (int b = 0; b < 2; ++b)
#pragma unroll
                for (int m = 0; m < 4; ++m)
#pragma unroll
                    for (int n = 0; n < 2; ++n) acc[a][b][m][n] = (f32x4){0.f, 0.f, 0.f, 0.f};
        cur = nxt; cA = nA; cB = nB; ++ui;
        if constexpr (ALIGN_EPI) { if (wr == 1) PG8_BAR; }
    }
    PG8_WAIT_V(0);
    if constexpr (!ALIGN_EPI) { if (wr == 0) PG8_BAR; }
    PG8_BAR;
    if constexpr (Epi::AFTER_DRAIN) { E.fused(acc, cur, wr, wc, fr, fq, lds, wid, lane); S.done(cur); }
#undef PG8_SA
#undef PG8_SB
#undef PG8_STAGE
#undef PG8_LDA
#undef PG8_LDB
#undef PG8_MMA
#undef PG8_WAIT_V
#undef PG8_WAIT_L
#undef PG8_BAR
#undef PG8_SCHED
}
}
using pg8::fast_sigmoid;
#define GAS __attribute__((address_space(1)))
#define LAS __attribute__((address_space(3)))
typedef unsigned short bf16;
typedef unsigned v4u __attribute__((ext_vector_type(4)));
typedef float f32x4 __attribute__((ext_vector_type(4)));
typedef short bf16x8 __attribute__((ext_vector_type(8)));
typedef GAS unsigned gu32;
typedef GAS unsigned long long gu64;
#define RLX_AGENT __ATOMIC_RELAXED, __HIP_MEMORY_SCOPE_AGENT
#define LDS_WAIT() asm volatile("s_waitcnt lgkmcnt(0)" ::: "memory")
#define VM_WAIT() asm volatile("s_waitcnt vmcnt(0)" ::: "memory")
__device__ __forceinline__ unsigned long long rt() { return __builtin_amdgcn_s_memrealtime(); }
__device__ __forceinline__ unsigned f2bf(float f) { unsigned u = __builtin_bit_cast(unsigned, f); return (u + 0x7fffu + ((u >> 16) & 1u)) >> 16; }
__device__ __forceinline__ unsigned pk2(float lo, float hi) { return f2bf(lo) | (f2bf(hi) << 16); }

#define XB_TMO      128
#define XB_XCNT(j)  (256  + 64 * (j))
#define XB_XSUB(j)  (1280 + 64 * (j))
#define XB_XGEN(j)  (2304 + 64 * (j))
#define XB_TOP      3328
#define XB_TOPGEN   3392
#define XCD_BAR_WORDS 3456
#define XB_SPIN_CAP (1u << 18)

__device__ __forceinline__ unsigned xb_ld(unsigned* p)              { return __hip_atomic_load(p, __ATOMIC_RELAXED, __HIP_MEMORY_SCOPE_AGENT); }
__device__ __forceinline__ unsigned xb_add(unsigned* p, unsigned v) { return __hip_atomic_fetch_add(p, v, __ATOMIC_RELAXED, __HIP_MEMORY_SCOPE_AGENT); }
__device__ __forceinline__ unsigned xb_xcc_id() { return (unsigned)__builtin_amdgcn_s_getreg((3 << 11) | 20) & 0xFu; }
#define XB_SPIN(cond, bar) do { unsigned _sp = 0; while (cond) { __builtin_amdgcn_s_sleep(1); \
    if ((++_sp & 255u) == 0u) { if (xb_ld(&(bar)[XB_TMO])) break; if (_sp > XB_SPIN_CAP) { atomicAdd(&(bar)[XB_TMO], 1u); break; } } } } while (0)

struct XcdBarrier {
    int wave;
    unsigned* bar; unsigned x;
    volatile LAS unsigned* st;
};

__device__ __forceinline__ XcdBarrier xcd_barrier_post(unsigned* bar, volatile LAS unsigned* st) {
    XcdBarrier b; b.bar = bar; b.x = xb_xcc_id(); b.st = st;
    if (threadIdx.x == 0) (void)xb_add(&bar[XB_XCNT(b.x)], 1u);
    return b;
}
__device__ __forceinline__ void xcd_barrier_complete(unsigned* bar, unsigned x, unsigned& nloc, unsigned& nx) {
    const unsigned G = gridDim.x * gridDim.y * gridDim.z;
    unsigned sum, cnt, mine, sp = 0u;
    for (;;) {
        sum = 0u; cnt = 0u; mine = 0u;
#pragma unroll
        for (unsigned j = 0; j < 16; ++j) { const unsigned c = xb_ld(&bar[XB_XCNT(j)]); sum += c; cnt += (c > 0u) ? 1u : 0u; mine = (j == x) ? c : mine; }
        if (sum == G) break;
        __builtin_amdgcn_s_sleep(1);
        if ((++sp & 255u) == 0u) { if (xb_ld(&bar[XB_TMO])) break; if (sp > XB_SPIN_CAP) { atomicAdd(&bar[XB_TMO], 1u); break; } }
    }
    nloc = mine > 0u ? mine : 1u; nx = cnt > 0u ? cnt : 1u;
}

__device__ __forceinline__ void xcd_barrier(const XcdBarrier& b) {
    asm volatile("s_waitcnt vmcnt(0)" ::: "memory");
    __syncthreads();
    unsigned lz_ = 0u; asm volatile("" : "+v"(lz_));
    if (b.wave == 0 && __builtin_amdgcn_mbcnt_hi(~0u, __builtin_amdgcn_mbcnt_lo(~0u, lz_)) == 0u) {
        unsigned* bar = b.bar;
        __builtin_amdgcn_s_waitcnt(0);
        unsigned nloc = b.st[0], nx = b.st[1];
        if (nloc == 0u) { xcd_barrier_complete(bar, b.x, nloc, nx); b.st[0] = nloc; b.st[1] = nx; }
        const unsigned old = xb_add(&bar[XB_XSUB(b.x)], 1u);
        const unsigned gen = old / nloc;
        if (old + 1u == (gen + 1u) * nloc) {
            __builtin_amdgcn_fence(__ATOMIC_RELEASE, "agent");
            asm volatile("s_waitcnt vmcnt(0)" ::: "memory");
            const unsigned og = xb_add(&bar[XB_TOP], 1u);
            const unsigned tg = og / nx;
            if (og + 1u == (tg + 1u) * nx) xb_add(&bar[XB_TOPGEN], 1u);
            else XB_SPIN(xb_ld(&bar[XB_TOPGEN]) == tg, bar);
            __builtin_amdgcn_fence(__ATOMIC_ACQUIRE, "agent");
            xb_add(&bar[XB_XGEN(b.x)], 1u);
            asm volatile("s_waitcnt vmcnt(0)" ::: "memory");
        } else {
            XB_SPIN(xb_ld(&bar[XB_XGEN(b.x)]) == gen, bar);
            __builtin_amdgcn_fence(__ATOMIC_ACQUIRE, "agent");
            asm volatile("s_waitcnt vmcnt(0)" ::: "memory");
        }
    }
    __syncthreads();
}
constexpr int NWAVES = 8, NTHR = 512;
constexpr int D = 1024, NB = 4, SEQ = 8192, DEPTH = 4, DECB = 32, DECS = 32, PAST = 2048;
constexpr int MP = NB * SEQ, MD = DECB * DECS, M = MP + MD, NPAN = M / 256, NSEQ = NB + DECB;
constexpr int DFF = 2816, NGU = 2 * DFF, NIN = 3328, NRW = 1792, NIG = NIN + 2 * D;
constexpr int HA = 4, HB = 8;
constexpr float LN_EPS = 1e-5f, GN_EPS = 64e-5f;
constexpr float ALPHA = 1.681792830507429f;
constexpr float QSCALE = 0.125f * 1.4426950408889634f;
constexpr float LOG2E = 1.4426950408889634f;
constexpr size_t OFF_Y = 0, OFF_KP = (size_t)M * D, OFF_VP = OFF_KP + (size_t)DEPTH * MP * 512, OFF_WKVP = OFF_VP + (size_t)DEPTH * MP * 512,
    OFF_SHP = OFF_WKVP + (size_t)DEPTH * NB * HB * 4096, OFF_KS = OFF_SHP + (size_t)DEPTH * NB * NRW, OFF_VS = OFF_KS + (size_t)DEPTH * MD * 512,
    OFF_WKVS = OFF_VS + (size_t)DEPTH * MD * 512, OFF_SHS = OFF_WKVS + (size_t)DEPTH * DECB * HB * 4096, OUT_TOTAL = OFF_SHS + (size_t)DEPTH * DECB * NRW;
static_assert(OUT_TOTAL == 177991680ull, "output size");
constexpr size_t al256(size_t x) { return (x + 255) & ~(size_t)255; }
constexpr size_t WS_CTL = 0, CTL_ZERO_BYTES = 1u << 20;
constexpr size_t WS_MOD = CTL_ZERO_BYTES;
constexpr size_t WS_LAM = WS_MOD + al256((size_t)DEPTH * NSEQ * 9 * D * 4);
constexpr size_t WS_W = WS_LAM + 256;
constexpr size_t WL_GU0 = 0, WL_GU1 = WL_GU0 + (size_t)NGU * D * 2, WL_DN0 = WL_GU1 + (size_t)NGU * D * 2, WL_DN1 = WL_DN0 + (size_t)D * DFF * 2,
    WL_IG = WL_DN1 + (size_t)D * DFF * 2, WL_BR = WL_IG + (size_t)NIG * D * 2, WL_O = WL_BR + (size_t)2048 * 512 * 2, WL_W2 = WL_O + (size_t)D * D * 2,
    WL_A2 = WL_W2 + 512 * 64 * 2, WL_G2 = WL_A2 + 512 * 64 * 2, WL_SIZE = WL_G2 + 512 * 128 * 2;
constexpr size_t WS_U = WS_W + (size_t)DEPTH * WL_SIZE;
constexpr size_t WS_ACT = WS_U + (size_t)M * D * 2;
constexpr size_t WS_F = WS_ACT + (size_t)M * DFF * 2;
constexpr size_t WS_Q = WS_F + (size_t)M * D * 4;
constexpr size_t WS_KB = WS_Q + (size_t)M * 512 * 2, WS_VB = WS_KB + (size_t)M * 512 * 2;
constexpr size_t WS_PRW = WS_VB + (size_t)M * 512 * 2;
constexpr size_t WS_GATES = WS_PRW + (size_t)M * NRW * 4;
constexpr size_t WS_YAB = WS_GATES + (size_t)M * 2048 * 2;
constexpr size_t WS_MERGED = WS_YAB + (size_t)2 * M * 512 * 2;
constexpr int NITEM_P = NB * (SEQ / 64) * HB, NITEM = NITEM_P + DECB * HB;
constexpr size_t WS_PT = WS_MERGED + (size_t)M * D * 2;
constexpr size_t WS_QT = WS_PT + (size_t)NITEM * 8192;
constexpr size_t WS_HT = WS_QT + (size_t)NITEM * 8192;
constexpr size_t WS_OT = WS_HT + (size_t)NITEM * 16384;
constexpr size_t WS_OB = WS_OT + (size_t)NITEM * 16384;
constexpr size_t WS_GG = WS_OB + (size_t)M * 512 * 4, WS_BON = WS_GG + (size_t)NITEM * 16384;
constexpr size_t WS_SC = WS_BON + (size_t)NITEM * 16384;
constexpr size_t WS_PLB = WS_SC + (size_t)NITEM * 8192;
constexpr size_t WS_SSB = WS_PLB + (size_t)M * 256 * 2;
constexpr size_t WS_FP = al256(WS_SSB + (size_t)DEPTH * DECB * 256 * 2);
constexpr size_t WS_END = WS_FP + (size_t)11 * MD * D * 4;
constexpr int CW_TMO = 0, CW_BAR = 4096, CW_QUEUE = 8192;
constexpr int RING_BYTES = 131072, EXTRA_OFF = 131072, LDSCTL_OFF = 146944, LDS_BYTES = 147456;

struct Args { const float* in[34]; float* out; unsigned char* ws; int ph_lo, ph_hi; };
static_assert(sizeof(Args) == 36 * 8 + 8, "Args has no padding");
enum { I_XP = 0, I_XS, I_CP, I_CS, I_CK, I_CV, I_SWKV, I_SSH, I_RELB, I_WADA, I_BADA, I_LNG, I_LNB, I_WGU, I_WDN, I_WIN, I_LAMQK, I_SUBG, I_MU, I_W0, I_W2, I_A0, I_A2, I_G2,
       I_KK, I_KA, I_RK, I_LNXG, I_LNXB, I_BRA, I_BRB, I_WGATE, I_BGATE, I_WO };

struct Frame { LAS unsigned char* lds; int tid, lane, wave, vcu, G; };

__device__ __forceinline__ int opq(int x) { asm volatile("" : "+s"(x)); return x; }
__device__ __forceinline__ Frame relaunder(const Frame& F) { Frame G = F; G.vcu = opq(G.vcu); G.G = opq(G.G); G.wave = opq(F.wave); { unsigned z_ = 0u; asm volatile("" : "+v"(z_)); G.lane = (int)__builtin_amdgcn_mbcnt_hi(~0u, __builtin_amdgcn_mbcnt_lo(~0u, z_)); }   G.tid = G.wave * 64 + G.lane; return G; }
__device__ __forceinline__ int row_seq(int row) { return row < MP ? (row >> 13) : NB + ((row - MP) >> 5); }
__device__ __forceinline__ int crow(int r, int hi) { return (r & 3) + 8 * (r >> 2) + 4 * hi; }
__device__ __forceinline__ float wave_sum(float v) {
#pragma unroll
    for (int o = 1; o < 64; o <<= 1) v += __shfl_xor(v, o);
    return v;
}
__device__ __forceinline__ unsigned cvtpk(float lo, float hi) { return pg8::cvt_pk_bf16(lo, hi); }
__device__ __forceinline__ unsigned short f2bf1(float x) { return (unsigned short)(pg8::cvt_pk_bf16(x, 0.f) & 0xffffu); }
__device__ __forceinline__ float bf2f(bf16 b) { return __uint_as_float((unsigned)b << 16); }
typedef float f32x16 __attribute__((ext_vector_type(16)));
typedef unsigned u32x2 __attribute__((ext_vector_type(2)));
#define LP(T, p) ((LAS T*)(p))

__device__ __forceinline__ void p0_transpose_item(const float* W, int K, int N, bf16* WT, int k0, int n0, int drow0, LAS float* scr, int lane) {
    float wv[32];
#pragma unroll
    for (int i = 0; i < 32; ++i) wv[i] = W[(size_t)(k0 + 2 * i + (lane >> 5)) * N + n0 + (lane & 31)];
#pragma unroll
    for (int i = 0; i < 32; ++i) scr[(2 * i + (lane >> 5)) * 33 + (lane & 31)] = wv[i];
    LDS_WAIT(); asm volatile("" ::: "memory");
    const int c = lane & 7;
#pragma unroll
    for (int j = 0; j < 4; ++j) { const int n = (lane >> 3) + 8 * j; const LAS float* s = scr + (8 * c) * 33 + n;
        v4u o; o.x = pk2(s[0 * 33], s[1 * 33]); o.y = pk2(s[2 * 33], s[3 * 33]); o.z = pk2(s[4 * 33], s[5 * 33]); o.w = pk2(s[6 * 33], s[7 * 33]);
        *(GAS v4u*)(WT + (size_t)(drow0 + n) * K + k0 + 8 * c) = o; }
    LDS_WAIT(); asm volatile("" ::: "memory");
}
__device__ __forceinline__ void conv_mat(const float* W, int K, int N, bf16* WT, int r, int row_off, bool gu, LAS float* scr, int lane) {
    const int nblk = N / 32, kb = r / nblk, nb = r % nblk, n0 = 32 * nb; int drow0 = row_off + n0;
    if (gu) { drow0 = n0 < DFF ? 256 * (n0 / 128) + (n0 % 128) : 256 * ((n0 - DFF) / 128) + 128 + ((n0 - DFF) % 128); }
    p0_transpose_item(W, K, N, WT, 64 * kb, n0, drow0, scr, lane);
}
__device__ __forceinline__ void ph_prologue(const Frame& F0, const Args& a) {
    const Frame F = relaunder(F0);
    unsigned char* ws = a.ws;
    LAS bf16* sc = LP(bf16, F.lds);
    for (int i = F.tid; i < NSEQ * D; i += NTHR) { const int s = i >> 10, k = i & 1023; const float c = s < NB ? a.in[I_CP][s * D + k] : a.in[I_CS][(s - NB) * D + k];
        sc[s * 1032 + k] = (bf16)f2bf(c * fast_sigmoid(c)); }
    __syncthreads();
    const int gw = F.vcu * NWAVES + F.wave, NGW = F.G * NWAVES; const int lane = F.lane, r32 = lane & 31, hi = lane >> 5;
    float* MOD = (float*)(ws + WS_MOD);
    for (int it = gw; it < DEPTH * 288; it += NGW) {
        const int l = it / 288, n0 = (it % 288) * 32;
        const float* W = a.in[I_WADA] + (size_t)l * D * 9216 + n0 + r32;
        f32x16 acc0 = {}, acc1 = {};
        const int rowB = (32 + r32) < NSEQ ? 32 + r32 : NSEQ - 1;
#pragma unroll 4
        for (int s = 0; s < 64; ++s) {
            const float* wp = W + (size_t)(16 * s + 8 * hi) * 9216;
            float w[8];
#pragma unroll
            for (int j = 0; j < 8; ++j) w[j] = wp[(size_t)j * 9216];
            v4u bw; bw.x = cvtpk(w[0], w[1]); bw.y = cvtpk(w[2], w[3]); bw.z = cvtpk(w[4], w[5]); bw.w = cvtpk(w[6], w[7]);
            const bf16x8 bfrag = __builtin_bit_cast(bf16x8, bw);
            const bf16x8 a0 = *LP(const bf16x8, sc + r32 * 1032 + 16 * s + 8 * hi);
            const bf16x8 a1 = *LP(const bf16x8, sc + rowB * 1032 + 16 * s + 8 * hi);
            acc0 = __builtin_amdgcn_mfma_f32_32x32x16_bf16(a0, bfrag, acc0, 0, 0, 0);
            acc1 = __builtin_amdgcn_mfma_f32_32x32x16_bf16(a1, bfrag, acc1, 0, 0, 0);
        }
        const float bias = a.in[I_BADA][(size_t)l * 9216 + n0 + r32];
#pragma unroll
        for (int r = 0; r < 16; ++r) { const int s0 = crow(r, hi); MOD[((size_t)l * NSEQ + s0) * 9216 + n0 + r32] = acc0[r] + bias;
            const int s1 = 32 + s0; if (s1 < NSEQ) MOD[((size_t)l * NSEQ + s1) * 9216 + n0 + r32] = acc1[r] + bias; }
    }
    LAS float* scr = LP(float, F.lds + 74304 + F.wave * 8448);
    constexpr int C0 = 16 * 176, C2 = 44 * 32, C4 = 16 * 104, C5 = 16 * 64, C6 = 8 * 32, C8 = 16 * 32, C9 = 16, C11 = 32;
    constexpr int PER_L = 2 * C0 + 2 * C2 + C4 + C5 + 2 * C6 + C8 + 2 * C9 + C11;
    for (int it = gw; it < DEPTH * PER_L; it += NGW) {
        const int l = it / PER_L; int r = it % PER_L; unsigned char* wl = ws + WS_W + (size_t)l * WL_SIZE;
        if (r < C0) { conv_mat(a.in[I_WGU] + (size_t)(l * 2 + 0) * D * NGU, D, NGU, (bf16*)(wl + WL_GU0), r, 0, true, scr, lane); continue; } r -= C0;
        if (r < C0) { conv_mat(a.in[I_WGU] + (size_t)(l * 2 + 1) * D * NGU, D, NGU, (bf16*)(wl + WL_GU1), r, 0, true, scr, lane); continue; } r -= C0;
        if (r < C2) { conv_mat(a.in[I_WDN] + (size_t)(l * 2 + 0) * DFF * D, DFF, D, (bf16*)(wl + WL_DN0), r, 0, false, scr, lane); continue; } r -= C2;
        if (r < C2) { conv_mat(a.in[I_WDN] + (size_t)(l * 2 + 1) * DFF * D, DFF, D, (bf16*)(wl + WL_DN1), r, 0, false, scr, lane); continue; } r -= C2;
        if (r < C4) { conv_mat(a.in[I_WIN] + (size_t)l * D * NIN, D, NIN, (bf16*)(wl + WL_IG), r, 0, false, scr, lane); continue; } r -= C4;
        if (r < C5) { conv_mat(a.in[I_WGATE] + (size_t)l * D * 2048, D, 2048, (bf16*)(wl + WL_IG), r, NIN, false, scr, lane); continue; } r -= C5;
        if (r < C6) { conv_mat(a.in[I_BRA] + (size_t)l * 512 * D, 512, D, (bf16*)(wl + WL_BR), r, 0, false, scr, lane); continue; } r -= C6;
        if (r < C6) { conv_mat(a.in[I_BRB] + (size_t)l * 512 * D, 512, D, (bf16*)(wl + WL_BR), r, 1024, false, scr, lane); continue; } r -= C6;
        if (r < C8) { conv_mat(a.in[I_WO] + (size_t)l * D * D, D, D, (bf16*)(wl + WL_O), r, 0, false, scr, lane); continue; } r -= C8;
        if (r < C9) { conv_mat(a.in[I_W2] + (size_t)l * 64 * 512, 64, 512, (bf16*)(wl + WL_W2), r, 0, false, scr, lane); continue; } r -= C9;
        if (r < C9) { conv_mat(a.in[I_A2] + (size_t)l * 64 * 512, 64, 512, (bf16*)(wl + WL_A2), r, 0, false, scr, lane); continue; } r -= C9;
        conv_mat(a.in[I_G2] + (size_t)l * 128 * 512, 128, 512, (bf16*)(wl + WL_G2), r, 0, false, scr, lane);
    }
    for (int z = gw * 64 + lane; z < DEPTH * DECB * 256; z += NGW * 64) ((bf16*)(ws + WS_SSB))[z] = (bf16)f2bf(a.in[I_SSH][(size_t)(z >> 8) * NRW + 1536 + (z & 255)]);
    if (blockIdx.x == 0 && F.wave == 0) {
        for (int l = 0; l < DEPTH; ++l) { const float* lq = a.in[I_LAMQK] + l * 256;
            const float s1 = wave_sum(lq[lane] * lq[64 + lane]), s2 = wave_sum(lq[128 + lane] * lq[192 + lane]);
            const float lam_init = 0.8f - 0.6f * expf(-0.3f * (float)l);
            if (lane == 0) ((float*)(ws + WS_LAM))[l] = expf(s1) - expf(s2) + lam_init; }
    }
}

__device__ __forceinline__ void ph_ln(const Frame& F0, const float* xin_p, const float* xin_s, const bf16* f, float gs, const float* gate_mod  ,
                                      const float* lng, const float* lnb, const float* modn  , float* xout, bf16* uout,
                                      const float* fparts = nullptr, int nparts = 0  ) {
    const Frame F = relaunder(F0);
    const int gw = F.vcu * NWAVES + F.wave, NGW = F.G * NWAVES, lane = F.lane;
    const int m0 = gw; if (m0 >= M) return;
    f32x4 cg[4], cb[4], cgate[4], csh[4], cscl[4]; int cseq = -1;
#pragma unroll
    for (int j = 0; j < 4; ++j) { cg[j] = f ? *(const f32x4*)(lng + 4 * lane + 256 * j) : (f32x4){0.f, 0.f, 0.f, 0.f}; cb[j] = f ? *(const f32x4*)(lnb + 4 * lane + 256 * j) : (f32x4){0.f, 0.f, 0.f, 0.f}; }
    auto xrow = [&](int m) -> const float* { return (xin_s && m >= MP) ? xin_s + (size_t)(m - MP) * D : xin_p + (size_t)m * D; };
    f32x4 v[4], vn[4]; u32x2 fw[4], fwn[4];
#pragma unroll
    for (int j = 0; j < 4; ++j) { vn[j] = *(const f32x4*)(xrow(m0) + 4 * lane + 256 * j); fwn[j] = (f && !(fparts && m0 >= MP)) ? *(const u32x2*)(f + (size_t)m0 * D + 4 * lane + 256 * j) : (u32x2){0u, 0u}; }
    for (int m = m0; m < M; m += NGW) {
        const int seq = row_seq(m);
#pragma unroll
        for (int j = 0; j < 4; ++j) { v[j] = vn[j]; fw[j] = fwn[j]; }
        { const int mn = m + NGW < M ? m + NGW : m;
#pragma unroll
          for (int j = 0; j < 4; ++j) { vn[j] = *(const f32x4*)(xrow(mn) + 4 * lane + 256 * j); fwn[j] = (f && !(fparts && mn >= MP)) ? *(const u32x2*)(f + (size_t)mn * D + 4 * lane + 256 * j) : (u32x2){0u, 0u}; } }
        if (seq != cseq) { cseq = seq;
#pragma unroll
            for (int j = 0; j < 4; ++j) { if (f) cgate[j] = *(const f32x4*)(gate_mod + (size_t)seq * 9216 + 4 * lane + 256 * j) * gs;
                if (modn) { csh[j] = *(const f32x4*)(modn + (size_t)seq * 9216 + 4 * lane + 256 * j); cscl[j] = *(const f32x4*)(modn + (size_t)seq * 9216 + D + 4 * lane + 256 * j) + 1.0f; } } }
        if (f) {
            float s = 0.f;
#pragma unroll
            for (int j = 0; j < 4; ++j) { f32x4 fv;
                if (fparts && m >= MP) { fv = (f32x4){0.f, 0.f, 0.f, 0.f}; for (int sp = 0; sp < nparts; ++sp) fv += *(const f32x4*)(fparts + ((size_t)sp * MD + (m - MP)) * D + 4 * lane + 256 * j); }
                else fv = (f32x4){__uint_as_float(fw[j].x << 16), __uint_as_float(fw[j].x & 0xffff0000u), __uint_as_float(fw[j].y << 16), __uint_as_float(fw[j].y & 0xffff0000u)};
                v[j] = v[j] * ALPHA + cgate[j] * fv; s += (v[j].x + v[j].y) + (v[j].z + v[j].w); }
            const float mean = wave_sum(s) * (1.f / D); float s2 = 0.f;
#pragma unroll
            for (int j = 0; j < 4; ++j) { v[j] = v[j] - mean; s2 += (v[j].x * v[j].x + v[j].y * v[j].y) + (v[j].z * v[j].z + v[j].w * v[j].w); }
            const float rstd = 1.0f / sqrtf(wave_sum(s2) * (1.f / D) + LN_EPS);
#pragma unroll
            for (int j = 0; j < 4; ++j) { v[j] = v[j] * rstd * cg[j] + cb[j]; *(f32x4*)(xout + (size_t)m * D + 4 * lane + 256 * j) = v[j]; }
        }
        if (modn) {
            float s = 0.f;
#pragma unroll
            for (int j = 0; j < 4; ++j) s += (v[j].x + v[j].y) + (v[j].z + v[j].w);
            const float mean = wave_sum(s) * (1.f / D); float s2 = 0.f;
#pragma unroll
            for (int j = 0; j < 4; ++j) { v[j] = v[j] - mean; s2 += (v[j].x * v[j].x + v[j].y * v[j].y) + (v[j].z * v[j].z + v[j].w * v[j].w); }
            const float rstd = 1.0f / sqrtf(wave_sum(s2) * (1.f / D) + LN_EPS);
#pragma unroll
            for (int j = 0; j < 4; ++j) { const f32x4 o = v[j] * rstd * cscl[j] + csh[j]; u32x2 w; w.x = cvtpk(o.x, o.y); w.y = cvtpk(o.z, o.w);
                *(u32x2*)(uout + (size_t)m * D + 4 * lane + 256 * j) = w; }
        }
    }
}
__device__ __forceinline__ int t5_bucket(int rel) {
    const int n = rel < 0 ? -rel : rel; int b;
    if (n < 8) b = n; else if (n < 12) b = 8; else if (n < 16) b = 9; else if (n < 23) b = 10; else if (n < 32) b = 11; else if (n < 46) b = 12; else if (n < 64) b = 13; else if (n < 91) b = 14; else b = 15;
    return (rel > 0 ? 16 : 0) + b;
}
typedef short v4i16_t __attribute__((ext_vector_type(4)));
__device__ __forceinline__ v4i16_t vtr(LAS const unsigned char* p) { return __builtin_amdgcn_ds_read_tr16_b64_v4i16((LAS v4i16_t*)p); }
constexpr int ATT_SLOT = 32768;
constexpr int ATT_TAB = EXTRA_OFF;
struct AttnP { const bf16* Q; const bf16* Kb; const bf16* Vb; const float* ck; const float* cv; bf16* YA; const float* relb; const float* subg; float lam, oml; };

__device__ __forceinline__ void attn_scores(LAS const unsigned char* slot, LAS const float* tab, const bf16x8 (&qf)[4], f32x16 (&o)[4], bf16x8 (&pf)[4], float& mrun, float& lrun,
                                            int map, int lane, int k0, int qpos, bool constb, int nvalid, bool first  ) {
    const int r32 = lane & 31, hi = lane >> 5;
    LAS const unsigned char* kb = slot + map * 8192 + hi * 1024 + r32 * 16;
    f32x16 p0, p1;
    const float cb = (constb ? tab[0] : 0.f) - (first ? 0.f : mrun);
#pragma unroll
    for (int r = 0; r < 16; ++r) { p0[r] = cb; p1[r] = cb; }
#pragma unroll
    for (int d0 = 0; d0 < 4; ++d0) {
        const bf16x8 k0f = *LP(const bf16x8, kb + d0 * 2048), k1f = *LP(const bf16x8, kb + d0 * 2048 + 512);
        p0 = __builtin_amdgcn_mfma_f32_32x32x16_bf16(k0f, qf[d0], p0, 0, 0, 0);
        p1 = __builtin_amdgcn_mfma_f32_32x32x16_bf16(k1f, qf[d0], p1, 0, 0, 0);
    }
    if (!constb) {
        const int base = k0 - qpos + 128;
#pragma unroll
        for (int r = 0; r < 16; ++r) { int i0 = base + crow(r, hi); int i1 = i0 + 32; i0 = i0 < 0 ? 0 : (i0 > 191 ? 191 : i0); i1 = i1 < 0 ? 0 : (i1 > 191 ? 191 : i1); p0[r] += tab[i0]; p1[r] += tab[i1]; }
    }
    if (nvalid < 64) {
#pragma unroll
        for (int r = 0; r < 16; ++r) { if (crow(r, hi) >= nvalid) p0[r] = -INFINITY; if (crow(r, hi) + 32 >= nvalid) p1[r] = -INFINITY; }
    }
    float ma = fmaxf(fmaxf(p0[0], p0[1]), p1[0]), mb = fmaxf(fmaxf(p0[2], p0[3]), p1[1]); ma = fmaxf(fmaxf(ma, p1[2]), p1[3]);
#pragma unroll
    for (int r = 4; r < 16; r += 4) { ma = fmaxf(fmaxf(ma, p0[r]), p0[r + 1]); mb = fmaxf(fmaxf(mb, p0[r + 2]), p0[r + 3]); ma = fmaxf(fmaxf(ma, p1[r]), p1[r + 1]); mb = fmaxf(fmaxf(mb, p1[r + 2]), p1[r + 3]); }
    float mx = fmaxf(ma, mb);
    mx = fmaxf(mx, __shfl_xor(mx, 32));
    if (first || __any(mx > 8.0f)) {
        const float delta = first ? mx : (mx > 8.0f ? mx : 0.f);
        const float alpha = first ? 0.f : __builtin_amdgcn_exp2f(-delta);
        mrun = first ? mx : mrun + delta;
        lrun *= alpha;
#pragma unroll
        for (int r = 0; r < 16; ++r) { p0[r] -= delta; p1[r] -= delta; }
#pragma unroll
        for (int c = 0; c < 4; ++c)
#pragma unroll
            for (int r = 0; r < 16; ++r) o[c][r] *= alpha;
    }
    float ls = 0.f;
#pragma unroll
    for (int r = 0; r < 16; ++r) { p0[r] = __builtin_amdgcn_exp2f(p0[r]); p1[r] = __builtin_amdgcn_exp2f(p1[r]); ls += p0[r] + p1[r]; }
    lrun += ls;
#pragma unroll
    for (int ks = 0; ks < 4; ++ks) { v4u w;
        if (ks < 2) { const int b = 8 * ks; w.x = cvtpk(p0[b], p0[b + 1]); w.y = cvtpk(p0[b + 2], p0[b + 3]); w.z = cvtpk(p0[b + 4], p0[b + 5]); w.w = cvtpk(p0[b + 6], p0[b + 7]); }
        else { const int b = 8 * (ks - 2); w.x = cvtpk(p1[b], p1[b + 1]); w.y = cvtpk(p1[b + 2], p1[b + 3]); w.z = cvtpk(p1[b + 4], p1[b + 5]); w.w = cvtpk(p1[b + 6], p1[b + 7]); }
        pf[ks] = __builtin_bit_cast(bf16x8, w); }
}
__device__ __forceinline__ void attn_pv(LAS const unsigned char* slot, const bf16x8 (&pf)[4], f32x16 (&o)[4], int lane) {
    const int hi = lane >> 5;
    LAS const unsigned char* vb = slot + 16384 + ((lane >> 4) & 1) * 32 + (lane & 3) * 8 + (4 * hi + ((lane & 15) >> 2)) * 64;
#pragma unroll
    for (int c = 0; c < 4; ++c)
#pragma unroll
        for (int ks = 0; ks < 4; ++ks) {
            const v4i16_t lo = vtr(vb + c * 4096 + (2 * ks) * 512), hh = vtr(vb + c * 4096 + (2 * ks + 1) * 512);
            const bf16x8 vf = (bf16x8){lo[0], lo[1], lo[2], lo[3], hh[0], hh[1], hh[2], hh[3]};
            o[c] = __builtin_amdgcn_mfma_f32_32x32x16_bf16(vf, pf[ks], o[c], 0, 0, 0);
        }
}

__device__ __forceinline__ int att_koff(int key, int ch) { return (ch >> 3) * 8192 + ((ch & 7) >> 1) * 2048 + (ch & 1) * 1024 + (key >> 5) * 512 + (key & 31) * 16; }
__device__ __forceinline__ int att_voff(int key, int ch) { return 16384 + (ch >> 2) * 4096 + (key >> 3) * 512 + (key & 7) * 64 + (ch & 3) * 16; }

__device__ __forceinline__ void attn_unit(const Frame& F, const AttnP& P, bool dec, int bidx, int h, int qb) {
    const int tid = F.tid, lane = F.lane, wave = F.wave, r32 = lane & 31, hi = lane >> 5;
    const int map = wave & 1, qs = wave >> 1;
    LAS unsigned char* lds = F.lds;
    LAS float* tab = LP(float, lds + ATT_TAB);
    const int rowbase = dec ? MP + bidx * DECS : bidx * SEQ;
    const int q0 = dec ? 0 : qb * 128;
    const int qpos0 = dec ? PAST : q0;
    const bool active = dec ? (qs == 0) : true;
    const int NT = dec ? (PAST / 64 + 1) : (2 * qb + 2);
    const int myNT = dec ? NT : (2 * qb + 1 + (qs >> 1));
    if (tid < 192) tab[tid] = P.relb[t5_bucket(tid - 128) * HA + h] * LOG2E;
    bf16x8 qf[4];
    { const bf16* qp = P.Q + (size_t)(rowbase + q0 + (active ? qs * 32 : 0) + r32) * 512 + h * 128 + map * 64 + 8 * hi;
#pragma unroll
      for (int d0 = 0; d0 < 4; ++d0) qf[d0] = *(const bf16x8*)(qp + 16 * d0); }
    f32x16 o[4];
#pragma unroll
    for (int c = 0; c < 4; ++c)
#pragma unroll
        for (int r = 0; r < 16; ++r) o[c][r] = 0.f;
    float mrun = -INFINITY, lrun = 0.f;
    const int qposw = qpos0 + qs * 32;
    v4u kreg[2], vreg[2];
    auto load_tile = [&](int t) {
#pragma unroll
        for (int i = 0; i < 2; ++i) { const int id = tid + 512 * i;
            const int kk = (id & 7) | ((id >> 7) << 3), kc = (id >> 3) & 15;
            const int vk = ((id >> 2) & 7) | ((id >> 7) << 3), vc = (id & 3) | (((id >> 5) & 3) << 2);
            if (!dec) { kreg[i] = *(const v4u*)(P.Kb + (size_t)(rowbase + 64 * t + kk) * 512 + h * 128 + kc * 8); vreg[i] = *(const v4u*)(P.Vb + (size_t)(rowbase + 64 * t + vk) * 512 + h * 128 + vc * 8); }
            else if (t < PAST / 64) { const size_t gk = ((size_t)(bidx * PAST + 64 * t + kk) * HA + h) * 128 + kc * 8, gv = ((size_t)(bidx * PAST + 64 * t + vk) * HA + h) * 128 + vc * 8;
                const f32x4 a0 = *(const f32x4*)(P.ck + gk), a1 = *(const f32x4*)(P.ck + gk + 4), b0 = *(const f32x4*)(P.cv + gv), b1 = *(const f32x4*)(P.cv + gv + 4);
                kreg[i] = (v4u){cvtpk(a0[0], a0[1]), cvtpk(a0[2], a0[3]), cvtpk(a1[0], a1[1]), cvtpk(a1[2], a1[3])};
                vreg[i] = (v4u){cvtpk(b0[0], b0[1]), cvtpk(b0[2], b0[3]), cvtpk(b1[0], b1[1]), cvtpk(b1[2], b1[3])}; }
            else { kreg[i] = kk < DECS ? *(const v4u*)(P.Kb + (size_t)(rowbase + kk) * 512 + h * 128 + kc * 8) : (v4u){0u, 0u, 0u, 0u};
                   vreg[i] = vk < DECS ? *(const v4u*)(P.Vb + (size_t)(rowbase + vk) * 512 + h * 128 + vc * 8) : (v4u){0u, 0u, 0u, 0u}; }
        }
    };
    auto store_tile_at = [&](int sloff) {
        LAS unsigned char* sb = lds + sloff;
#pragma unroll
        for (int i = 0; i < 2; ++i) { const int id = tid + 512 * i;
            const int kk = (id & 7) | ((id >> 7) << 3), kc = (id >> 3) & 15, vk = ((id >> 2) & 7) | ((id >> 7) << 3), vc = (id & 3) | (((id >> 5) & 3) << 2);
            *LP(v4u, sb + att_koff(kk, kc)) = kreg[i]; *LP(v4u, sb + att_voff(vk, vc)) = vreg[i]; }
    };
    __syncthreads();
    load_tile(0); store_tile_at(0);
    __syncthreads();
    const bool late = wave >= 4;
    bf16x8 pf[4];
    bool pend = false;
    int sl_prev = 0, sl_cur = 0, sl_next = ATT_SLOT;
    for (int t = 0; t < NT; ++t) {
        if (t + 1 < NT) load_tile(t + 1);
        const bool mine = active && t < myNT;
        if (late) {
            if (pend) attn_pv(lds + sl_prev, pf, o, lane);
            pend = mine;
        }
        if (mine) {
            const int k0 = 64 * t;
            const bool constb = (k0 + 63 - qposw) <= -91;
            attn_scores(lds + sl_cur, tab, qf, o, pf, mrun, lrun, map, lane, k0, qposw + r32, constb, (dec && t == NT - 1) ? DECS : 64, t == 0);
            if (!late) attn_pv(lds + sl_cur, pf, o, lane);
        }
        if (t + 1 < NT) store_tile_at(sl_next);
        __syncthreads();
        sl_prev = sl_cur; sl_cur = sl_next; sl_next = sl_next == 2 * ATT_SLOT ? 0 : sl_next + ATT_SLOT;
    }
    if (late && pend) attn_pv(lds + sl_prev, pf, o, lane);
    __syncthreads();
    lrun += __shfl_xor(lrun, 32);
    const float inv = 1.0f / lrun;
    LAS float* ex = LP(float, lds + (wave >> 1) * 16384);
    if (map == 1) {
#pragma unroll
        for (int c = 0; c < 4; ++c)
#pragma unroll
            for (int r = 0; r < 16; ++r) ex[(c * 16 + r) * 64 + lane] = o[c][r] * inv;
    }
    __syncthreads();
    LAS bf16* yst = LP(bf16, lds + 65536 + (wave >> 1) * 8448);
    if (map == 0) {
        float ss = 0.f;
#pragma unroll
        for (int c = 0; c < 4; ++c)
#pragma unroll
            for (int r = 0; r < 16; ++r) { const float v = o[c][r] * inv - P.lam * ex[(c * 16 + r) * 64 + lane]; o[c][r] = v; ss += v * v; }
        ss += __shfl_xor(ss, 32);
        const float rs = 1.0f / sqrtf(ss * (1.f / 128.f) + LN_EPS) * P.oml;
#pragma unroll
        for (int c = 0; c < 4; ++c)
#pragma unroll
            for (int r = 0; r < 16; ++r) { const int dv = 32 * c + crow(r, hi); yst[r32 * 132 + dv] = (bf16)f2bf(o[c][r] * rs * P.subg[dv]); }
    }
    __syncthreads();
    if (map == 0 && active) {
#pragma unroll
        for (int i = 0; i < 8; ++i) { const int row = i * 4 + (lane >> 4), ch = lane & 15;
            const u32x2 a = *LP(const u32x2, yst + row * 132 + ch * 8), b = *LP(const u32x2, yst + row * 132 + ch * 8 + 4);
            *(v4u*)(P.YA + (size_t)(rowbase + q0 + qs * 32 + row) * 512 + h * 128 + ch * 8) = (v4u){a.x, a.y, b.x, b.y}; }
    }
}
__device__ __forceinline__ void ph_attn(const Frame& F0, const AttnP& P, unsigned* qcount) {
    const Frame F = relaunder(F0);
    LAS unsigned* qslot = LP(unsigned, F.lds + LDSCTL_OFF + 64);
    for (;;) {
        __syncthreads();
        if (F.tid == 0) *qslot = __hip_atomic_fetch_add(qcount, 1u, __ATOMIC_RELAXED, __HIP_MEMORY_SCOPE_AGENT);
        __syncthreads();
        const int u = __builtin_amdgcn_readfirstlane((int)*qslot);
        if (u >= 1024 + DECB * HA) break;
        constexpr int DEC_AT = 16 * (63 - 16);
        const bool isdec = u >= DEC_AT && u < DEC_AT + DECB * HA;
        const int up = u < DEC_AT ? u : u - DECB * HA, d = u - DEC_AT;
        attn_unit(F, P, isdec, isdec ? d >> 2 : (up & 15) >> 2, isdec ? d & 3 : up & 3, isdec ? 0 : 63 - (up >> 4));
    }
}
constexpr int R1_RT = 0, R1_KH = 9216, R1_BH = 18432, R1_KAP = 27648, R1_KAPT = 36864, R1_VT = 46080, R1_BBT = 55296, R1_KBT = 64512;
constexpr int R1_ABKF = 73728, R1_AKK = 90368, R1_ABR = 99584, R1_AKR = 108800, R1_MB = 118016;
constexpr int R1_MF = R1_KH, R1_GT = R1_KAP, R1_WT = R1_ABKF, R1_UT = R1_KH;
constexpr int R1_LW = 73728, R1_LA = 82944, R1_LG = 92160;
constexpr int R1_RED = EXTRA_OFF, R1_CS = EXTRA_OFF + 1024, R1_GTV = EXTRA_OFF + 2048, R1_T16 = EXTRA_OFF + 2304, R1_MUL = EXTRA_OFF + 5632;
typedef unsigned short u16;
__device__ __forceinline__ f32x4 mfma16(bf16x8 a, bf16x8 b, f32x4 c) { return __builtin_amdgcn_mfma_f32_16x16x32_bf16(a, b, c, 0, 0, 0); }
__device__ __forceinline__ void mm64(f32x4 (&acc)[2], LAS const unsigned char* X, LAS const unsigned char* Y, int tm, int tn0, int lane) {
    const int i = lane & 15, q = lane >> 4;
#pragma unroll
    for (int s = 0; s < 2; ++s) {
        const bf16x8 af = *LP(const bf16x8, X + ((16 * tm + i) * 72 + 32 * s + 8 * q) * 2);
#pragma unroll
        for (int j = 0; j < 2; ++j) { const bf16x8 bfr = *LP(const bf16x8, Y + ((16 * (tn0 + j) + i) * 72 + 32 * s + 8 * q) * 2); acc[j] = mfma16(af, bfr, acc[j]); }
    }
}
__device__ __forceinline__ void st_tr(LAS unsigned char* arr, const f32x4& v, int n, int t0) {
    u32x2 w; w.x = cvtpk(v[0], v[1]); w.y = cvtpk(v[2], v[3]); *LP(u32x2, arr + (n * 72 + t0) * 2) = w;
}
__device__ __forceinline__ f32x4 prod16(f32x4 acc, LAS const float* X, int sx, LAS const float* Y, int sy, int lane) {
    const int i = lane & 15, q = lane >> 4;
#pragma unroll
    for (int s = 0; s < 4; ++s) acc = __builtin_amdgcn_mfma_f32_16x16x4f32(X[i * sx + 4 * s + q], Y[(4 * s + q) * sy + i], acc, 0, 0, 0);
    return acc;
}
__device__ __forceinline__ float tanh_fast(float x) { return 1.0f - 2.0f * __builtin_amdgcn_rcpf(1.0f + __expf(2.0f * x)); }

__device__ __forceinline__ int frag_a(int row, int k) { return ((row >> 4) * 2 + (k >> 5)) * 512 + (((k >> 2) & 3) * 16 + (row & 15)) * 8 + 4 * ((k >> 4) & 1) + (k & 3); }
__device__ __forceinline__ int frag_c(int c, int r0) { return (((c >> 4) * 4 + (r0 >> 4)) * 64 + ((r0 >> 2) & 3) * 16 + (c & 15)) * 4; }
__device__ __forceinline__ void ph_rwkv1(const Frame& F0, const Args& a, int l) {
    const Frame F = relaunder(F0);
    unsigned char* ws = a.ws; LAS unsigned char* lds = F.lds;
    int tid = F.tid, lane = F.lane, i = lane & 15, q = lane >> 4, t0 = 0; const int wave = F.wave, tm = wave >> 1, tnb = 2 * (wave & 1);
#define R1_RELANE() do { int l_ = F.lane; asm volatile("" : "+v"(l_)); lane = l_; i = lane & 15; q = lane >> 4; tid = wave * 64 + lane; t0 = 16 * tm + 4 * q; } while (0)
    const bf16* PRW = (const bf16*)(ws + WS_PRW);
    const unsigned char* wl = ws + WS_W + (size_t)l * WL_SIZE;
    const bf16* W2t = (const bf16*)(wl + WL_W2); const bf16* A2t = (const bf16*)(wl + WL_A2); const bf16* G2t = (const bf16*)(wl + WL_G2);
    const float* mu = a.in[I_MU] + (size_t)l * NRW; const float* w0 = a.in[I_W0] + l * 512; const float* a0 = a.in[I_A0] + l * 512;
    const float* k_k = a.in[I_KK] + l * 512; const float* k_a = a.in[I_KA] + l * 512; const float* r_k = a.in[I_RK] + l * 512;
    bf16* GG = (bf16*)(ws + WS_GG); bf16* BON = (bf16*)(ws + WS_BON);
    LAS float* RED = LP(float, lds + R1_RED); LAS float* CS = LP(float, lds + R1_CS); LAS float* GTV = LP(float, lds + R1_GTV);
    LAS float* ABKF = LP(float, lds + R1_ABKF); LAS float* MF = LP(float, lds + R1_MF);
    if (tid < 256) LP(float, lds + R1_MUL)[tid] = mu[1536 + tid];
    __syncthreads();
    struct R1Item { int h, row0, tval; const float* prev0; const bf16* prevr; const bf16* prevb; };
    auto item_info = [&](int it) -> R1Item { R1Item I;
        if (it < NITEM_P) { const int s = it >> 10, c = (it >> 3) & 127; I.h = it & 7; I.row0 = s * SEQ + 64 * c; I.tval = 64; I.prev0 = nullptr; I.prevr = c > 0 ? PRW + (size_t)(I.row0 - 1) * NRW : nullptr; I.prevb = c > 0 ? I.prevr + 1536 : nullptr; }
        else { const int b = (it - NITEM_P) >> 3; I.h = it & 7; I.row0 = MP + DECS * b; I.tval = DECS; I.prev0 = a.in[I_SSH] + (size_t)(l * DECB + b) * NRW; I.prevr = nullptr; I.prevb = (const bf16*)(ws + WS_SSB) + (size_t)(l * DECB + b) * 256; }
        return I; };
    v4u lp[4], lq[4];
    float gp[2][4][3], gq[2][3], cst[2][8]; bool pqz = false;
    auto load_top = [&](const R1Item& I) {
        const int t0s = tid >> 3, part = tid & 7; const bool v0 = t0s < I.tval;
        const bf16* pl_ = PRW + (size_t)(I.row0 + (v0 ? t0s : 0)) * NRW + 1536 + 32 * part;
        const bf16* pq_ = (v0 && t0s > 0) ? pl_ - NRW : (I.prevb ? I.prevb + 32 * part : pl_);
        pqz = !(v0 && t0s > 0) && !I.prevb;
#pragma unroll
        for (int e = 0; e < 4; ++e) { lp[e] = *(const v4u*)(pl_ + 8 * e); lq[e] = *(const v4u*)(pq_ + 8 * e); }
#pragma unroll
        for (int j = 0; j < 2; ++j) { const int col = I.h * 64 + 16 * (tnb + j) + i; const int tb = 16 * tm + 4 * q;
#pragma unroll
            for (int r = 0; r < 4; ++r) { const unsigned po = (unsigned)(I.row0 + min(tb + r, I.tval - 1)) * NRW + col; gp[j][r][0] = bf2f(PRW[po]); gp[j][r][1] = bf2f(PRW[po + 512]); gp[j][r][2] = bf2f(PRW[po + 1024]); }
            const bf16* pb = tb > 0 ? PRW + (size_t)(I.row0 + min(tb, I.tval) - 1) * NRW : I.prevr;
            if (pb) { gq[j][0] = bf2f(pb[col]); gq[j][1] = bf2f(pb[512 + col]); gq[j][2] = bf2f(pb[1024 + col]); }
            else if (I.prev0) { gq[j][0] = I.prev0[col]; gq[j][1] = I.prev0[512 + col]; gq[j][2] = I.prev0[1024 + col]; }
            else { gq[j][0] = 0.f; gq[j][1] = 0.f; gq[j][2] = 0.f; }
            cst[j][0] = mu[col]; cst[j][1] = mu[512 + col]; cst[j][2] = mu[1024 + col]; cst[j][3] = w0[col]; cst[j][4] = a0[col]; cst[j][5] = k_k[col]; cst[j][6] = k_a[col]; cst[j][7] = r_k[col]; }
    };
    R1Item cur = item_info(F.vcu < NITEM ? F.vcu : 0), nxt = cur;
    if (F.vcu < NITEM) { R1_RELANE(); load_top(cur); }
    for (int it = F.vcu; it < NITEM; it += F.G) {
        const int h = cur.h, row0 = cur.row0, tval = cur.tval;
        R1_RELANE();
        const int t0s = tid >> 3, part = tid & 7;
        const bool v0 = t0s < tval;
        { LAS unsigned char* dst = part < 2 ? lds + R1_LW + (t0s * 72 + 32 * part) * 2 : (part < 4 ? lds + R1_LA + (t0s * 72 + 32 * (part - 2)) * 2 : lds + R1_LG + (t0s * 136 + 32 * (part - 4)) * 2);
          LAS const float* mul = LP(const float, lds + R1_MUL) + 32 * part;
#pragma unroll
          for (int e8 = 0; e8 < 4; ++e8) { float x[8];
#pragma unroll
              for (int e = 0; e < 2; ++e) { const unsigned pa_ = e ? lp[e8].z : lp[e8].x, pb_ = e ? lp[e8].w : lp[e8].y, qa_ = e ? lq[e8].z : lq[e8].x, qb_ = e ? lq[e8].w : lq[e8].y;
                  const f32x4 pv = {__uint_as_float(pa_ << 16), __uint_as_float(pa_ & 0xffff0000u), __uint_as_float(pb_ << 16), __uint_as_float(pb_ & 0xffff0000u)};
                  const f32x4 qv = pqz ? (f32x4){0.f, 0.f, 0.f, 0.f} : (f32x4){__uint_as_float(qa_ << 16), __uint_as_float(qa_ & 0xffff0000u), __uint_as_float(qb_ << 16), __uint_as_float(qb_ & 0xffff0000u)};
                  const f32x4 m4 = *LP(const f32x4, mul + 8 * e8 + 4 * e);
                  const f32x4 xm = pv + (qv - pv) * m4;
#pragma unroll
                  for (int z = 0; z < 4; ++z) x[4 * e + z] = !v0 ? 0.f : (part < 2 ? tanh_fast(xm[z]) : (part < 4 ? xm[z] : fast_sigmoid(xm[z]))); }
              *LP(v4u, dst + e8 * 16) = (v4u){cvtpk(x[0], x[1]), cvtpk(x[2], x[3]), cvtpk(x[4], x[5]), cvtpk(x[6], x[7])}; }
        }
        bf16x8 bW[2][2], bA[2][2], bG[4][2];
#pragma unroll
        for (int j = 0; j < 2; ++j) { const int n = h * 64 + 16 * (tnb + j) + i;
#pragma unroll
            for (int s = 0; s < 2; ++s) { bW[s][j] = *(const bf16x8*)(W2t + (size_t)n * 64 + 32 * s + 8 * q); bA[s][j] = *(const bf16x8*)(A2t + (size_t)n * 64 + 32 * s + 8 * q); }
#pragma unroll
            for (int s = 0; s < 4; ++s) bG[s][j] = *(const bf16x8*)(G2t + (size_t)n * 128 + 32 * s + 8 * q); }
        __syncthreads();
        f32x4 aw[2], aa[2], ag[2];
#pragma unroll
        for (int j = 0; j < 2; ++j) { aw[j] = (f32x4){0.f, 0.f, 0.f, 0.f}; aa[j] = aw[j]; ag[j] = aw[j]; }
#pragma unroll
        for (int s = 0; s < 2; ++s) {
            const bf16x8 fw = *LP(const bf16x8, lds + R1_LW + ((16 * tm + i) * 72 + 32 * s + 8 * q) * 2), fa = *LP(const bf16x8, lds + R1_LA + ((16 * tm + i) * 72 + 32 * s + 8 * q) * 2);
#pragma unroll
            for (int j = 0; j < 2; ++j) { aw[j] = mfma16(fw, bW[s][j], aw[j]); aa[j] = mfma16(fa, bA[s][j], aa[j]); }
        }
#pragma unroll
        for (int s = 0; s < 4; ++s) {
            const bf16x8 fg = *LP(const bf16x8, lds + R1_LG + ((16 * tm + i) * 136 + 32 * s + 8 * q) * 2);
#pragma unroll
            for (int j = 0; j < 2; ++j) ag[j] = mfma16(fg, bG[s][j], ag[j]);
        }
        float xr[2][4], kp[2][4], xv[2][4], lw[2][4], av[2][4], kkr[2][4];
        float ssq[4] = {0.f, 0.f, 0.f, 0.f}, bsum[4] = {0.f, 0.f, 0.f, 0.f};
#pragma unroll
        for (int j = 0; j < 2; ++j) { const int n = 16 * (tnb + j) + i;
            const float mur = cst[j][0], muk = cst[j][1], muv = cst[j][2], w0c = cst[j][3], a0c = cst[j][4], kkc = cst[j][5], kac = cst[j][6], rkc = cst[j][7];
#pragma unroll
            for (int r = 0; r < 4; ++r) { const int t = 16 * tm + 4 * q + r; const bool valid = t < tval;
                const float pr = gp[j][r][0], pk = gp[j][r][1], pv = gp[j][r][2];
                const float qr = r ? gp[j][r - 1][0] : gq[j][0], qk = r ? gp[j][r - 1][1] : gq[j][1], qv = r ? gp[j][r - 1][2] : gq[j][2];
                const float r_ = pr + (qr - pr) * mur, k_ = pk + (qk - pk) * muk, v_ = pv + (qv - pv) * muv;
                const float wpre = w0c + aw[j][r];
                const float sp = fmaxf(-wpre, 0.f) + __logf(1.0f + __expf(-fabsf(wpre)));
                const float wlog = -sp - 0.5f;
                const float a_ = fast_sigmoid(a0c + aa[j][r]);
                const float kk_ = k_ * kkc, kp_ = k_ * (1.0f + (a_ - 1.0f) * kac);
                xr[j][r] = valid ? r_ : 0.f; kp[j][r] = valid ? kp_ : 0.f; xv[j][r] = valid ? v_ : 0.f; lw[j][r] = valid ? -__expf(wlog) : 0.f; av[j][r] = valid ? a_ : 0.f; kkr[j][r] = valid ? kk_ : 0.f;
                ssq[r] += kkr[j][r] * kkr[j][r]; bsum[r] += xr[j][r] * kp[j][r] * rkc;
            }
            *(u32x2*)(GG + (size_t)it * 4096 + frag_c(n, 16 * tm + 4 * q)) = (u32x2){cvtpk(ag[j][0], ag[j][1]), cvtpk(ag[j][2], ag[j][3])}; }
#pragma unroll
        for (int r = 0; r < 4; ++r) {
#pragma unroll
            for (int o = 1; o < 16; o <<= 1) { ssq[r] += __shfl_xor(ssq[r], o); bsum[r] += __shfl_xor(bsum[r], o); }
            if (i == 0) { const int t = 16 * tm + 4 * q + r; RED[(t * 2 + (wave & 1)) * 2 + 0] = ssq[r]; RED[(t * 2 + (wave & 1)) * 2 + 1] = bsum[r]; } }
        { const int itn = it + F.G < NITEM ? it + F.G : it; nxt = item_info(itn); R1_RELANE(); load_top(nxt); }
        float cin[2][4], exq[2];
#pragma unroll
        for (int j = 0; j < 2; ++j) { cin[j][0] = lw[j][0]; cin[j][1] = cin[j][0] + lw[j][1]; cin[j][2] = cin[j][1] + lw[j][2]; cin[j][3] = cin[j][2] + lw[j][3];
            const float tot = cin[j][3]; float ex = 0.f, wt = 0.f;
#pragma unroll
            for (int qq = 0; qq < 4; ++qq) { const float tq = __shfl(tot, i + 16 * qq); wt += tq; ex += qq < q ? tq : 0.f; }
            exq[j] = ex; if (q == 0) CS[tm * 64 + 16 * (tnb + j) + i] = wt; }
        for (int z = tid; z < 2304; z += NTHR) LP(unsigned, lds + R1_MB)[z] = 0u;
        __syncthreads();
        R1_RELANE();
#pragma unroll
        for (int j = 0; j < 2; ++j) { const int n = 16 * (tnb + j) + i, col = h * 64 + n; float tmex = 0.f, csT = 0.f;
#pragma unroll
            for (int z = 0; z < 4; ++z) { const float c_ = CS[z * 64 + n]; csT += c_; tmex += z < tm ? c_ : 0.f; }
            const float gTj = __expf(csT);
            if (tm == 0 && q == 0) GTV[n] = gTj;
            f32x4 vKapT, vVT, vBbT, vKbT, vBon;
#pragma unroll
            for (int r = 0; r < 4; ++r) { const int t = 16 * tm + 4 * q + r;
                const float cst = tmex + exq[j] + cin[j][r], csp = cst - lw[j][r];
                const float sq = RED[(t * 2 + 0) * 2 + 0] + RED[(t * 2 + 1) * 2 + 0], bt = RED[(t * 2 + 0) * 2 + 1] + RED[(t * 2 + 1) * 2 + 1];
                const float kk_ = kkr[j][r] * __builtin_amdgcn_rsqf(fmaxf(sq, 1e-24f)), b_ = kk_ * av[j][r];
                const float gt = __expf(cst), gi = __builtin_amdgcn_rcpf(gt), gp = __expf(csp), ge = gTj * gi;
                LP(u16, lds + R1_RT)[t * 72 + n] = f2bf1(xr[j][r] * gt);
                LP(u16, lds + R1_KH)[t * 72 + n] = f2bf1(kp[j][r] * gi);
                LP(u16, lds + R1_BH)[t * 72 + n] = f2bf1(b_ * gi);
                LP(u16, lds + R1_KAP)[t * 72 + n] = f2bf1(kk_ * gp);
                vKapT[r] = kk_ * gp; vVT[r] = xv[j][r]; vBbT[r] = b_ * ge; vKbT[r] = kp[j][r] * ge;
                vBon[r] = bt * xv[j][r];
                asm volatile("" ::: "memory");
            }
            const int t0 = 16 * tm + 4 * q;
            *(u32x2*)(BON + (size_t)it * 4096 + frag_c(n, t0)) = (u32x2){cvtpk(vBon[0], vBon[1]), cvtpk(vBon[2], vBon[3])};
            st_tr(lds + R1_KAPT, vKapT, n, t0); st_tr(lds + R1_VT, vVT, n, t0); st_tr(lds + R1_BBT, vBbT, n, t0); st_tr(lds + R1_KBT, vKbT, n, t0);
            asm volatile("" ::: "memory");
        }
        __syncthreads();
        R1_RELANE();
        { f32x4 c1[2], c2[2];
#pragma unroll
          for (int j = 0; j < 2; ++j) { c1[j] = (f32x4){0.f, 0.f, 0.f, 0.f}; c2[j] = c1[j]; }
          mm64(c1, lds + R1_KAP, lds + R1_BH, tm, tnb, lane); mm64(c2, lds + R1_KAP, lds + R1_KH, tm, tnb, lane);
#pragma unroll
          for (int j = 0; j < 2; ++j) { const int ic = 16 * (tnb + j) + i;
#pragma unroll
              for (int r = 0; r < 4; ++r) { const int t = 16 * tm + 4 * q + r;
                  ABKF[t * 65 + ic] = ic < t ? c1[j][r] : 0.f;
                  LP(u16, lds + R1_AKK)[t * 72 + ic] = f2bf1(ic < t ? c2[j][r] : 0.f); } }
        }
        asm volatile("" ::: "memory");
        { f32x4 c3[2], c4[2];
#pragma unroll
          for (int j = 0; j < 2; ++j) { c3[j] = (f32x4){0.f, 0.f, 0.f, 0.f}; c4[j] = c3[j]; }
          mm64(c3, lds + R1_RT, lds + R1_BH, tm, tnb, lane);  mm64(c4, lds + R1_RT, lds + R1_KH, tm, tnb, lane);
#pragma unroll
          for (int j = 0; j < 2; ++j) { const int ic = 16 * (tnb + j) + i;
#pragma unroll
              for (int r = 0; r < 4; ++r) { const int t = 16 * tm + 4 * q + r;
                  LP(u16, lds + R1_ABR)[t * 72 + ic] = f2bf1(ic <= t ? c3[j][r] : 0.f);
                  LP(u16, lds + R1_AKR)[t * 72 + ic] = f2bf1(ic <= t ? c4[j][r] : 0.f); } }
        }
        __syncthreads();
#ifndef R1REP4
#define R1REP4 1
#endif
#pragma unroll 1
        for (int rep4 = 0; rep4 < R1REP4; ++rep4) {
        R1_RELANE();
        if (wave == 0) { const int g = q, c = i; float m[16];
#pragma unroll
            for (int ii = 0; ii < 16; ++ii) { float acc = ii == c ? 1.f : 0.f;
#pragma unroll
                for (int jj = 0; jj < ii; ++jj) acc -= ABKF[(16 * g + ii) * 65 + 16 * g + jj] * m[jj];
                m[ii] = acc; MF[(16 * g + ii) * 65 + 16 * g + c] = acc; LP(u16, lds + R1_MB)[(16 * g + ii) * 72 + 16 * g + c] = (u16)f2bf(acc); } }
        __syncthreads();
#define BLK(P, bi, bj) ((P) + (16 * (bi)) * 65 + 16 * (bj))
#define PUTM(bi, bj, acc) do { _Pragma("unroll") for (int r = 0; r < 4; ++r) { MF[(16 * (bi) + 4 * q + r) * 65 + 16 * (bj) + i] = -(acc)[r]; LP(u16, lds + R1_MB)[(16 * (bi) + 4 * q + r) * 72 + 16 * (bj) + i] = (u16)f2bf(-(acc)[r]); } } while (0)
        { LAS float* T = LP(float, lds + R1_T16) + wave * 272; const f32x4 z4 = {0.f, 0.f, 0.f, 0.f};
          if (wave < 3) { const int bi = wave + 1, bj = wave; f32x4 t = prod16(z4, BLK(ABKF, bi, bj), 65, BLK(MF, bj, bj), 65, lane);
#pragma unroll
              for (int r = 0; r < 4; ++r) T[(4 * q + r) * 17 + i] = t[r];
              f32x4 mres = prod16(z4, BLK(MF, bi, bi), 65, T, 17, lane); PUTM(bi, bj, mres); }
          __syncthreads();
          if (wave < 2) { const int bi = wave + 2, bj = wave; f32x4 t = prod16(z4, BLK(ABKF, bi, bj), 65, BLK(MF, bj, bj), 65, lane); t = prod16(t, BLK(ABKF, bi, bj + 1), 65, BLK(MF, bj + 1, bj), 65, lane);
#pragma unroll
              for (int r = 0; r < 4; ++r) T[(4 * q + r) * 17 + i] = t[r];
              f32x4 mres = prod16(z4, BLK(MF, bi, bi), 65, T, 17, lane); PUTM(bi, bj, mres); }
          __syncthreads();
          if (wave == 0) { f32x4 t = prod16(z4, BLK(ABKF, 3, 0), 65, BLK(MF, 0, 0), 65, lane); t = prod16(t, BLK(ABKF, 3, 1), 65, BLK(MF, 1, 0), 65, lane); t = prod16(t, BLK(ABKF, 3, 2), 65, BLK(MF, 2, 0), 65, lane);
#pragma unroll
              for (int r = 0; r < 4; ++r) T[(4 * q + r) * 17 + i] = t[r];
              f32x4 mres = prod16(z4, BLK(MF, 3, 3), 65, T, 17, lane); PUTM(3, 0, mres); }
          __syncthreads();
        }
#undef BLK
#undef PUTM
        }
        R1_RELANE();
        {
            const int sl = wave & 3, nb = 16 * sl + i;
            auto afrag = [&](int arr, int rt, int st) -> bf16x8 { return *LP(const bf16x8, lds + arr + ((16 * rt + i) * 72 + 32 * st + 8 * q) * 2); };
            auto afragp = [&](int arr, int rt, int st) -> bf16x8 { const u32x2 a0 = *LP(const u32x2, lds + arr + ((16 * rt + i) * 72 + 32 * st + 4 * q) * 2), a1 = *LP(const u32x2, lds + arr + ((16 * rt + i) * 72 + 32 * st + 16 + 4 * q) * 2);
                                                                  return __builtin_bit_cast(bf16x8, (v4u){a0.x, a0.y, a1.x, a1.y}); };
            auto packb = [&](const f32x4& lo, const f32x4& hi2) -> bf16x8 { return __builtin_bit_cast(bf16x8, (v4u){cvtpk(lo[0], lo[1]), cvtpk(lo[2], lo[3]), cvtpk(hi2[0], hi2[1]), cvtpk(hi2[2], hi2[3])}); };
            const f32x4 z4 = {0.f, 0.f, 0.f, 0.f};
            if (wave < 4) {
                bf16x8 vfr[2];
#pragma unroll
                for (int st = 0; st < 2; ++st) vfr[st] = *LP(const bf16x8, lds + R1_VT + (nb * 72 + 32 * st + 8 * q) * 2);
                f32x4 g[4], u[4];
#pragma unroll
                for (int rt = 0; rt < 4; ++rt) { g[rt] = mfma16(afrag(R1_AKK, rt, 0), vfr[0], z4); g[rt] = mfma16(afrag(R1_AKK, rt, 1), vfr[1], g[rt]); }
                bf16x8 gb[2] = {packb(g[0], g[1]), packb(g[2], g[3])};
#pragma unroll
                for (int rt = 0; rt < 4; ++rt) { u[rt] = mfma16(afragp(R1_MB, rt, 0), gb[0], z4); u[rt] = mfma16(afragp(R1_MB, rt, 1), gb[1], u[rt]); }
                bf16x8 ub[2] = {packb(u[0], u[1]), packb(u[2], u[3])};
                bf16* OT = (bf16*)(ws + WS_OT) + (size_t)it * 4096; float* HT = (float*)(ws + WS_HT) + (size_t)it * 4096;
#pragma unroll
                for (int rt = 0; rt < 4; ++rt) {
                    f32x4 o1 = mfma16(afrag(R1_AKR, rt, 0), vfr[0], z4); o1 = mfma16(afrag(R1_AKR, rt, 1), vfr[1], o1);
                    f32x4 o2 = mfma16(afragp(R1_ABR, rt, 0), ub[0], z4); o2 = mfma16(afragp(R1_ABR, rt, 1), ub[1], o2);
                    { const f32x4 od = o1 - o2; *(u32x2*)(OT + ((sl * 4 + rt) * 64 + lane) * 4) = (u32x2){cvtpk(od[0], od[1]), cvtpk(od[2], od[3])}; }
                    f32x4 h1 = mfma16(afrag(R1_KBT, rt, 0), vfr[0], z4); h1 = mfma16(afrag(R1_KBT, rt, 1), vfr[1], h1);
                    f32x4 h2 = mfma16(afragp(R1_BBT, rt, 0), ub[0], z4); h2 = mfma16(afragp(R1_BBT, rt, 1), ub[1], h2);
                    *(f32x4*)(HT + ((sl * 4 + rt) * 64 + lane) * 4) = h1 - h2;
                }
            } else {
                bf16x8 kfr[2];
#pragma unroll
                for (int st = 0; st < 2; ++st) kfr[st] = *LP(const bf16x8, lds + R1_KAPT + (nb * 72 + 32 * st + 8 * q) * 2);
                f32x4 w[4];
#pragma unroll
                for (int rt = 0; rt < 4; ++rt) { w[rt] = mfma16(afrag(R1_MB, rt, 0), kfr[0], z4); w[rt] = mfma16(afrag(R1_MB, rt, 1), kfr[1], w[rt]); }
                bf16x8 wb[2] = {packb(w[0], w[1]), packb(w[2], w[3])};
                LAS u16* QTs = LP(u16, lds + R1_KH); LAS u16* PTs = LP(u16, lds + R1_BH);
                const float gtv = GTV[nb];
#pragma unroll
                for (int rt = 0; rt < 4; ++rt) {
                    f32x4 cq = mfma16(afragp(R1_ABR, rt, 0), wb[0], z4); cq = mfma16(afragp(R1_ABR, rt, 1), wb[1], cq);
                    f32x4 cp = mfma16(afragp(R1_BBT, rt, 0), wb[0], z4); cp = mfma16(afragp(R1_BBT, rt, 1), wb[1], cp);
#pragma unroll
                    for (int r = 0; r < 4; ++r) { const int t = 16 * rt + 4 * q + r;
                        QTs[frag_a(t, nb)] = f2bf1(bf2f(LP(u16, lds + R1_RT)[t * 72 + nb]) - cq[r]);
                        PTs[frag_a(t, nb)] = f2bf1((t == nb ? gtv : 0.f) - cp[r]); }
                }
            }
        }
        cur = nxt;
        __syncthreads();
        { R1_RELANE();
          v4u* QTg = (v4u*)((bf16*)(ws + WS_QT) + (size_t)it * 4096); v4u* PTg = (v4u*)((bf16*)(ws + WS_PT) + (size_t)it * 4096);
          QTg[tid] = *LP(const v4u, lds + R1_KH + tid * 16); PTg[tid] = *LP(const v4u, lds + R1_BH + tid * 16); }
    }
}

struct R2St { bf16x8 pa[4][2]; f32x4 hh[4]; };
__device__ __forceinline__ void r2_load(R2St& o, const unsigned char* ws, int it, int lane, int vs) {
    const bf16* PT = (const bf16*)(ws + WS_PT) + (size_t)it * 4096; const float* HT = (const float*)(ws + WS_HT) + (size_t)it * 4096;
#pragma unroll
    for (int tt = 0; tt < 4; ++tt) {
#pragma unroll
        for (int s = 0; s < 2; ++s) o.pa[tt][s] = *(const bf16x8*)(PT + ((tt * 2 + s) * 64 + lane) * 8);
        o.hh[tt] = *(const f32x4*)(HT + ((vs * 4 + tt) * 64 + lane) * 4);
    }
}
__device__ __forceinline__ void r2_step(const R2St& r, f32x4 (&S)[4], unsigned char* ws, int it, int vs, int lane) {
    bf16x8 bs[2];
#pragma unroll
    for (int s = 0; s < 2; ++s) { v4u w; w.x = cvtpk(S[2 * s][0], S[2 * s][1]); w.y = cvtpk(S[2 * s][2], S[2 * s][3]); w.z = cvtpk(S[2 * s + 1][0], S[2 * s + 1][1]); w.w = cvtpk(S[2 * s + 1][2], S[2 * s + 1][3]); bs[s] = __builtin_bit_cast(bf16x8, w);
        *(v4u*)(ws + WS_SC + (size_t)it * 8192 + (size_t)((vs * 2 + s) * 64 + lane) * 16) = w; }
#pragma unroll
    for (int kt = 0; kt < 4; ++kt) { f32x4 acc = r.hh[kt];
#pragma unroll
        for (int s = 0; s < 2; ++s) acc = mfma16(r.pa[kt][s], bs[s], acc);
        S[kt] = acc; }
}
__device__ __forceinline__ void ph_rwkv2(const Frame& F0, const Args& a, int l) {
    const Frame F = relaunder(F0);
    unsigned char* ws = a.ws;
    const int lane = F.lane, i = lane & 15, q = lane >> 4;
    for (int slot = F.vcu * NWAVES + F.wave; slot < 2048; slot += F.G * NWAVES) {
        int nchunk, item0, h, vs; float* sout; f32x4 S[4];
        if ((slot & 15) == 0) { const int pu = slot >> 4; const int s = pu >> 5; h = (pu >> 2) & 7; vs = pu & 3; nchunk = SEQ / 64; item0 = s * 1024 + h;
            sout = a.out + OFF_WKVP + ((size_t)(l * NB + s) * HB + h) * 4096;
#pragma unroll
            for (int kt = 0; kt < 4; ++kt) S[kt] = (f32x4){0.f, 0.f, 0.f, 0.f}; }
        else { const int d = slot - (slot >> 4) - 1; if (d >= DECB * HB * 4) continue; const int b = d >> 5; h = (d >> 2) & 7; vs = d & 3; nchunk = 1; item0 = NITEM_P + b * 8 + h;
            sout = a.out + OFF_WKVS + ((size_t)(l * DECB + b) * HB + h) * 4096;
            const float* sin = a.in[I_SWKV] + ((size_t)(l * DECB + b) * HB + h) * 4096 + (16 * vs + i) * 64 + 4 * q;
#pragma unroll
            for (int kt = 0; kt < 4; ++kt) S[kt] = *(const f32x4*)(sin + 16 * kt); }
        const int v = 16 * vs + i;
        const int itl = item0 + 8 * (nchunk - 1);
        R2St r0, r1, r2;
        r2_load(r0, ws, item0, lane, vs);
        r2_load(r1, ws, min(item0 + 8, itl), lane, vs);
        r2_load(r2, ws, min(item0 + 16, itl), lane, vs);
        int c = 0;
#pragma unroll 1
        for (; c + 3 <= nchunk; c += 3) {
            const int it = item0 + 8 * c;
            r2_step(r0, S, ws, it, vs, lane);      r2_load(r0, ws, min(it + 24, itl), lane, vs);
            r2_step(r1, S, ws, it + 8, vs, lane);  r2_load(r1, ws, min(it + 32, itl), lane, vs);
            r2_step(r2, S, ws, it + 16, vs, lane); r2_load(r2, ws, min(it + 40, itl), lane, vs);
        }
        if (c < nchunk) { r2_step(r0, S, ws, item0 + 8 * c, vs, lane); ++c; }
        if (c < nchunk) { r2_step(r1, S, ws, item0 + 8 * c, vs, lane); ++c; }
#pragma unroll
        for (int kt = 0; kt < 4; ++kt) *(f32x4*)(sout + (size_t)v * 64 + 16 * kt + 4 * q) = S[kt];
    }
}
__device__ __forceinline__ void ph_rwkv3(const Frame& F0, const Args& a, int l) {
    const Frame F = relaunder(F0);
    const unsigned char* ws = a.ws;
    bf16* YB = (bf16*)(a.ws + WS_YAB) + (size_t)M * 512; const float* lg = a.in[I_LNXG] + l * 512; const float* lb = a.in[I_LNXB] + l * 512;
    const int lane = F.lane, i = lane & 15, q = lane >> 4;
    LAS unsigned char* st = F.lds + F.wave * 9216;
    for (int it = F.vcu * NWAVES + F.wave; it < NITEM; it += F.G * NWAVES) {
        const bool dec = it >= NITEM_P; int h, row0, ntt;
        if (!dec) { const int s = it >> 10, c = (it >> 3) & 127; h = it & 7; row0 = s * SEQ + 64 * c; ntt = 4; }
        else { const int b = (it - NITEM_P) >> 3; h = it & 7; row0 = MP + DECS * b; ntt = 2; }
        const bf16* QT = (const bf16*)(ws + WS_QT) + (size_t)it * 4096; const bf16* OT = (const bf16*)(ws + WS_OT) + (size_t)it * 4096;
        const bf16* GG = (const bf16*)(ws + WS_GG) + (size_t)it * 4096; const bf16* BON = (const bf16*)(ws + WS_BON) + (size_t)it * 4096;
        auto ld4 = [](const bf16* p) -> f32x4 { const u32x2 w = *(const u32x2*)p; return (f32x4){__uint_as_float(w.x << 16), __uint_as_float(w.x & 0xffff0000u), __uint_as_float(w.y << 16), __uint_as_float(w.y & 0xffff0000u)}; };
        bf16x8 bfr[4][2];
#pragma unroll
        for (int vs = 0; vs < 4; ++vs)
#pragma unroll
            for (int s = 0; s < 2; ++s) bfr[vs][s] = *(const bf16x8*)(ws + WS_SC + (size_t)it * 8192 + (size_t)((vs * 2 + s) * 64 + lane) * 16);
        float lgv[4], lbv[4];
#pragma unroll
        for (int vs = 0; vs < 4; ++vs) { lgv[vs] = lg[h * 64 + 16 * vs + i]; lbv[vs] = lb[h * 64 + 16 * vs + i]; }
#pragma unroll
        for (int tt = 0; tt < 4; ++tt) if (tt < ntt) {
            bf16x8 af[2];
#pragma unroll
            for (int s = 0; s < 2; ++s) af[s] = *(const bf16x8*)(QT + ((tt * 2 + s) * 64 + lane) * 8);
            f32x4 acc[4];
#pragma unroll
            for (int vs = 0; vs < 4; ++vs) { acc[vs] = ld4(OT + ((vs * 4 + tt) * 64 + lane) * 4); acc[vs] = mfma16(af[0], bfr[vs][0], acc[vs]); acc[vs] = mfma16(af[1], bfr[vs][1], acc[vs]); }
            f32x4 sm = (acc[0] + acc[1]) + (acc[2] + acc[3]);
#pragma unroll
            for (int o = 1; o < 16; o <<= 1) { sm[0] += __shfl_xor(sm[0], o); sm[1] += __shfl_xor(sm[1], o); sm[2] += __shfl_xor(sm[2], o); sm[3] += __shfl_xor(sm[3], o); }
            const f32x4 mean = sm * (1.f / 64.f);
            f32x4 s2 = {0.f, 0.f, 0.f, 0.f};
#pragma unroll
            for (int vs = 0; vs < 4; ++vs) { acc[vs] = acc[vs] - mean; s2 += acc[vs] * acc[vs]; }
#pragma unroll
            for (int o = 1; o < 16; o <<= 1) { s2[0] += __shfl_xor(s2[0], o); s2[1] += __shfl_xor(s2[1], o); s2[2] += __shfl_xor(s2[2], o); s2[3] += __shfl_xor(s2[3], o); }
            f32x4 rstd;
#pragma unroll
            for (int r = 0; r < 4; ++r) rstd[r] = 1.0f / sqrtf(s2[r] * (1.f / 64.f) + GN_EPS);
#pragma unroll
            for (int vs = 0; vs < 4; ++vs) { const int v = 16 * vs + i;
                const f32x4 bn = ld4(BON + ((vs * 4 + tt) * 64 + lane) * 4), gg = ld4(GG + ((vs * 4 + tt) * 64 + lane) * 4);
                const f32x4 y = (acc[vs] * rstd * lgv[vs] + lbv[vs] + bn) * gg;
#pragma unroll
                for (int r = 0; r < 4; ++r) LP(u16, st)[(16 * tt + 4 * q + r) * 72 + v] = (u16)f2bf(y[r]); }
        }
#pragma unroll
        for (int rr = 0; rr < 8; ++rr) { const int trow = rr * 8 + (lane >> 3), c8 = lane & 7;
            if (trow < 16 * ntt) *(v4u*)(YB + (size_t)(row0 + trow) * 512 + h * 64 + 8 * c8) = *LP(const v4u, st + (trow * 72 + 8 * c8) * 2); }
    }
}
constexpr int NPH_LAYER = 13, NPH = 2 + DEPTH * NPH_LAYER;
#ifndef MK_LAUNCH_PER_PHASE
#define MK_LAUNCH_PER_PHASE 0
#endif
typedef const __attribute__((address_space(4))) Args* KArgsPtr;
__device__ __forceinline__ const Args& kargs() { KArgsPtr p = (KArgsPtr)__builtin_amdgcn_kernarg_segment_ptr(); asm volatile("" : "+s"(p)); return *(const Args*)p; }
template <unsigned PHMASK> __global__ void __launch_bounds__(NTHR, 2) fwd(Args args_unused) {
    extern __shared__ __attribute__((aligned(16))) unsigned char lds_raw[];
    Frame F;
    F.lds = (LAS unsigned char*)lds_raw;
    F.tid = 0; F.lane = 0; F.wave = __builtin_amdgcn_readfirstlane((int)threadIdx.x >> 6);
    F.G = gridDim.x; { const int bx = blockIdx.x; F.vcu = (F.G % 8 == 0) ? (bx % 8) * (F.G / 8) + bx / 8 : bx; }
    volatile LAS unsigned* MISC = (volatile LAS unsigned*)(F.lds + LDSCTL_OFF);
    for (int u = threadIdx.x; u < (LDS_BYTES - LDSCTL_OFF) / 4; u += NTHR) ((LAS unsigned*)(F.lds + LDSCTL_OFF))[u] = 0u;
    __syncthreads();
    int lo, hi; { const Args& a = kargs(); lo = a.ph_lo; hi = a.ph_hi; }
    XcdBarrier bar; { const Args& a = kargs(); bar.bar = (unsigned*)(a.ws + WS_CTL) + CW_BAR; } bar.x = 0; bar.st = nullptr;
    if (hi - lo > 1) bar = xcd_barrier_post(bar.bar, MISC + 8);
    bar.wave = F.wave;
#define IN(k) (lo <= (k) && (k) < hi)
#define ON(n, k) (((PHMASK >> (n)) & 1u) && IN(k))
#define SEAM(k) do { if (IN(k) && IN((k) + 1)) xcd_barrier(bar); } while (0)
#define WSP(T, off) ((T*)(a.ws + (off)))
#ifndef REP_MASK
#define REP_MASK 0u
#endif
#define REPS(n) ((((REP_MASK) >> (n)) & 1u) ? 2 : 1)
    if (ON(13, 0)) { const Args& a = kargs(); ph_prologue(F, a); } SEAM(0);
    if (ON(14, 1)) { const Args& a = kargs(); ph_ln(F, a.in[I_XP], a.in[I_XS], nullptr, 0.f, nullptr, nullptr, nullptr, WSP(float, WS_MOD), nullptr, WSP(bf16, WS_U)); } SEAM(1);
#pragma unroll 1
    for (int l = 0; l < DEPTH; ++l) {
        const int pb = 2 + l * NPH_LAYER;
        const size_t wlo = WS_W + (size_t)l * WL_SIZE, modo = WS_MOD + (size_t)l * NSEQ * 9216 * 4;
        for (int rep_ = 0; rep_ < REPS(0); ++rep_) if (ON(0, pb + 0)) { if (rep_) xcd_barrier(bar); const Args& a = kargs(); pg8::Gemm g{WSP(bf16, WS_U), WSP(const bf16, wlo + WL_GU0), M, NGU, D}; pg8::StaticOrder S; S.init(M, NGU, opq(F.G), opq((int)blockIdx.x)); pg8::EpiSwiglu E{WSP(bf16, WS_ACT), DFF};
            pg8::gemm_phase<pg8::EpiSwiglu, pg8::StaticOrder, true, true>(F.lds, g, S, E, opq(F.wave)); } SEAM(pb + 0);
        for (int rep_ = 0; rep_ < REPS(1); ++rep_) if (ON(1, pb + 1)) { if (rep_) xcd_barrier(bar); const Args& a = kargs(); pg8::Gemm g{WSP(bf16, WS_ACT), WSP(const bf16, wlo + WL_DN0), M, D, DFF}; pg8::SplitOrder S; S.init(MP, D, opq(F.G), opq((int)blockIdx.x), DFF / 256); pg8::EpiF32S E{WSP(bf16, WS_F), WSP(float, WS_FP), D, MP, MD};
            pg8::gemm_phase<pg8::EpiF32S, pg8::SplitOrder, true, true>(F.lds, g, S, E, opq(F.wave)); } SEAM(pb + 1);
        for (int rep_ = 0; rep_ < REPS(2); ++rep_) if (ON(2, pb + 2)) { if (rep_) xcd_barrier(bar); const Args& a = kargs(); const float* modl = WSP(float, modo);
            ph_ln(F, l == 0 ? a.in[I_XP] : a.out, l == 0 ? a.in[I_XS] : nullptr, WSP(bf16, WS_F), 0.5f, modl + 2 * D, a.in[I_LNG] + (l * 3 + 0) * D, a.in[I_LNB] + (l * 3 + 0) * D, modl + 3 * D, a.out, WSP(bf16, WS_U), WSP(float, WS_FP), DFF / 256); } SEAM(pb + 2);
        for (int rep_ = 0; rep_ < REPS(3); ++rep_) if (ON(3, pb + 3)) { if (rep_) xcd_barrier(bar); const Args& a = kargs(); pg8::Gemm g{WSP(bf16, WS_U), WSP(const bf16, wlo + WL_IG), M, NIG, D}; pg8::StaticOrder S; S.init(M, NIG, opq(F.G), opq((int)blockIdx.x));
            pg8::EpiProj E{WSP(bf16, WS_Q), WSP(bf16, WS_KB), WSP(bf16, WS_VB), WSP(bf16, WS_PRW), WSP(bf16, WS_GATES), a.in[I_BGATE] + l * 2048,
                a.out + OFF_KP + (size_t)l * MP * 512, a.out + OFF_VP + (size_t)l * MP * 512, a.out + OFF_KS + (size_t)l * MD * 512, a.out + OFF_VS + (size_t)l * MD * 512,
                a.out + OFF_SHP + (size_t)l * NB * NRW, a.out + OFF_SHS + (size_t)l * DECB * NRW, QSCALE};
            pg8::gemm_phase<pg8::EpiProj, pg8::StaticOrder, true, true>(F.lds, g, S, E, opq(F.wave)); } SEAM(pb + 3);
        for (int rep_ = 0; rep_ < REPS(4); ++rep_) if (ON(4, pb + 4)) { if (rep_) xcd_barrier(bar); const Args& a = kargs(); ph_rwkv1(F, a, l); } SEAM(pb + 4);
        if (ON(5, pb + 5)) { const Args& a = kargs(); ph_rwkv2(F, a, l); }
        if (ON(5, pb + 5)) { const Args& a = kargs();
            AttnP P{WSP(bf16, WS_Q), WSP(bf16, WS_KB), WSP(bf16, WS_VB), a.in[I_CK] + (size_t)l * DECB * PAST * 512, a.in[I_CV] + (size_t)l * DECB * PAST * 512, WSP(bf16, WS_YAB), a.in[I_RELB], a.in[I_SUBG] + l * 128,
                    WSP(float, WS_LAM)[l], 1.0f - (0.8f - 0.6f * expf(-0.3f * (float)l))};
            ph_attn(F, P, (unsigned*)(a.ws + WS_CTL) + CW_QUEUE + 64 * l); } SEAM(pb + 5);
        for (int rep_ = 0; rep_ < REPS(6); ++rep_) if (ON(6, pb + 6)) { if (rep_) xcd_barrier(bar); const Args& a = kargs(); ph_rwkv3(F, a, l); } SEAM(pb + 6);
        for (int rep_ = 0; rep_ < REPS(7); ++rep_) if (ON(7, pb + 7)) { if (rep_) xcd_barrier(bar); const Args& a = kargs(); pg8::Gemm g{WSP(bf16, WS_YAB), WSP(const bf16, wlo + WL_BR), 2 * M, 2048, 512}; pg8::PairOrder S{NPAN * 4, opq(F.G), opq((int)blockIdx.x), NPAN}; pg8::EpiMerge E{WSP(bf16, WS_MERGED), WSP(bf16, WS_GATES), NPAN};
            pg8::gemm_phase<pg8::EpiMerge, pg8::PairOrder, true, true>(F.lds, g, S, E, opq(F.wave)); } SEAM(pb + 7);
        for (int rep_ = 0; rep_ < REPS(8); ++rep_) if (ON(8, pb + 8)) { if (rep_) xcd_barrier(bar); const Args& a = kargs(); pg8::Gemm g{WSP(bf16, WS_MERGED), WSP(const bf16, wlo + WL_O), M, D, D}; pg8::SplitOrder S; S.init(MP, D, opq(F.G), opq((int)blockIdx.x), D / 256); pg8::EpiF32S E{WSP(bf16, WS_F), WSP(float, WS_FP), D, MP, MD};
            pg8::gemm_phase<pg8::EpiF32S, pg8::SplitOrder, true, true>(F.lds, g, S, E, opq(F.wave)); } SEAM(pb + 8);
        for (int rep_ = 0; rep_ < REPS(9); ++rep_) if (ON(9, pb + 9)) { if (rep_) xcd_barrier(bar); const Args& a = kargs(); const float* modl = WSP(float, modo);
            ph_ln(F, a.out, nullptr, WSP(bf16, WS_F), 1.0f, modl + 5 * D, a.in[I_LNG] + (l * 3 + 1) * D, a.in[I_LNB] + (l * 3 + 1) * D, modl + 6 * D, a.out, WSP(bf16, WS_U), WSP(float, WS_FP), D / 256); } SEAM(pb + 9);
        for (int rep_ = 0; rep_ < REPS(10); ++rep_) if (ON(10, pb + 10)) { if (rep_) xcd_barrier(bar); const Args& a = kargs(); pg8::Gemm g{WSP(bf16, WS_U), WSP(const bf16, wlo + WL_GU1), M, NGU, D}; pg8::StaticOrder S; S.init(M, NGU, opq(F.G), opq((int)blockIdx.x)); pg8::EpiSwiglu E{WSP(bf16, WS_ACT), DFF};
            pg8::gemm_phase<pg8::EpiSwiglu, pg8::StaticOrder, true, true>(F.lds, g, S, E, opq(F.wave)); } SEAM(pb + 10);
        for (int rep_ = 0; rep_ < REPS(11); ++rep_) if (ON(11, pb + 11)) { if (rep_) xcd_barrier(bar); const Args& a = kargs(); pg8::Gemm g{WSP(bf16, WS_ACT), WSP(const bf16, wlo + WL_DN1), M, D, DFF}; pg8::SplitOrder S; S.init(MP, D, opq(F.G), opq((int)blockIdx.x), DFF / 256); pg8::EpiF32S E{WSP(bf16, WS_F), WSP(float, WS_FP), D, MP, MD};
            pg8::gemm_phase<pg8::EpiF32S, pg8::SplitOrder, true, true>(F.lds, g, S, E, opq(F.wave)); } SEAM(pb + 11);
        for (int rep_ = 0; rep_ < REPS(12); ++rep_) if (ON(12, pb + 12)) { if (rep_) xcd_barrier(bar); const Args& a = kargs(); const float* modl = WSP(float, modo);
            ph_ln(F, a.out, nullptr, WSP(bf16, WS_F), 0.5f, modl + 8 * D, a.in[I_LNG] + (l * 3 + 2) * D, a.in[I_LNB] + (l * 3 + 2) * D, l + 1 < DEPTH ? modl + (size_t)NSEQ * 9216 : nullptr, a.out, WSP(bf16, WS_U), WSP(float, WS_FP), DFF / 256); } SEAM(pb + 12);
    }
#undef IN
#undef ON
#undef SEAM
#undef WSP
}

#if MK_LAUNCH_PER_PHASE
static const void* phase_fn(int k) {
    switch (k) { case 0: return (const void*)fwd<1u << 0>; case 1: return (const void*)fwd<1u << 1>; case 2: return (const void*)fwd<1u << 2>; case 3: return (const void*)fwd<1u << 3>;
        case 4: return (const void*)fwd<1u << 4>; case 5: return (const void*)fwd<1u << 5>; case 6: return (const void*)fwd<1u << 6>; case 7: return (const void*)fwd<1u << 7>;
        case 8: return (const void*)fwd<1u << 8>; case 9: return (const void*)fwd<1u << 9>; case 10: return (const void*)fwd<1u << 10>; case 11: return (const void*)fwd<1u << 11>;
        case 12: return (const void*)fwd<1u << 12>; case 13: return (const void*)fwd<1u << 13>; case 14: return (const void*)fwd<1u << 14>; default: return (const void*)fwd<1u << 15>; }
}
#else
#ifndef FULL_MASK
#define FULL_MASK 0xFFFFu
#endif
static const void* phase_fn(int) { return (const void*)fwd<FULL_MASK>; }
#endif

extern "C" void kernel_launch(void* const* d_in, const int* in_sizes, int n_in, void* d_out, int out_size, void* d_ws, size_t ws_size, hipStream_t stream) {
    static int grid = 0;
    if (grid == 0) {
        if (n_in != 34 || (size_t)out_size != OUT_TOTAL || ws_size < WS_END) { fprintf(stderr, "kernel_launch: unexpected shapes: n_in %d out %d ws %zu (need %zu)\n", n_in, out_size, ws_size, (size_t)WS_END); grid = -1; return; }
        int dev = 0, cus = 0, per_cu = 0;
        if (hipGetDevice(&dev) != hipSuccess || hipDeviceGetAttribute(&cus, hipDeviceAttributeMultiprocessorCount, dev) != hipSuccess) { grid = -1; return; }
        for (int k = 0; k < 16; ++k) if (hipFuncSetAttribute(phase_fn(k), hipFuncAttributeMaxDynamicSharedMemorySize, LDS_BYTES) != hipSuccess) { fprintf(stderr, "kernel_launch: hipFuncSetAttribute failed\n"); grid = -1; return; }
        if (hipOccupancyMaxActiveBlocksPerMultiprocessor(&per_cu, phase_fn(15), NTHR, LDS_BYTES) != hipSuccess || per_cu < 1) fprintf(stderr, "kernel_launch: occupancy query reports %d\n", per_cu);
        (void)hipGetLastError();
        grid = cus;
    }
    if (grid < 0) return;
    (void)hipMemsetAsync((char*)d_ws + WS_CTL, 0, CTL_ZERO_BYTES, stream);
    Args a{};
    for (int i = 0; i < 34; ++i) a.in[i] = (const float*)d_in[i];
    a.out = (float*)d_out; a.ws = (unsigned char*)d_ws;
#if MK_LAUNCH_PER_PHASE
#ifndef MAXPH
#define MAXPH NPH
#endif
    for (int p = 0; p < MAXPH; ++p) { a.ph_lo = p; a.ph_hi = p + 1; const int kind = p < 2 ? 13 + p : (p - 2) % NPH_LAYER; void* kargs[] = {&a}; (void)hipLaunchKernel(phase_fn(kind), dim3(grid), dim3(NTHR), kargs, LDS_BYTES, stream); }
#else
    a.ph_lo = 0; a.ph_hi = NPH; { void* kargs[] = {&a}; (void)hipLaunchKernel(phase_fn(15), dim3(grid), dim3(NTHR), kargs, LDS_BYTES, stream); }
#endif
}
```

```cpp
#include <hip/hip_runtime.h>
#include <hip/hip_bf16.h>
#include <cstdio>
#include <cstdint>
#include <cmath>
namespace pg8 {
#define PG8_LAS __attribute__((address_space(3)))
typedef unsigned short bf16_t;
typedef short bf16x8 __attribute__((ext_vector_type(8)));
typedef float f32x4 __attribute__((ext_vector_type(4)));
typedef unsigned u32x4 __attribute__((ext_vector_type(4)));
constexpr int BM = 256, BK = 64, HALF = 128, HTB = HALF * BK * 2  , STAGE_BYTES = 8 * HTB, NXCD = 8, WGM = 8;

__host__ __device__ __forceinline__ int lds_byte(int r, int c) { const int st = (r >> 4) * 2 + (c >> 5), rr = r & 15, cc = c & 31, ob = rr * 64 + cc * 2; return st * 1024 + (ob ^ (((ob >> 9) & 1) << 5)); }
__host__ __device__ __forceinline__ void stage_rc(int b, int& R, int& C) { const int st = b / 1024, sb = b % 1024, swz = sb ^ (((sb >> 9) & 1) << 5); R = (st >> 1) * 16 + swz / 64; C = (st & 1) * 32 + (swz % 64) / 2; }
__host__ __device__ __forceinline__ int perm32(int rho) { const int n = rho >> 4, i = rho & 15; return 8 * (i >> 2) + 4 * n + (i & 3); }

struct Unit { int pm, pn, k0, ntk, ks; };
struct Gemm { const bf16_t* A; const bf16_t* Bt; int M, N, K; };

struct StaticOrder {
    int nM, nN, nwg, G, c;
    __host__ __device__ void init(int M, int N, int G_, int c_) { nM = M / BM; nN = N / BM; nwg = nM * nN; G = G_; c = c_; }
    __host__ __device__ bool next(int i, Unit& u) const {
        const long L = (long)i * G + c; if (L >= nwg) return false;
        int wgid = (int)L; { const int q = nwg / NXCD, r = nwg % NXCD, xcd = wgid % NXCD, off = wgid / NXCD; wgid = (xcd < r ? xcd * (q + 1) : r * (q + 1) + (xcd - r) * q) + off; }
        const int nig = WGM * nN, gid = wgid / nig, fm = gid * WGM, gsz = (nM - fm) < WGM ? (nM - fm) : WGM;
        u.pm = fm + ((wgid % nig) % gsz); u.pn = (wgid % nig) / gsz; u.k0 = 0; u.ntk = 0; u.ks = -1; return true;
    }
    __device__ __forceinline__ void a_ready(const Unit&) const {}
    __device__ __forceinline__ void done(const Unit&) const {}
};

typedef float f32x2c_t __attribute__((ext_vector_type(2))); typedef __bf16 bf16x2c_t __attribute__((ext_vector_type(2)));
__device__ __forceinline__ unsigned cvt_pk_bf16(float lo, float hi) { f32x2c_t v = {lo, hi}; bf16x2c_t b = __builtin_convertvector(v, bf16x2c_t); return __builtin_bit_cast(unsigned, b); }
typedef float f32x2 __attribute__((ext_vector_type(2)));
__device__ __forceinline__ float fast_sigmoid(float x) { return __builtin_amdgcn_rcpf(1.0f + __expf(-x)); }
struct EpiSwiglu {
    static constexpr bool PERM = true, AFTER_DRAIN = false, KEEPS = false;
    bf16_t* O; int ldc;
    __device__ __forceinline__ void operator()(const f32x4 (&acc)[2][2][4][2], const Unit& u, int wr, int wc, int fr, int fq) const {
        const int row0 = u.pm * BM + wr * 64 + fr; const int col0 = u.pn * 128 + wc * 32 + 8 * fq;
#pragma unroll
        for (int ai = 0; ai < 2; ++ai)
#pragma unroll
            for (int m = 0; m < 4; ++m) { bf16_t* rowp = O + (size_t)(row0 + ai * HALF + m * 16) * ldc + col0;
                float v[8];
#pragma unroll
                for (int n = 0; n < 2; ++n)
#pragma unroll
                    for (int e = 0; e < 4; ++e) { const float g = acc[ai][0][m][n][e], up = acc[ai][1][m][n][e]; v[n * 4 + e] = g * fast_sigmoid(g) * up; }
                u32x4 w; w.x = cvt_pk_bf16(v[0], v[1]); w.y = cvt_pk_bf16(v[2], v[3]); w.z = cvt_pk_bf16(v[4], v[5]); w.w = cvt_pk_bf16(v[6], v[7]);
                *(u32x4*)rowp = w; }
    }
};
struct EpiF32 {
    static constexpr bool PERM = false, AFTER_DRAIN = false, KEEPS = false;
    float* O; int ldc;
    __device__ __forceinline__ void operator()(const f32x4 (&acc)[2][2][4][2], const Unit& u, int wr, int wc, int fr, int fq) const {
        const int row0 = u.pm * BM + wr * 64 + fr; const int col0 = u.pn * BM + wc * 32 + 4 * fq;
#pragma unroll
        for (int ai = 0; ai < 2; ++ai)
#pragma unroll
            for (int m = 0; m < 4; ++m) { float* rowp = O + (size_t)(row0 + ai * HALF + m * 16) * ldc + col0;
#pragma unroll
                for (int bj = 0; bj < 2; ++bj)
#pragma unroll
                    for (int n = 0; n < 2; ++n) *(f32x4*)(rowp + bj * HALF + n * 16) = acc[ai][bj][m][n]; }
    }
};
struct EpiProj {
    static constexpr bool PERM = true, AFTER_DRAIN = false, KEEPS = false;
    bf16_t* Q; bf16_t* Kb; bf16_t* Vb; bf16_t* PRW; bf16_t* GATES; const float* bgate;
    float* outKp; float* outVp; float* outKs; float* outVs; float* outShp; float* outShs;
    float qscale;
    __device__ __forceinline__ void operator()(const f32x4 (&acc)[2][2][4][2], const Unit& u, int wr, int wc, int fr, int fq) const {
        const int row0 = u.pm * BM + wr * 64 + fr; const int pn = u.pn; const int cw = wc * 32 + 8 * fq;
        const bool prompt = u.pm < 128;
        auto pack8 = [](const f32x4& a, const f32x4& b) -> u32x4 { u32x4 w; w.x = cvt_pk_bf16(a[0], a[1]); w.y = cvt_pk_bf16(a[2], a[3]); w.z = cvt_pk_bf16(b[0], b[1]); w.w = cvt_pk_bf16(b[2], b[3]); return w; };
#pragma unroll
        for (int ai = 0; ai < 2; ++ai)
#pragma unroll
            for (int m = 0; m < 4; ++m) { const int row = row0 + ai * HALF + m * 16;
#pragma unroll
                for (int bj = 0; bj < 2; ++bj) { const f32x4 v0 = acc[ai][bj][m][0], v1 = acc[ai][bj][m][1]; const int ct = bj * HALF + cw;
                    if (pn < 2) { const int c = pn * 256 + ct; *(u32x4*)(Q + (size_t)row * 512 + c) = pack8(v0 * qscale, v1 * qscale); }
                    else if (pn < 6) { const bool isk = pn < 4; const int c = (pn - (isk ? 2 : 4)) * 256 + ct;
                        *(u32x4*)((isk ? Kb : Vb) + (size_t)row * 512 + c) = pack8(v0, v1);
                        float* o = prompt ? (isk ? outKp : outVp) + (size_t)row * 512 + c : (isk ? outKs : outVs) + (size_t)(row - 32768) * 512 + c;
                        __builtin_nontemporal_store(v0, (f32x4*)o); __builtin_nontemporal_store(v1, (f32x4*)(o + 4)); }
                    else if (pn < 13) { const int c = (pn - 6) * 256 + ct; *(u32x4*)(PRW + (size_t)row * 1792 + c) = pack8(v0, v1);
                        if (prompt) { if ((row & 8191) == 8191) { float* so = outShp + (size_t)(row >> 13) * 1792 + c; *(f32x4*)so = v0; *(f32x4*)(so + 4) = v1; } }
                        else { const int rd = row - 32768; if ((rd & 31) == 31) { float* so = outShs + (size_t)(rd >> 5) * 1792 + c; *(f32x4*)so = v0; *(f32x4*)(so + 4) = v1; } } }
                    else { const int c = (pn - 13) * 256 + ct; const f32x4 b0 = *(const f32x4*)(bgate + c), b1 = *(const f32x4*)(bgate + c + 4);
                        f32x4 s0, s1;
#pragma unroll
                        for (int e = 0; e < 4; ++e) { s0[e] = fast_sigmoid(v0[e] + b0[e]); s1[e] = fast_sigmoid(v1[e] + b1[e]); }
                        *(u32x4*)(GATES + (size_t)row * 2048 + c) = pack8(s0, s1); }
                } }
    }
};
struct EpiMerge {
    static constexpr bool PERM = true, AFTER_DRAIN = false, KEEPS = true;
    bf16_t* OUT; const bf16_t* GATES; int npan;
    __device__ __forceinline__ bool apply(f32x4 (&acc)[2][2][4][2], const Unit& u, int wr, int wc, int fr, int fq) const {
        const int which = u.pm >= npan ? 1 : 0; const int pm = u.pm - which * npan, pn = u.pn - which * 4;
        const int row0 = pm * BM + wr * 64 + fr; const int col0 = pn * BM + wc * 32 + 8 * fq;
        auto lo4 = [](const u32x4& w) -> f32x4 { f32x4 g; g[0] = __uint_as_float(w.x << 16); g[1] = __uint_as_float(w.x & 0xffff0000u); g[2] = __uint_as_float(w.y << 16); g[3] = __uint_as_float(w.y & 0xffff0000u); return g; };
        auto hi4 = [](const u32x4& w) -> f32x4 { f32x4 g; g[0] = __uint_as_float(w.z << 16); g[1] = __uint_as_float(w.z & 0xffff0000u); g[2] = __uint_as_float(w.w << 16); g[3] = __uint_as_float(w.w & 0xffff0000u); return g; };
        auto clampg = [](f32x4 g) -> f32x4 { g[0] = fmaxf(g[0], 1e-30f); g[1] = fmaxf(g[1], 1e-30f); g[2] = fmaxf(g[2], 1e-30f); g[3] = fmaxf(g[3], 1e-30f); return g; };
        auto rcp4 = [](const f32x4& g) -> f32x4 { f32x4 r; r[0] = __builtin_amdgcn_rcpf(g[0]); r[1] = __builtin_amdgcn_rcpf(g[1]); r[2] = __builtin_amdgcn_rcpf(g[2]); r[3] = __builtin_amdgcn_rcpf(g[3]); return r; };
        u32x4 ac[2], an[2], bc[2], bn[2];
        auto issue = [&](int g) { const int r = row0 + (g >> 2) * HALF + (g & 3) * 16;
#pragma unroll
            for (int bj = 0; bj < 2; ++bj) { bn[bj] = *(const u32x4*)(GATES + (size_t)r * 2048 + 1024 + col0 + bj * HALF); if (!which) an[bj] = *(const u32x4*)(GATES + (size_t)r * 2048 + col0 + bj * HALF); } };
        issue(0);
#pragma unroll
        for (int g = 0; g < 8; ++g) { const int ai = g >> 2, m = g & 3;
#pragma unroll
            for (int bj = 0; bj < 2; ++bj) { ac[bj] = an[bj]; bc[bj] = bn[bj]; }
            if (g < 7) issue(g + 1);
            const size_t ro = (size_t)(row0 + ai * HALF + m * 16) * 1024 + col0;
#pragma unroll
            for (int bj = 0; bj < 2; ++bj) { const f32x4 gb0 = clampg(lo4(bc[bj])), gb1 = clampg(hi4(bc[bj]));
                if (which == 0) { acc[ai][bj][m][0] = acc[ai][bj][m][0] * (lo4(ac[bj]) * rcp4(gb0)); acc[ai][bj][m][1] = acc[ai][bj][m][1] * (hi4(ac[bj]) * rcp4(gb1)); }
                else { const f32x4 t0 = acc[ai][bj][m][0] * gb0, t1 = acc[ai][bj][m][1] * gb1; u32x4 w; w.x = cvt_pk_bf16(t0[0], t0[1]); w.y = cvt_pk_bf16(t0[2], t0[3]); w.z = cvt_pk_bf16(t1[0], t1[1]); w.w = cvt_pk_bf16(t1[2], t1[3]);
                    *(u32x4*)(OUT + ro + bj * HALF) = w; } }
        }
        return which == 0;
    }
};
struct SplitOrder {
    StaticOrder base; int G, c, nslice, nbase;
    __device__ __forceinline__ void init(int Mprompt, int N, int G_, int c_, int nslice_) { base.init(Mprompt, N, G_, c_); G = G_; c = c_; nslice = nslice_; nbase = c_ < base.nwg ? (base.nwg - c_ + G_ - 1) / G_ : 0; }
    __device__ __forceinline__ bool next(int i, Unit& u) const {
        if (i < nbase) return base.next(i, u);
        const int e = (i - nbase) * G + c; if (e >= 16 * nslice) return false;
        const int tile = e / nslice, sl = e - tile * nslice; u.pm = base.nM + (tile >> 2); u.pn = tile & 3; u.k0 = sl * 256; u.ntk = 4; u.ks = sl; return true;
    }
    __device__ __forceinline__ void a_ready(const Unit&) const {}
    __device__ __forceinline__ void done(const Unit&) const {}
};
struct EpiF32S {
    static constexpr bool PERM = true, AFTER_DRAIN = false, KEEPS = false;
    bf16_t* O; float* FP; int ldc, mprompt, mdec;
    __device__ __forceinline__ void operator()(const f32x4 (&acc)[2][2][4][2], const Unit& u, int wr, int wc, int fr, int fq) const {
        const int row0 = u.pm * BM + wr * 64 + fr; const int col0 = u.pn * BM + wc * 32 + 8 * fq;
        if (u.ks < 0) {
#pragma unroll
            for (int ai = 0; ai < 2; ++ai)
#pragma unroll
                for (int m = 0; m < 4; ++m) { bf16_t* rowp = O + (size_t)(row0 + ai * HALF + m * 16) * ldc + col0;
#pragma unroll
                    for (int bj = 0; bj < 2; ++bj) { const f32x4 v0 = acc[ai][bj][m][0], v1 = acc[ai][bj][m][1]; u32x4 w; w.x = cvt_pk_bf16(v0[0], v0[1]); w.y = cvt_pk_bf16(v0[2], v0[3]); w.z = cvt_pk_bf16(v1[0], v1[1]); w.w = cvt_pk_bf16(v1[2], v1[3]);
                        *(u32x4*)(rowp + bj * HALF) = w; } }
        } else {
            float* base = FP + ((size_t)u.ks * mdec + (row0 - mprompt)) * ldc;
#pragma unroll
            for (int ai = 0; ai < 2; ++ai)
#pragma unroll
                for (int m = 0; m < 4; ++m) { float* rowp = base + (size_t)(ai * HALF + m * 16) * ldc + col0;
#pragma unroll
                    for (int bj = 0; bj < 2; ++bj)
#pragma unroll
                        for (int n = 0; n < 2; ++n) *(f32x4*)(rowp + bj * HALF + n * 4) = acc[ai][bj][m][n]; }
        }
    }
};
struct PairOrder {
    int ntile, G, c, npan, tile0;
    __device__ __forceinline__ bool next(int i, Unit& u) const { const int tile = tile0 + (i >> 1) * G + c; if (tile >= ntile) return false; const int which = i & 1; u.pm = (tile >> 2) + which * npan; u.pn = (tile & 3) + which * 4; u.k0 = 0; u.ntk = 0; u.ks = -1; return true; }
    __device__ __forceinline__ void a_ready(const Unit&) const {}
    __device__ __forceinline__ void done(const Unit&) const {}
};
template <class Epi, class Sched, bool ALIGN_EPI = false, bool SP2 = false>
__device__ __forceinline__ void gemm_phase(PG8_LAS unsigned char* lds, const Gemm g, const Sched& S, const Epi& E, int wave_s) {
    unsigned z_ = 0u; asm volatile("" : "+v"(z_));
    int tid_ = wave_s * 64 + (int)__builtin_amdgcn_mbcnt_hi(~0u, __builtin_amdgcn_mbcnt_lo(~0u, z_));
    const int tid = tid_, wid = __builtin_amdgcn_readfirstlane(tid >> 6), lane = tid & 63, wr = wid >> 2, wc = wid & 3, fr = lane & 15, fq = lane >> 4;
    const int K = g.K, ntK = K / BK;
    unsigned voffA[2], voffB[2];
#pragma unroll
    for (int i = 0; i < 2; ++i) { int R, C; stage_rc(tid * 16 + i * 8192, R, C); const int Rb = Epi::PERM ? ((R & ~31) + perm32(R & 31)) : R;
        voffA[i] = (unsigned)(R * K + C) * 2u; voffB[i] = (unsigned)(Rb * K + C) * 2u; }
    const size_t kstep = (size_t)(BK * 2);
    const size_t hstep = (size_t)HALF * K * 2;
    const size_t tstep = 2 * hstep;
    const unsigned ldsw = (unsigned)wid * 1024u;
    const int aoff = lds_byte(wr * 64 + fr, fq * 8), boff = lds_byte(wc * 32 + fr, fq * 8);
#define PG8_SA(b, h) (((b) * 2 + (h)) * HTB)
#define PG8_SB(b, h) ((4 + (b) * 2 + (h)) * HTB)
#define PG8_STAGE(bufoff, gbase, voff) do { _Pragma("unroll") for (int _i = 0; _i < 2; ++_i) \
        __builtin_amdgcn_global_load_lds((const unsigned*)((const char*)(gbase) + (voff)[_i]), (PG8_LAS unsigned*)(lds + (bufoff) + ldsw + _i * 8192), 16, 0, 0); } while (0)
#define PG8_LDA(dst, b, h) do { _Pragma("unroll") for (int m = 0; m < 4; ++m) _Pragma("unroll") for (int k = 0; k < 2; ++k) dst[m][k] = *(const PG8_LAS bf16x8*)(lds + PG8_SA(b, h) + aoff + m * 2048 + k * 1024); } while (0)
#define PG8_LDB(dst, b, h) do { _Pragma("unroll") for (int n = 0; n < 2; ++n) _Pragma("unroll") for (int k = 0; k < 2; ++k) dst[n][k] = *(const PG8_LAS bf16x8*)(lds + PG8_SB(b, h) + boff + n * 2048 + k * 1024); } while (0)
#define PG8_MMA(ai, bj, At, Bt) do { __builtin_amdgcn_s_setprio(1); _Pragma("unroll") for (int m = 0; m < 4; ++m) _Pragma("unroll") for (int n = 0; n < 2; ++n) _Pragma("unroll") for (int k = 0; k < 2; ++k) \
        acc[ai][bj][m][n] = __builtin_amdgcn_mfma_f32_16x16x32_bf16(Bt[n][k], At[m][k], acc[ai][bj][m][n], 0, 0, 0); __builtin_amdgcn_s_setprio(0); } while (0)
#define PG8_WAIT_V(n) asm volatile("s_waitcnt vmcnt(" #n ")" ::: "memory")
#define PG8_WAIT_L(n) asm volatile("s_waitcnt lgkmcnt(" #n ")" ::: "memory")
#define PG8_BAR __builtin_amdgcn_s_barrier()
#define PG8_SCHED __builtin_amdgcn_sched_barrier(0)
    Unit cur, nxt; int ui = 0;
    if (!S.next(0, cur)) return;
    f32x4 acc[2][2][4][2];
#pragma unroll
    for (int a = 0; a < 2; ++a)
#pragma unroll
        for (int b = 0; b < 2; ++b)
#pragma unroll
            for (int m = 0; m < 4; ++m)
#pragma unroll
                for (int n = 0; n < 2; ++n) acc[a][b][m][n] = (f32x4){0.f, 0.f, 0.f, 0.f};
    bf16x8 At[4][2], B0[2][2], B1[2][2];
    const char* cA = (const char*)g.A + (size_t)cur.pm * tstep + (size_t)cur.k0 * 2; const char* cB = (const char*)g.Bt + (size_t)cur.pn * tstep + (size_t)cur.k0 * 2;
    S.a_ready(cur);
    if constexpr (SP2) {
        PG8_STAGE(PG8_SB(0, 0), cB, voffB); PG8_STAGE(PG8_SB(0, 1), cB + hstep, voffB); PG8_STAGE(PG8_SA(0, 0), cA, voffA); PG8_STAGE(PG8_SA(0, 1), cA + hstep, voffA);
        if (wr == 1) PG8_BAR;
        PG8_WAIT_V(2); PG8_BAR;
        PG8_STAGE(PG8_SB(1, 0), cB + kstep, voffB); PG8_STAGE(PG8_SA(1, 0), cA + kstep, voffA); PG8_STAGE(PG8_SB(1, 1), cB + hstep + kstep, voffB);
        PG8_WAIT_V(6); PG8_BAR;
    } else {
        PG8_STAGE(PG8_SB(0, 0), cB, voffB); PG8_STAGE(PG8_SA(0, 0), cA, voffA); PG8_STAGE(PG8_SB(0, 1), cB + hstep, voffB); PG8_STAGE(PG8_SA(0, 1), cA + hstep, voffA);
        if (wr == 1) PG8_BAR;
        PG8_WAIT_V(4); PG8_BAR;
        PG8_STAGE(PG8_SB(1, 0), cB + kstep, voffB); PG8_STAGE(PG8_SA(1, 0), cA + kstep, voffA); PG8_STAGE(PG8_SB(1, 1), cB + hstep + kstep, voffB);
        PG8_WAIT_V(6); PG8_BAR;
    }
    for (;;) {
        const bool has_next = S.next(ui + 1, nxt);
        const char* nA = has_next ? (const char*)g.A + (size_t)nxt.pm * tstep + (size_t)nxt.k0 * 2 : cA; const char* nB = has_next ? (const char*)g.Bt + (size_t)nxt.pn * tstep + (size_t)nxt.k0 * 2 : cB;
        const int nt = cur.ntk ? cur.ntk : ntK;
        for (int t = 0; t < nt; t += 2) {
            const bool last = (t == nt - 2);
            const char* a1 = cA + (size_t)(t + 1) * kstep;
            const char* a2 = last ? nA : cA + (size_t)(t + 2) * kstep; const char* b2 = last ? nB : cB + (size_t)(t + 2) * kstep;
            const char* a3 = a2 + kstep; const char* b3 = b2 + kstep;
            if (last && has_next) S.a_ready(nxt);
            if constexpr (SP2) {
            PG8_LDB(B0, 0, 0); PG8_LDB(B1, 0, 1); PG8_SCHED; PG8_LDA(At, 0, 0); PG8_STAGE(PG8_SA(1, 1), a1 + hstep, voffA);
            PG8_WAIT_V(8); PG8_WAIT_L(0); PG8_BAR; PG8_MMA(0, 0, At, B0); PG8_MMA(0, 1, At, B1); PG8_BAR; PG8_SCHED;
            PG8_LDA(At, 0, 1); PG8_STAGE(PG8_SB(0, 0), b2, voffB); PG8_STAGE(PG8_SB(0, 1), b2 + hstep, voffB); PG8_STAGE(PG8_SA(0, 0), a2, voffA);
            PG8_WAIT_V(8); PG8_WAIT_L(0); PG8_BAR; PG8_MMA(1, 0, At, B0); PG8_MMA(1, 1, At, B1); PG8_BAR; PG8_SCHED;
            PG8_LDB(B0, 1, 0); PG8_LDB(B1, 1, 1); PG8_SCHED; PG8_LDA(At, 1, 0); PG8_STAGE(PG8_SA(0, 1), a2 + hstep, voffA);
            PG8_WAIT_V(8); PG8_WAIT_L(0); PG8_BAR; PG8_MMA(0, 0, At, B0); PG8_MMA(0, 1, At, B1); PG8_BAR; PG8_SCHED;
            PG8_LDA(At, 1, 1); PG8_STAGE(PG8_SB(1, 0), b3, voffB); PG8_STAGE(PG8_SB(1, 1), b3 + hstep, voffB); PG8_STAGE(PG8_SA(1, 0), a3, voffA);
            PG8_WAIT_V(8); PG8_WAIT_L(0); PG8_BAR; PG8_MMA(1, 0, At, B0); PG8_MMA(1, 1, At, B1); PG8_BAR; PG8_SCHED;
            } else {
            PG8_LDB(B0, 0, 0); PG8_SCHED; PG8_LDA(At, 0, 0); PG8_STAGE(PG8_SA(1, 1), a1 + hstep, voffA);
            PG8_WAIT_L(8); PG8_BAR; PG8_WAIT_L(0); PG8_MMA(0, 0, At, B0); PG8_BAR; PG8_SCHED;
            PG8_LDB(B1, 0, 1); PG8_STAGE(PG8_SB(0, 0), b2, voffB);
            PG8_BAR; PG8_WAIT_L(0); PG8_MMA(0, 1, At, B1); PG8_BAR;
            PG8_LDA(At, 0, 1); PG8_STAGE(PG8_SA(0, 0), a2, voffA);
            PG8_BAR; PG8_WAIT_L(0); PG8_MMA(1, 0, At, B0); PG8_BAR; PG8_SCHED;
            PG8_STAGE(PG8_SB(0, 1), b2 + hstep, voffB);
            PG8_WAIT_V(6); PG8_BAR; PG8_MMA(1, 1, At, B1); PG8_BAR;
            PG8_LDB(B0, 1, 0); PG8_SCHED; PG8_LDA(At, 1, 0); PG8_STAGE(PG8_SA(0, 1), a2 + hstep, voffA);
            PG8_WAIT_L(8); PG8_BAR; PG8_WAIT_L(0); PG8_MMA(0, 0, At, B0); PG8_BAR; PG8_SCHED;
            PG8_LDB(B1, 1, 1); PG8_STAGE(PG8_SB(1, 0), b3, voffB);
            PG8_BAR; PG8_WAIT_L(0); PG8_MMA(0, 1, At, B1); PG8_BAR;
            PG8_LDA(At, 1, 1); PG8_STAGE(PG8_SA(1, 0), a3, voffA);
            PG8_BAR; PG8_WAIT_L(0); PG8_MMA(1, 0, At, B0); PG8_BAR; PG8_SCHED;
            PG8_STAGE(PG8_SB(1, 1), b3 + hstep, voffB);
            PG8_WAIT_V(6); PG8_BAR; PG8_MMA(1, 1, At, B1); PG8_BAR;
            }
        }
        if constexpr (ALIGN_EPI) { if (wr == 0) PG8_BAR; }
        bool keep_acc = false;
        if constexpr (!Epi::AFTER_DRAIN) { if constexpr (Epi::KEEPS) keep_acc = E.apply(acc, cur, wr, wc, fr, fq); else E(acc, cur, wr, wc, fr, fq); S.done(cur); }
        if (!has_next) break;
        if (!keep_acc)
#pragma unroll
        for (int a = 0; a < 2; ++a)
#pragma unroll
            for (int b = 0; b < 2; ++b)
#pragma unroll
                for (int m = 0; m < 4; ++m)
#pragma unroll
                    for (int n = 0; n < 2; ++n) acc[a][b][m][n] = (f32x4){0.f, 0.f, 0.f, 0.f};
        cur = nxt; cA = nA; cB = nB; ++ui;
        if constexpr (ALIGN_EPI) { if (wr == 1) PG8_BAR; }
    }
    PG8_WAIT_V(0);
    if constexpr (!ALIGN_EPI) { if (wr == 0) PG8_BAR; }
    PG8_BAR;
    if constexpr (Epi::AFTER_DRAIN) { E.fused(acc, cur, wr, wc, fr, fq, lds, wid, lane); S.done(cur); }
#undef PG8_SA
#undef PG8_SB
#undef PG8_STAGE
#undef PG8_LDA
#undef PG8_LDB
#undef PG8_MMA
#undef PG8_WAIT_V
#undef PG8_WAIT_L
#undef PG8_BAR
#undef PG8_SCHED
}
}
using pg8::fast_sigmoid;
#define GAS __attribute__((address_space(1)))
#define LAS __attribute__((address_space(3)))
typedef unsigned short bf16;
typedef unsigned v4u __attribute__((ext_vector_type(4)));
typedef float f32x4 __attribute__((ext_vector_type(4)));
typedef short bf16x8 __attribute__((ext_vector_type(8)));
typedef GAS unsigned gu32;
typedef GAS unsigned long long gu64;
#define RLX_AGENT __ATOMIC_RELAXED, __HIP_MEMORY_SCOPE_AGENT
#define LDS_WAIT() asm volatile("s_waitcnt lgkmcnt(0)" ::: "memory")
#define VM_WAIT() asm volatile("s_waitcnt vmcnt(0)" ::: "memory")
__device__ __forceinline__ unsigned long long rt() { return __builtin_amdgcn_s_memrealtime(); }
__device__ __forceinline__ unsigned f2bf(float f) { unsigned u = __builtin_bit_cast(unsigned, f); return (u + 0x7fffu + ((u >> 16) & 1u)) >> 16; }
__device__ __forceinline__ unsigned pk2(float lo, float hi) { return f2bf(lo) | (f2bf(hi) << 16); }

#define XB_TMO      128
#define XB_XCNT(j)  (256  + 64 * (j))
#define XB_XSUB(j)  (1280 + 64 * (j))
#define XB_XGEN(j)  (2304 + 64 * (j))
#define XB_TOP      3328
#define XB_TOPGEN   3392
#define XCD_BAR_WORDS 3456
#define XB_SPIN_CAP (1u << 18)

__device__ __forceinline__ unsigned xb_ld(unsigned* p)              { return __hip_atomic_load(p, __ATOMIC_RELAXED, __HIP_MEMORY_SCOPE_AGENT); }
__device__ __forceinline__ unsigned xb_add(unsigned* p, unsigned v) { return __hip_atomic_fetch_add(p, v, __ATOMIC_RELAXED, __HIP_MEMORY_SCOPE_AGENT); }
__device__ __forceinline__ unsigned xb_xcc_id() { return (unsigned)__builtin_amdgcn_s_getreg((3 << 11) | 20) & 0xFu; }
#define XB_SPIN(cond, bar) do { unsigned _sp = 0; while (cond) { __builtin_amdgcn_s_sleep(1); \
    if ((++_sp & 255u) == 0u) { if (xb_ld(&(bar)[XB_TMO])) break; if (_sp > XB_SPIN_CAP) { atomicAdd(&(bar)[XB_TMO], 1u); break; } } } } while (0)

struct XcdBarrier {
    int wave;
    unsigned* bar; unsigned x;
    volatile LAS unsigned* st;
};

__device__ __forceinline__ XcdBarrier xcd_barrier_post(unsigned* bar, volatile LAS unsigned* st) {
    XcdBarrier b; b.bar = bar; b.x = xb_xcc_id(); b.st = st;
    if (threadIdx.x == 0) (void)xb_add(&bar[XB_XCNT(b.x)], 1u);
    return b;
}
__device__ __forceinline__ void xcd_barrier_complete(unsigned* bar, unsigned x, unsigned& nloc, unsigned& nx) {
    const unsigned G = gridDim.x * gridDim.y * gridDim.z;
    unsigned sum, cnt, mine, sp = 0u;
    for (;;) {
        sum = 0u; cnt = 0u; mine = 0u;
#pragma unroll
        for (unsigned j = 0; j < 16; ++j) { const unsigned c = xb_ld(&bar[XB_XCNT(j)]); sum += c; cnt += (c > 0u) ? 1u : 0u; mine = (j == x) ? c : mine; }
        if (sum == G) break;
        __builtin_amdgcn_s_sleep(1);
        if ((++sp & 255u) == 0u) { if (xb_ld(&bar[XB_TMO])) break; if (sp > XB_SPIN_CAP) { atomicAdd(&bar[XB_TMO], 1u); break; } }
    }
    nloc = mine > 0u ? mine : 1u; nx = cnt > 0u ? cnt : 1u;
}

__device__ __forceinline__ void xcd_barrier(const XcdBarrier& b) {
    asm volatile("s_waitcnt vmcnt(0)" ::: "memory");
    __syncthreads();
    unsigned lz_ = 0u; asm volatile("" : "+v"(lz_));
    if (b.wave == 0 && __builtin_amdgcn_mbcnt_hi(~0u, __builtin_amdgcn_mbcnt_lo(~0u, lz_)) == 0u) {
        unsigned* bar = b.bar;
        __builtin_amdgcn_s_waitcnt(0);
        unsigned nloc = b.st[0], nx = b.st[1];
        if (nloc == 0u) { xcd_barrier_complete(bar, b.x, nloc, nx); b.st[0] = nloc; b.st[1] = nx; }
        const unsigned old = xb_add(&bar[XB_XSUB(b.x)], 1u);
        const unsigned gen = old / nloc;
        if (old + 1u == (gen + 1u) * nloc) {
            __builtin_amdgcn_fence(__ATOMIC_RELEASE, "agent");
            asm volatile("s_waitcnt vmcnt(0)" ::: "memory");
            const unsigned og = xb_add(&bar[XB_TOP], 1u);
            const unsigned tg = og / nx;
            if (og + 1u == (tg + 1u) * nx) xb_add(&bar[XB_TOPGEN], 1u);
            else XB_SPIN(xb_ld(&bar[XB_TOPGEN]) == tg, bar);
            __builtin_amdgcn_fence(__ATOMIC_ACQUIRE, "agent");
            xb_add(&bar[XB_XGEN(b.x)], 1u);
            asm volatile("s_waitcnt vmcnt(0)" ::: "memory");
        } else {
            XB_SPIN(xb_ld(&bar[XB_XGEN(b.x)]) == gen, bar);
            __builtin_amdgcn_fence(__ATOMIC_ACQUIRE, "agent");
            asm volatile("s_waitcnt vmcnt(0)" ::: "memory");
        }
    }
    __syncthreads();
}
constexpr int NWAVES = 8, NTHR = 512;
constexpr int D = 1024, NB = 4, SEQ = 8192, DEPTH = 4, DECB = 32, DECS = 32, PAST = 2048;
constexpr int MP = NB * SEQ, MD = DECB * DECS, M = MP + MD, NPAN = M / 256, NSEQ = NB + DECB;
constexpr int DFF = 2816, NGU = 2 * DFF, NIN = 3328, NRW = 1792, NIG = NIN + 2 * D;
constexpr int HA = 4, HB = 8;
constexpr float LN_EPS = 1e-5f, GN_EPS = 64e-5f;
constexpr float ALPHA = 1.681792830507429f;
constexpr float QSCALE = 0.125f * 1.4426950408889634f;
constexpr float LOG2E = 1.4426950408889634f;
constexpr size_t OFF_Y = 0, OFF_KP = (size_t)M * D, OFF_VP = OFF_KP + (size_t)DEPTH * MP * 512, OFF_WKVP = OFF_VP + (size_t)DEPTH * MP * 512,
    OFF_SHP = OFF_WKVP + (size_t)DEPTH * NB * HB * 4096, OFF_KS = OFF_SHP + (size_t)DEPTH * NB * NRW, OFF_VS = OFF_KS + (size_t)DEPTH * MD * 512,
    OFF_WKVS = OFF_VS + (size_t)DEPTH * MD * 512, OFF_SHS = OFF_WKVS + (size_t)DEPTH * DECB * HB * 4096, OUT_TOTAL = OFF_SHS + (size_t)DEPTH * DECB * NRW;
static_assert(OUT_TOTAL == 177991680ull, "output size");
constexpr size_t al256(size_t x) { return (x + 255) & ~(size_t)255; }
constexpr size_t WS_CTL = 0, CTL_ZERO_BYTES = 1u << 20;
constexpr size_t WS_MOD = CTL_ZERO_BYTES;
constexpr size_t WS_LAM = WS_MOD + al256((size_t)DEPTH * NSEQ * 9 * D * 4);
constexpr size_t WS_W = WS_LAM + 256;
constexpr size_t WL_GU0 = 0, WL_GU1 = WL_GU0 + (size_t)NGU * D * 2, WL_DN0 = WL_GU1 + (size_t)NGU * D * 2, WL_DN1 = WL_DN0 + (size_t)D * DFF * 2,
    WL_IG = WL_DN1 + (size_t)D * DFF * 2, WL_BR = WL_IG + (size_t)NIG * D * 2, WL_O = WL_BR + (size_t)2048 * 512 * 2, WL_W2 = WL_O + (size_t)D * D * 2,
    WL_A2 = WL_W2 + 512 * 64 * 2, WL_G2 = WL_A2 + 512 * 64 * 2, WL_SIZE = WL_G2 + 512 * 128 * 2;
constexpr size_t WS_U = WS_W + (size_t)DEPTH * WL_SIZE;
constexpr size_t WS_ACT = WS_U + (size_t)M * D * 2;
constexpr size_t WS_F = WS_ACT + (size_t)M * DFF * 2;
constexpr size_t WS_Q = WS_F + (size_t)M * D * 4;
constexpr size_t WS_KB = WS_Q + (size_t)M * 512 * 2, WS_VB = WS_KB + (size_t)M * 512 * 2;
constexpr size_t WS_PRW = WS_VB + (size_t)M * 512 * 2;
constexpr size_t WS_GATES = WS_PRW + (size_t)M * NRW * 4;
constexpr size_t WS_YAB = WS_GATES + (size_t)M * 2048 * 2;
constexpr size_t WS_MERGED = WS_YAB + (size_t)2 * M * 512 * 2;
constexpr int NITEM_P = NB * (SEQ / 64) * HB, NITEM = NITEM_P + DECB * HB;
constexpr size_t WS_PT = WS_MERGED + (size_t)M * D * 2;
constexpr size_t WS_QT = WS_PT + (size_t)NITEM * 8192;
constexpr size_t WS_HT = WS_QT + (size_t)NITEM * 8192;
constexpr size_t WS_OT = WS_HT + (size_t)NITEM * 16384;
constexpr size_t WS_OB = WS_OT + (size_t)NITEM * 16384;
constexpr size_t WS_GG = WS_OB + (size_t)M * 512 * 4, WS_BON = WS_GG + (size_t)NITEM * 16384;
constexpr size_t WS_SC = WS_BON + (size_t)NITEM * 16384;
constexpr size_t WS_PLB = WS_SC + (size_t)NITEM * 8192;
constexpr size_t WS_SSB = WS_PLB + (size_t)M * 256 * 2;
constexpr size_t WS_FP = al256(WS_SSB + (size_t)DEPTH * DECB * 256 * 2);
constexpr size_t WS_XB = WS_FP + (size_t)11 * MD * D * 4;
constexpr size_t WS_END = WS_XB + (size_t)M * D * 2;
constexpr int CW_TMO = 0, CW_BAR = 4096, CW_QUEUE = 8192;
constexpr int RING_BYTES = 131072, EXTRA_OFF = 131072, LDSCTL_OFF = 146944, LDS_BYTES = 147456;

struct Args { const float* in[34]; float* out; unsigned char* ws; int ph_lo, ph_hi; };
static_assert(sizeof(Args) == 36 * 8 + 8, "Args has no padding");
enum { I_XP = 0, I_XS, I_CP, I_CS, I_CK, I_CV, I_SWKV, I_SSH, I_RELB, I_WADA, I_BADA, I_LNG, I_LNB, I_WGU, I_WDN, I_WIN, I_LAMQK, I_SUBG, I_MU, I_W0, I_W2, I_A0, I_A2, I_G2,
       I_KK, I_KA, I_RK, I_LNXG, I_LNXB, I_BRA, I_BRB, I_WGATE, I_BGATE, I_WO };

struct Frame { LAS unsigned char* lds; int tid, lane, wave, vcu, G; };

__device__ __forceinline__ int opq(int x) { asm volatile("" : "+s"(x)); return x; }
__device__ __forceinline__ Frame relaunder(const Frame& F) { Frame G = F; G.vcu = opq(G.vcu); G.G = opq(G.G); G.wave = opq(F.wave); { unsigned z_ = 0u; asm volatile("" : "+v"(z_)); G.lane = (int)__builtin_amdgcn_mbcnt_hi(~0u, __builtin_amdgcn_mbcnt_lo(~0u, z_)); }   G.tid = G.wave * 64 + G.lane; return G; }
__device__ __forceinline__ int row_seq(int row) { return row < MP ? (row >> 13) : NB + ((row - MP) >> 5); }
__device__ __forceinline__ int crow(int r, int hi) { return (r & 3) + 8 * (r >> 2) + 4 * hi; }
template <int CTRL> __device__ __forceinline__ float dpp_mov(float x) { return __builtin_bit_cast(float, __builtin_amdgcn_update_dpp(0, __builtin_bit_cast(int, x), CTRL, 0xF, 0xF, true)); }
template <int CTRL, int ROWMASK> __device__ __forceinline__ float dpp_rows(float x) { return __builtin_bit_cast(float, __builtin_amdgcn_update_dpp(0, __builtin_bit_cast(int, x), CTRL, ROWMASK, 0xF, false)); }
__device__ __forceinline__ float wave_sum(float v) {
    v += dpp_mov<0xB1>(v); v += dpp_mov<0x4E>(v); v += dpp_mov<0x141>(v); v += dpp_mov<0x140>(v);
    v += dpp_rows<0x142, 0xA>(v); v += dpp_rows<0x143, 0xC>(v);
    return __builtin_bit_cast(float, __builtin_amdgcn_readlane(__builtin_bit_cast(int, v), 63));
}
__device__ __forceinline__ void wave_sum2(float& a, float& b) {
    a += dpp_mov<0xB1>(a); b += dpp_mov<0xB1>(b); a += dpp_mov<0x4E>(a); b += dpp_mov<0x4E>(b); a += dpp_mov<0x141>(a); b += dpp_mov<0x141>(b); a += dpp_mov<0x140>(a); b += dpp_mov<0x140>(b);
    a += dpp_rows<0x142, 0xA>(a); b += dpp_rows<0x142, 0xA>(b); a += dpp_rows<0x143, 0xC>(a); b += dpp_rows<0x143, 0xC>(b);
    a = __builtin_bit_cast(float, __builtin_amdgcn_readlane(__builtin_bit_cast(int, a), 63)); b = __builtin_bit_cast(float, __builtin_amdgcn_readlane(__builtin_bit_cast(int, b), 63));
}
__device__ __forceinline__ unsigned cvtpk(float lo, float hi) { return pg8::cvt_pk_bf16(lo, hi); }
__device__ __forceinline__ unsigned short f2bf1(float x) { return (unsigned short)(pg8::cvt_pk_bf16(x, 0.f) & 0xffffu); }
__device__ __forceinline__ float bf2f(bf16 b) { return __uint_as_float((unsigned)b << 16); }
typedef float f32x16 __attribute__((ext_vector_type(16)));
typedef unsigned u32x2 __attribute__((ext_vector_type(2)));
#define LP(T, p) ((LAS T*)(p))

__device__ __forceinline__ void p0_transpose_item(const float* W, int K, int N, bf16* WT, int k0, int n0, int drow0, LAS float* scr, int lane) {
    float wv[32];
#pragma unroll
    for (int i = 0; i < 32; ++i) wv[i] = W[(size_t)(k0 + 2 * i + (lane >> 5)) * N + n0 + (lane & 31)];
#pragma unroll
    for (int i = 0; i < 32; ++i) scr[(2 * i + (lane >> 5)) * 33 + (lane & 31)] = wv[i];
    LDS_WAIT(); asm volatile("" ::: "memory");
    const int c = lane & 7;
#pragma unroll
    for (int j = 0; j < 4; ++j) { const int n = (lane >> 3) + 8 * j; const LAS float* s = scr + (8 * c) * 33 + n;
        v4u o; o.x = pk2(s[0 * 33], s[1 * 33]); o.y = pk2(s[2 * 33], s[3 * 33]); o.z = pk2(s[4 * 33], s[5 * 33]); o.w = pk2(s[6 * 33], s[7 * 33]);
        *(GAS v4u*)(WT + (size_t)(drow0 + n) * K + k0 + 8 * c) = o; }
    LDS_WAIT(); asm volatile("" ::: "memory");
}
__device__ __forceinline__ void conv_mat(const float* W, int K, int N, bf16* WT, int r, int row_off, bool gu, LAS float* scr, int lane) {
    const int nblk = N / 32, kb = r / nblk, nb = r % nblk, n0 = 32 * nb; int drow0 = row_off + n0;
    if (gu) { drow0 = n0 < DFF ? 256 * (n0 / 128) + (n0 % 128) : 256 * ((n0 - DFF) / 128) + 128 + ((n0 - DFF) % 128); }
    p0_transpose_item(W, K, N, WT, 64 * kb, n0, drow0, scr, lane);
}
constexpr int CV0 = 16 * 176, CV2 = 44 * 32, CV4 = 16 * 104, CV5 = 16 * 64, CV6 = 8 * 32, CV8 = 16 * 32, CV9 = 16, CV11 = 32;
constexpr int CONV_PER_L = 2 * CV0 + 2 * CV2 + CV4 + CV5 + 2 * CV6 + CV8 + 2 * CV9 + CV11;
__device__ __forceinline__ void conv_item(const Args& a, unsigned char* ws, int l, int r, LAS float* scr, int lane) {
    unsigned char* wl = ws + WS_W + (size_t)l * WL_SIZE;
    if (r < CV0) { conv_mat(a.in[I_WGU] + (size_t)(l * 2 + 0) * D * NGU, D, NGU, (bf16*)(wl + WL_GU0), r, 0, true, scr, lane); return; } r -= CV0;
    if (r < CV0) { conv_mat(a.in[I_WGU] + (size_t)(l * 2 + 1) * D * NGU, D, NGU, (bf16*)(wl + WL_GU1), r, 0, true, scr, lane); return; } r -= CV0;
    if (r < CV2) { conv_mat(a.in[I_WDN] + (size_t)(l * 2 + 0) * DFF * D, DFF, D, (bf16*)(wl + WL_DN0), r, 0, false, scr, lane); return; } r -= CV2;
    if (r < CV2) { conv_mat(a.in[I_WDN] + (size_t)(l * 2 + 1) * DFF * D, DFF, D, (bf16*)(wl + WL_DN1), r, 0, false, scr, lane); return; } r -= CV2;
    if (r < CV4) { conv_mat(a.in[I_WIN] + (size_t)l * D * NIN, D, NIN, (bf16*)(wl + WL_IG), r, 0, false, scr, lane); return; } r -= CV4;
    if (r < CV5) { conv_mat(a.in[I_WGATE] + (size_t)l * D * 2048, D, 2048, (bf16*)(wl + WL_IG), r, NIN, false, scr, lane); return; } r -= CV5;
    if (r < CV6) { conv_mat(a.in[I_BRA] + (size_t)l * 512 * D, 512, D, (bf16*)(wl + WL_BR), r, 0, false, scr, lane); return; } r -= CV6;
    if (r < CV6) { conv_mat(a.in[I_BRB] + (size_t)l * 512 * D, 512, D, (bf16*)(wl + WL_BR), r, 1024, false, scr, lane); return; } r -= CV6;
    if (r < CV8) { conv_mat(a.in[I_WO] + (size_t)l * D * D, D, D, (bf16*)(wl + WL_O), r, 0, false, scr, lane); return; } r -= CV8;
    if (r < CV9) { conv_mat(a.in[I_W2] + (size_t)l * 64 * 512, 64, 512, (bf16*)(wl + WL_W2), r, 0, false, scr, lane); return; } r -= CV9;
    if (r < CV9) { conv_mat(a.in[I_A2] + (size_t)l * 64 * 512, 64, 512, (bf16*)(wl + WL_A2), r, 0, false, scr, lane); return; } r -= CV9;
    conv_mat(a.in[I_G2] + (size_t)l * 128 * 512, 128, 512, (bf16*)(wl + WL_G2), r, 0, false, scr, lane);
}
__device__ __forceinline__ void ph_conv_idle(const Frame& F0, const Args& a, int lnext, int nunits) {
    const Frame F = relaunder(F0);
    const int G = F.G, c = opq((int)blockIdx.x), nextra = nunits % G, nfree = nextra ? G - nextra : G, idx = nextra ? c - nextra : c;
    if (idx < 0) return;
    LAS float* scr = LP(float, F.lds + F.wave * 8448);
#pragma unroll 1
    for (int it = idx * NWAVES + F.wave; it < CONV_PER_L; it += nfree * NWAVES) conv_item(a, a.ws, lnext, it, scr, F.lane);
}
__device__ __forceinline__ void ph_prologue(const Frame& F0, const Args& a) {
    const Frame F = relaunder(F0);
    unsigned char* ws = a.ws;
    LAS bf16* sc = LP(bf16, F.lds);
    for (int i = F.tid; i < NSEQ * D; i += NTHR) { const int s = i >> 10, k = i & 1023; const float c = s < NB ? a.in[I_CP][s * D + k] : a.in[I_CS][(s - NB) * D + k];
        sc[s * 1032 + k] = (bf16)f2bf(c * fast_sigmoid(c)); }
    __syncthreads();
    const int gw = F.vcu * NWAVES + F.wave, NGW = F.G * NWAVES; const int lane = F.lane, r32 = lane & 31, hi = lane >> 5;
    float* MOD = (float*)(ws + WS_MOD);
    for (int it = gw; it < DEPTH * 288; it += NGW) {
        const int l = it / 288, n0 = (it % 288) * 32;
        const float* W = a.in[I_WADA] + (size_t)l * D * 9216 + n0 + r32;
        f32x16 acc0 = {}, acc1 = {};
        const int rowB = (32 + r32) < NSEQ ? 32 + r32 : NSEQ - 1;
#pragma unroll 4
        for (int s = 0; s < 64; ++s) {
            const float* wp = W + (size_t)(16 * s + 8 * hi) * 9216;
            float w[8];
#pragma unroll
            for (int j = 0; j < 8; ++j) w[j] = wp[(size_t)j * 9216];
            v4u bw; bw.x = cvtpk(w[0], w[1]); bw.y = cvtpk(w[2], w[3]); bw.z = cvtpk(w[4], w[5]); bw.w = cvtpk(w[6], w[7]);
            const bf16x8 bfrag = __builtin_bit_cast(bf16x8, bw);
            const bf16x8 a0 = *LP(const bf16x8, sc + r32 * 1032 + 16 * s + 8 * hi);
            const bf16x8 a1 = *LP(const bf16x8, sc + rowB * 1032 + 16 * s + 8 * hi);
            acc0 = __builtin_amdgcn_mfma_f32_32x32x16_bf16(a0, bfrag, acc0, 0, 0, 0);
            acc1 = __builtin_amdgcn_mfma_f32_32x32x16_bf16(a1, bfrag, acc1, 0, 0, 0);
        }
        const float bias = a.in[I_BADA][(size_t)l * 9216 + n0 + r32];
#pragma unroll
        for (int r = 0; r < 16; ++r) { const int s0 = crow(r, hi); MOD[((size_t)l * NSEQ + s0) * 9216 + n0 + r32] = acc0[r] + bias;
            const int s1 = 32 + s0; if (s1 < NSEQ) MOD[((size_t)l * NSEQ + s1) * 9216 + n0 + r32] = acc1[r] + bias; }
    }
    LAS float* scr = LP(float, F.lds + 74304 + F.wave * 8448);
    for (int it = gw; it < CONV_PER_L; it += NGW) conv_item(a, ws, 0, it, scr, lane);
    for (int z = gw * 64 + lane; z < DEPTH * DECB * 256; z += NGW * 64) ((bf16*)(ws + WS_SSB))[z] = (bf16)f2bf(a.in[I_SSH][(size_t)(z >> 8) * NRW + 1536 + (z & 255)]);
    if (blockIdx.x == 0 && F.wave == 0) {
        for (int l = 0; l < DEPTH; ++l) { const float* lq = a.in[I_LAMQK] + l * 256;
            const float s1 = wave_sum(lq[lane] * lq[64 + lane]), s2 = wave_sum(lq[128 + lane] * lq[192 + lane]);
            const float lam_init = 0.8f - 0.6f * expf(-0.3f * (float)l);
            if (lane == 0) ((float*)(ws + WS_LAM))[l] = expf(s1) - expf(s2) + lam_init; }
    }
}

template <bool HASF, bool XBIN, bool XBOUT, bool MODN>
__device__ __forceinline__ void ph_ln(const Frame& F0, const float* xin_p, const float* xin_s, const bf16* f, float gs, const float* gate_mod  ,
                                      const float* lng, const float* lnb, const float* modn  , float* xout, bf16* uout,
                                      const float* fparts = nullptr, int nparts = 0  , const bf16* xin_b = nullptr  , bf16* xout_b = nullptr  ) {
    const Frame F = relaunder(F0);
    const int gw = F.vcu * NWAVES + F.wave, NGW = F.G * NWAVES, lane = F.lane;
    const int m0 = gw; if (m0 >= M) return;
    f32x4 cg[4], cb[4], cgate[4], csh[4], cscl[4]; int cseq = -1;
    if constexpr (HASF) {
#pragma unroll
        for (int j = 0; j < 4; ++j) { cg[j] = *(const f32x4*)(lng + 4 * lane + 256 * j); cb[j] = *(const f32x4*)(lnb + 4 * lane + 256 * j); } }
    auto up = [](u32x2 w) -> f32x4 { return (f32x4){__uint_as_float(w.x << 16), __uint_as_float(w.x & 0xffff0000u), __uint_as_float(w.y << 16), __uint_as_float(w.y & 0xffff0000u)}; };
    auto ldx = [&](int m, int j) -> f32x4 { if constexpr (XBIN) return up(*(const u32x2*)(xin_b + (size_t)m * D + 4 * lane + 256 * j));
                                           else { const float* xr = m >= MP ? xin_s + (size_t)(m - MP) * D : xin_p + (size_t)m * D; return *(const f32x4*)(xr + 4 * lane + 256 * j); } };
    auto ldf = [&](int m, int j) -> u32x2 { const int mf = m < MP ? m : MP - 1; return *(const u32x2*)(f + (size_t)mf * D + 4 * lane + 256 * j); };
    f32x4 v[4], vn[4]; u32x2 fw[4], fwn[4];
#pragma unroll
    for (int j = 0; j < 4; ++j) { vn[j] = ldx(m0, j); if constexpr (HASF) fwn[j] = ldf(m0, j); }
#pragma unroll 2
    for (int m = m0; m < M; m += NGW) {
        const int seq = row_seq(m);
#pragma unroll
        for (int j = 0; j < 4; ++j) { v[j] = vn[j]; if constexpr (HASF) fw[j] = fwn[j]; }
        { const int mn = m + NGW < M ? m + NGW : m;
#pragma unroll
          for (int j = 0; j < 4; ++j) { vn[j] = ldx(mn, j); if constexpr (HASF) fwn[j] = ldf(mn, j); } }
        if (seq != cseq) { cseq = seq;
#pragma unroll
            for (int j = 0; j < 4; ++j) { if constexpr (HASF) cgate[j] = *(const f32x4*)(gate_mod + (size_t)seq * 9216 + 4 * lane + 256 * j) * gs;
                if constexpr (MODN) { csh[j] = *(const f32x4*)(modn + (size_t)seq * 9216 + 4 * lane + 256 * j); cscl[j] = *(const f32x4*)(modn + (size_t)seq * 9216 + D + 4 * lane + 256 * j) + 1.0f; } } }
        if constexpr (HASF) {
            if (m >= MP) {
#pragma unroll
                for (int j = 0; j < 4; ++j) v[j] = v[j] * ALPHA;
                for (int sp = 0; sp < nparts; ++sp) {
#pragma unroll
                    for (int j = 0; j < 4; ++j) v[j] += cgate[j] * *(const f32x4*)(fparts + ((size_t)sp * MD + (m - MP)) * D + 4 * lane + 256 * j); }
            } else {
#pragma unroll
                for (int j = 0; j < 4; ++j) v[j] = v[j] * ALPHA + cgate[j] * up(fw[j]);
            }
            float s = 0.f, s2 = 0.f;
#pragma unroll
            for (int j = 0; j < 4; ++j) { s += (v[j].x + v[j].y) + (v[j].z + v[j].w); s2 += (v[j].x * v[j].x + v[j].y * v[j].y) + (v[j].z * v[j].z + v[j].w * v[j].w); }
            wave_sum2(s, s2);
            const float mean = s * (1.f / D), rstd = __builtin_amdgcn_rsqf(fmaxf(s2 * (1.f / D) - mean * mean, 0.f) + LN_EPS);
#pragma unroll
            for (int j = 0; j < 4; ++j) { const f32x4 ga = cg[j] * rstd; v[j] = v[j] * ga + (cb[j] - ga * mean);
                if constexpr (XBOUT) { u32x2 w; w.x = cvtpk(v[j].x, v[j].y); w.y = cvtpk(v[j].z, v[j].w); *(u32x2*)(xout_b + (size_t)m * D + 4 * lane + 256 * j) = w;
                    v[j] = up(w); }
                else *(f32x4*)(xout + (size_t)m * D + 4 * lane + 256 * j) = v[j]; }
        }
        if constexpr (MODN) {
            float s = 0.f, s2 = 0.f;
#pragma unroll
            for (int j = 0; j < 4; ++j) { s += (v[j].x + v[j].y) + (v[j].z + v[j].w); s2 += (v[j].x * v[j].x + v[j].y * v[j].y) + (v[j].z * v[j].z + v[j].w * v[j].w); }
            wave_sum2(s, s2);
            const float mean = s * (1.f / D), rstd = __builtin_amdgcn_rsqf(fmaxf(s2 * (1.f / D) - mean * mean, 0.f) + LN_EPS);
#pragma unroll
            for (int j = 0; j < 4; ++j) { const f32x4 ga = cscl[j] * rstd; const f32x4 o = v[j] * ga + (csh[j] - ga * mean); u32x2 w; w.x = cvtpk(o.x, o.y); w.y = cvtpk(o.z, o.w);
                *(u32x2*)(uout + (size_t)m * D + 4 * lane + 256 * j) = w; }
        }
    }
}
__device__ __forceinline__ int t5_bucket(int rel) {
    const int n = rel < 0 ? -rel : rel; int b;
    if (n < 8) b = n; else if (n < 12) b = 8; else if (n < 16) b = 9; else if (n < 23) b = 10; else if (n < 32) b = 11; else if (n < 46) b = 12; else if (n < 64) b = 13; else if (n < 91) b = 14; else b = 15;
    return (rel > 0 ? 16 : 0) + b;
}
typedef short v4i16_t __attribute__((ext_vector_type(4)));
__device__ __forceinline__ v4i16_t vtr(LAS const unsigned char* p) { return __builtin_amdgcn_ds_read_tr16_b64_v4i16((LAS v4i16_t*)p); }
constexpr int ATT_SLOT = 32768;
constexpr int ATT_TAB = EXTRA_OFF;
struct AttnP { const bf16* Q; const bf16* Kb; const bf16* Vb; const float* ck; const float* cv; bf16* YA; const float* relb; const float* subg; float lam, oml; };

__device__ __forceinline__ void attn_scores(LAS const unsigned char* slot, LAS const float* tab, const bf16x8 (&qf)[4], f32x16 (&o)[4], bf16x8 (&pf)[4], float& mrun, float& lrun,
                                            int map, int lane, int k0, int qpos, bool constb, int nvalid, bool first  ) {
    const int r32 = lane & 31, hi = lane >> 5;
    LAS const unsigned char* kb = slot + map * 8192 + hi * 1024 + r32 * 16;
    f32x16 p0, p1;
    const float cb = (constb ? tab[0] : 0.f) - (first ? 0.f : mrun);
#pragma unroll
    for (int r = 0; r < 16; ++r) { p0[r] = cb; p1[r] = cb; }
    { bf16x8 kf[4];
      auto rdk = [&](int f) { kf[f & 3] = *LP(const bf16x8, kb + (f >> 1) * 2048 + (f & 1) * 512); };
      rdk(0); rdk(1); rdk(2);
#pragma unroll
      for (int f = 0; f < 8; ++f) {
          if (f + 3 < 8) rdk(f + 3);
          if (f & 1) p1 = __builtin_amdgcn_mfma_f32_32x32x16_bf16(kf[f & 3], qf[f >> 1], p1, 0, 0, 0);
          else       p0 = __builtin_amdgcn_mfma_f32_32x32x16_bf16(kf[f & 3], qf[f >> 1], p0, 0, 0, 0);
          __builtin_amdgcn_sched_barrier(0);
      } }
    if (!constb) {
        const int base = k0 - qpos + 128;
#pragma unroll
        for (int r = 0; r < 16; ++r) { int i0 = base + crow(r, hi); int i1 = i0 + 32; i0 = i0 < 0 ? 0 : (i0 > 191 ? 191 : i0); i1 = i1 < 0 ? 0 : (i1 > 191 ? 191 : i1); p0[r] += tab[i0]; p1[r] += tab[i1]; }
    }
    if (nvalid < 64) {
#pragma unroll
        for (int r = 0; r < 16; ++r) { if (crow(r, hi) >= nvalid) p0[r] = -INFINITY; if (crow(r, hi) + 32 >= nvalid) p1[r] = -INFINITY; }
    }
    float ma = fmaxf(fmaxf(p0[0], p0[1]), p1[0]), mb = fmaxf(fmaxf(p0[2], p0[3]), p1[1]); ma = fmaxf(fmaxf(ma, p1[2]), p1[3]);
#pragma unroll
    for (int r = 4; r < 16; r += 4) { ma = fmaxf(fmaxf(ma, p0[r]), p0[r + 1]); mb = fmaxf(fmaxf(mb, p0[r + 2]), p0[r + 3]); ma = fmaxf(fmaxf(ma, p1[r]), p1[r + 1]); mb = fmaxf(fmaxf(mb, p1[r + 2]), p1[r + 3]); }
    float mx = fmaxf(ma, mb);
    if (first || __any(mx > 8.0f)) {
        mx = fmaxf(mx, __shfl_xor(mx, 32));
        const float delta = first ? mx : (mx > 8.0f ? mx : 0.f);
        const float alpha = first ? 0.f : __builtin_amdgcn_exp2f(-delta);
        mrun = first ? mx : mrun + delta;
        lrun *= alpha;
#pragma unroll
        for (int r = 0; r < 16; ++r) { p0[r] -= delta; p1[r] -= delta; }
#pragma unroll
        for (int c = 0; c < 4; ++c)
#pragma unroll
            for (int r = 0; r < 16; ++r) o[c][r] *= alpha;
    }
    float ls = 0.f;
#pragma unroll
    for (int r = 0; r < 16; ++r) { p0[r] = __builtin_amdgcn_exp2f(p0[r]); p1[r] = __builtin_amdgcn_exp2f(p1[r]); ls += p0[r] + p1[r]; }
    lrun += ls;
#pragma unroll
    for (int ks = 0; ks < 4; ++ks) { v4u w;
        if (ks < 2) { const int b = 8 * ks; w.x = cvtpk(p0[b], p0[b + 1]); w.y = cvtpk(p0[b + 2], p0[b + 3]); w.z = cvtpk(p0[b + 4], p0[b + 5]); w.w = cvtpk(p0[b + 6], p0[b + 7]); }
        else { const int b = 8 * (ks - 2); w.x = cvtpk(p1[b], p1[b + 1]); w.y = cvtpk(p1[b + 2], p1[b + 3]); w.z = cvtpk(p1[b + 4], p1[b + 5]); w.w = cvtpk(p1[b + 6], p1[b + 7]); }
        pf[ks] = __builtin_bit_cast(bf16x8, w); }
}
__device__ __forceinline__ void attn_pv(LAS const unsigned char* slot, const bf16x8 (&pf)[4], f32x16 (&o)[4], int lane) {
    const int hi = lane >> 5;
    LAS const unsigned char* vb = slot + 16384 + ((lane >> 4) & 1) * 32 + (lane & 3) * 8 + (4 * hi + ((lane & 15) >> 2)) * 64;
    v4i16_t lo[4], hh[4];
    auto rd = [&](int f, int sl_) { lo[sl_] = vtr(vb + (f >> 2) * 4096 + (2 * (f & 3)) * 512); hh[sl_] = vtr(vb + (f >> 2) * 4096 + (2 * (f & 3) + 1) * 512); };
    rd(0, 0); rd(1, 1); rd(2, 2);
#pragma unroll
    for (int f = 0; f < 16; ++f) {
        if (f + 3 < 16) rd(f + 3, (f + 3) & 3);
        const v4i16_t l_ = lo[f & 3], h_ = hh[f & 3];
        const bf16x8 vf = (bf16x8){l_[0], l_[1], l_[2], l_[3], h_[0], h_[1], h_[2], h_[3]};
        o[f >> 2] = __builtin_amdgcn_mfma_f32_32x32x16_bf16(vf, pf[f & 3], o[f >> 2], 0, 0, 0);
        __builtin_amdgcn_sched_barrier(0);
    }
}

__device__ __forceinline__ int att_koff(int key, int ch) { return (ch >> 3) * 8192 + ((ch & 7) >> 1) * 2048 + (ch & 1) * 1024 + (key >> 5) * 512 + (key & 31) * 16; }
__device__ __forceinline__ int att_voff(int key, int ch) { return 16384 + (ch >> 2) * 4096 + (key >> 3) * 512 + (key & 7) * 64 + (ch & 3) * 16; }

__device__ __forceinline__ void attn_unit(const Frame& F, const AttnP& P, bool dec, int bidx, int h, int qb) {
    const int tid = F.tid, lane = F.lane, wave = F.wave, r32 = lane & 31, hi = lane >> 5;
    const int map = wave & 1, qs = wave >> 1;
    LAS unsigned char* lds = F.lds;
    LAS float* tab = LP(float, lds + ATT_TAB);
    const int rowbase = dec ? MP + bidx * DECS : bidx * SEQ;
    const int q0 = dec ? 0 : qb * 128;
    const int qpos0 = dec ? PAST : q0;
    const bool active = dec ? (qs == 0) : true;
    const int NT = dec ? (PAST / 64 + 1) : (2 * qb + 2);
    const int myNT = dec ? NT : (2 * qb + 1 + (qs >> 1));
    if (tid < 192) tab[tid] = P.relb[t5_bucket(tid - 128) * HA + h] * LOG2E;
    else if (tid < 320) tab[tid] = P.subg[tid - 192];
    bf16x8 qf[4];
    { const bf16* qp = P.Q + (size_t)(rowbase + q0 + (active ? qs * 32 : 0) + r32) * 512 + h * 128 + map * 64 + 8 * hi;
#pragma unroll
      for (int d0 = 0; d0 < 4; ++d0) qf[d0] = *(const bf16x8*)(qp + 16 * d0); }
    f32x16 o[4];
#pragma unroll
    for (int c = 0; c < 4; ++c)
#pragma unroll
        for (int r = 0; r < 16; ++r) o[c][r] = 0.f;
    float mrun = -INFINITY, lrun = 0.f;
    const int qposw = qpos0 + qs * 32;
    v4u kreg[2], vreg[2];
    auto load_tile = [&](int t) {
#pragma unroll
        for (int i = 0; i < 2; ++i) { const int id = tid + 512 * i;
            const int kk = (id & 7) | ((id >> 7) << 3), kc = (id >> 3) & 15;
            const int vk = ((id >> 2) & 7) | ((id >> 7) << 3), vc = (id & 3) | (((id >> 5) & 3) << 2);
            if (!dec) { kreg[i] = *(const v4u*)(P.Kb + (size_t)(rowbase + 64 * t + kk) * 512 + h * 128 + kc * 8); vreg[i] = *(const v4u*)(P.Vb + (size_t)(rowbase + 64 * t + vk) * 512 + h * 128 + vc * 8); }
            else if (t < PAST / 64) { const size_t gk = ((size_t)(bidx * PAST + 64 * t + kk) * HA + h) * 128 + kc * 8, gv = ((size_t)(bidx * PAST + 64 * t + vk) * HA + h) * 128 + vc * 8;
                const f32x4 a0 = *(const f32x4*)(P.ck + gk), a1 = *(const f32x4*)(P.ck + gk + 4), b0 = *(const f32x4*)(P.cv + gv), b1 = *(const f32x4*)(P.cv + gv + 4);
                kreg[i] = (v4u){cvtpk(a0[0], a0[1]), cvtpk(a0[2], a0[3]), cvtpk(a1[0], a1[1]), cvtpk(a1[2], a1[3])};
                vreg[i] = (v4u){cvtpk(b0[0], b0[1]), cvtpk(b0[2], b0[3]), cvtpk(b1[0], b1[1]), cvtpk(b1[2], b1[3])}; }
            else { kreg[i] = kk < DECS ? *(const v4u*)(P.Kb + (size_t)(rowbase + kk) * 512 + h * 128 + kc * 8) : (v4u){0u, 0u, 0u, 0u};
                   vreg[i] = vk < DECS ? *(const v4u*)(P.Vb + (size_t)(rowbase + vk) * 512 + h * 128 + vc * 8) : (v4u){0u, 0u, 0u, 0u}; }
        }
    };
    auto store_tile_at = [&](int sloff) {
        LAS unsigned char* sb = lds + sloff;
#pragma unroll
        for (int i = 0; i < 2; ++i) { const int id = tid + 512 * i;
            const int kk = (id & 7) | ((id >> 7) << 3), kc = (id >> 3) & 15, vk = ((id >> 2) & 7) | ((id >> 7) << 3), vc = (id & 3) | (((id >> 5) & 3) << 2);
            *LP(v4u, sb + att_koff(kk, kc)) = kreg[i]; *LP(v4u, sb + att_voff(vk, vc)) = vreg[i]; }
    };
    __syncthreads();
    load_tile(0); store_tile_at(0);
    __syncthreads();
    const bool late = wave >= 4;
    bf16x8 pf[4];
    bool pend = false;
    int sl_prev = 0, sl_cur = 0, sl_next = ATT_SLOT;
    for (int t = 0; t < NT; ++t) {
        if (t + 1 < NT) load_tile(t + 1);
        const bool mine = active && t < myNT;
        if (late) {
            if (pend) attn_pv(lds + sl_prev, pf, o, lane);
            pend = mine;
        }
        if (mine) {
            const int k0 = 64 * t;
            const bool constb = (k0 + 63 - qposw) <= -91;
            attn_scores(lds + sl_cur, tab, qf, o, pf, mrun, lrun, map, lane, k0, qposw + r32, constb, (dec && t == NT - 1) ? DECS : 64, t == 0);
            if (!late) attn_pv(lds + sl_cur, pf, o, lane);
        }
        if (t + 1 < NT) store_tile_at(sl_next);
        __syncthreads();
        sl_prev = sl_cur; sl_cur = sl_next; sl_next = sl_next == 2 * ATT_SLOT ? 0 : sl_next + ATT_SLOT;
    }
    if (late && pend) attn_pv(lds + sl_prev, pf, o, lane);
    __syncthreads();
    lrun += __shfl_xor(lrun, 32);
    const float inv = 1.0f / lrun;
    LAS float* ex = LP(float, lds + (wave >> 1) * 16384);
    if (map == 1) {
#pragma unroll
        for (int c = 0; c < 4; ++c)
#pragma unroll
            for (int r = 0; r < 16; ++r) ex[(c * 16 + r) * 64 + lane] = o[c][r] * inv;
    }
    __syncthreads();
    LAS bf16* yst = LP(bf16, lds + 65536 + (wave >> 1) * 8448);
    if (map == 0) {
        float ss = 0.f;
#pragma unroll
        for (int c = 0; c < 4; ++c)
#pragma unroll
            for (int r = 0; r < 16; ++r) { const float v = o[c][r] * inv - P.lam * ex[(c * 16 + r) * 64 + lane]; o[c][r] = v; ss += v * v; }
        ss += __shfl_xor(ss, 32);
        const float rs = 1.0f / sqrtf(ss * (1.f / 128.f) + LN_EPS) * P.oml;
#pragma unroll
        for (int c = 0; c < 4; ++c)
#pragma unroll
            for (int r = 0; r < 16; ++r) { const int dv = 32 * c + crow(r, hi); yst[r32 * 132 + dv] = (bf16)f2bf(o[c][r] * rs * tab[192 + dv]); }
    }
    __syncthreads();
    if (map == 0 && active) {
#pragma unroll
        for (int i = 0; i < 8; ++i) { const int row = i * 4 + (lane >> 4), ch = lane & 15;
            const u32x2 a = *LP(const u32x2, yst + row * 132 + ch * 8), b = *LP(const u32x2, yst + row * 132 + ch * 8 + 4);
            *(v4u*)(P.YA + (size_t)(rowbase + q0 + qs * 32 + row) * 512 + h * 128 + ch * 8) = (v4u){a.x, a.y, b.x, b.y}; }
    }
}
__device__ __forceinline__ void ph_attn(const Frame& F0, const AttnP& P, unsigned* qcount) {
    const Frame F = relaunder(F0);
    LAS unsigned* qslot = LP(unsigned, F.lds + LDSCTL_OFF + 64);
    for (;;) {
        __syncthreads();
        if (F.tid == 0) *qslot = __hip_atomic_fetch_add(qcount, 1u, __ATOMIC_RELAXED, __HIP_MEMORY_SCOPE_AGENT);
        __syncthreads();
        const int u = __builtin_amdgcn_readfirstlane((int)*qslot);
        if (u >= 1024 + DECB * HA) break;
        constexpr int DEC_AT = 16 * (63 - 16);
        const bool isdec = u >= DEC_AT && u < DEC_AT + DECB * HA;
        const int up = u < DEC_AT ? u : u - DECB * HA, d = u - DEC_AT;
        attn_unit(F, P, isdec, isdec ? d >> 2 : (up & 15) >> 2, isdec ? d & 3 : up & 3, isdec ? 0 : 63 - (up >> 4));
    }
}
constexpr int R1_RT = 0, R1_KH = 9216, R1_BH = 18432, R1_KAP = 27648, R1_KAPT = 36864, R1_VT = 46080, R1_BBT = 55296, R1_KBT = 64512;
constexpr int R1_ABKF = 73728, R1_AKK = 90368, R1_ABR = 99584, R1_AKR = 108800, R1_MB = 118016;
constexpr int R1_MF = R1_KH, R1_GT = R1_KAP, R1_WT = R1_ABKF, R1_UT = R1_KH;
constexpr int R1_LW = 73728, R1_LA = 82944, R1_LG = 92160;
constexpr int R1_RED = EXTRA_OFF, R1_CS = EXTRA_OFF + 1024, R1_GTV = EXTRA_OFF + 2048, R1_T16 = EXTRA_OFF + 2304, R1_MUL = EXTRA_OFF + 5632;
typedef unsigned short u16;
__device__ __forceinline__ f32x4 mfma16(bf16x8 a, bf16x8 b, f32x4 c) { return __builtin_amdgcn_mfma_f32_16x16x32_bf16(a, b, c, 0, 0, 0); }
__device__ __forceinline__ void mm64(f32x4 (&acc)[2], LAS const unsigned char* X, LAS const unsigned char* Y, int tm, int tn0, int lane) {
    const int i = lane & 15, q = lane >> 4;
#pragma unroll
    for (int s = 0; s < 2; ++s) {
        const bf16x8 af = *LP(const bf16x8, X + ((16 * tm + i) * 72 + 32 * s + 8 * q) * 2);
#pragma unroll
        for (int j = 0; j < 2; ++j) { const bf16x8 bfr = *LP(const bf16x8, Y + ((16 * (tn0 + j) + i) * 72 + 32 * s + 8 * q) * 2); acc[j] = mfma16(af, bfr, acc[j]); }
    }
}
__device__ __forceinline__ void st_tr(LAS unsigned char* arr, const f32x4& v, int n, int t0) {
    u32x2 w; w.x = cvtpk(v[0], v[1]); w.y = cvtpk(v[2], v[3]); *LP(u32x2, arr + (n * 72 + t0) * 2) = w;
}
__device__ __forceinline__ f32x4 prod16(f32x4 acc, LAS const float* X, int sx, LAS const float* Y, int sy, int lane) {
    const int i = lane & 15, q = lane >> 4;
#pragma unroll
    for (int s = 0; s < 4; ++s) acc = __builtin_amdgcn_mfma_f32_16x16x4f32(X[i * sx + 4 * s + q], Y[(4 * s + q) * sy + i], acc, 0, 0, 0);
    return acc;
}
__device__ __forceinline__ float tanh_fast(float x) { return 1.0f - 2.0f * __builtin_amdgcn_rcpf(1.0f + __expf(2.0f * x)); }

__device__ __forceinline__ float red16(float x) { x += dpp_mov<0xB1>(x); x += dpp_mov<0x4E>(x); x += dpp_mov<0x141>(x); x += dpp_mov<0x140>(x); return x; }
__device__ __forceinline__ int frag_a(int row, int k) { return ((row >> 4) * 2 + (k >> 5)) * 512 + (((k >> 2) & 3) * 16 + (row & 15)) * 8 + 4 * ((k >> 4) & 1) + (k & 3); }
__device__ __forceinline__ int frag_c(int c, int r0) { return (((c >> 4) * 4 + (r0 >> 4)) * 64 + ((r0 >> 2) & 3) * 16 + (c & 15)) * 4; }
__device__ __forceinline__ void ph_rwkv1(const Frame& F0, const Args& a, int l) {
    const Frame F = relaunder(F0);
    unsigned char* ws = a.ws; LAS unsigned char* lds = F.lds;
    int tid = F.tid, lane = F.lane, i = lane & 15, q = lane >> 4, t0 = 0; const int wave = F.wave, tm = wave >> 1, tnb = 2 * (wave & 1);
#define R1_RELANE() do { int l_ = F.lane; asm volatile("" : "+v"(l_)); lane = l_; i = lane & 15; q = lane >> 4; tid = wave * 64 + lane; t0 = 16 * tm + 4 * q; } while (0)
    const bf16* PRW = (const bf16*)(ws + WS_PRW);
    const unsigned char* wl = ws + WS_W + (size_t)l * WL_SIZE;
    const bf16* W2t = (const bf16*)(wl + WL_W2); const bf16* A2t = (const bf16*)(wl + WL_A2); const bf16* G2t = (const bf16*)(wl + WL_G2);
    const float* mu = a.in[I_MU] + (size_t)l * NRW; const float* w0 = a.in[I_W0] + l * 512; const float* a0 = a.in[I_A0] + l * 512;
    const float* k_k = a.in[I_KK] + l * 512; const float* k_a = a.in[I_KA] + l * 512; const float* r_k = a.in[I_RK] + l * 512;
    bf16* GG = (bf16*)(ws + WS_GG); bf16* BON = (bf16*)(ws + WS_BON);
    LAS float* RED = LP(float, lds + R1_RED); LAS float* CS = LP(float, lds + R1_CS); LAS float* GTV = LP(float, lds + R1_GTV);
    LAS float* ABKF = LP(float, lds + R1_ABKF); LAS float* MF = LP(float, lds + R1_MF);
    if (tid < 256) LP(float, lds + R1_MUL)[tid] = mu[1536 + tid];
    __syncthreads();
    struct R1Item { int h, row0, tval; const float* prev0; const bf16* prevr; const bf16* prevb; };
    auto item_info = [&](int it) -> R1Item { R1Item I;
        if (it < NITEM_P) { const int s = it >> 10, c = (it >> 3) & 127; I.h = it & 7; I.row0 = s * SEQ + 64 * c; I.tval = 64; I.prev0 = nullptr; I.prevr = c > 0 ? PRW + (size_t)(I.row0 - 1) * NRW : nullptr; I.prevb = c > 0 ? I.prevr + 1536 : nullptr; }
        else { const int b = (it - NITEM_P) >> 3; I.h = it & 7; I.row0 = MP + DECS * b; I.tval = DECS; I.prev0 = a.in[I_SSH] + (size_t)(l * DECB + b) * NRW; I.prevr = nullptr; I.prevb = (const bf16*)(ws + WS_SSB) + (size_t)(l * DECB + b) * 256; }
        return I; };
    v4u lp[4], lq[4];
    float gp[2][4][3], gq[2][3], cst[2][8]; bool pqz = false; int csth = -1;
    auto load_top = [&](const R1Item& I) {
        const int t0s = tid >> 3, part = tid & 7; const bool v0 = t0s < I.tval;
        const bf16* pl_ = PRW + (size_t)(I.row0 + (v0 ? t0s : 0)) * NRW + 1536 + 32 * part;
        const bf16* pq_ = (v0 && t0s > 0) ? pl_ - NRW : (I.prevb ? I.prevb + 32 * part : pl_);
        pqz = !(v0 && t0s > 0) && !I.prevb;
#pragma unroll
        for (int e = 0; e < 4; ++e) { lp[e] = *(const v4u*)(pl_ + 8 * e); lq[e] = *(const v4u*)(pq_ + 8 * e); }
#pragma unroll
        for (int j = 0; j < 2; ++j) { const int col = I.h * 64 + 16 * (tnb + j) + i; const int tb = 16 * tm + 4 * q;
            const int tbl = 16 * tm < I.tval ? tb : 0;
#pragma unroll
            for (int r = 0; r < 4; ++r) { const unsigned po = (unsigned)(I.row0 + tbl + r) * NRW + col; gp[j][r][0] = bf2f(PRW[po]); gp[j][r][1] = bf2f(PRW[po + 512]); gp[j][r][2] = bf2f(PRW[po + 1024]); }
            const bf16* pb = tb > 0 ? PRW + (size_t)(I.row0 + min(tb, I.tval) - 1) * NRW : I.prevr;
            if (pb) { gq[j][0] = bf2f(pb[col]); gq[j][1] = bf2f(pb[512 + col]); gq[j][2] = bf2f(pb[1024 + col]); }
            else if (I.prev0) { gq[j][0] = I.prev0[col]; gq[j][1] = I.prev0[512 + col]; gq[j][2] = I.prev0[1024 + col]; }
            else { gq[j][0] = 0.f; gq[j][1] = 0.f; gq[j][2] = 0.f; }
            if (I.h != csth) { cst[j][0] = mu[col]; cst[j][1] = mu[512 + col]; cst[j][2] = mu[1024 + col]; cst[j][3] = w0[col]; cst[j][4] = a0[col]; cst[j][5] = k_k[col]; cst[j][6] = k_a[col]; cst[j][7] = r_k[col]; } }
        csth = I.h;
    };
    bf16x8 bW[2][2], bA[2][2], bG[4][2]; int wfh = -1;
    R1Item cur = item_info(F.vcu < NITEM ? F.vcu : 0), nxt = cur;
    if (F.vcu < NITEM) { R1_RELANE(); load_top(cur); }
    for (int it = F.vcu; it < NITEM; it += F.G) {
        const int h = cur.h, row0 = cur.row0, tval = cur.tval;
        R1_RELANE();
        const int t0s = tid >> 3, part = tid & 7;
        { LAS unsigned char* dst = part < 2 ? lds + R1_LW + (t0s * 72 + 32 * part) * 2 : (part < 4 ? lds + R1_LA + (t0s * 72 + 32 * (part - 2)) * 2 : lds + R1_LG + (t0s * 136 + 32 * (part - 4)) * 2);
          LAS const float* mul = LP(const float, lds + R1_MUL) + 32 * part;
          const float sl2 = part < 2 ? 2.885390082f : -1.442695041f, fa_ = part < 2 ? -2.f : 1.f, fb_ = part < 2 ? 1.f : 0.f; const bool idm = (part & 6) == 2;
#pragma unroll
          for (int e8 = 0; e8 < 4; ++e8) { float x[8];
#pragma unroll
              for (int e = 0; e < 2; ++e) { const unsigned pa_ = e ? lp[e8].z : lp[e8].x, pb_ = e ? lp[e8].w : lp[e8].y, qa_ = e ? lq[e8].z : lq[e8].x, qb_ = e ? lq[e8].w : lq[e8].y;
                  const f32x4 pv = {__uint_as_float(pa_ << 16), __uint_as_float(pa_ & 0xffff0000u), __uint_as_float(pb_ << 16), __uint_as_float(pb_ & 0xffff0000u)};
                  const f32x4 qv = pqz ? (f32x4){0.f, 0.f, 0.f, 0.f} : (f32x4){__uint_as_float(qa_ << 16), __uint_as_float(qa_ & 0xffff0000u), __uint_as_float(qb_ << 16), __uint_as_float(qb_ & 0xffff0000u)};
                  const f32x4 m4 = *LP(const f32x4, mul + 8 * e8 + 4 * e);
                  const f32x4 xm = pv + (qv - pv) * m4;
#pragma unroll
                  for (int z = 0; z < 4; ++z) { const float rc = __builtin_amdgcn_rcpf(1.0f + __builtin_amdgcn_exp2f(xm[z] * sl2)); x[4 * e + z] = idm ? xm[z] : __builtin_fmaf(fa_, rc, fb_); } }
              *LP(v4u, dst + e8 * 16) = (v4u){cvtpk(x[0], x[1]), cvtpk(x[2], x[3]), cvtpk(x[4], x[5]), cvtpk(x[6], x[7])}; }
        }
        if (h != wfh) { wfh = h;
#pragma unroll
        for (int j = 0; j < 2; ++j) { const int n = h * 64 + 16 * (tnb + j) + i;
#pragma unroll
            for (int s = 0; s < 2; ++s) { bW[s][j] = *(const bf16x8*)(W2t + (size_t)n * 64 + 32 * s + 8 * q); bA[s][j] = *(const bf16x8*)(A2t + (size_t)n * 64 + 32 * s + 8 * q); }
#pragma unroll
            for (int s = 0; s < 4; ++s) bG[s][j] = *(const bf16x8*)(G2t + (size_t)n * 128 + 32 * s + 8 * q); } }
        __syncthreads();
        f32x4 aw[2], aa[2], ag[2];
#pragma unroll
        for (int j = 0; j < 2; ++j) { aw[j] = (f32x4){0.f, 0.f, 0.f, 0.f}; aa[j] = aw[j]; ag[j] = aw[j]; }
#pragma unroll
        for (int s = 0; s < 2; ++s) {
            const bf16x8 fw = *LP(const bf16x8, lds + R1_LW + ((16 * tm + i) * 72 + 32 * s + 8 * q) * 2), fa = *LP(const bf16x8, lds + R1_LA + ((16 * tm + i) * 72 + 32 * s + 8 * q) * 2);
#pragma unroll
            for (int j = 0; j < 2; ++j) { aw[j] = mfma16(fw, bW[s][j], aw[j]); aa[j] = mfma16(fa, bA[s][j], aa[j]); }
        }
#pragma unroll
        for (int s = 0; s < 4; ++s) {
            const bf16x8 fg = *LP(const bf16x8, lds + R1_LG + ((16 * tm + i) * 136 + 32 * s + 8 * q) * 2);
#pragma unroll
            for (int j = 0; j < 2; ++j) ag[j] = mfma16(fg, bG[s][j], ag[j]);
        }
        float xr[2][4], kp[2][4], xv[2][4], lw[2][4], av[2][4], kkr[2][4];
        float ssq[4] = {0.f, 0.f, 0.f, 0.f}, bsum[4] = {0.f, 0.f, 0.f, 0.f};
#pragma unroll
        for (int j = 0; j < 2; ++j) { const int n = 16 * (tnb + j) + i;
            const float mur = cst[j][0], muk = cst[j][1], muv = cst[j][2], w0c = cst[j][3], a0c = cst[j][4], kkc = cst[j][5], kac = cst[j][6], rkc = cst[j][7];
#pragma unroll
            for (int r = 0; r < 4; ++r) {
                const float pr = gp[j][r][0], pk = gp[j][r][1], pv = gp[j][r][2];
                const float qr = r ? gp[j][r - 1][0] : gq[j][0], qk = r ? gp[j][r - 1][1] : gq[j][1], qv = r ? gp[j][r - 1][2] : gq[j][2];
                const float r_ = pr + (qr - pr) * mur, k_ = pk + (qk - pk) * muk, v_ = pv + (qv - pv) * muv;
                const float wpre = w0c + aw[j][r];
                const float lw2 = -0.87503877f * fast_sigmoid(wpre);
                const float a_ = fast_sigmoid(a0c + aa[j][r]);
                const float kk_ = k_ * kkc, kp_ = k_ * (1.0f + (a_ - 1.0f) * kac);
                xr[j][r] = r_; kp[j][r] = kp_; xv[j][r] = v_; lw[j][r] = lw2; av[j][r] = a_; kkr[j][r] = kk_;
                ssq[r] += kk_ * kk_; bsum[r] += r_ * kp_ * rkc;
            }
            *(u32x2*)(GG + (size_t)it * 4096 + frag_c(n, 16 * tm + 4 * q)) = (u32x2){cvtpk(ag[j][0], ag[j][1]), cvtpk(ag[j][2], ag[j][3])}; }
        if (16 * tm >= tval) {
            asm volatile("" ::: "memory");
#pragma unroll
            for (int j = 0; j < 2; ++j)
#pragma unroll
                for (int r = 0; r < 4; ++r) { xr[j][r] = 0.f; kp[j][r] = 0.f; xv[j][r] = 0.f; lw[j][r] = 0.f; av[j][r] = 0.f; kkr[j][r] = 0.f; ssq[r] = 0.f; bsum[r] = 0.f; }
        }
#pragma unroll
        for (int r = 0; r < 4; ++r) {
            ssq[r] = red16(ssq[r]); bsum[r] = red16(bsum[r]);
            if (i == 0) { const int t = 16 * tm + 4 * q + r; RED[(t * 2 + (wave & 1)) * 2 + 0] = ssq[r]; RED[(t * 2 + (wave & 1)) * 2 + 1] = bsum[r]; } }
        { const int itn = it + F.G < NITEM ? it + F.G : it; nxt = item_info(itn); R1_RELANE(); load_top(nxt); }
        float cin[2][4], exq[2];
#pragma unroll
        for (int j = 0; j < 2; ++j) { cin[j][0] = lw[j][0]; cin[j][1] = cin[j][0] + lw[j][1]; cin[j][2] = cin[j][1] + lw[j][2]; cin[j][3] = cin[j][2] + lw[j][3];
            const float tot = cin[j][3]; float ex = 0.f, wt = 0.f;
#pragma unroll
            for (int qq = 0; qq < 4; ++qq) { const float tq = __shfl(tot, i + 16 * qq); wt += tq; ex += qq < q ? tq : 0.f; }
            exq[j] = ex; if (q == 0) CS[tm * 64 + 16 * (tnb + j) + i] = wt; }
        for (int z = tid; z < 2304; z += NTHR) LP(unsigned, lds + R1_MB)[z] = 0u;
        __syncthreads();
        R1_RELANE();
#pragma unroll
        for (int j = 0; j < 2; ++j) { const int n = 16 * (tnb + j) + i, col = h * 64 + n; float tmex = 0.f, csT = 0.f;
#pragma unroll
            for (int z = 0; z < 4; ++z) { const float c_ = CS[z * 64 + n]; csT += c_; tmex += z < tm ? c_ : 0.f; }
            const float gTj = __builtin_amdgcn_exp2f(csT);
            if (tm == 0 && q == 0) GTV[n] = gTj;
            f32x4 vKapT, vVT, vBbT, vKbT, vBon;
#pragma unroll
            for (int r = 0; r < 4; ++r) { const int t = 16 * tm + 4 * q + r;
                const float cst = tmex + exq[j] + cin[j][r], csp = cst - lw[j][r];
                const float sq = RED[(t * 2 + 0) * 2 + 0] + RED[(t * 2 + 1) * 2 + 0], bt = RED[(t * 2 + 0) * 2 + 1] + RED[(t * 2 + 1) * 2 + 1];
                const float kk_ = kkr[j][r] * __builtin_amdgcn_rsqf(fmaxf(sq, 1e-24f)), b_ = kk_ * av[j][r];
                const float gt = __builtin_amdgcn_exp2f(cst), gi = __builtin_amdgcn_rcpf(gt), gp = __builtin_amdgcn_exp2f(csp), ge = gTj * gi;
                LP(u16, lds + R1_RT)[t * 72 + n] = f2bf1(xr[j][r] * gt);
                LP(u16, lds + R1_KH)[t * 72 + n] = f2bf1(kp[j][r] * gi);
                LP(u16, lds + R1_BH)[t * 72 + n] = f2bf1(b_ * gi);
                LP(u16, lds + R1_KAP)[t * 72 + n] = f2bf1(kk_ * gp);
                vKapT[r] = kk_ * gp; vVT[r] = xv[j][r]; vBbT[r] = b_ * ge; vKbT[r] = kp[j][r] * ge;
                vBon[r] = bt * xv[j][r];
                asm volatile("" ::: "memory");
            }
            const int t0 = 16 * tm + 4 * q;
            *(u32x2*)(BON + (size_t)it * 4096 + frag_c(n, t0)) = (u32x2){cvtpk(vBon[0], vBon[1]), cvtpk(vBon[2], vBon[3])};
            st_tr(lds + R1_KAPT, vKapT, n, t0); st_tr(lds + R1_VT, vVT, n, t0); st_tr(lds + R1_BBT, vBbT, n, t0); st_tr(lds + R1_KBT, vKbT, n, t0);
            asm volatile("" ::: "memory");
        }
        __syncthreads();
        R1_RELANE();
        { f32x4 c1[2], c2[2];
#pragma unroll
          for (int j = 0; j < 2; ++j) { c1[j] = (f32x4){0.f, 0.f, 0.f, 0.f}; c2[j] = c1[j]; }
          mm64(c1, lds + R1_KAP, lds + R1_BH, tm, tnb, lane); mm64(c2, lds + R1_KAP, lds + R1_KH, tm, tnb, lane);
#pragma unroll
          for (int j = 0; j < 2; ++j) { const int ic = 16 * (tnb + j) + i;
#pragma unroll
              for (int r = 0; r < 4; ++r) { const int t = 16 * tm + 4 * q + r;
                  ABKF[t * 65 + ic] = ic < t ? c1[j][r] : 0.f;
                  LP(u16, lds + R1_AKK)[t * 72 + ic] = f2bf1(ic < t ? c2[j][r] : 0.f); } }
        }
        asm volatile("" ::: "memory");
        { f32x4 c3[2], c4[2];
#pragma unroll
          for (int j = 0; j < 2; ++j) { c3[j] = (f32x4){0.f, 0.f, 0.f, 0.f}; c4[j] = c3[j]; }
          mm64(c3, lds + R1_RT, lds + R1_BH, tm, tnb, lane);  mm64(c4, lds + R1_RT, lds + R1_KH, tm, tnb, lane);
#pragma unroll
          for (int j = 0; j < 2; ++j) { const int ic = 16 * (tnb + j) + i;
#pragma unroll
              for (int r = 0; r < 4; ++r) { const int t = 16 * tm + 4 * q + r;
                  LP(u16, lds + R1_ABR)[t * 72 + ic] = f2bf1(ic <= t ? c3[j][r] : 0.f);
                  LP(u16, lds + R1_AKR)[t * 72 + ic] = f2bf1(ic <= t ? c4[j][r] : 0.f); } }
        }
        __syncthreads();
#ifndef R1REP4
#define R1REP4 1
#endif
#pragma unroll 1
        for (int rep4 = 0; rep4 < R1REP4; ++rep4) {
        R1_RELANE();
        if (wave == 0) { const int g = q, c = i; float m[16];
#pragma unroll
            for (int ii = 0; ii < 16; ++ii) { float acc = ii == c ? 1.f : 0.f;
#pragma unroll
                for (int jj = 0; jj < ii; ++jj) acc -= ABKF[(16 * g + ii) * 65 + 16 * g + jj] * m[jj];
                m[ii] = acc; MF[(16 * g + ii) * 65 + 16 * g + c] = acc; LP(u16, lds + R1_MB)[(16 * g + ii) * 72 + 16 * g + c] = (u16)f2bf(acc); } }
        __syncthreads();
#define BLK(P, bi, bj) ((P) + (16 * (bi)) * 65 + 16 * (bj))
#define PUTM(bi, bj, acc) do { _Pragma("unroll") for (int r = 0; r < 4; ++r) { MF[(16 * (bi) + 4 * q + r) * 65 + 16 * (bj) + i] = -(acc)[r]; LP(u16, lds + R1_MB)[(16 * (bi) + 4 * q + r) * 72 + 16 * (bj) + i] = (u16)f2bf(-(acc)[r]); } } while (0)
        { LAS float* T = LP(float, lds + R1_T16) + wave * 272; const f32x4 z4 = {0.f, 0.f, 0.f, 0.f};
          if (wave < 3) { const int bi = wave + 1, bj = wave; f32x4 t = prod16(z4, BLK(ABKF, bi, bj), 65, BLK(MF, bj, bj), 65, lane);
#pragma unroll
              for (int r = 0; r < 4; ++r) T[(4 * q + r) * 17 + i] = t[r];
              f32x4 mres = prod16(z4, BLK(MF, bi, bi), 65, T, 17, lane); PUTM(bi, bj, mres); }
          __syncthreads();
          if (wave < 2) { const int bi = wave + 2, bj = wave; f32x4 t = prod16(z4, BLK(ABKF, bi, bj), 65, BLK(MF, bj, bj), 65, lane); t = prod16(t, BLK(ABKF, bi, bj + 1), 65, BLK(MF, bj + 1, bj), 65, lane);
#pragma unroll
              for (int r = 0; r < 4; ++r) T[(4 * q + r) * 17 + i] = t[r];
              f32x4 mres = prod16(z4, BLK(MF, bi, bi), 65, T, 17, lane); PUTM(bi, bj, mres); }
          __syncthreads();
          if (wave == 0) { f32x4 t = prod16(z4, BLK(ABKF, 3, 0), 65, BLK(MF, 0, 0), 65, lane); t = prod16(t, BLK(ABKF, 3, 1), 65, BLK(MF, 1, 0), 65, lane); t = prod16(t, BLK(ABKF, 3, 2), 65, BLK(MF, 2, 0), 65, lane);
#pragma unroll
              for (int r = 0; r < 4; ++r) T[(4 * q + r) * 17 + i] = t[r];
              f32x4 mres = prod16(z4, BLK(MF, 3, 3), 65, T, 17, lane); PUTM(3, 0, mres); }
          __syncthreads();
        }
#undef BLK
#undef PUTM
        }
        R1_RELANE();
        {
            const int sl = wave & 3, nb = 16 * sl + i;
            auto afrag = [&](int arr, int rt, int st) -> bf16x8 { return *LP(const bf16x8, lds + arr + ((16 * rt + i) * 72 + 32 * st + 8 * q) * 2); };
            auto afragp = [&](int arr, int rt, int st) -> bf16x8 { const u32x2 a0 = *LP(const u32x2, lds + arr + ((16 * rt + i) * 72 + 32 * st + 4 * q) * 2), a1 = *LP(const u32x2, lds + arr + ((16 * rt + i) * 72 + 32 * st + 16 + 4 * q) * 2);
                                                                  return __builtin_bit_cast(bf16x8, (v4u){a0.x, a0.y, a1.x, a1.y}); };
            auto packb = [&](const f32x4& lo, const f32x4& hi2) -> bf16x8 { return __builtin_bit_cast(bf16x8, (v4u){cvtpk(lo[0], lo[1]), cvtpk(lo[2], lo[3]), cvtpk(hi2[0], hi2[1]), cvtpk(hi2[2], hi2[3])}); };
            const f32x4 z4 = {0.f, 0.f, 0.f, 0.f};
            if (wave < 4) {
                bf16x8 vfr[2];
#pragma unroll
                for (int st = 0; st < 2; ++st) vfr[st] = *LP(const bf16x8, lds + R1_VT + (nb * 72 + 32 * st + 8 * q) * 2);
                f32x4 g[4], u[4];
#pragma unroll
                for (int rt = 0; rt < 4; ++rt) { g[rt] = mfma16(afrag(R1_AKK, rt, 0), vfr[0], z4); g[rt] = mfma16(afrag(R1_AKK, rt, 1), vfr[1], g[rt]); }
                bf16x8 gb[2] = {packb(g[0], g[1]), packb(g[2], g[3])};
#pragma unroll
                for (int rt = 0; rt < 4; ++rt) { u[rt] = mfma16(afragp(R1_MB, rt, 0), gb[0], z4); u[rt] = mfma16(afragp(R1_MB, rt, 1), gb[1], u[rt]); }
                bf16x8 ub[2] = {packb(u[0], u[1]), packb(u[2], u[3])};
                bf16* OT = (bf16*)(ws + WS_OT) + (size_t)it * 4096; float* HT = (float*)(ws + WS_HT) + (size_t)it * 4096;
#pragma unroll
                for (int rt = 0; rt < 4; ++rt) {
                    f32x4 o1 = mfma16(afrag(R1_AKR, rt, 0), vfr[0], z4); o1 = mfma16(afrag(R1_AKR, rt, 1), vfr[1], o1);
                    f32x4 o2 = mfma16(afragp(R1_ABR, rt, 0), ub[0], z4); o2 = mfma16(afragp(R1_ABR, rt, 1), ub[1], o2);
                    { const f32x4 od = o1 - o2; *(u32x2*)(OT + ((sl * 4 + rt) * 64 + lane) * 4) = (u32x2){cvtpk(od[0], od[1]), cvtpk(od[2], od[3])}; }
                    f32x4 h1 = mfma16(afrag(R1_KBT, rt, 0), vfr[0], z4); h1 = mfma16(afrag(R1_KBT, rt, 1), vfr[1], h1);
                    f32x4 h2 = mfma16(afragp(R1_BBT, rt, 0), ub[0], z4); h2 = mfma16(afragp(R1_BBT, rt, 1), ub[1], h2);
                    *(f32x4*)(HT + ((sl * 4 + rt) * 64 + lane) * 4) = h1 - h2;
                }
            } else {
                bf16x8 kfr[2];
#pragma unroll
                for (int st = 0; st < 2; ++st) kfr[st] = *LP(const bf16x8, lds + R1_KAPT + (nb * 72 + 32 * st + 8 * q) * 2);
                f32x4 w[4];
#pragma unroll
                for (int rt = 0; rt < 4; ++rt) { w[rt] = mfma16(afrag(R1_MB, rt, 0), kfr[0], z4); w[rt] = mfma16(afrag(R1_MB, rt, 1), kfr[1], w[rt]); }
                bf16x8 wb[2] = {packb(w[0], w[1]), packb(w[2], w[3])};
                LAS u16* QTs = LP(u16, lds + R1_KH); LAS u16* PTs = LP(u16, lds + R1_BH);
                const float gtv = GTV[nb];
#pragma unroll
                for (int rt = 0; rt < 4; ++rt) {
                    f32x4 cq = mfma16(afragp(R1_ABR, rt, 0), wb[0], z4); cq = mfma16(afragp(R1_ABR, rt, 1), wb[1], cq);
                    f32x4 cp = mfma16(afragp(R1_BBT, rt, 0), wb[0], z4); cp = mfma16(afragp(R1_BBT, rt, 1), wb[1], cp);
#pragma unroll
                    for (int r = 0; r < 4; ++r) { const int t = 16 * rt + 4 * q + r;
                        QTs[frag_a(t, nb)] = f2bf1(bf2f(LP(u16, lds + R1_RT)[t * 72 + nb]) - cq[r]);
                        PTs[frag_a(t, nb)] = f2bf1((t == nb ? gtv : 0.f) - cp[r]); }
                }
            }
        }
        cur = nxt;
        __syncthreads();
        { R1_RELANE();
          v4u* QTg = (v4u*)((bf16*)(ws + WS_QT) + (size_t)it * 4096); v4u* PTg = (v4u*)((bf16*)(ws + WS_PT) + (size_t)it * 4096);
          QTg[tid] = *LP(const v4u, lds + R1_KH + tid * 16); PTg[tid] = *LP(const v4u, lds + R1_BH + tid * 16); }
    }
}

struct R2St { bf16x8 pa[4][2]; f32x4 hh[4]; };
__device__ __forceinline__ void r2_load(R2St& o, const unsigned char* ws, int it, int lane, int vs) {
    const bf16* PT = (const bf16*)(ws + WS_PT) + (size_t)it * 4096; const float* HT = (const float*)(ws + WS_HT) + (size_t)it * 4096;
#pragma unroll
    for (int tt = 0; tt < 4; ++tt) {
#pragma unroll
        for (int s = 0; s < 2; ++s) o.pa[tt][s] = *(const bf16x8*)(PT + ((tt * 2 + s) * 64 + lane) * 8);
        o.hh[tt] = *(const f32x4*)(HT + ((vs * 4 + tt) * 64 + lane) * 4);
    }
}
__device__ __forceinline__ void r2_step(const R2St& r, f32x4 (&S)[4], unsigned char* ws, int it, int vs, int lane) {
    bf16x8 bs[2];
#pragma unroll
    for (int s = 0; s < 2; ++s) { v4u w; w.x = cvtpk(S[2 * s][0], S[2 * s][1]); w.y = cvtpk(S[2 * s][2], S[2 * s][3]); w.z = cvtpk(S[2 * s + 1][0], S[2 * s + 1][1]); w.w = cvtpk(S[2 * s + 1][2], S[2 * s + 1][3]); bs[s] = __builtin_bit_cast(bf16x8, w);
        *(v4u*)(ws + WS_SC + (size_t)it * 8192 + (size_t)((vs * 2 + s) * 64 + lane) * 16) = w; }
#pragma unroll
    for (int kt = 0; kt < 4; ++kt) { f32x4 acc = r.hh[kt];
#pragma unroll
        for (int s = 0; s < 2; ++s) acc = mfma16(r.pa[kt][s], bs[s], acc);
        S[kt] = acc; }
}
__device__ __forceinline__ bool r3_skip(int G) { return G >= 32 && (G & 15) == 0; }
__device__ __forceinline__ void ph_rwkv2(const Frame& F0, const Args& a, int l) {
    const Frame F = relaunder(F0);
    unsigned char* ws = a.ws;
    const int lane = F.lane, i = lane & 15, q = lane >> 4;
    int j0, jstep, jend;
    if (r3_skip(F.G)) { if ((F.vcu & 15) == 0) { j0 = (F.vcu >> 4) * NWAVES + F.wave; jstep = (F.G >> 4) * NWAVES; jend = 128; }
                        else { j0 = 128 + (F.vcu - (F.vcu >> 4) - 1) * NWAVES + F.wave; jstep = (F.G - (F.G >> 4)) * NWAVES; jend = 128 + DECB * HB * 4; } }
    else { j0 = F.vcu * NWAVES + F.wave; jstep = F.G * NWAVES; jend = 128 + DECB * HB * 4; }
    for (int job = j0; job < jend; job += jstep) {
        int nchunk, item0, h, vs; float* sout; f32x4 S[4];
        if (job < 128) { const int pu = job; const int s = pu >> 5; h = (pu >> 2) & 7; vs = pu & 3; nchunk = SEQ / 64; item0 = s * 1024 + h;
            sout = a.out + OFF_WKVP + ((size_t)(l * NB + s) * HB + h) * 4096;
#pragma unroll
            for (int kt = 0; kt < 4; ++kt) S[kt] = (f32x4){0.f, 0.f, 0.f, 0.f}; }
        else { const int d = job - 128; const int b = d >> 5; h = (d >> 2) & 7; vs = d & 3; nchunk = 1; item0 = NITEM_P + b * 8 + h;
            sout = a.out + OFF_WKVS + ((size_t)(l * DECB + b) * HB + h) * 4096;
            const float* sin = a.in[I_SWKV] + ((size_t)(l * DECB + b) * HB + h) * 4096 + (16 * vs + i) * 64 + 4 * q;
#pragma unroll
            for (int kt = 0; kt < 4; ++kt) S[kt] = *(const f32x4*)(sin + 16 * kt); }
        const int v = 16 * vs + i;
        const int itl = item0 + 8 * (nchunk - 1);
        R2St r0, r1, r2;
        r2_load(r0, ws, item0, lane, vs);
        r2_load(r1, ws, min(item0 + 8, itl), lane, vs);
        r2_load(r2, ws, min(item0 + 16, itl), lane, vs);
        int c = 0;
#pragma unroll 1
        for (; c + 3 <= nchunk; c += 3) {
            const int it = item0 + 8 * c;
            r2_step(r0, S, ws, it, vs, lane);      r2_load(r0, ws, min(it + 24, itl), lane, vs);
            r2_step(r1, S, ws, it + 8, vs, lane);  r2_load(r1, ws, min(it + 32, itl), lane, vs);
            r2_step(r2, S, ws, it + 16, vs, lane); r2_load(r2, ws, min(it + 40, itl), lane, vs);
        }
        if (c < nchunk) { r2_step(r0, S, ws, item0 + 8 * c, vs, lane); ++c; }
        if (c < nchunk) { r2_step(r1, S, ws, item0 + 8 * c, vs, lane); ++c; }
#pragma unroll
        for (int kt = 0; kt < 4; ++kt) *(f32x4*)(sout + (size_t)v * 64 + 16 * kt + 4 * q) = S[kt];
    }
}
struct R3In { bf16x8 af[2]; u32x2 ot[4], gg[4], bn[4]; };
__device__ __forceinline__ void r3_load(R3In& p, const unsigned char* ws, int u, int lane) {
    const int it = u >> 2, tt = u & 3;
    const bf16* QT = (const bf16*)(ws + WS_QT) + (size_t)it * 4096; const bf16* OT = (const bf16*)(ws + WS_OT) + (size_t)it * 4096;
    const bf16* GG = (const bf16*)(ws + WS_GG) + (size_t)it * 4096; const bf16* BON = (const bf16*)(ws + WS_BON) + (size_t)it * 4096;
#pragma unroll
    for (int s = 0; s < 2; ++s) p.af[s] = *(const bf16x8*)(QT + ((tt * 2 + s) * 64 + lane) * 8);
#pragma unroll
    for (int vs = 0; vs < 4; ++vs) { const int o = ((vs * 4 + tt) * 64 + lane) * 4; p.ot[vs] = *(const u32x2*)(OT + o); p.gg[vs] = *(const u32x2*)(GG + o); p.bn[vs] = *(const u32x2*)(BON + o); }
}
__device__ __forceinline__ void r3_loadb(bf16x8 (&b)[4][2], const unsigned char* ws, int it, int lane) {
#pragma unroll
    for (int vs = 0; vs < 4; ++vs)
#pragma unroll
        for (int s = 0; s < 2; ++s) b[vs][s] = *(const bf16x8*)(ws + WS_SC + (size_t)it * 8192 + (size_t)((vs * 2 + s) * 64 + lane) * 16);
}
__device__ __forceinline__ void r3_loadb_dec(bf16x8 (&b)[4][2], const float* sin, int lane) {
    const int i = lane & 15, q = lane >> 4;
#pragma unroll
    for (int vs = 0; vs < 4; ++vs)
#pragma unroll
        for (int s = 0; s < 2; ++s) { const float* p = sin + (16 * vs + i) * 64 + 32 * s + 4 * q; const f32x4 x0 = *(const f32x4*)p, x1 = *(const f32x4*)(p + 16);
            v4u w; w.x = cvtpk(x0[0], x0[1]); w.y = cvtpk(x0[2], x0[3]); w.z = cvtpk(x1[0], x1[1]); w.w = cvtpk(x1[2], x1[3]); b[vs][s] = __builtin_bit_cast(bf16x8, w); }
}
template <bool DEC>
__device__ __forceinline__ void ph_rwkv3(const Frame& F0, const Args& a, int l) {
    const Frame F = relaunder(F0);
    const unsigned char* ws = a.ws;
    bf16* YB = (bf16*)(a.ws + WS_YAB) + (size_t)M * 512; const float* lg = a.in[I_LNXG] + l * 512; const float* lb = a.in[I_LNXB] + l * 512;
    const float* sdec = a.in[I_SWKV] + (size_t)l * DECB * HB * 4096;
    const int lane = F.lane, i = lane & 15, q = lane >> 4;
    LAS unsigned char* st = F.lds + F.wave * 2304;
    const int gw = F.vcu * NWAVES + F.wave, NW = F.G * NWAVES; constexpr int NU = NITEM_P * 4, NUD = DECB * HB * 2;
    int wv, NWk;
    if (DEC && !r3_skip(F.G)) { wv = gw; NWk = NW; }
    else if (DEC || r3_skip(F.G)) { if ((F.vcu & 15) == 0) return; wv = (F.vcu - (F.vcu >> 4) - 1) * NWAVES + F.wave; NWk = (F.G - (F.G >> 4)) * NWAVES; }
    else { wv = gw; NWk = NW; }
    const int u0 = DEC ? 0 : (int)((long)wv * NU / NWk), u1 = DEC ? (wv < NUD ? (NUD - wv + NWk - 1) / NWk : 0) : (int)((long)(wv + 1) * NU / NWk);
    auto unit_at = [&](int k) -> int { if (!DEC) return k; const int e = wv + k * NWk; return (NITEM_P + (e >> 1)) * 4 + (e & 1); };
    auto loadb = [&](bf16x8 (&b)[4][2], int it) { if (DEC) r3_loadb_dec(b, sdec + (size_t)(it - NITEM_P) * 4096, lane); else r3_loadb(b, ws, it, lane); };
    if (u0 >= u1) return;
    auto up4 = [](u32x2 w) -> f32x4 { return (f32x4){__uint_as_float(w.x << 16), __uint_as_float(w.x & 0xffff0000u), __uint_as_float(w.y << 16), __uint_as_float(w.y & 0xffff0000u)}; };
    R3In cur, nxt, nx2; bf16x8 bfr[4][2], bfn[4][2];
    r3_load(nxt, ws, unit_at(u0), lane); r3_load(nx2, ws, unit_at(u0 + 1 < u1 ? u0 + 1 : u0), lane); loadb(bfn, unit_at(u0) >> 2);
    int cit = -1; float lgv[4], lbv[4];
#pragma unroll 1
    for (int k = u0; k < u1; ++k) {
        const int u = unit_at(k); const int it = u >> 2, tt = u & 3;
        cur = nxt; nxt = nx2;
        if (it != cit) {
#pragma unroll
            for (int vs = 0; vs < 4; ++vs) { bfr[vs][0] = bfn[vs][0]; bfr[vs][1] = bfn[vs][1]; }
            cit = it; const int h = it & 7;
#pragma unroll
            for (int vs = 0; vs < 4; ++vs) { lgv[vs] = lg[h * 64 + 16 * vs + i]; lbv[vs] = lb[h * 64 + 16 * vs + i]; }
        }
        { const int un = unit_at(k + 1 < u1 ? k + 1 : k); r3_load(nx2, ws, unit_at(k + 2 < u1 ? k + 2 : u1 - 1), lane); if ((un >> 2) != it) loadb(bfn, un >> 2); }
        const bool dec = it >= NITEM_P;
        if (dec && tt >= 2) continue;
        const int h = it & 7, row0 = dec ? MP + DECS * ((it - NITEM_P) >> 3) : (it >> 10) * SEQ + 64 * ((it >> 3) & 127);
        f32x4 acc[4];
#pragma unroll
        for (int vs = 0; vs < 4; ++vs) { acc[vs] = up4(cur.ot[vs]); acc[vs] = mfma16(cur.af[0], bfr[vs][0], acc[vs]); acc[vs] = mfma16(cur.af[1], bfr[vs][1], acc[vs]); }
        f32x4 sm = (acc[0] + acc[1]) + (acc[2] + acc[3]);
#pragma unroll
        for (int r = 0; r < 4; ++r) sm[r] = red16(sm[r]);
        const f32x4 mean = sm * (1.f / 64.f);
        f32x4 s2 = {0.f, 0.f, 0.f, 0.f};
#pragma unroll
        for (int vs = 0; vs < 4; ++vs) { acc[vs] = acc[vs] - mean; s2 += acc[vs] * acc[vs]; }
#pragma unroll
        for (int r = 0; r < 4; ++r) s2[r] = red16(s2[r]);
        f32x4 rstd;
#pragma unroll
        for (int r = 0; r < 4; ++r) rstd[r] = __builtin_amdgcn_rsqf(s2[r] * (1.f / 64.f) + GN_EPS);
#pragma unroll
        for (int vs = 0; vs < 4; ++vs) { const int v = 16 * vs + i;
            const f32x4 y = (acc[vs] * rstd * lgv[vs] + lbv[vs] + up4(cur.bn[vs])) * up4(cur.gg[vs]);
#pragma unroll
            for (int r = 0; r < 4; ++r) LP(u16, st)[(4 * q + r) * 72 + v] = f2bf1(y[r]); }
        { const int trow = lane >> 2, c8 = (lane & 3) * 2;
          bf16* yp = YB + (size_t)(row0 + 16 * tt + trow) * 512 + h * 64 + 8 * c8;
          *(v4u*)yp = *LP(const v4u, st + (trow * 72 + 8 * c8) * 2); *(v4u*)(yp + 8) = *LP(const v4u, st + (trow * 72 + 8 * c8 + 8) * 2); }
    }
}
constexpr int NPH_LAYER = 13, NPH = 2 + DEPTH * NPH_LAYER;
#ifndef MK_LAUNCH_PER_PHASE
#define MK_LAUNCH_PER_PHASE 0
#endif
typedef const __attribute__((address_space(4))) Args* KArgsPtr;
__device__ __forceinline__ const Args& kargs() { KArgsPtr p = (KArgsPtr)__builtin_amdgcn_kernarg_segment_ptr(); asm volatile("" : "+s"(p)); return *(const Args*)p; }
template <unsigned PHMASK> __global__ void __launch_bounds__(NTHR, 2) fwd(Args args_unused) {
    extern __shared__ __attribute__((aligned(16))) unsigned char lds_raw[];
    Frame F;
    F.lds = (LAS unsigned char*)lds_raw;
    F.tid = 0; F.lane = 0; F.wave = __builtin_amdgcn_readfirstlane((int)threadIdx.x >> 6);
    F.G = gridDim.x; { const int bx = blockIdx.x; F.vcu = (F.G % 8 == 0) ? (bx % 8) * (F.G / 8) + bx / 8 : bx; }
    volatile LAS unsigned* MISC = (volatile LAS unsigned*)(F.lds + LDSCTL_OFF);
    for (int u = threadIdx.x; u < (LDS_BYTES - LDSCTL_OFF) / 4; u += NTHR) ((LAS unsigned*)(F.lds + LDSCTL_OFF))[u] = 0u;
    __syncthreads();
    int lo, hi; { const Args& a = kargs(); lo = a.ph_lo; hi = a.ph_hi; }
    XcdBarrier bar; { const Args& a = kargs(); bar.bar = (unsigned*)(a.ws + WS_CTL) + CW_BAR; } bar.x = 0; bar.st = nullptr;
    if (hi - lo > 1) bar = xcd_barrier_post(bar.bar, MISC + 8);
    bar.wave = F.wave;
#define IN(k) (lo <= (k) && (k) < hi)
#define ON(n, k) (((PHMASK >> (n)) & 1u) && IN(k))
#define SEAM(k) do { if (IN(k) && IN((k) + 1)) xcd_barrier(bar); } while (0)
#define WSP(T, off) ((T*)(a.ws + (off)))
#ifndef REP_MASK
#define REP_MASK 0u
#endif
#define REPS(n) ((((REP_MASK) >> (n)) & 1u) ? 2 : 1)
    if (ON(13, 0)) { const Args& a = kargs(); ph_prologue(F, a); } SEAM(0);
    if (ON(14, 1)) { const Args& a = kargs(); ph_ln<false, false, false, true>(F, a.in[I_XP], a.in[I_XS], nullptr, 0.f, nullptr, nullptr, nullptr, WSP(float, WS_MOD), nullptr, WSP(bf16, WS_U)); } SEAM(1);
#pragma unroll 1
    for (int l = 0; l < DEPTH; ++l) {
        const int pb = 2 + l * NPH_LAYER;
        const size_t wlo = WS_W + (size_t)l * WL_SIZE, modo = WS_MOD + (size_t)l * NSEQ * 9216 * 4;
        for (int rep_ = 0; rep_ < REPS(0); ++rep_) if (ON(0, pb + 0)) { if (rep_) xcd_barrier(bar); const Args& a = kargs(); pg8::Gemm g{WSP(bf16, WS_U), WSP(const bf16, wlo + WL_GU0), M, NGU, D}; pg8::StaticOrder S; S.init(M, NGU, opq(F.G), opq((int)blockIdx.x)); pg8::EpiSwiglu E{WSP(bf16, WS_ACT), DFF};
            pg8::gemm_phase<pg8::EpiSwiglu, pg8::StaticOrder, true, true>(F.lds, g, S, E, opq(F.wave));
            if (l + 1 < DEPTH) ph_conv_idle(F, a, l + 1, NPAN * (NGU / 256)); } SEAM(pb + 0);
        for (int rep_ = 0; rep_ < REPS(1); ++rep_) if (ON(1, pb + 1)) { if (rep_) xcd_barrier(bar); const Args& a = kargs(); pg8::Gemm g{WSP(bf16, WS_ACT), WSP(const bf16, wlo + WL_DN0), M, D, DFF}; pg8::SplitOrder S; S.init(MP, D, opq(F.G), opq((int)blockIdx.x), DFF / 256); pg8::EpiF32S E{WSP(bf16, WS_F), WSP(float, WS_FP), D, MP, MD};
            pg8::gemm_phase<pg8::EpiF32S, pg8::SplitOrder, true, true>(F.lds, g, S, E, opq(F.wave)); } SEAM(pb + 1);
        for (int rep_ = 0; rep_ < REPS(2); ++rep_) if (ON(2, pb + 2)) { if (rep_) xcd_barrier(bar); const Args& a = kargs(); const float* modl = WSP(float, modo);
            if (l == 0) ph_ln<true, false, true, true>(F, a.in[I_XP], a.in[I_XS], WSP(bf16, WS_F), 0.5f, modl + 2 * D, a.in[I_LNG] + (l * 3 + 0) * D, a.in[I_LNB] + (l * 3 + 0) * D, modl + 3 * D, nullptr, WSP(bf16, WS_U), WSP(float, WS_FP), DFF / 256, nullptr, WSP(bf16, WS_XB));
            else ph_ln<true, true, true, true>(F, nullptr, nullptr, WSP(bf16, WS_F), 0.5f, modl + 2 * D, a.in[I_LNG] + (l * 3 + 0) * D, a.in[I_LNB] + (l * 3 + 0) * D, modl + 3 * D, nullptr, WSP(bf16, WS_U), WSP(float, WS_FP), DFF / 256, WSP(const bf16, WS_XB), WSP(bf16, WS_XB)); } SEAM(pb + 2);
        for (int rep_ = 0; rep_ < REPS(3); ++rep_) if (ON(3, pb + 3)) { if (rep_) xcd_barrier(bar); const Args& a = kargs(); pg8::Gemm g{WSP(bf16, WS_U), WSP(const bf16, wlo + WL_IG), M, NIG, D}; pg8::StaticOrder S; S.init(M, NIG, opq(F.G), opq((int)blockIdx.x));
            pg8::EpiProj E{WSP(bf16, WS_Q), WSP(bf16, WS_KB), WSP(bf16, WS_VB), WSP(bf16, WS_PRW), WSP(bf16, WS_GATES), a.in[I_BGATE] + l * 2048,
                a.out + OFF_KP + (size_t)l * MP * 512, a.out + OFF_VP + (size_t)l * MP * 512, a.out + OFF_KS + (size_t)l * MD * 512, a.out + OFF_VS + (size_t)l * MD * 512,
                a.out + OFF_SHP + (size_t)l * NB * NRW, a.out + OFF_SHS + (size_t)l * DECB * NRW, QSCALE};
            pg8::gemm_phase<pg8::EpiProj, pg8::StaticOrder, true, true>(F.lds, g, S, E, opq(F.wave)); } SEAM(pb + 3);
        for (int rep_ = 0; rep_ < REPS(4); ++rep_) if (ON(4, pb + 4)) { if (rep_) xcd_barrier(bar); const Args& a = kargs(); ph_rwkv1(F, a, l); } SEAM(pb + 4);
        if (ON(5, pb + 5)) { const Args& a = kargs(); ph_rwkv2(F, a, l); }
        if (ON(5, pb + 5)) { const Args& a = kargs(); ph_rwkv3<true>(F, a, l); }
        if (ON(5, pb + 5)) { const Args& a = kargs();
            AttnP P{WSP(bf16, WS_Q), WSP(bf16, WS_KB), WSP(bf16, WS_VB), a.in[I_CK] + (size_t)l * DECB * PAST * 512, a.in[I_CV] + (size_t)l * DECB * PAST * 512, WSP(bf16, WS_YAB), a.in[I_RELB], a.in[I_SUBG] + l * 128,
                    WSP(float, WS_LAM)[l], 1.0f - (0.8f - 0.6f * expf(-0.3f * (float)l))};
            ph_attn(F, P, (unsigned*)(a.ws + WS_CTL) + CW_QUEUE + 64 * l); } SEAM(pb + 5);
        if (ON(6, pb + 6)) { const Args& a = kargs(); ph_rwkv3<false>(F, a, l); }
#pragma unroll 1
        for (int pass = 0; pass < 2; ++pass) { if (pass) SEAM(pb + 6);
            if (pass ? ON(7, pb + 7) : ON(6, pb + 6)) { const Args& a = kargs(); pg8::Gemm g{WSP(bf16, WS_YAB), WSP(const bf16, wlo + WL_BR), 2 * M, 2048, 512};
                const int G_ = opq(F.G), bx_ = opq((int)blockIdx.x), vcu_ = opq(F.vcu); const bool sk = r3_skip(G_);
                pg8::PairOrder S{pass ? (MP / 256) * 4 : NPAN * 4, (pass || !sk) ? G_ : (G_ >> 4), pass ? bx_ : (!sk ? bx_ : ((vcu_ & 15) == 0 ? (vcu_ >> 4) : NPAN * 4)), NPAN, pass ? 0 : (MP / 256) * 4};
                pg8::EpiMerge E{WSP(bf16, WS_MERGED), WSP(bf16, WS_GATES), NPAN};
                pg8::gemm_phase<pg8::EpiMerge, pg8::PairOrder, true, true>(F.lds, g, S, E, opq(F.wave)); } }
        SEAM(pb + 7);
        for (int rep_ = 0; rep_ < REPS(8); ++rep_) if (ON(8, pb + 8)) { if (rep_) xcd_barrier(bar); const Args& a = kargs(); pg8::Gemm g{WSP(bf16, WS_MERGED), WSP(const bf16, wlo + WL_O), M, D, D}; pg8::SplitOrder S; S.init(MP, D, opq(F.G), opq((int)blockIdx.x), D / 256); pg8::EpiF32S E{WSP(bf16, WS_F), WSP(float, WS_FP), D, MP, MD};
            pg8::gemm_phase<pg8::EpiF32S, pg8::SplitOrder, true, true>(F.lds, g, S, E, opq(F.wave)); } SEAM(pb + 8);
        for (int rep_ = 0; rep_ < REPS(9); ++rep_) if (ON(9, pb + 9)) { if (rep_) xcd_barrier(bar); const Args& a = kargs(); const float* modl = WSP(float, modo);
            ph_ln<true, true, true, true>(F, nullptr, nullptr, WSP(bf16, WS_F), 1.0f, modl + 5 * D, a.in[I_LNG] + (l * 3 + 1) * D, a.in[I_LNB] + (l * 3 + 1) * D, modl + 6 * D, nullptr, WSP(bf16, WS_U), WSP(float, WS_FP), D / 256, WSP(const bf16, WS_XB), WSP(bf16, WS_XB)); } SEAM(pb + 9);
        for (int rep_ = 0; rep_ < REPS(10); ++rep_) if (ON(10, pb + 10)) { if (rep_) xcd_barrier(bar); const Args& a = kargs(); pg8::Gemm g{WSP(bf16, WS_U), WSP(const bf16, wlo + WL_GU1), M, NGU, D}; pg8::StaticOrder S; S.init(M, NGU, opq(F.G), opq((int)blockIdx.x)); pg8::EpiSwiglu E{WSP(bf16, WS_ACT), DFF};
            pg8::gemm_phase<pg8::EpiSwiglu, pg8::StaticOrder, true, true>(F.lds, g, S, E, opq(F.wave)); } SEAM(pb + 10);
        for (int rep_ = 0; rep_ < REPS(11); ++rep_) if (ON(11, pb + 11)) { if (rep_) xcd_barrier(bar); const Args& a = kargs(); pg8::Gemm g{WSP(bf16, WS_ACT), WSP(const bf16, wlo + WL_DN1), M, D, DFF}; pg8::SplitOrder S; S.init(MP, D, opq(F.G), opq((int)blockIdx.x), DFF / 256); pg8::EpiF32S E{WSP(bf16, WS_F), WSP(float, WS_FP), D, MP, MD};
            pg8::gemm_phase<pg8::EpiF32S, pg8::SplitOrder, true, true>(F.lds, g, S, E, opq(F.wave)); } SEAM(pb + 11);
        for (int rep_ = 0; rep_ < REPS(12); ++rep_) if (ON(12, pb + 12)) { if (rep_) xcd_barrier(bar); const Args& a = kargs(); const float* modl = WSP(float, modo);
            if (l + 1 < DEPTH) ph_ln<true, true, true, true>(F, nullptr, nullptr, WSP(bf16, WS_F), 0.5f, modl + 8 * D, a.in[I_LNG] + (l * 3 + 2) * D, a.in[I_LNB] + (l * 3 + 2) * D, modl + (size_t)NSEQ * 9216, nullptr, WSP(bf16, WS_U), WSP(float, WS_FP), DFF / 256, WSP(const bf16, WS_XB), WSP(bf16, WS_XB));
            else ph_ln<true, true, false, false>(F, nullptr, nullptr, WSP(bf16, WS_F), 0.5f, modl + 8 * D, a.in[I_LNG] + (l * 3 + 2) * D, a.in[I_LNB] + (l * 3 + 2) * D, nullptr, a.out, nullptr, WSP(float, WS_FP), DFF / 256, WSP(const bf16, WS_XB), nullptr); } SEAM(pb + 12);
    }
#undef IN
#undef ON
#undef SEAM
#undef WSP
}

#if MK_LAUNCH_PER_PHASE
static const void* phase_fn(int k) {
    switch (k) { case 0: return (const void*)fwd<1u << 0>; case 1: return (const void*)fwd<1u << 1>; case 2: return (const void*)fwd<1u << 2>; case 3: return (const void*)fwd<1u << 3>;
        case 4: return (const void*)fwd<1u << 4>; case 5: return (const void*)fwd<1u << 5>; case 6: return (const void*)fwd<1u << 6>; case 7: return (const void*)fwd<1u << 7>;
        case 8: return (const void*)fwd<1u << 8>; case 9: return (const void*)fwd<1u << 9>; case 10: return (const void*)fwd<1u << 10>; case 11: return (const void*)fwd<1u << 11>;
        case 12: return (const void*)fwd<1u << 12>; case 13: return (const void*)fwd<1u << 13>; case 14: return (const void*)fwd<1u << 14>; default: return (const void*)fwd<1u << 15>; }
}
#else
#ifndef FULL_MASK
#define FULL_MASK 0xFFFFu
#endif
static const void* phase_fn(int) { return (const void*)fwd<FULL_MASK>; }
#endif

extern "C" void kernel_launch(void* const* d_in, const int* in_sizes, int n_in, void* d_out, int out_size, void* d_ws, size_t ws_size, hipStream_t stream) {
    static int grid = 0;
    if (grid == 0) {
        if (n_in != 34 || (size_t)out_size != OUT_TOTAL || ws_size < WS_END) { fprintf(stderr, "kernel_launch: unexpected shapes: n_in %d out %d ws %zu (need %zu)\n", n_in, out_size, ws_size, (size_t)WS_END); grid = -1; return; }
        int dev = 0, cus = 0, per_cu = 0;
        if (hipGetDevice(&dev) != hipSuccess || hipDeviceGetAttribute(&cus, hipDeviceAttributeMultiprocessorCount, dev) != hipSuccess) { grid = -1; return; }
        for (int k = 0; k < 16; ++k) if (hipFuncSetAttribute(phase_fn(k), hipFuncAttributeMaxDynamicSharedMemorySize, LDS_BYTES) != hipSuccess) { fprintf(stderr, "kernel_launch: hipFuncSetAttribute failed\n"); grid = -1; return; }
        if (hipOccupancyMaxActiveBlocksPerMultiprocessor(&per_cu, phase_fn(15), NTHR, LDS_BYTES) != hipSuccess || per_cu < 1) fprintf(stderr, "kernel_launch: occupancy query reports %d\n", per_cu);
        (void)hipGetLastError();
        grid = cus;
    }
    if (grid < 0) return;
    (void)hipMemsetAsync((char*)d_ws + WS_CTL, 0, CTL_ZERO_BYTES, stream);
    Args a{};
    for (int i = 0; i < 34; ++i) a.in[i] = (const float*)d_in[i];
    a.out = (float*)d_out; a.ws = (unsigned char*)d_ws;
#if MK_LAUNCH_PER_PHASE
#ifndef MAXPH
#define MAXPH NPH
#endif
    for (int p = 0; p < MAXPH; ++p) { a.ph_lo = p; a.ph_hi = p + 1; const int kind = p < 2 ? 13 + p : (p - 2) % NPH_LAYER; void* kargs[] = {&a}; (void)hipLaunchKernel(phase_fn(kind), dim3(grid), dim3(NTHR), kargs, LDS_BYTES, stream); }
#else
    a.ph_lo = 0; a.ph_hi = NPH; { void* kargs[] = {&a}; (void)hipLaunchKernel(phase_fn(15), dim3(grid), dim3(NTHR), kargs, LDS_BYTES, stream); }
#endif
}
```

```cpp
#include <hip/hip_runtime.h>
#include <hip/hip_bf16.h>
#include <cstdio>
#include <cstdint>
#include <cmath>
namespace pg8 {
#define PG8_LAS __attribute__((address_space(3)))
typedef unsigned short bf16_t;
typedef short bf16x8 __attribute__((ext_vector_type(8)));
typedef float f32x4 __attribute__((ext_vector_type(4)));
typedef unsigned u32x4 __attribute__((ext_vector_type(4)));
constexpr int BM = 256, BK = 64, HALF = 128, HTB = HALF * BK * 2  , STAGE_BYTES = 8 * HTB, NXCD = 8, WGM = 8;

__host__ __device__ __forceinline__ int lds_byte(int r, int c) { const int st = (r >> 4) * 2 + (c >> 5), rr = r & 15, cc = c & 31, ob = rr * 64 + cc * 2; return st * 1024 + (ob ^ (((ob >> 9) & 1) << 5)); }
__host__ __device__ __forceinline__ void stage_rc(int b, int& R, int& C) { const int st = b / 1024, sb = b % 1024, swz = sb ^ (((sb >> 9) & 1) << 5); R = (st >> 1) * 16 + swz / 64; C = (st & 1) * 32 + (swz % 64) / 2; }
__host__ __device__ __forceinline__ int perm32(int rho) { const int n = rho >> 4, i = rho & 15; return 8 * (i >> 2) + 4 * n + (i & 3); }

struct Unit { int pm, pn, k0, ntk, ks; };
struct Gemm { const bf16_t* A; const bf16_t* Bt; int M, N, K; };

struct StaticOrder {
    int nM, nN, nwg, G, c;
    __host__ __device__ void init(int M, int N, int G_, int c_) { nM = M / BM; nN = N / BM; nwg = nM * nN; G = G_; c = c_; }
    __host__ __device__ bool next(int i, Unit& u) const {
        const long L = (long)i * G + c; if (L >= nwg) return false;
        int wgid = (int)L; { const int q = nwg / NXCD, r = nwg % NXCD, xcd = wgid % NXCD, off = wgid / NXCD; wgid = (xcd < r ? xcd * (q + 1) : r * (q + 1) + (xcd - r) * q) + off; }
        const int nig = WGM * nN, gid = wgid / nig, fm = gid * WGM, gsz = (nM - fm) < WGM ? (nM - fm) : WGM;
        u.pm = fm + ((wgid % nig) % gsz); u.pn = (wgid % nig) / gsz; u.k0 = 0; u.ntk = 0; u.ks = -1; return true;
    }
    __device__ __forceinline__ void a_ready(const Unit&) const {}
    __device__ __forceinline__ void done(const Unit&) const {}
};

typedef float f32x2c_t __attribute__((ext_vector_type(2))); typedef __bf16 bf16x2c_t __attribute__((ext_vector_type(2)));
__device__ __forceinline__ unsigned cvt_pk_bf16(float lo, float hi) { f32x2c_t v = {lo, hi}; bf16x2c_t b = __builtin_convertvector(v, bf16x2c_t); return __builtin_bit_cast(unsigned, b); }
typedef float f32x2 __attribute__((ext_vector_type(2)));
__device__ __forceinline__ float fast_sigmoid(float x) { return __builtin_amdgcn_rcpf(1.0f + __expf(-x)); }
struct EpiSwiglu {
    static constexpr bool PERM = true, AFTER_DRAIN = false, KEEPS = false;
    bf16_t* O; int ldc;
    __device__ __forceinline__ void operator()(const f32x4 (&acc)[2][2][4][2], const Unit& u, int wr, int wc, int fr, int fq) const {
        const int row0 = u.pm * BM + wr * 64 + fr; const int col0 = u.pn * 128 + wc * 32 + 8 * fq;
#pragma unroll
        for (int ai = 0; ai < 2; ++ai)
#pragma unroll
            for (int m = 0; m < 4; ++m) { bf16_t* rowp = O + (size_t)(row0 + ai * HALF + m * 16) * ldc + col0;
                float v[8];
#pragma unroll
                for (int n = 0; n < 2; ++n)
#pragma unroll
                    for (int e = 0; e < 4; ++e) { const float g = acc[ai][0][m][n][e], up = acc[ai][1][m][n][e]; v[n * 4 + e] = g * fast_sigmoid(g) * up; }
                u32x4 w; w.x = cvt_pk_bf16(v[0], v[1]); w.y = cvt_pk_bf16(v[2], v[3]); w.z = cvt_pk_bf16(v[4], v[5]); w.w = cvt_pk_bf16(v[6], v[7]);
                *(u32x4*)rowp = w; }
    }
};
struct EpiF32 {
    static constexpr bool PERM = false, AFTER_DRAIN = false, KEEPS = false;
    float* O; int ldc;
    __device__ __forceinline__ void operator()(const f32x4 (&acc)[2][2][4][2], const Unit& u, int wr, int wc, int fr, int fq) const {
        const int row0 = u.pm * BM + wr * 64 + fr; const int col0 = u.pn * BM + wc * 32 + 4 * fq;
#pragma unroll
        for (int ai = 0; ai < 2; ++ai)
#pragma unroll
            for (int m = 0; m < 4; ++m) { float* rowp = O + (size_t)(row0 + ai * HALF + m * 16) * ldc + col0;
#pragma unroll
                for (int bj = 0; bj < 2; ++bj)
#pragma unroll
                    for (int n = 0; n < 2; ++n) *(f32x4*)(rowp + bj * HALF + n * 16) = acc[ai][bj][m][n]; }
    }
};
struct EpiProj {
    static constexpr bool PERM = true, AFTER_DRAIN = false, KEEPS = false;
    bf16_t* Q; bf16_t* Kb; bf16_t* Vb; bf16_t* PRW; bf16_t* GATES; const float* bgate;
    float* outKp; float* outVp; float* outKs; float* outVs; float* outShp; float* outShs;
    float qscale;
    __device__ __forceinline__ void operator()(const f32x4 (&acc)[2][2][4][2], const Unit& u, int wr, int wc, int fr, int fq) const {
        const int row0 = u.pm * BM + wr * 64 + fr; const int pn = u.pn; const int cw = wc * 32 + 8 * fq;
        const bool prompt = u.pm < 128;
        auto pack8 = [](const f32x4& a, const f32x4& b) -> u32x4 { u32x4 w; w.x = cvt_pk_bf16(a[0], a[1]); w.y = cvt_pk_bf16(a[2], a[3]); w.z = cvt_pk_bf16(b[0], b[1]); w.w = cvt_pk_bf16(b[2], b[3]); return w; };
#pragma unroll
        for (int ai = 0; ai < 2; ++ai)
#pragma unroll
            for (int m = 0; m < 4; ++m) { const int row = row0 + ai * HALF + m * 16;
#pragma unroll
                for (int bj = 0; bj < 2; ++bj) { const f32x4 v0 = acc[ai][bj][m][0], v1 = acc[ai][bj][m][1]; const int ct = bj * HALF + cw;
                    if (pn < 2) { const int c = pn * 256 + ct; *(u32x4*)(Q + (size_t)row * 512 + c) = pack8(v0 * qscale, v1 * qscale); }
                    else if (pn < 6) { const bool isk = pn < 4; const int c = (pn - (isk ? 2 : 4)) * 256 + ct;
                        *(u32x4*)((isk ? Kb : Vb) + (size_t)row * 512 + c) = pack8(v0, v1);
                        float* o = prompt ? (isk ? outKp : outVp) + (size_t)row * 512 + c : (isk ? outKs : outVs) + (size_t)(row - 32768) * 512 + c;
                        __builtin_nontemporal_store(v0, (f32x4*)o); __builtin_nontemporal_store(v1, (f32x4*)(o + 4)); }
                    else if (pn < 13) { const int c = (pn - 6) * 256 + ct; *(u32x4*)(PRW + (size_t)row * 1792 + c) = pack8(v0, v1);
                        if (prompt) { if ((row & 8191) == 8191) { float* so = outShp + (size_t)(row >> 13) * 1792 + c; *(f32x4*)so = v0; *(f32x4*)(so + 4) = v1; } }
                        else { const int rd = row - 32768; if ((rd & 31) == 31) { float* so = outShs + (size_t)(rd >> 5) * 1792 + c; *(f32x4*)so = v0; *(f32x4*)(so + 4) = v1; } } }
                    else { const int c = (pn - 13) * 256 + ct; const f32x4 b0 = *(const f32x4*)(bgate + c), b1 = *(const f32x4*)(bgate + c + 4);
                        f32x4 s0, s1;
#pragma unroll
                        for (int e = 0; e < 4; ++e) { s0[e] = fast_sigmoid(v0[e] + b0[e]); s1[e] = fast_sigmoid(v1[e] + b1[e]); }
                        *(u32x4*)(GATES + (size_t)row * 2048 + c) = pack8(s0, s1); }
                } }
    }
};
struct EpiMerge {
    static constexpr bool PERM = true, AFTER_DRAIN = false, KEEPS = true;
    bf16_t* OUT; const bf16_t* GATES; int npan;
    __device__ __forceinline__ bool apply(f32x4 (&acc)[2][2][4][2], const Unit& u, int wr, int wc, int fr, int fq) const {
        const int which = u.pm >= npan ? 1 : 0; const int pm = u.pm - which * npan, pn = u.pn - which * 4;
        const int row0 = pm * BM + wr * 64 + fr; const int col0 = pn * BM + wc * 32 + 8 * fq;
        auto lo4 = [](const u32x4& w) -> f32x4 { f32x4 g; g[0] = __uint_as_float(w.x << 16); g[1] = __uint_as_float(w.x & 0xffff0000u); g[2] = __uint_as_float(w.y << 16); g[3] = __uint_as_float(w.y & 0xffff0000u); return g; };
        auto hi4 = [](const u32x4& w) -> f32x4 { f32x4 g; g[0] = __uint_as_float(w.z << 16); g[1] = __uint_as_float(w.z & 0xffff0000u); g[2] = __uint_as_float(w.w << 16); g[3] = __uint_as_float(w.w & 0xffff0000u); return g; };
        auto clampg = [](f32x4 g) -> f32x4 { g[0] = fmaxf(g[0], 1e-30f); g[1] = fmaxf(g[1], 1e-30f); g[2] = fmaxf(g[2], 1e-30f); g[3] = fmaxf(g[3], 1e-30f); return g; };
        auto rcp4 = [](const f32x4& g) -> f32x4 { f32x4 r; r[0] = __builtin_amdgcn_rcpf(g[0]); r[1] = __builtin_amdgcn_rcpf(g[1]); r[2] = __builtin_amdgcn_rcpf(g[2]); r[3] = __builtin_amdgcn_rcpf(g[3]); return r; };
        u32x4 ac[2], an[2], bc[2], bn[2];
        auto issue = [&](int g) { const int r = row0 + (g >> 2) * HALF + (g & 3) * 16;
#pragma unroll
            for (int bj = 0; bj < 2; ++bj) { bn[bj] = *(const u32x4*)(GATES + (size_t)r * 2048 + 1024 + col0 + bj * HALF); if (!which) an[bj] = *(const u32x4*)(GATES + (size_t)r * 2048 + col0 + bj * HALF); } };
        issue(0);
#pragma unroll
        for (int g = 0; g < 8; ++g) { const int ai = g >> 2, m = g & 3;
#pragma unroll
            for (int bj = 0; bj < 2; ++bj) { ac[bj] = an[bj]; bc[bj] = bn[bj]; }
            if (g < 7) issue(g + 1);
            const size_t ro = (size_t)(row0 + ai * HALF + m * 16) * 1024 + col0;
#pragma unroll
            for (int bj = 0; bj < 2; ++bj) { const f32x4 gb0 = clampg(lo4(bc[bj])), gb1 = clampg(hi4(bc[bj]));
                if (which == 0) { acc[ai][bj][m][0] = acc[ai][bj][m][0] * (lo4(ac[bj]) * rcp4(gb0)); acc[ai][bj][m][1] = acc[ai][bj][m][1] * (hi4(ac[bj]) * rcp4(gb1)); }
                else { const f32x4 t0 = acc[ai][bj][m][0] * gb0, t1 = acc[ai][bj][m][1] * gb1; u32x4 w; w.x = cvt_pk_bf16(t0[0], t0[1]); w.y = cvt_pk_bf16(t0[2], t0[3]); w.z = cvt_pk_bf16(t1[0], t1[1]); w.w = cvt_pk_bf16(t1[2], t1[3]);
                    *(u32x4*)(OUT + ro + bj * HALF) = w; } }
        }
        return which == 0;
    }
};
struct SplitOrder {
    StaticOrder base; int G, c, nslice, nbase;
    __device__ __forceinline__ void init(int Mprompt, int N, int G_, int c_, int nslice_) { base.init(Mprompt, N, G_, c_); G = G_; c = c_; nslice = nslice_; nbase = c_ < base.nwg ? (base.nwg - c_ + G_ - 1) / G_ : 0; }
    __device__ __forceinline__ bool next(int i, Unit& u) const {
        if (i < nbase) return base.next(i, u);
        const int e = (i - nbase) * G + c; if (e >= 16 * nslice) return false;
        const int tile = e / nslice, sl = e - tile * nslice; u.pm = base.nM + (tile >> 2); u.pn = tile & 3; u.k0 = sl * 256; u.ntk = 4; u.ks = sl; return true;
    }
    __device__ __forceinline__ void a_ready(const Unit&) const {}
    __device__ __forceinline__ void done(const Unit&) const {}
};
struct EpiF32S {
    static constexpr bool PERM = true, AFTER_DRAIN = false, KEEPS = false;
    bf16_t* O; float* FP; int ldc, mprompt, mdec;
    __device__ __forceinline__ void operator()(const f32x4 (&acc)[2][2][4][2], const Unit& u, int wr, int wc, int fr, int fq) const {
        const int row0 = u.pm * BM + wr * 64 + fr; const int col0 = u.pn * BM + wc * 32 + 8 * fq;
        if (u.ks < 0) {
#pragma unroll
            for (int ai = 0; ai < 2; ++ai)
#pragma unroll
                for (int m = 0; m < 4; ++m) { bf16_t* rowp = O + (size_t)(row0 + ai * HALF + m * 16) * ldc + col0;
#pragma unroll
                    for (int bj = 0; bj < 2; ++bj) { const f32x4 v0 = acc[ai][bj][m][0], v1 = acc[ai][bj][m][1]; u32x4 w; w.x = cvt_pk_bf16(v0[0], v0[1]); w.y = cvt_pk_bf16(v0[2], v0[3]); w.z = cvt_pk_bf16(v1[0], v1[1]); w.w = cvt_pk_bf16(v1[2], v1[3]);
                        *(u32x4*)(rowp + bj * HALF) = w; } }
        } else {
            float* base = FP + ((size_t)u.ks * mdec + (row0 - mprompt)) * ldc;
#pragma unroll
            for (int ai = 0; ai < 2; ++ai)
#pragma unroll
                for (int m = 0; m < 4; ++m) { float* rowp = base + (size_t)(ai * HALF + m * 16) * ldc + col0;
#pragma unroll
                    for (int bj = 0; bj < 2; ++bj)
#pragma unroll
                        for (int n = 0; n < 2; ++n) *(f32x4*)(rowp + bj * HALF + n * 4) = acc[ai][bj][m][n]; }
        }
    }
};
struct PairOrder {
    int ntile, G, c, npan, tile0;
    __device__ __forceinline__ bool next(int i, Unit& u) const { const int tile = tile0 + (i >> 1) * G + c; if (tile >= ntile) return false; const int which = i & 1; u.pm = (tile >> 2) + which * npan; u.pn = (tile & 3) + which * 4; u.k0 = 0; u.ntk = 0; u.ks = -1; return true; }
    __device__ __forceinline__ void a_ready(const Unit&) const {}
    __device__ __forceinline__ void done(const Unit&) const {}
};
template <class Epi, class Sched, bool ALIGN_EPI = false, bool SP2 = false>
__device__ __forceinline__ void gemm_phase(PG8_LAS unsigned char* lds, const Gemm g, const Sched& S, const Epi& E, int wave_s) {
    unsigned z_ = 0u; asm volatile("" : "+v"(z_));
    int tid_ = wave_s * 64 + (int)__builtin_amdgcn_mbcnt_hi(~0u, __builtin_amdgcn_mbcnt_lo(~0u, z_));
    const int tid = tid_, wid = __builtin_amdgcn_readfirstlane(tid >> 6), lane = tid & 63, wr = wid >> 2, wc = wid & 3, fr = lane & 15, fq = lane >> 4;
    const int K = g.K, ntK = K / BK;
    unsigned voffA[2], voffB[2];
#pragma unroll
    for (int i = 0; i < 2; ++i) { int R, C; stage_rc(tid * 16 + i * 8192, R, C); const int Rb = Epi::PERM ? ((R & ~31) + perm32(R & 31)) : R;
        voffA[i] = (unsigned)(R * K + C) * 2u; voffB[i] = (unsigned)(Rb * K + C) * 2u; }
    const size_t kstep = (size_t)(BK * 2);
    const size_t hstep = (size_t)HALF * K * 2;
    const size_t tstep = 2 * hstep;
    const unsigned ldsw = (unsigned)wid * 1024u;
    const int aoff = lds_byte(wr * 64 + fr, fq * 8), boff = lds_byte(wc * 32 + fr, fq * 8);
#define PG8_SA(b, h) (((b) * 2 + (h)) * HTB)
#define PG8_SB(b, h) ((4 + (b) * 2 + (h)) * HTB)
#define PG8_STAGE(bufoff, gbase, voff) do { _Pragma("unroll") for (int _i = 0; _i < 2; ++_i) \
        __builtin_amdgcn_global_load_lds((const unsigned*)((const char*)(gbase) + (voff)[_i]), (PG8_LAS unsigned*)(lds + (bufoff) + ldsw + _i * 8192), 16, 0, 0); } while (0)
#define PG8_LDA(dst, b, h) do { _Pragma("unroll") for (int m = 0; m < 4; ++m) _Pragma("unroll") for (int k = 0; k < 2; ++k) dst[m][k] = *(const PG8_LAS bf16x8*)(lds + PG8_SA(b, h) + aoff + m * 2048 + k * 1024); } while (0)
#define PG8_LDB(dst, b, h) do { _Pragma("unroll") for (int n = 0; n < 2; ++n) _Pragma("unroll") for (int k = 0; k < 2; ++k) dst[n][k] = *(const PG8_LAS bf16x8*)(lds + PG8_SB(b, h) + boff + n * 2048 + k * 1024); } while (0)
#define PG8_MMA(ai, bj, At, Bt) do { __builtin_amdgcn_s_setprio(1); _Pragma("unroll") for (int m = 0; m < 4; ++m) _Pragma("unroll") for (int n = 0; n < 2; ++n) _Pragma("unroll") for (int k = 0; k < 2; ++k) \
        acc[ai][bj][m][n] = __builtin_amdgcn_mfma_f32_16x16x32_bf16(Bt[n][k], At[m][k], acc[ai][bj][m][n], 0, 0, 0); __builtin_amdgcn_s_setprio(0); } while (0)
#define PG8_WAIT_V(n) asm volatile("s_waitcnt vmcnt(" #n ")" ::: "memory")
#define PG8_WAIT_L(n) asm volatile("s_waitcnt lgkmcnt(" #n ")" ::: "memory")
#define PG8_BAR __builtin_amdgcn_s_barrier()
#define PG8_SCHED __builtin_amdgcn_sched_barrier(0)
    Unit cur, nxt; int ui = 0;
    if (!S.next(0, cur)) return;
    f32x4 acc[2][2][4][2];
#pragma unroll
    for (int a = 0; a < 2; ++a)
#pragma unroll
        for (int b = 0; b < 2; ++b)
#pragma unroll
            for (int m = 0; m < 4; ++m)
#pragma unroll
                for (int n = 0; n < 2; ++n) acc[a][b][m][n] = (f32x4){0.f, 0.f, 0.f, 0.f};
    bf16x8 At[4][2], B0[2][2], B1[2][2];
    const char* cA = (const char*)g.A + (size_t)cur.pm * tstep + (size_t)cur.k0 * 2; const char* cB = (const char*)g.Bt + (size_t)cur.pn * tstep + (size_t)cur.k0 * 2;
    S.a_ready(cur);
    if constexpr (SP2) {
        PG8_STAGE(PG8_SB(0, 0), cB, voffB); PG8_STAGE(PG8_SB(0, 1), cB + hstep, voffB); PG8_STAGE(PG8_SA(0, 0), cA, voffA); PG8_STAGE(PG8_SA(0, 1), cA + hstep, voffA);
        if (wr == 1) PG8_BAR;
        PG8_WAIT_V(2); PG8_BAR;
        PG8_STAGE(PG8_SB(1, 0), cB + kstep, voffB); PG8_STAGE(PG8_SA(1, 0), cA + kstep, voffA); PG8_STAGE(PG8_SB(1, 1), cB + hstep + kstep, voffB);
        PG8_WAIT_V(6); PG8_BAR;
    } else {
        PG8_STAGE(PG8_SB(0, 0), cB, voffB); PG8_STAGE(PG8_SA(0, 0), cA, voffA); PG8_STAGE(PG8_SB(0, 1), cB + hstep, voffB); PG8_STAGE(PG8_SA(0, 1), cA + hstep, voffA);
        if (wr == 1) PG8_BAR;
        PG8_WAIT_V(4); PG8_BAR;
        PG8_STAGE(PG8_SB(1, 0), cB + kstep, voffB); PG8_STAGE(PG8_SA(1, 0), cA + kstep, voffA); PG8_STAGE(PG8_SB(1, 1), cB + hstep + kstep, voffB);
        PG8_WAIT_V(6); PG8_BAR;
    }
    for (;;) {
        const bool has_next = S.next(ui + 1, nxt);
        const char* nA = has_next ? (const char*)g.A + (size_t)nxt.pm * tstep + (size_t)nxt.k0 * 2 : cA; const char* nB = has_next ? (const char*)g.Bt + (size_t)nxt.pn * tstep + (size_t)nxt.k0 * 2 : cB;
        const int nt = cur.ntk ? cur.ntk : ntK;
        for (int t = 0; t < nt; t += 2) {
            const bool last = (t == nt - 2);
            const char* a1 = cA + (size_t)(t + 1) * kstep;
            const char* a2 = last ? nA : cA + (size_t)(t + 2) * kstep; const char* b2 = last ? nB : cB + (size_t)(t + 2) * kstep;
            const char* a3 = a2 + kstep; const char* b3 = b2 + kstep;
            if (last && has_next) S.a_ready(nxt);
            if constexpr (SP2) {
            PG8_LDB(B0, 0, 0); PG8_LDB(B1, 0, 1); PG8_SCHED; PG8_LDA(At, 0, 0); PG8_STAGE(PG8_SA(1, 1), a1 + hstep, voffA);
            PG8_WAIT_V(8); PG8_WAIT_L(0); PG8_BAR; PG8_MMA(0, 0, At, B0); PG8_MMA(0, 1, At, B1); PG8_BAR; PG8_SCHED;
            PG8_LDA(At, 0, 1); PG8_STAGE(PG8_SB(0, 0), b2, voffB); PG8_STAGE(PG8_SB(0, 1), b2 + hstep, voffB); PG8_STAGE(PG8_SA(0, 0), a2, voffA);
            PG8_WAIT_V(8); PG8_WAIT_L(0); PG8_BAR; PG8_MMA(1, 0, At, B0); PG8_MMA(1, 1, At, B1); PG8_BAR; PG8_SCHED;
            PG8_LDB(B0, 1, 0); PG8_LDB(B1, 1, 1); PG8_SCHED; PG8_LDA(At, 1, 0); PG8_STAGE(PG8_SA(0, 1), a2 + hstep, voffA);
            PG8_WAIT_V(8); PG8_WAIT_L(0); PG8_BAR; PG8_MMA(0, 0, At, B0); PG8_MMA(0, 1, At, B1); PG8_BAR; PG8_SCHED;
            PG8_LDA(At, 1, 1); PG8_STAGE(PG8_SB(1, 0), b3, voffB); PG8_STAGE(PG8_SB(1, 1), b3 + hstep, voffB); PG8_STAGE(PG8_SA(1, 0), a3, voffA);
            PG8_WAIT_V(8); PG8_WAIT_L(0); PG8_BAR; PG8_MMA(1, 0, At, B0); PG8_MMA(1, 1, At, B1); PG8_BAR; PG8_SCHED;
            } else {
            PG8_LDB(B0, 0, 0); PG8_SCHED; PG8_LDA(At, 0, 0); PG8_STAGE(PG8_SA(1, 1), a1 + hstep, voffA);
            PG8_WAIT_L(8); PG8_BAR; PG8_WAIT_L(0); PG8_MMA(0, 0, At, B0); PG8_BAR; PG8_SCHED;
            PG8_LDB(B1, 0, 1); PG8_STAGE(PG8_SB(0, 0), b2, voffB);
            PG8_BAR; PG8_WAIT_L(0); PG8_MMA(0, 1, At, B1); PG8_BAR;
            PG8_LDA(At, 0, 1); PG8_STAGE(PG8_SA(0, 0), a2, voffA);
            PG8_BAR; PG8_WAIT_L(0); PG8_MMA(1, 0, At, B0); PG8_BAR; PG8_SCHED;
            PG8_STAGE(PG8_SB(0, 1), b2 + hstep, voffB);
            PG8_WAIT_V(6); PG8_BAR; PG8_MMA(1, 1, At, B1); PG8_BAR;
            PG8_LDB(B0, 1, 0); PG8_SCHED; PG8_LDA(At, 1, 0); PG8_STAGE(PG8_SA(0, 1), a2 + hstep, voffA);
            PG8_WAIT_L(8); PG8_BAR; PG8_WAIT_L(0); PG8_MMA(0, 0, At, B0); PG8_BAR; PG8_SCHED;
            PG8_LDB(B1, 1, 1); PG8_STAGE(PG8_SB(1, 0), b3, voffB);
            PG8_BAR; PG8_WAIT_L(0); PG8_MMA(0, 1, At, B1); PG8_BAR;
            PG8_LDA(At, 1, 1); PG8_STAGE(PG8_SA(1, 0), a3, voffA);
            PG8_BAR; PG8_WAIT_L(0); PG8_MMA(1, 0, At, B0); PG8_BAR; PG8_SCHED;
            PG8_STAGE(PG8_SB(1, 1), b3 + hstep, voffB);
            PG8_WAIT_V(6); PG8_BAR; PG8_MMA(1, 1, At, B1); PG8_BAR;
            }
        }
        if constexpr (ALIGN_EPI) { if (wr == 0) PG8_BAR; }
        bool keep_acc = false;
        if constexpr (!Epi::AFTER_DRAIN) { if constexpr (Epi::KEEPS) keep_acc = E.apply(acc, cur, wr, wc, fr, fq); else E(acc, cur, wr, wc, fr, fq); S.done(cur); }
        if (!has_next) break;
        if (!keep_acc)
#pragma unroll
        for (int a = 0; a < 2; ++a)
#pragma unroll
            for (int b = 0; b < 2; ++b)
#pragma unroll
                for (int m = 0; m < 4; ++m)
#pragma unroll
                    for (int n = 0; n < 2; ++n) acc[a][b][m][n] = (f32x4){0.f, 0.f, 0.f, 0.f};
        cur = nxt; cA = nA; cB = nB; ++ui;
        if constexpr (ALIGN_EPI) { if (wr == 1) PG8_BAR; }
    }
    PG8_WAIT_V(0);
    if constexpr (!ALIGN_EPI) { if (wr == 0) PG8_BAR; }
    PG8_BAR;
    if constexpr (Epi::AFTER_DRAIN) { E.fused(acc, cur, wr, wc, fr, fq, lds, wid, lane); S.done(cur); }
#undef PG8_SA
#undef PG8_SB
#undef PG8_STAGE
#undef PG8_LDA
#undef PG8_LDB
#undef PG8_MMA
#undef PG8_WAIT_V
#undef PG8_WAIT_L
#undef PG8_BAR
#undef PG8_SCHED
}
}
using pg8::fast_sigmoid;
#define GAS __attribute__((address_space(1)))
#define LAS __attribute__((address_space(3)))
typedef unsigned short bf16;
typedef unsigned v4u __attribute__((ext_vector_type(4)));
typedef float f32x4 __attribute__((ext_vector_type(4)));
typedef short bf16x8 __attribute__((ext_vector_type(8)));
typedef GAS unsigned gu32;
typedef GAS unsigned long long gu64;
#define RLX_AGENT __ATOMIC_RELAXED, __HIP_MEMORY_SCOPE_AGENT
#define LDS_WAIT() asm volatile("s_waitcnt lgkmcnt(0)" ::: "memory")
#define VM_WAIT() asm volatile("s_waitcnt vmcnt(0)" ::: "memory")
__device__ __forceinline__ unsigned long long rt() { return __builtin_amdgcn_s_memrealtime(); }
__device__ __forceinline__ unsigned f2bf(float f) { unsigned u = __builtin_bit_cast(unsigned, f); return (u + 0x7fffu + ((u >> 16) & 1u)) >> 16; }
__device__ __forceinline__ unsigned pk2(float lo, float hi) { return f2bf(lo) | (f2bf(hi) << 16); }

#define XB_TMO      128
#define XB_XCNT(j)  (256  + 64 * (j))
#define XB_XSUB(j)  (1280 + 64 * (j))
#define XB_XGEN(j)  (2304 + 64 * (j))
#define XB_TOP      3328
#define XB_TOPGEN   3392
#define XCD_BAR_WORDS 3456
#define XB_SPIN_CAP (1u << 18)

__device__ __forceinline__ unsigned xb_ld(unsigned* p)              { return __hip_atomic_load(p, __ATOMIC_RELAXED, __HIP_MEMORY_SCOPE_AGENT); }
__device__ __forceinline__ unsigned xb_add(unsigned* p, unsigned v) { return __hip_atomic_fetch_add(p, v, __ATOMIC_RELAXED, __HIP_MEMORY_SCOPE_AGENT); }
__device__ __forceinline__ unsigned xb_xcc_id() { return (unsigned)__builtin_amdgcn_s_getreg((3 << 11) | 20) & 0xFu; }
#define XB_SPIN(cond, bar) do { unsigned _sp = 0; while (cond) { __builtin_amdgcn_s_sleep(1); \
    if ((++_sp & 255u) == 0u) { if (xb_ld(&(bar)[XB_TMO])) break; if (_sp > XB_SPIN_CAP) { atomicAdd(&(bar)[XB_TMO], 1u); break; } } } } while (0)

struct XcdBarrier {
    int wave;
    unsigned* bar; unsigned x;
    volatile LAS unsigned* st;
};

__device__ __forceinline__ XcdBarrier xcd_barrier_post(unsigned* bar, volatile LAS unsigned* st) {
    XcdBarrier b; b.bar = bar; b.x = xb_xcc_id(); b.st = st;
    if (threadIdx.x == 0) (void)xb_add(&bar[XB_XCNT(b.x)], 1u);
    return b;
}
__device__ __forceinline__ void xcd_barrier_complete(unsigned* bar, unsigned x, unsigned& nloc, unsigned& nx) {
    const unsigned G = gridDim.x * gridDim.y * gridDim.z;
    unsigned sum, cnt, mine, sp = 0u;
    for (;;) {
        sum = 0u; cnt = 0u; mine = 0u;
#pragma unroll
        for (unsigned j = 0; j < 16; ++j) { const unsigned c = xb_ld(&bar[XB_XCNT(j)]); sum += c; cnt += (c > 0u) ? 1u : 0u; mine = (j == x) ? c : mine; }
        if (sum == G) break;
        __builtin_amdgcn_s_sleep(1);
        if ((++sp & 255u) == 0u) { if (xb_ld(&bar[XB_TMO])) break; if (sp > XB_SPIN_CAP) { atomicAdd(&bar[XB_TMO], 1u); break; } }
    }
    nloc = mine > 0u ? mine : 1u; nx = cnt > 0u ? cnt : 1u;
}

__device__ __forceinline__ void xcd_barrier(const XcdBarrier& b) {
    asm volatile("s_waitcnt vmcnt(0)" ::: "memory");
    __syncthreads();
    unsigned lz_ = 0u; asm volatile("" : "+v"(lz_));
    if (b.wave == 0 && __builtin_amdgcn_mbcnt_hi(~0u, __builtin_amdgcn_mbcnt_lo(~0u, lz_)) == 0u) {
        unsigned* bar = b.bar;
        __builtin_amdgcn_s_waitcnt(0);
        unsigned nloc = b.st[0], nx = b.st[1];
        if (nloc == 0u) { xcd_barrier_complete(bar, b.x, nloc, nx); b.st[0] = nloc; b.st[1] = nx; }
        const unsigned old = xb_add(&bar[XB_XSUB(b.x)], 1u);
        const unsigned gen = old / nloc;
        if (old + 1u == (gen + 1u) * nloc) {
            __builtin_amdgcn_fence(__ATOMIC_RELEASE, "agent");
            asm volatile("s_waitcnt vmcnt(0)" ::: "memory");
            const unsigned og = xb_add(&bar[XB_TOP], 1u);
            const unsigned tg = og / nx;
            if (og + 1u == (tg + 1u) * nx) xb_add(&bar[XB_TOPGEN], 1u);
            else XB_SPIN(xb_ld(&bar[XB_TOPGEN]) == tg, bar);
            __builtin_amdgcn_fence(__ATOMIC_ACQUIRE, "agent");
            xb_add(&bar[XB_XGEN(b.x)], 1u);
            asm volatile("s_waitcnt vmcnt(0)" ::: "memory");
        } else {
            XB_SPIN(xb_ld(&bar[XB_XGEN(b.x)]) == gen, bar);
            __builtin_amdgcn_fence(__ATOMIC_ACQUIRE, "agent");
            asm volatile("s_waitcnt vmcnt(0)" ::: "memory");
        }
    }
    __syncthreads();
}
constexpr int NWAVES = 8, NTHR = 512;
constexpr int D = 1024, NB = 4, SEQ = 8192, DEPTH = 4, DECB = 32, DECS = 32, PAST = 2048;
constexpr int MP = NB * SEQ, MD = DECB * DECS, M = MP + MD, NPAN = M / 256, NSEQ = NB + DECB;
constexpr int DFF = 2816, NGU = 2 * DFF, NIN = 3328, NRW = 1792, NIG = NIN + 2 * D;
constexpr int HA = 4, HB = 8;
constexpr float LN_EPS = 1e-5f, GN_EPS = 64e-5f;
constexpr float ALPHA = 1.681792830507429f;
constexpr float QSCALE = 0.125f * 1.4426950408889634f;
constexpr float LOG2E = 1.4426950408889634f;
constexpr size_t OFF_Y = 0, OFF_KP = (size_t)M * D, OFF_VP = OFF_KP + (size_t)DEPTH * MP * 512, OFF_WKVP = OFF_VP + (size_t)DEPTH * MP * 512,
    OFF_SHP = OFF_WKVP + (size_t)DEPTH * NB * HB * 4096, OFF_KS = OFF_SHP + (size_t)DEPTH * NB * NRW, OFF_VS = OFF_KS + (size_t)DEPTH * MD * 512,
    OFF_WKVS = OFF_VS + (size_t)DEPTH * MD * 512, OFF_SHS = OFF_WKVS + (size_t)DEPTH * DECB * HB * 4096, OUT_TOTAL = OFF_SHS + (size_t)DEPTH * DECB * NRW;
static_assert(OUT_TOTAL == 177991680ull, "output size");
constexpr size_t al256(size_t x) { return (x + 255) & ~(size_t)255; }
constexpr size_t WS_CTL = 0, CTL_ZERO_BYTES = 1u << 20;
constexpr size_t WS_MOD = CTL_ZERO_BYTES;
constexpr size_t WS_LAM = WS_MOD + al256((size_t)DEPTH * NSEQ * 9 * D * 4);
constexpr size_t WS_W = WS_LAM + 256;
constexpr size_t WL_GU0 = 0, WL_GU1 = WL_GU0 + (size_t)NGU * D * 2, WL_DN0 = WL_GU1 + (size_t)NGU * D * 2, WL_DN1 = WL_DN0 + (size_t)D * DFF * 2,
    WL_IG = WL_DN1 + (size_t)D * DFF * 2, WL_BR = WL_IG + (size_t)NIG * D * 2, WL_O = WL_BR + (size_t)2048 * 512 * 2, WL_W2 = WL_O + (size_t)D * D * 2,
    WL_A2 = WL_W2 + 512 * 64 * 2, WL_G2 = WL_A2 + 512 * 64 * 2, WL_SIZE = WL_G2 + 512 * 128 * 2;
constexpr size_t WS_U = WS_W + (size_t)DEPTH * WL_SIZE;
constexpr size_t WS_ACT = WS_U + (size_t)M * D * 2;
constexpr size_t WS_F = WS_ACT + (size_t)M * DFF * 2;
constexpr size_t WS_Q = WS_F + (size_t)M * D * 4;
constexpr size_t WS_KB = WS_Q + (size_t)M * 512 * 2, WS_VB = WS_KB + (size_t)M * 512 * 2;
constexpr size_t WS_PRW = WS_VB + (size_t)M * 512 * 2;
constexpr size_t WS_GATES = WS_PRW + (size_t)M * NRW * 4;
constexpr size_t WS_YAB = WS_GATES + (size_t)M * 2048 * 2;
constexpr size_t WS_MERGED = WS_YAB + (size_t)2 * M * 512 * 2;
constexpr int NITEM_P = NB * (SEQ / 64) * HB, NITEM = NITEM_P + DECB * HB;
constexpr size_t WS_PT = WS_MERGED + (size_t)M * D * 2;
constexpr size_t WS_QT = WS_PT + (size_t)NITEM * 8192;
constexpr size_t WS_HT = WS_QT + (size_t)NITEM * 8192;
constexpr size_t WS_OT = WS_HT + (size_t)NITEM * 16384;
constexpr size_t WS_OB = WS_OT + (size_t)NITEM * 16384;
constexpr size_t WS_GG = WS_OB + (size_t)M * 512 * 4, WS_BON = WS_GG + (size_t)NITEM * 16384;
constexpr size_t WS_SC = WS_BON + (size_t)NITEM * 16384;
constexpr size_t WS_PLB = WS_SC + (size_t)NITEM * 8192;
constexpr size_t WS_SSB = WS_PLB + (size_t)M * 256 * 2;
constexpr size_t WS_FP = al256(WS_SSB + (size_t)DEPTH * DECB * 256 * 2);
constexpr size_t WS_XB = WS_FP + (size_t)11 * MD * D * 4;
constexpr size_t WS_END = WS_XB + (size_t)M * D * 2;
constexpr int CW_TMO = 0, CW_BAR = 4096, CW_QUEUE = 8192;
constexpr int RING_BYTES = 131072, EXTRA_OFF = 131072, LDSCTL_OFF = 146944, LDS_BYTES = 147456;

struct Args { const float* in[34]; float* out; unsigned char* ws; int ph_lo, ph_hi; };
static_assert(sizeof(Args) == 36 * 8 + 8, "Args has no padding");
enum { I_XP = 0, I_XS, I_CP, I_CS, I_CK, I_CV, I_SWKV, I_SSH, I_RELB, I_WADA, I_BADA, I_LNG, I_LNB, I_WGU, I_WDN, I_WIN, I_LAMQK, I_SUBG, I_MU, I_W0, I_W2, I_A0, I_A2, I_G2,
       I_KK, I_KA, I_RK, I_LNXG, I_LNXB, I_BRA, I_BRB, I_WGATE, I_BGATE, I_WO };

struct Frame { LAS unsigned char* lds; int tid, lane, wave, vcu, G; };

__device__ __forceinline__ int opq(int x) { asm volatile("" : "+s"(x)); return x; }
__device__ __forceinline__ Frame relaunder(const Frame& F) { Frame G = F; G.vcu = opq(G.vcu); G.G = opq(G.G); G.wave = opq(F.wave); { unsigned z_ = 0u; asm volatile("" : "+v"(z_)); G.lane = (int)__builtin_amdgcn_mbcnt_hi(~0u, __builtin_amdgcn_mbcnt_lo(~0u, z_)); }   G.tid = G.wave * 64 + G.lane; return G; }
__device__ __forceinline__ int row_seq(int row) { return row < MP ? (row >> 13) : NB + ((row - MP) >> 5); }
__device__ __forceinline__ int crow(int r, int hi) { return (r & 3) + 8 * (r >> 2) + 4 * hi; }
template <int CTRL> __device__ __forceinline__ float dpp_mov(float x) { return __builtin_bit_cast(float, __builtin_amdgcn_update_dpp(0, __builtin_bit_cast(int, x), CTRL, 0xF, 0xF, true)); }
template <int CTRL, int ROWMASK> __device__ __forceinline__ float dpp_rows(float x) { return __builtin_bit_cast(float, __builtin_amdgcn_update_dpp(0, __builtin_bit_cast(int, x), CTRL, ROWMASK, 0xF, false)); }
__device__ __forceinline__ float wave_sum(float v) {
    v += dpp_mov<0xB1>(v); v += dpp_mov<0x4E>(v); v += dpp_mov<0x141>(v); v += dpp_mov<0x140>(v);
    v += dpp_rows<0x142, 0xA>(v); v += dpp_rows<0x143, 0xC>(v);
    return __builtin_bit_cast(float, __builtin_amdgcn_readlane(__builtin_bit_cast(int, v), 63));
}
__device__ __forceinline__ void wave_sum2(float& a, float& b) {
    a += dpp_mov<0xB1>(a); b += dpp_mov<0xB1>(b); a += dpp_mov<0x4E>(a); b += dpp_mov<0x4E>(b); a += dpp_mov<0x141>(a); b += dpp_mov<0x141>(b); a += dpp_mov<0x140>(a); b += dpp_mov<0x140>(b);
    a += dpp_rows<0x142, 0xA>(a); b += dpp_rows<0x142, 0xA>(b); a += dpp_rows<0x143, 0xC>(a); b += dpp_rows<0x143, 0xC>(b);
    a = __builtin_bit_cast(float, __builtin_amdgcn_readlane(__builtin_bit_cast(int, a), 63)); b = __builtin_bit_cast(float, __builtin_amdgcn_readlane(__builtin_bit_cast(int, b), 63));
}
__device__ __forceinline__ unsigned cvtpk(float lo, float hi) { return pg8::cvt_pk_bf16(lo, hi); }
__device__ __forceinline__ unsigned short f2bf1(float x) { return (unsigned short)(pg8::cvt_pk_bf16(x, 0.f) & 0xffffu); }
__device__ __forceinline__ float bf2f(bf16 b) { return __uint_as_float((unsigned)b << 16); }
typedef float f32x16 __attribute__((ext_vector_type(16)));
typedef unsigned u32x2 __attribute__((ext_vector_type(2)));
#define LP(T, p) ((LAS T*)(p))

__device__ __forceinline__ void p0_transpose_item(const float* W, int K, int N, bf16* WT, int k0, int n0, int drow0, LAS float* scr, int lane) {
    float wv[32];
#pragma unroll
    for (int i = 0; i < 32; ++i) wv[i] = W[(size_t)(k0 + 2 * i + (lane >> 5)) * N + n0 + (lane & 31)];
#pragma unroll
    for (int i = 0; i < 32; ++i) scr[(2 * i + (lane >> 5)) * 33 + (lane & 31)] = wv[i];
    LDS_WAIT(); asm volatile("" ::: "memory");
    const int c = lane & 7;
#pragma unroll
    for (int j = 0; j < 4; ++j) { const int n = (lane >> 3) + 8 * j; const LAS float* s = scr + (8 * c) * 33 + n;
        v4u o; o.x = pk2(s[0 * 33], s[1 * 33]); o.y = pk2(s[2 * 33], s[3 * 33]); o.z = pk2(s[4 * 33], s[5 * 33]); o.w = pk2(s[6 * 33], s[7 * 33]);
        *(GAS v4u*)(WT + (size_t)(drow0 + n) * K + k0 + 8 * c) = o; }
    LDS_WAIT(); asm volatile("" ::: "memory");
}
__device__ __forceinline__ void conv_mat(const float* W, int K, int N, bf16* WT, int r, int row_off, bool gu, LAS float* scr, int lane) {
    const int nblk = N / 32, kb = r / nblk, nb = r % nblk, n0 = 32 * nb; int drow0 = row_off + n0;
    if (gu) { drow0 = n0 < DFF ? 256 * (n0 / 128) + (n0 % 128) : 256 * ((n0 - DFF) / 128) + 128 + ((n0 - DFF) % 128); }
    p0_transpose_item(W, K, N, WT, 64 * kb, n0, drow0, scr, lane);
}
constexpr int CV0 = 16 * 176, CV2 = 44 * 32, CV4 = 16 * 104, CV5 = 16 * 64, CV6 = 8 * 32, CV8 = 16 * 32, CV9 = 16, CV11 = 32;
constexpr int CONV_PER_L = 2 * CV0 + 2 * CV2 + CV4 + CV5 + 2 * CV6 + CV8 + 2 * CV9 + CV11;
__device__ __forceinline__ void conv_item(const Args& a, unsigned char* ws, int l, int r, LAS float* scr, int lane) {
    unsigned char* wl = ws + WS_W + (size_t)l * WL_SIZE;
    if (r < CV0) { conv_mat(a.in[I_WGU] + (size_t)(l * 2 + 0) * D * NGU, D, NGU, (bf16*)(wl + WL_GU0), r, 0, true, scr, lane); return; } r -= CV0;
    if (r < CV0) { conv_mat(a.in[I_WGU] + (size_t)(l * 2 + 1) * D * NGU, D, NGU, (bf16*)(wl + WL_GU1), r, 0, true, scr, lane); return; } r -= CV0;
    if (r < CV2) { conv_mat(a.in[I_WDN] + (size_t)(l * 2 + 0) * DFF * D, DFF, D, (bf16*)(wl + WL_DN0), r, 0, false, scr, lane); return; } r -= CV2;
    if (r < CV2) { conv_mat(a.in[I_WDN] + (size_t)(l * 2 + 1) * DFF * D, DFF, D, (bf16*)(wl + WL_DN1), r, 0, false, scr, lane); return; } r -= CV2;
    if (r < CV4) { conv_mat(a.in[I_WIN] + (size_t)l * D * NIN, D, NIN, (bf16*)(wl + WL_IG), r, 0, false, scr, lane); return; } r -= CV4;
    if (r < CV5) { conv_mat(a.in[I_WGATE] + (size_t)l * D * 2048, D, 2048, (bf16*)(wl + WL_IG), r, NIN, false, scr, lane); return; } r -= CV5;
    if (r < CV6) { conv_mat(a.in[I_BRA] + (size_t)l * 512 * D, 512, D, (bf16*)(wl + WL_BR), r, 0, false, scr, lane); return; } r -= CV6;
    if (r < CV6) { conv_mat(a.in[I_BRB] + (size_t)l * 512 * D, 512, D, (bf16*)(wl + WL_BR), r, 1024, false, scr, lane); return; } r -= CV6;
    if (r < CV8) { conv_mat(a.in[I_WO] + (size_t)l * D * D, D, D, (bf16*)(wl + WL_O), r, 0, false, scr, lane); return; } r -= CV8;
    if (r < CV9) { conv_mat(a.in[I_W2] + (size_t)l * 64 * 512, 64, 512, (bf16*)(wl + WL_W2), r, 0, false, scr, lane); return; } r -= CV9;
    if (r < CV9) { conv_mat(a.in[I_A2] + (size_t)l * 64 * 512, 64, 512, (bf16*)(wl + WL_A2), r, 0, false, scr, lane); return; } r -= CV9;
    conv_mat(a.in[I_G2] + (size_t)l * 128 * 512, 128, 512, (bf16*)(wl + WL_G2), r, 0, false, scr, lane);
}
__device__ __forceinline__ void ph_conv_idle(const Frame& F0, const Args& a, int lnext, int nunits) {
    const Frame F = relaunder(F0);
    const int G = F.G, c = opq((int)blockIdx.x), nextra = nunits % G, nfree = nextra ? G - nextra : G, idx = nextra ? c - nextra : c;
    if (idx < 0) return;
    LAS float* scr = LP(float, F.lds + F.wave * 8448);
#pragma unroll 1
    for (int it = idx * NWAVES + F.wave; it < CONV_PER_L; it += nfree * NWAVES) conv_item(a, a.ws, lnext, it, scr, F.lane);
}
__device__ __forceinline__ void ph_prologue(const Frame& F0, const Args& a) {
    const Frame F = relaunder(F0);
    unsigned char* ws = a.ws;
    LAS bf16* sc = LP(bf16, F.lds);
    for (int i = F.tid; i < NSEQ * D; i += NTHR) { const int s = i >> 10, k = i & 1023; const float c = s < NB ? a.in[I_CP][s * D + k] : a.in[I_CS][(s - NB) * D + k];
        sc[s * 1032 + k] = (bf16)f2bf(c * fast_sigmoid(c)); }
    __syncthreads();
    const int gw = F.vcu * NWAVES + F.wave, NGW = F.G * NWAVES; const int lane = F.lane, r32 = lane & 31, hi = lane >> 5;
    float* MOD = (float*)(ws + WS_MOD);
    for (int it = gw; it < DEPTH * 288; it += NGW) {
        const int l = it / 288, n0 = (it % 288) * 32;
        const float* W = a.in[I_WADA] + (size_t)l * D * 9216 + n0 + r32;
        f32x16 acc0 = {}, acc1 = {};
        const int rowB = (32 + r32) < NSEQ ? 32 + r32 : NSEQ - 1;
#pragma unroll 4
        for (int s = 0; s < 64; ++s) {
            const float* wp = W + (size_t)(16 * s + 8 * hi) * 9216;
            float w[8];
#pragma unroll
            for (int j = 0; j < 8; ++j) w[j] = wp[(size_t)j * 9216];
            v4u bw; bw.x = cvtpk(w[0], w[1]); bw.y = cvtpk(w[2], w[3]); bw.z = cvtpk(w[4], w[5]); bw.w = cvtpk(w[6], w[7]);
            const bf16x8 bfrag = __builtin_bit_cast(bf16x8, bw);
            const bf16x8 a0 = *LP(const bf16x8, sc + r32 * 1032 + 16 * s + 8 * hi);
            const bf16x8 a1 = *LP(const bf16x8, sc + rowB * 1032 + 16 * s + 8 * hi);
            acc0 = __builtin_amdgcn_mfma_f32_32x32x16_bf16(a0, bfrag, acc0, 0, 0, 0);
            acc1 = __builtin_amdgcn_mfma_f32_32x32x16_bf16(a1, bfrag, acc1, 0, 0, 0);
        }
        const float bias = a.in[I_BADA][(size_t)l * 9216 + n0 + r32];
#pragma unroll
        for (int r = 0; r < 16; ++r) { const int s0 = crow(r, hi); MOD[((size_t)l * NSEQ + s0) * 9216 + n0 + r32] = acc0[r] + bias;
            const int s1 = 32 + s0; if (s1 < NSEQ) MOD[((size_t)l * NSEQ + s1) * 9216 + n0 + r32] = acc1[r] + bias; }
    }
    LAS float* scr = LP(float, F.lds + 74304 + F.wave * 8448);
    for (int it = gw; it < CONV_PER_L; it += NGW) conv_item(a, ws, 0, it, scr, lane);
    for (int z = gw * 64 + lane; z < DEPTH * DECB * 256; z += NGW * 64) ((bf16*)(ws + WS_SSB))[z] = (bf16)f2bf(a.in[I_SSH][(size_t)(z >> 8) * NRW + 1536 + (z & 255)]);
    if (blockIdx.x == 0 && F.wave == 0) {
        for (int l = 0; l < DEPTH; ++l) { const float* lq = a.in[I_LAMQK] + l * 256;
            const float s1 = wave_sum(lq[lane] * lq[64 + lane]), s2 = wave_sum(lq[128 + lane] * lq[192 + lane]);
            const float lam_init = 0.8f - 0.6f * expf(-0.3f * (float)l);
            if (lane == 0) ((float*)(ws + WS_LAM))[l] = expf(s1) - expf(s2) + lam_init; }
    }
}

template <bool HASF, bool XBIN, bool XBOUT, bool MODN>
__device__ __forceinline__ void ph_ln(const Frame& F0, const float* xin_p, const float* xin_s, const bf16* f, float gs, const float* gate_mod  ,
                                      const float* lng, const float* lnb, const float* modn  , float* xout, bf16* uout,
                                      const float* fparts = nullptr, int nparts = 0  , const bf16* xin_b = nullptr  , bf16* xout_b = nullptr  ) {
    const Frame F = relaunder(F0);
    const int gw = F.vcu * NWAVES + F.wave, NGW = F.G * NWAVES, lane = F.lane;
    const int m0 = gw; if (m0 >= M) return;
    f32x4 cg[4], cb[4], cgate[4], csh[4], cscl[4]; int cseq = -1;
    if constexpr (HASF) {
#pragma unroll
        for (int j = 0; j < 4; ++j) { cg[j] = *(const f32x4*)(lng + 4 * lane + 256 * j); cb[j] = *(const f32x4*)(lnb + 4 * lane + 256 * j); } }
    auto up = [](u32x2 w) -> f32x4 { return (f32x4){__uint_as_float(w.x << 16), __uint_as_float(w.x & 0xffff0000u), __uint_as_float(w.y << 16), __uint_as_float(w.y & 0xffff0000u)}; };
    auto ldx = [&](int m, int j) -> f32x4 { if constexpr (XBIN) return up(*(const u32x2*)(xin_b + (size_t)m * D + 4 * lane + 256 * j));
                                           else { const float* xr = m >= MP ? xin_s + (size_t)(m - MP) * D : xin_p + (size_t)m * D; return *(const f32x4*)(xr + 4 * lane + 256 * j); } };
    auto ldf = [&](int m, int j) -> u32x2 { const int mf = m < MP ? m : MP - 1; return *(const u32x2*)(f + (size_t)mf * D + 4 * lane + 256 * j); };
    f32x4 v[4], vn[4]; u32x2 fw[4], fwn[4];
#pragma unroll
    for (int j = 0; j < 4; ++j) { vn[j] = ldx(m0, j); if constexpr (HASF) fwn[j] = ldf(m0, j); }
#pragma unroll 2
    for (int m = m0; m < M; m += NGW) {
        const int seq = row_seq(m);
#pragma unroll
        for (int j = 0; j < 4; ++j) { v[j] = vn[j]; if constexpr (HASF) fw[j] = fwn[j]; }
        { const int mn = m + NGW < M ? m + NGW : m;
#pragma unroll
          for (int j = 0; j < 4; ++j) { vn[j] = ldx(mn, j); if constexpr (HASF) fwn[j] = ldf(mn, j); } }
        if (seq != cseq) { cseq = seq;
#pragma unroll
            for (int j = 0; j < 4; ++j) { if constexpr (HASF) cgate[j] = *(const f32x4*)(gate_mod + (size_t)seq * 9216 + 4 * lane + 256 * j) * gs;
                if constexpr (MODN) { csh[j] = *(const f32x4*)(modn + (size_t)seq * 9216 + 4 * lane + 256 * j); cscl[j] = *(const f32x4*)(modn + (size_t)seq * 9216 + D + 4 * lane + 256 * j) + 1.0f; } } }
        if constexpr (HASF) {
            if (m >= MP) {
#pragma unroll
                for (int j = 0; j < 4; ++j) v[j] = v[j] * ALPHA;
                for (int sp = 0; sp < nparts; ++sp) {
#pragma unroll
                    for (int j = 0; j < 4; ++j) v[j] += cgate[j] * *(const f32x4*)(fparts + ((size_t)sp * MD + (m - MP)) * D + 4 * lane + 256 * j); }
            } else {
#pragma unroll
                for (int j = 0; j < 4; ++j) v[j] = v[j] * ALPHA + cgate[j] * up(fw[j]);
            }
            float s = 0.f, s2 = 0.f;
#pragma unroll
            for (int j = 0; j < 4; ++j) { s += (v[j].x + v[j].y) + (v[j].z + v[j].w); s2 += (v[j].x * v[j].x + v[j].y * v[j].y) + (v[j].z * v[j].z + v[j].w * v[j].w); }
            wave_sum2(s, s2);
            const float mean = s * (1.f / D), rstd = __builtin_amdgcn_rsqf(fmaxf(s2 * (1.f / D) - mean * mean, 0.f) + LN_EPS);
#pragma unroll
            for (int j = 0; j < 4; ++j) { const f32x4 ga = cg[j] * rstd; v[j] = v[j] * ga + (cb[j] - ga * mean);
                if constexpr (XBOUT) { u32x2 w; w.x = cvtpk(v[j].x, v[j].y); w.y = cvtpk(v[j].z, v[j].w); *(u32x2*)(xout_b + (size_t)m * D + 4 * lane + 256 * j) = w;
                    v[j] = up(w); }
                else *(f32x4*)(xout + (size_t)m * D + 4 * lane + 256 * j) = v[j]; }
        }
        if constexpr (MODN) {
            float s = 0.f, s2 = 0.f;
#pragma unroll
            for (int j = 0; j < 4; ++j) { s += (v[j].x + v[j].y) + (v[j].z + v[j].w); s2 += (v[j].x * v[j].x + v[j].y * v[j].y) + (v[j].z * v[j].z + v[j].w * v[j].w); }
            wave_sum2(s, s2);
            const float mean = s * (1.f / D), rstd = __builtin_amdgcn_rsqf(fmaxf(s2 * (1.f / D) - mean * mean, 0.f) + LN_EPS);
#pragma unroll
            for (int j = 0; j < 4; ++j) { const f32x4 ga = cscl[j] * rstd; const f32x4 o = v[j] * ga + (csh[j] - ga * mean); u32x2 w; w.x = cvtpk(o.x, o.y); w.y = cvtpk(o.z, o.w);
                *(u32x2*)(uout + (size_t)m * D + 4 * lane + 256 * j) = w; }
        }
    }
}
__device__ __forceinline__ int t5_bucket(int rel) {
    const int n = rel < 0 ? -rel : rel; int b;
    if (n < 8) b = n; else if (n < 12) b = 8; else if (n < 16) b = 9; else if (n < 23) b = 10; else if (n < 32) b = 11; else if (n < 46) b = 12; else if (n < 64) b = 13; else if (n < 91) b = 14; else b = 15;
    return (rel > 0 ? 16 : 0) + b;
}
typedef short v4i16_t __attribute__((ext_vector_type(4)));
__device__ __forceinline__ v4i16_t vtr(LAS const unsigned char* p) { return __builtin_amdgcn_ds_read_tr16_b64_v4i16((LAS v4i16_t*)p); }
constexpr int ATT_SLOT = 32768;
constexpr int ATT_TAB = EXTRA_OFF;
struct AttnP { const bf16* Q; const bf16* Kb; const bf16* Vb; const float* ck; const float* cv; bf16* YA; const float* relb; const float* subg; float lam, oml; };

__device__ __forceinline__ void attn_scores(LAS const unsigned char* slot, LAS const float* tab, const bf16x8 (&qf)[4], f32x16 (&o)[4], bf16x8 (&pf)[4], float& mrun, float& lrun,
                                            int map, int lane, int k0, int qpos, bool constb, int nvalid, bool first  ) {
    const int r32 = lane & 31, hi = lane >> 5;
    LAS const unsigned char* kb = slot + map * 8192 + hi * 1024 + r32 * 16;
    f32x16 p0, p1;
    const float cb = (constb ? tab[0] : 0.f) - (first ? 0.f : mrun);
#pragma unroll
    for (int r = 0; r < 16; ++r) { p0[r] = cb; p1[r] = cb; }
    { bf16x8 kf[4];
      auto rdk = [&](int f) { kf[f & 3] = *LP(const bf16x8, kb + (f >> 1) * 2048 + (f & 1) * 512); };
      rdk(0); rdk(1); rdk(2);
#pragma unroll
      for (int f = 0; f < 8; ++f) {
          if (f + 3 < 8) rdk(f + 3);
          if (f & 1) p1 = __builtin_amdgcn_mfma_f32_32x32x16_bf16(kf[f & 3], qf[f >> 1], p1, 0, 0, 0);
          else       p0 = __builtin_amdgcn_mfma_f32_32x32x16_bf16(kf[f & 3], qf[f >> 1], p0, 0, 0, 0);
          __builtin_amdgcn_sched_barrier(0);
      } }
    if (!constb) {
        const int base = k0 - qpos + 128;
#pragma unroll
        for (int r = 0; r < 16; ++r) { int i0 = base + crow(r, hi); int i1 = i0 + 32; i0 = i0 < 0 ? 0 : (i0 > 191 ? 191 : i0); i1 = i1 < 0 ? 0 : (i1 > 191 ? 191 : i1); p0[r] += tab[i0]; p1[r] += tab[i1]; }
    }
    if (nvalid < 64) {
#pragma unroll
        for (int r = 0; r < 16; ++r) { if (crow(r, hi) >= nvalid) p0[r] = -INFINITY; if (crow(r, hi) + 32 >= nvalid) p1[r] = -INFINITY; }
    }
    float ma = fmaxf(fmaxf(p0[0], p0[1]), p1[0]), mb = fmaxf(fmaxf(p0[2], p0[3]), p1[1]); ma = fmaxf(fmaxf(ma, p1[2]), p1[3]);
#pragma unroll
    for (int r = 4; r < 16; r += 4) { ma = fmaxf(fmaxf(ma, p0[r]), p0[r + 1]); mb = fmaxf(fmaxf(mb, p0[r + 2]), p0[r + 3]); ma = fmaxf(fmaxf(ma, p1[r]), p1[r + 1]); mb = fmaxf(fmaxf(mb, p1[r + 2]), p1[r + 3]); }
    float mx = fmaxf(ma, mb);
    if (first || __any(mx > 8.0f)) {
        mx = fmaxf(mx, __shfl_xor(mx, 32));
        const float delta = first ? mx : (mx > 8.0f ? mx : 0.f);
        const float alpha = first ? 0.f : __builtin_amdgcn_exp2f(-delta);
        mrun = first ? mx : mrun + delta;
        lrun *= alpha;
#pragma unroll
        for (int r = 0; r < 16; ++r) { p0[r] -= delta; p1[r] -= delta; }
#pragma unroll
        for (int c = 0; c < 4; ++c)
#pragma unroll
            for (int r = 0; r < 16; ++r) o[c][r] *= alpha;
    }
    float ls = 0.f;
#pragma unroll
    for (int r = 0; r < 16; ++r) { p0[r] = __builtin_amdgcn_exp2f(p0[r]); p1[r] = __builtin_amdgcn_exp2f(p1[r]); ls += p0[r] + p1[r]; }
    lrun += ls;
#pragma unroll
    for (int ks = 0; ks < 4; ++ks) { v4u w;
        if (ks < 2) { const int b = 8 * ks; w.x = cvtpk(p0[b], p0[b + 1]); w.y = cvtpk(p0[b + 2], p0[b + 3]); w.z = cvtpk(p0[b + 4], p0[b + 5]); w.w = cvtpk(p0[b + 6], p0[b + 7]); }
        else { const int b = 8 * (ks - 2); w.x = cvtpk(p1[b], p1[b + 1]); w.y = cvtpk(p1[b + 2], p1[b + 3]); w.z = cvtpk(p1[b + 4], p1[b + 5]); w.w = cvtpk(p1[b + 6], p1[b + 7]); }
        pf[ks] = __builtin_bit_cast(bf16x8, w); }
}
__device__ __forceinline__ void attn_pv(LAS const unsigned char* slot, const bf16x8 (&pf)[4], f32x16 (&o)[4], int lane) {
    const int hi = lane >> 5;
    LAS const unsigned char* vb = slot + 16384 + ((lane >> 4) & 1) * 32 + (lane & 3) * 8 + (4 * hi + ((lane & 15) >> 2)) * 64;
    v4i16_t lo[4], hh[4];
    auto rd = [&](int f, int sl_) { lo[sl_] = vtr(vb + (f >> 2) * 4096 + (2 * (f & 3)) * 512); hh[sl_] = vtr(vb + (f >> 2) * 4096 + (2 * (f & 3) + 1) * 512); };
    rd(0, 0); rd(1, 1); rd(2, 2);
#pragma unroll
    for (int f = 0; f < 16; ++f) {
        if (f + 3 < 16) rd(f + 3, (f + 3) & 3);
        const v4i16_t l_ = lo[f & 3], h_ = hh[f & 3];
        const bf16x8 vf = (bf16x8){l_[0], l_[1], l_[2], l_[3], h_[0], h_[1], h_[2], h_[3]};
        o[f >> 2] = __builtin_amdgcn_mfma_f32_32x32x16_bf16(vf, pf[f & 3], o[f >> 2], 0, 0, 0);
        __builtin_amdgcn_sched_barrier(0);
    }
}

__device__ __forceinline__ int att_koff(int key, int ch) { return (ch >> 3) * 8192 + ((ch & 7) >> 1) * 2048 + (ch & 1) * 1024 + (key >> 5) * 512 + (key & 31) * 16; }
__device__ __forceinline__ int att_voff(int key, int ch) { return 16384 + (ch >> 2) * 4096 + (key >> 3) * 512 + (key & 7) * 64 + (ch & 3) * 16; }

__device__ __forceinline__ void attn_unit(const Frame& F, const AttnP& P, bool dec, int bidx, int h, int qb) {
    const int tid = F.tid, lane = F.lane, wave = F.wave, r32 = lane & 31, hi = lane >> 5;
    const int map = wave & 1, qs = wave >> 1;
    LAS unsigned char* lds = F.lds;
    LAS float* tab = LP(float, lds + ATT_TAB);
    const int rowbase = dec ? MP + bidx * DECS : bidx * SEQ;
    const int q0 = dec ? 0 : qb * 128;
    const int qpos0 = dec ? PAST : q0;
    const bool active = dec ? (qs == 0) : true;
    const int NT = dec ? (PAST / 64 + 1) : (2 * qb + 2);
    const int myNT = dec ? NT : (2 * qb + 1 + (qs >> 1));
    if (tid < 192) tab[tid] = P.relb[t5_bucket(tid - 128) * HA + h] * LOG2E;
    bf16x8 qf[4];
    { const bf16* qp = P.Q + (size_t)(rowbase + q0 + (active ? qs * 32 : 0) + r32) * 512 + h * 128 + map * 64 + 8 * hi;
#pragma unroll
      for (int d0 = 0; d0 < 4; ++d0) qf[d0] = *(const bf16x8*)(qp + 16 * d0); }
    f32x16 o[4];
#pragma unroll
    for (int c = 0; c < 4; ++c)
#pragma unroll
        for (int r = 0; r < 16; ++r) o[c][r] = 0.f;
    float mrun = -INFINITY, lrun = 0.f;
    const int qposw = qpos0 + qs * 32;
    v4u kreg[2], vreg[2];
    auto load_tile = [&](int t) {
#pragma unroll
        for (int i = 0; i < 2; ++i) { const int id = tid + 512 * i;
            const int kk = (id & 7) | ((id >> 7) << 3), kc = (id >> 3) & 15;
            const int vk = ((id >> 2) & 7) | ((id >> 7) << 3), vc = (id & 3) | (((id >> 5) & 3) << 2);
            if (!dec) { kreg[i] = *(const v4u*)(P.Kb + (size_t)(rowbase + 64 * t + kk) * 512 + h * 128 + kc * 8); vreg[i] = *(const v4u*)(P.Vb + (size_t)(rowbase + 64 * t + vk) * 512 + h * 128 + vc * 8); }
            else if (t < PAST / 64) { const size_t gk = ((size_t)(bidx * PAST + 64 * t + kk) * HA + h) * 128 + kc * 8, gv = ((size_t)(bidx * PAST + 64 * t + vk) * HA + h) * 128 + vc * 8;
                const f32x4 a0 = *(const f32x4*)(P.ck + gk), a1 = *(const f32x4*)(P.ck + gk + 4), b0 = *(const f32x4*)(P.cv + gv), b1 = *(const f32x4*)(P.cv + gv + 4);
                kreg[i] = (v4u){cvtpk(a0[0], a0[1]), cvtpk(a0[2], a0[3]), cvtpk(a1[0], a1[1]), cvtpk(a1[2], a1[3])};
                vreg[i] = (v4u){cvtpk(b0[0], b0[1]), cvtpk(b0[2], b0[3]), cvtpk(b1[0], b1[1]), cvtpk(b1[2], b1[3])}; }
            else { kreg[i] = kk < DECS ? *(const v4u*)(P.Kb + (size_t)(rowbase + kk) * 512 + h * 128 + kc * 8) : (v4u){0u, 0u, 0u, 0u};
                   vreg[i] = vk < DECS ? *(const v4u*)(P.Vb + (size_t)(rowbase + vk) * 512 + h * 128 + vc * 8) : (v4u){0u, 0u, 0u, 0u}; }
        }
    };
    auto store_tile_at = [&](int sloff) {
        LAS unsigned char* sb = lds + sloff;
#pragma unroll
        for (int i = 0; i < 2; ++i) { const int id = tid + 512 * i;
            const int kk = (id & 7) | ((id >> 7) << 3), kc = (id >> 3) & 15, vk = ((id >> 2) & 7) | ((id >> 7) << 3), vc = (id & 3) | (((id >> 5) & 3) << 2);
            *LP(v4u, sb + att_koff(kk, kc)) = kreg[i]; *LP(v4u, sb + att_voff(vk, vc)) = vreg[i]; }
    };
    __syncthreads();
    load_tile(0); store_tile_at(0);
    __syncthreads();
    const bool late = wave >= 4;
    bf16x8 pf[4];
    bool pend = false;
    int sl_prev = 0, sl_cur = 0, sl_next = ATT_SLOT;
    for (int t = 0; t < NT; ++t) {
        if (t + 1 < NT) load_tile(t + 1);
        const bool mine = active && t < myNT;
        if (late) {
            if (pend) attn_pv(lds + sl_prev, pf, o, lane);
            pend = mine;
        }
        if (mine) {
            const int k0 = 64 * t;
            const bool constb = (k0 + 63 - qposw) <= -91;
            attn_scores(lds + sl_cur, tab, qf, o, pf, mrun, lrun, map, lane, k0, qposw + r32, constb, (dec && t == NT - 1) ? DECS : 64, t == 0);
            if (!late) attn_pv(lds + sl_cur, pf, o, lane);
        }
        if (t + 1 < NT) store_tile_at(sl_next);
        __syncthreads();
        sl_prev = sl_cur; sl_cur = sl_next; sl_next = sl_next == 2 * ATT_SLOT ? 0 : sl_next + ATT_SLOT;
    }
    if (late && pend) attn_pv(lds + sl_prev, pf, o, lane);
    __syncthreads();
    lrun += __shfl_xor(lrun, 32);
    const float inv = 1.0f / lrun;
    LAS float* ex = LP(float, lds + (wave >> 1) * 16384);
    if (map == 1) {
#pragma unroll
        for (int c = 0; c < 4; ++c)
#pragma unroll
            for (int r = 0; r < 16; ++r) ex[(c * 16 + r) * 64 + lane] = o[c][r] * inv;
    }
    __syncthreads();
    LAS bf16* yst = LP(bf16, lds + 65536 + (wave >> 1) * 8448);
    if (map == 0) {
        float ss = 0.f;
#pragma unroll
        for (int c = 0; c < 4; ++c)
#pragma unroll
            for (int r = 0; r < 16; ++r) { const float v = o[c][r] * inv - P.lam * ex[(c * 16 + r) * 64 + lane]; o[c][r] = v; ss += v * v; }
        ss += __shfl_xor(ss, 32);
        const float rs = 1.0f / sqrtf(ss * (1.f / 128.f) + LN_EPS) * P.oml;
#pragma unroll
        for (int c = 0; c < 4; ++c)
#pragma unroll
            for (int r = 0; r < 16; ++r) { const int dv = 32 * c + crow(r, hi); yst[r32 * 132 + dv] = (bf16)f2bf(o[c][r] * rs * P.subg[dv]); }
    }
    __syncthreads();
    if (map == 0 && active) {
#pragma unroll
        for (int i = 0; i < 8; ++i) { const int row = i * 4 + (lane >> 4), ch = lane & 15;
            const u32x2 a = *LP(const u32x2, yst + row * 132 + ch * 8), b = *LP(const u32x2, yst + row * 132 + ch * 8 + 4);
            *(v4u*)(P.YA + (size_t)(rowbase + q0 + qs * 32 + row) * 512 + h * 128 + ch * 8) = (v4u){a.x, a.y, b.x, b.y}; }
    }
}
__device__ __forceinline__ void ph_attn(const Frame& F0, const AttnP& P, unsigned* qcount) {
    const Frame F = relaunder(F0);
    LAS unsigned* qslot = LP(unsigned, F.lds + LDSCTL_OFF + 64);
    for (;;) {
        __syncthreads();
        if (F.tid == 0) *qslot = __hip_atomic_fetch_add(qcount, 1u, __ATOMIC_RELAXED, __HIP_MEMORY_SCOPE_AGENT);
        __syncthreads();
        const int u = __builtin_amdgcn_readfirstlane((int)*qslot);
        if (u >= 1024 + DECB * HA) break;
        constexpr int DEC_AT = 16 * (63 - 16);
        const bool isdec = u >= DEC_AT && u < DEC_AT + DECB * HA;
        const int up = u < DEC_AT ? u : u - DECB * HA, d = u - DEC_AT;
        attn_unit(F, P, isdec, isdec ? d >> 2 : (up & 15) >> 2, isdec ? d & 3 : up & 3, isdec ? 0 : 63 - (up >> 4));
    }
}
constexpr int R1_RT = 0, R1_KH = 9216, R1_BH = 18432, R1_KAP = 27648, R1_KAPT = 36864, R1_VT = 46080, R1_BBT = 55296, R1_KBT = 64512;
constexpr int R1_ABKF = 73728, R1_AKK = 90368, R1_ABR = 99584, R1_AKR = 108800, R1_MB = 118016;
constexpr int R1_MF = R1_KH, R1_GT = R1_KAP, R1_WT = R1_ABKF, R1_UT = R1_KH;
constexpr int R1_LW = 73728, R1_LA = 82944, R1_LG = 92160;
constexpr int R1_RED = EXTRA_OFF, R1_CS = EXTRA_OFF + 1024, R1_GTV = EXTRA_OFF + 2048, R1_T16 = EXTRA_OFF + 2304, R1_MUL = EXTRA_OFF + 5632;
typedef unsigned short u16;
__device__ __forceinline__ f32x4 mfma16(bf16x8 a, bf16x8 b, f32x4 c) { return __builtin_amdgcn_mfma_f32_16x16x32_bf16(a, b, c, 0, 0, 0); }
__device__ __forceinline__ void mm64(f32x4 (&acc)[2], LAS const unsigned char* X, LAS const unsigned char* Y, int tm, int tn0, int lane) {
    const int i = lane & 15, q = lane >> 4;
#pragma unroll
    for (int s = 0; s < 2; ++s) {
        const bf16x8 af = *LP(const bf16x8, X + ((16 * tm + i) * 72 + 32 * s + 8 * q) * 2);
#pragma unroll
        for (int j = 0; j < 2; ++j) { const bf16x8 bfr = *LP(const bf16x8, Y + ((16 * (tn0 + j) + i) * 72 + 32 * s + 8 * q) * 2); acc[j] = mfma16(af, bfr, acc[j]); }
    }
}
__device__ __forceinline__ void st_tr(LAS unsigned char* arr, const f32x4& v, int n, int t0) {
    u32x2 w; w.x = cvtpk(v[0], v[1]); w.y = cvtpk(v[2], v[3]); *LP(u32x2, arr + (n * 72 + t0) * 2) = w;
}
__device__ __forceinline__ f32x4 prod16(f32x4 acc, LAS const float* X, int sx, LAS const float* Y, int sy, int lane) {
    const int i = lane & 15, q = lane >> 4;
#pragma unroll
    for (int s = 0; s < 4; ++s) acc = __builtin_amdgcn_mfma_f32_16x16x4f32(X[i * sx + 4 * s + q], Y[(4 * s + q) * sy + i], acc, 0, 0, 0);
    return acc;
}
__device__ __forceinline__ float tanh_fast(float x) { return 1.0f - 2.0f * __builtin_amdgcn_rcpf(1.0f + __expf(2.0f * x)); }

__device__ __forceinline__ float red16(float x) { x += dpp_mov<0xB1>(x); x += dpp_mov<0x4E>(x); x += dpp_mov<0x141>(x); x += dpp_mov<0x140>(x); return x; }
__device__ __forceinline__ int frag_a(int row, int k) { return ((row >> 4) * 2 + (k >> 5)) * 512 + (((k >> 2) & 3) * 16 + (row & 15)) * 8 + 4 * ((k >> 4) & 1) + (k & 3); }
__device__ __forceinline__ int frag_c(int c, int r0) { return (((c >> 4) * 4 + (r0 >> 4)) * 64 + ((r0 >> 2) & 3) * 16 + (c & 15)) * 4; }
__device__ __forceinline__ void ph_rwkv1(const Frame& F0, const Args& a, int l) {
    const Frame F = relaunder(F0);
    unsigned char* ws = a.ws; LAS unsigned char* lds = F.lds;
    int tid = F.tid, lane = F.lane, i = lane & 15, q = lane >> 4, t0 = 0; const int wave = F.wave, tm = wave >> 1, tnb = 2 * (wave & 1);
#define R1_RELANE() do { int l_ = F.lane; asm volatile("" : "+v"(l_)); lane = l_; i = lane & 15; q = lane >> 4; tid = wave * 64 + lane; t0 = 16 * tm + 4 * q; } while (0)
    const bf16* PRW = (const bf16*)(ws + WS_PRW);
    const unsigned char* wl = ws + WS_W + (size_t)l * WL_SIZE;
    const bf16* W2t = (const bf16*)(wl + WL_W2); const bf16* A2t = (const bf16*)(wl + WL_A2); const bf16* G2t = (const bf16*)(wl + WL_G2);
    const float* mu = a.in[I_MU] + (size_t)l * NRW; const float* w0 = a.in[I_W0] + l * 512; const float* a0 = a.in[I_A0] + l * 512;
    const float* k_k = a.in[I_KK] + l * 512; const float* k_a = a.in[I_KA] + l * 512; const float* r_k = a.in[I_RK] + l * 512;
    bf16* GG = (bf16*)(ws + WS_GG); bf16* BON = (bf16*)(ws + WS_BON);
    LAS float* RED = LP(float, lds + R1_RED); LAS float* CS = LP(float, lds + R1_CS); LAS float* GTV = LP(float, lds + R1_GTV);
    LAS float* ABKF = LP(float, lds + R1_ABKF); LAS float* MF = LP(float, lds + R1_MF);
    if (tid < 256) LP(float, lds + R1_MUL)[tid] = mu[1536 + tid];
    __syncthreads();
    struct R1Item { int h, row0, tval; const float* prev0; const bf16* prevr; const bf16* prevb; };
    auto item_info = [&](int it) -> R1Item { R1Item I;
        if (it < NITEM_P) { const int s = it >> 10, c = (it >> 3) & 127; I.h = it & 7; I.row0 = s * SEQ + 64 * c; I.tval = 64; I.prev0 = nullptr; I.prevr = c > 0 ? PRW + (size_t)(I.row0 - 1) * NRW : nullptr; I.prevb = c > 0 ? I.prevr + 1536 : nullptr; }
        else { const int b = (it - NITEM_P) >> 3; I.h = it & 7; I.row0 = MP + DECS * b; I.tval = DECS; I.prev0 = a.in[I_SSH] + (size_t)(l * DECB + b) * NRW; I.prevr = nullptr; I.prevb = (const bf16*)(ws + WS_SSB) + (size_t)(l * DECB + b) * 256; }
        return I; };
    v4u lp[4], lq[4];
    float gp[2][4][3], gq[2][3], cst[2][8]; bool pqz = false; int csth = -1;
    auto load_top = [&](const R1Item& I) {
        const int t0s = tid >> 3, part = tid & 7; const bool v0 = t0s < I.tval;
        const bf16* pl_ = PRW + (size_t)(I.row0 + (v0 ? t0s : 0)) * NRW + 1536 + 32 * part;
        const bf16* pq_ = (v0 && t0s > 0) ? pl_ - NRW : (I.prevb ? I.prevb + 32 * part : pl_);
        pqz = !(v0 && t0s > 0) && !I.prevb;
#pragma unroll
        for (int e = 0; e < 4; ++e) { lp[e] = *(const v4u*)(pl_ + 8 * e); lq[e] = *(const v4u*)(pq_ + 8 * e); }
#pragma unroll
        for (int j = 0; j < 2; ++j) { const int col = I.h * 64 + 16 * (tnb + j) + i; const int tb = 16 * tm + 4 * q;
            const int tbl = 16 * tm < I.tval ? tb : 0;
#pragma unroll
            for (int r = 0; r < 4; ++r) { const unsigned po = (unsigned)(I.row0 + tbl + r) * NRW + col; gp[j][r][0] = bf2f(PRW[po]); gp[j][r][1] = bf2f(PRW[po + 512]); gp[j][r][2] = bf2f(PRW[po + 1024]); }
            const bf16* pb = tb > 0 ? PRW + (size_t)(I.row0 + min(tb, I.tval) - 1) * NRW : I.prevr;
            if (pb) { gq[j][0] = bf2f(pb[col]); gq[j][1] = bf2f(pb[512 + col]); gq[j][2] = bf2f(pb[1024 + col]); }
            else if (I.prev0) { gq[j][0] = I.prev0[col]; gq[j][1] = I.prev0[512 + col]; gq[j][2] = I.prev0[1024 + col]; }
            else { gq[j][0] = 0.f; gq[j][1] = 0.f; gq[j][2] = 0.f; }
            if (I.h != csth) { cst[j][0] = mu[col]; cst[j][1] = mu[512 + col]; cst[j][2] = mu[1024 + col]; cst[j][3] = w0[col]; cst[j][4] = a0[col]; cst[j][5] = k_k[col]; cst[j][6] = k_a[col]; cst[j][7] = r_k[col]; } }
        csth = I.h;
    };
    bf16x8 bW[2][2], bA[2][2], bG[4][2]; int wfh = -1;
    int itp = -1;
#define R1_COPY_OUT(IT) do { v4u* QTg_ = (v4u*)((bf16*)(ws + WS_QT) + (size_t)(IT) * 4096); v4u* PTg_ = (v4u*)((bf16*)(ws + WS_PT) + (size_t)(IT) * 4096); \
        QTg_[tid] = *LP(const v4u, lds + R1_KH + tid * 16); PTg_[tid] = *LP(const v4u, lds + R1_BH + tid * 16); } while (0)
    R1Item cur = item_info(F.vcu < NITEM ? F.vcu : 0), nxt = cur;
    if (F.vcu < NITEM) { R1_RELANE(); load_top(cur); }
    for (int it = F.vcu; it < NITEM; it += F.G) {
        const int h = cur.h, row0 = cur.row0, tval = cur.tval;
        R1_RELANE();
        const int t0s = tid >> 3, part = tid & 7;
        { LAS unsigned char* dst = part < 2 ? lds + R1_LW + (t0s * 72 + 32 * part) * 2 : (part < 4 ? lds + R1_LA + (t0s * 72 + 32 * (part - 2)) * 2 : lds + R1_LG + (t0s * 136 + 32 * (part - 4)) * 2);
          LAS const float* mul = LP(const float, lds + R1_MUL) + 32 * part;
          const float sl2 = part < 2 ? 2.885390082f : -1.442695041f, fa_ = part < 2 ? -2.f : 1.f, fb_ = part < 2 ? 1.f : 0.f; const bool idm = (part & 6) == 2;
#pragma unroll
          for (int e8 = 0; e8 < 4; ++e8) { float x[8];
#pragma unroll
              for (int e = 0; e < 2; ++e) { const unsigned pa_ = e ? lp[e8].z : lp[e8].x, pb_ = e ? lp[e8].w : lp[e8].y, qa_ = e ? lq[e8].z : lq[e8].x, qb_ = e ? lq[e8].w : lq[e8].y;
                  const f32x4 pv = {__uint_as_float(pa_ << 16), __uint_as_float(pa_ & 0xffff0000u), __uint_as_float(pb_ << 16), __uint_as_float(pb_ & 0xffff0000u)};
                  const f32x4 qv = pqz ? (f32x4){0.f, 0.f, 0.f, 0.f} : (f32x4){__uint_as_float(qa_ << 16), __uint_as_float(qa_ & 0xffff0000u), __uint_as_float(qb_ << 16), __uint_as_float(qb_ & 0xffff0000u)};
                  const f32x4 m4 = *LP(const f32x4, mul + 8 * e8 + 4 * e);
                  const f32x4 xm = pv + (qv - pv) * m4;
#pragma unroll
                  for (int z = 0; z < 4; ++z) { const float rc = __builtin_amdgcn_rcpf(1.0f + __builtin_amdgcn_exp2f(xm[z] * sl2)); x[4 * e + z] = idm ? xm[z] : __builtin_fmaf(fa_, rc, fb_); } }
              *LP(v4u, dst + e8 * 16) = (v4u){cvtpk(x[0], x[1]), cvtpk(x[2], x[3]), cvtpk(x[4], x[5]), cvtpk(x[6], x[7])}; }
        }
        if (h != wfh) { wfh = h;
#pragma unroll
        for (int j = 0; j < 2; ++j) { const int n = h * 64 + 16 * (tnb + j) + i;
#pragma unroll
            for (int s = 0; s < 2; ++s) { bW[s][j] = *(const bf16x8*)(W2t + (size_t)n * 64 + 32 * s + 8 * q); bA[s][j] = *(const bf16x8*)(A2t + (size_t)n * 64 + 32 * s + 8 * q); }
#pragma unroll
            for (int s = 0; s < 4; ++s) bG[s][j] = *(const bf16x8*)(G2t + (size_t)n * 128 + 32 * s + 8 * q); } }
        __syncthreads();
        if (itp >= 0) R1_COPY_OUT(itp);
        f32x4 aw[2], aa[2], ag[2];
#pragma unroll
        for (int j = 0; j < 2; ++j) { aw[j] = (f32x4){0.f, 0.f, 0.f, 0.f}; aa[j] = aw[j]; ag[j] = aw[j]; }
#pragma unroll
        for (int s = 0; s < 2; ++s) {
            const bf16x8 fw = *LP(const bf16x8, lds + R1_LW + ((16 * tm + i) * 72 + 32 * s + 8 * q) * 2), fa = *LP(const bf16x8, lds + R1_LA + ((16 * tm + i) * 72 + 32 * s + 8 * q) * 2);
#pragma unroll
            for (int j = 0; j < 2; ++j) { aw[j] = mfma16(fw, bW[s][j], aw[j]); aa[j] = mfma16(fa, bA[s][j], aa[j]); }
        }
#pragma unroll
        for (int s = 0; s < 4; ++s) {
            const bf16x8 fg = *LP(const bf16x8, lds + R1_LG + ((16 * tm + i) * 136 + 32 * s + 8 * q) * 2);
#pragma unroll
            for (int j = 0; j < 2; ++j) ag[j] = mfma16(fg, bG[s][j], ag[j]);
        }
        float xr[2][4], kp[2][4], xv[2][4], lw[2][4], av[2][4], kkr[2][4];
        float ssq[4] = {0.f, 0.f, 0.f, 0.f}, bsum[4] = {0.f, 0.f, 0.f, 0.f};
#pragma unroll
        for (int j = 0; j < 2; ++j) { const int n = 16 * (tnb + j) + i;
            const float mur = cst[j][0], muk = cst[j][1], muv = cst[j][2], w0c = cst[j][3], a0c = cst[j][4], kkc = cst[j][5], kac = cst[j][6], rkc = cst[j][7];
#pragma unroll
            for (int r = 0; r < 4; ++r) {
                const float pr = gp[j][r][0], pk = gp[j][r][1], pv = gp[j][r][2];
                const float qr = r ? gp[j][r - 1][0] : gq[j][0], qk = r ? gp[j][r - 1][1] : gq[j][1], qv = r ? gp[j][r - 1][2] : gq[j][2];
                const float r_ = pr + (qr - pr) * mur, k_ = pk + (qk - pk) * muk, v_ = pv + (qv - pv) * muv;
                const float wpre = w0c + aw[j][r];
                const float lw2 = -0.87503877f * fast_sigmoid(wpre);
                const float a_ = fast_sigmoid(a0c + aa[j][r]);
                const float kk_ = k_ * kkc, kp_ = k_ * (1.0f + (a_ - 1.0f) * kac);
                xr[j][r] = r_; kp[j][r] = kp_; xv[j][r] = v_; lw[j][r] = lw2; av[j][r] = a_; kkr[j][r] = kk_;
                ssq[r] += kk_ * kk_; bsum[r] += r_ * kp_ * rkc;
            }
            *(u32x2*)(GG + (size_t)it * 4096 + frag_c(n, 16 * tm + 4 * q)) = (u32x2){cvtpk(ag[j][0], ag[j][1]), cvtpk(ag[j][2], ag[j][3])}; }
        if (16 * tm >= tval) {
            asm volatile("" ::: "memory");
#pragma unroll
            for (int j = 0; j < 2; ++j)
#pragma unroll
                for (int r = 0; r < 4; ++r) { xr[j][r] = 0.f; kp[j][r] = 0.f; xv[j][r] = 0.f; lw[j][r] = 0.f; av[j][r] = 0.f; kkr[j][r] = 0.f; ssq[r] = 0.f; bsum[r] = 0.f; }
        }
#pragma unroll
        for (int r = 0; r < 4; ++r) {
            ssq[r] = red16(ssq[r]); bsum[r] = red16(bsum[r]);
            if (i == 0) { const int t = 16 * tm + 4 * q + r; RED[(t * 2 + (wave & 1)) * 2 + 0] = ssq[r]; RED[(t * 2 + (wave & 1)) * 2 + 1] = bsum[r]; } }
        { const int itn = it + F.G < NITEM ? it + F.G : it; nxt = item_info(itn); R1_RELANE(); load_top(nxt); }
        float cin[2][4], exq[2];
#pragma unroll
        for (int j = 0; j < 2; ++j) { cin[j][0] = lw[j][0]; cin[j][1] = cin[j][0] + lw[j][1]; cin[j][2] = cin[j][1] + lw[j][2]; cin[j][3] = cin[j][2] + lw[j][3];
            const float tot = cin[j][3]; float ex = 0.f, wt = 0.f;
#pragma unroll
            for (int qq = 0; qq < 4; ++qq) { const float tq = __shfl(tot, i + 16 * qq); wt += tq; ex += qq < q ? tq : 0.f; }
            exq[j] = ex; if (q == 0) CS[tm * 64 + 16 * (tnb + j) + i] = wt; }
        for (int z = tid; z < 2304; z += NTHR) LP(unsigned, lds + R1_MB)[z] = 0u;
        __syncthreads();
        R1_RELANE();
#pragma unroll
        for (int j = 0; j < 2; ++j) { const int n = 16 * (tnb + j) + i, col = h * 64 + n; float tmex = 0.f, csT = 0.f;
#pragma unroll
            for (int z = 0; z < 4; ++z) { const float c_ = CS[z * 64 + n]; csT += c_; tmex += z < tm ? c_ : 0.f; }
            const float gTj = __builtin_amdgcn_exp2f(csT);
            if (tm == 0 && q == 0) GTV[n] = gTj;
            f32x4 vKapT, vVT, vBbT, vKbT, vBon;
#pragma unroll
            for (int r = 0; r < 4; ++r) { const int t = 16 * tm + 4 * q + r;
                const float cst = tmex + exq[j] + cin[j][r], csp = cst - lw[j][r];
                const float sq = RED[(t * 2 + 0) * 2 + 0] + RED[(t * 2 + 1) * 2 + 0], bt = RED[(t * 2 + 0) * 2 + 1] + RED[(t * 2 + 1) * 2 + 1];
                const float kk_ = kkr[j][r] * __builtin_amdgcn_rsqf(fmaxf(sq, 1e-24f)), b_ = kk_ * av[j][r];
                const float gt = __builtin_amdgcn_exp2f(cst), gi = __builtin_amdgcn_rcpf(gt), gp = __builtin_amdgcn_exp2f(csp), ge = gTj * gi;
                LP(u16, lds + R1_RT)[t * 72 + n] = f2bf1(xr[j][r] * gt);
                LP(u16, lds + R1_KH)[t * 72 + n] = f2bf1(kp[j][r] * gi);
                LP(u16, lds + R1_BH)[t * 72 + n] = f2bf1(b_ * gi);
                LP(u16, lds + R1_KAP)[t * 72 + n] = f2bf1(kk_ * gp);
                vKapT[r] = kk_ * gp; vVT[r] = xv[j][r]; vBbT[r] = b_ * ge; vKbT[r] = kp[j][r] * ge;
                vBon[r] = bt * xv[j][r];
                asm volatile("" ::: "memory");
            }
            const int t0 = 16 * tm + 4 * q;
            *(u32x2*)(BON + (size_t)it * 4096 + frag_c(n, t0)) = (u32x2){cvtpk(vBon[0], vBon[1]), cvtpk(vBon[2], vBon[3])};
            st_tr(lds + R1_KAPT, vKapT, n, t0); st_tr(lds + R1_VT, vVT, n, t0); st_tr(lds + R1_BBT, vBbT, n, t0); st_tr(lds + R1_KBT, vKbT, n, t0);
            asm volatile("" ::: "memory");
        }
        __syncthreads();
        R1_RELANE();
        { f32x4 c1[2], c2[2];
#pragma unroll
          for (int j = 0; j < 2; ++j) { c1[j] = (f32x4){0.f, 0.f, 0.f, 0.f}; c2[j] = c1[j]; }
          mm64(c1, lds + R1_KAP, lds + R1_BH, tm, tnb, lane); mm64(c2, lds + R1_KAP, lds + R1_KH, tm, tnb, lane);
#pragma unroll
          for (int j = 0; j < 2; ++j) { const int ic = 16 * (tnb + j) + i;
#pragma unroll
              for (int r = 0; r < 4; ++r) { const int t = 16 * tm + 4 * q + r;
                  ABKF[t * 65 + ic] = ic < t ? c1[j][r] : 0.f;
                  LP(u16, lds + R1_AKK)[t * 72 + ic] = f2bf1(ic < t ? c2[j][r] : 0.f); } }
        }
        asm volatile("" ::: "memory");
        { f32x4 c3[2], c4[2];
#pragma unroll
          for (int j = 0; j < 2; ++j) { c3[j] = (f32x4){0.f, 0.f, 0.f, 0.f}; c4[j] = c3[j]; }
          mm64(c3, lds + R1_RT, lds + R1_BH, tm, tnb, lane);  mm64(c4, lds + R1_RT, lds + R1_KH, tm, tnb, lane);
#pragma unroll
          for (int j = 0; j < 2; ++j) { const int ic = 16 * (tnb + j) + i;
#pragma unroll
              for (int r = 0; r < 4; ++r) { const int t = 16 * tm + 4 * q + r;
                  LP(u16, lds + R1_ABR)[t * 72 + ic] = f2bf1(ic <= t ? c3[j][r] : 0.f);
                  LP(u16, lds + R1_AKR)[t * 72 + ic] = f2bf1(ic <= t ? c4[j][r] : 0.f); } }
        }
        __syncthreads();
#ifndef R1REP4
#define R1REP4 1
#endif
#pragma unroll 1
        for (int rep4 = 0; rep4 < R1REP4; ++rep4) {
        R1_RELANE();
        if (wave == 0) { const int g = q, c = i; float m[16];
#pragma unroll
            for (int ii = 0; ii < 16; ++ii) { float acc = ii == c ? 1.f : 0.f;
#pragma unroll
                for (int jj = 0; jj < ii; ++jj) acc -= ABKF[(16 * g + ii) * 65 + 16 * g + jj] * m[jj];
                m[ii] = acc; MF[(16 * g + ii) * 65 + 16 * g + c] = acc; LP(u16, lds + R1_MB)[(16 * g + ii) * 72 + 16 * g + c] = (u16)f2bf(acc); } }
        __syncthreads();
#define BLK(P, bi, bj) ((P) + (16 * (bi)) * 65 + 16 * (bj))
#define PUTM(bi, bj, acc) do { _Pragma("unroll") for (int r = 0; r < 4; ++r) { MF[(16 * (bi) + 4 * q + r) * 65 + 16 * (bj) + i] = -(acc)[r]; LP(u16, lds + R1_MB)[(16 * (bi) + 4 * q + r) * 72 + 16 * (bj) + i] = (u16)f2bf(-(acc)[r]); } } while (0)
        { LAS float* T = LP(float, lds + R1_T16) + wave * 272; const f32x4 z4 = {0.f, 0.f, 0.f, 0.f};
          if (wave < 3) { const int bi = wave + 1, bj = wave; f32x4 t = prod16(z4, BLK(ABKF, bi, bj), 65, BLK(MF, bj, bj), 65, lane);
#pragma unroll
              for (int r = 0; r < 4; ++r) T[(4 * q + r) * 17 + i] = t[r];
              f32x4 mres = prod16(z4, BLK(MF, bi, bi), 65, T, 17, lane); PUTM(bi, bj, mres); }
          __syncthreads();
          if (wave < 2) { const int bi = wave + 2, bj = wave; f32x4 t = prod16(z4, BLK(ABKF, bi, bj), 65, BLK(MF, bj, bj), 65, lane); t = prod16(t, BLK(ABKF, bi, bj + 1), 65, BLK(MF, bj + 1, bj), 65, lane);
#pragma unroll
              for (int r = 0; r < 4; ++r) T[(4 * q + r) * 17 + i] = t[r];
              f32x4 mres = prod16(z4, BLK(MF, bi, bi), 65, T, 17, lane); PUTM(bi, bj, mres); }
          __syncthreads();
          if (wave == 0) { f32x4 t = prod16(z4, BLK(ABKF, 3, 0), 65, BLK(MF, 0, 0), 65, lane); t = prod16(t, BLK(ABKF, 3, 1), 65, BLK(MF, 1, 0), 65, lane); t = prod16(t, BLK(ABKF, 3, 2), 65, BLK(MF, 2, 0), 65, lane);
#pragma unroll
              for (int r = 0; r < 4; ++r) T[(4 * q + r) * 17 + i] = t[r];
              f32x4 mres = prod16(z4, BLK(MF, 3, 3), 65, T, 17, lane); PUTM(3, 0, mres); }
          __syncthreads();
        }
#undef BLK
#undef PUTM
        }
        R1_RELANE();
        {
            const int sl = wave & 3, nb = 16 * sl + i;
            auto afrag = [&](int arr, int rt, int st) -> bf16x8 { return *LP(const bf16x8, lds + arr + ((16 * rt + i) * 72 + 32 * st + 8 * q) * 2); };
            auto afragp = [&](int arr, int rt, int st) -> bf16x8 { const u32x2 a0 = *LP(const u32x2, lds + arr + ((16 * rt + i) * 72 + 32 * st + 4 * q) * 2), a1 = *LP(const u32x2, lds + arr + ((16 * rt + i) * 72 + 32 * st + 16 + 4 * q) * 2);
                                                                  return __builtin_bit_cast(bf16x8, (v4u){a0.x, a0.y, a1.x, a1.y}); };
            auto packb = [&](const f32x4& lo, const f32x4& hi2) -> bf16x8 { return __builtin_bit_cast(bf16x8, (v4u){cvtpk(lo[0], lo[1]), cvtpk(lo[2], lo[3]), cvtpk(hi2[0], hi2[1]), cvtpk(hi2[2], hi2[3])}); };
            const f32x4 z4 = {0.f, 0.f, 0.f, 0.f};
            if (wave < 4) {
                bf16x8 vfr[2];
#pragma unroll
                for (int st = 0; st < 2; ++st) vfr[st] = *LP(const bf16x8, lds + R1_VT + (nb * 72 + 32 * st + 8 * q) * 2);
                f32x4 g[4], u[4];
#pragma unroll
                for (int rt = 0; rt < 4; ++rt) { g[rt] = mfma16(afrag(R1_AKK, rt, 0), vfr[0], z4); g[rt] = mfma16(afrag(R1_AKK, rt, 1), vfr[1], g[rt]); }
                bf16x8 gb[2] = {packb(g[0], g[1]), packb(g[2], g[3])};
#pragma unroll
                for (int rt = 0; rt < 4; ++rt) { u[rt] = mfma16(afragp(R1_MB, rt, 0), gb[0], z4); u[rt] = mfma16(afragp(R1_MB, rt, 1), gb[1], u[rt]); }
                bf16x8 ub[2] = {packb(u[0], u[1]), packb(u[2], u[3])};
                bf16* OT = (bf16*)(ws + WS_OT) + (size_t)it * 4096; float* HT = (float*)(ws + WS_HT) + (size_t)it * 4096;
#pragma unroll
                for (int rt = 0; rt < 4; ++rt) {
                    f32x4 o1 = mfma16(afrag(R1_AKR, rt, 0), vfr[0], z4); o1 = mfma16(afrag(R1_AKR, rt, 1), vfr[1], o1);
                    f32x4 o2 = mfma16(afragp(R1_ABR, rt, 0), ub[0], z4); o2 = mfma16(afragp(R1_ABR, rt, 1), ub[1], o2);
                    { const f32x4 od = o1 - o2; *(u32x2*)(OT + ((sl * 4 + rt) * 64 + lane) * 4) = (u32x2){cvtpk(od[0], od[1]), cvtpk(od[2], od[3])}; }
                    f32x4 h1 = mfma16(afrag(R1_KBT, rt, 0), vfr[0], z4); h1 = mfma16(afrag(R1_KBT, rt, 1), vfr[1], h1);
                    f32x4 h2 = mfma16(afragp(R1_BBT, rt, 0), ub[0], z4); h2 = mfma16(afragp(R1_BBT, rt, 1), ub[1], h2);
                    *(f32x4*)(HT + ((sl * 4 + rt) * 64 + lane) * 4) = h1 - h2;
                }
            } else {
                bf16x8 kfr[2];
#pragma unroll
                for (int st = 0; st < 2; ++st) kfr[st] = *LP(const bf16x8, lds + R1_KAPT + (nb * 72 + 32 * st + 8 * q) * 2);
                f32x4 w[4];
#pragma unroll
                for (int rt = 0; rt < 4; ++rt) { w[rt] = mfma16(afrag(R1_MB, rt, 0), kfr[0], z4); w[rt] = mfma16(afrag(R1_MB, rt, 1), kfr[1], w[rt]); }
                bf16x8 wb[2] = {packb(w[0], w[1]), packb(w[2], w[3])};
                LAS u16* QTs = LP(u16, lds + R1_KH); LAS u16* PTs = LP(u16, lds + R1_BH);
                const float gtv = GTV[nb];
#pragma unroll
                for (int rt = 0; rt < 4; ++rt) {
                    f32x4 cq = mfma16(afragp(R1_ABR, rt, 0), wb[0], z4); cq = mfma16(afragp(R1_ABR, rt, 1), wb[1], cq);
                    f32x4 cp = mfma16(afragp(R1_BBT, rt, 0), wb[0], z4); cp = mfma16(afragp(R1_BBT, rt, 1), wb[1], cp);
#pragma unroll
                    for (int r = 0; r < 4; ++r) { const int t = 16 * rt + 4 * q + r;
                        QTs[frag_a(t, nb)] = f2bf1(bf2f(LP(u16, lds + R1_RT)[t * 72 + nb]) - cq[r]);
                        PTs[frag_a(t, nb)] = f2bf1((t == nb ? gtv : 0.f) - cp[r]); }
                }
            }
        }
        cur = nxt;
        __syncthreads();
        itp = it;
    }
    if (itp >= 0) { R1_RELANE(); R1_COPY_OUT(itp); }
#undef R1_COPY_OUT
}

struct R2St { bf16x8 pa[4][2]; f32x4 hh[4]; };
__device__ __forceinline__ void r2_load(R2St& o, const unsigned char* ws, int it, int lane, int vs) {
    const bf16* PT = (const bf16*)(ws + WS_PT) + (size_t)it * 4096; const float* HT = (const float*)(ws + WS_HT) + (size_t)it * 4096;
#pragma unroll
    for (int tt = 0; tt < 4; ++tt) {
#pragma unroll
        for (int s = 0; s < 2; ++s) o.pa[tt][s] = *(const bf16x8*)(PT + ((tt * 2 + s) * 64 + lane) * 8);
        o.hh[tt] = *(const f32x4*)(HT + ((vs * 4 + tt) * 64 + lane) * 4);
    }
}
__device__ __forceinline__ void r2_step(const R2St& r, f32x4 (&S)[4], unsigned char* ws, int it, int vs, int lane) {
    bf16x8 bs[2];
#pragma unroll
    for (int s = 0; s < 2; ++s) { v4u w; w.x = cvtpk(S[2 * s][0], S[2 * s][1]); w.y = cvtpk(S[2 * s][2], S[2 * s][3]); w.z = cvtpk(S[2 * s + 1][0], S[2 * s + 1][1]); w.w = cvtpk(S[2 * s + 1][2], S[2 * s + 1][3]); bs[s] = __builtin_bit_cast(bf16x8, w);
        *(v4u*)(ws + WS_SC + (size_t)it * 8192 + (size_t)((vs * 2 + s) * 64 + lane) * 16) = w; }
#pragma unroll
    for (int kt = 0; kt < 4; ++kt) { f32x4 acc = r.hh[kt];
#pragma unroll
        for (int s = 0; s < 2; ++s) acc = mfma16(r.pa[kt][s], bs[s], acc);
        S[kt] = acc; }
}
__device__ __forceinline__ bool r3_skip(int G) { return G >= 32 && (G & 15) == 0; }
__device__ __forceinline__ void ph_rwkv2(const Frame& F0, const Args& a, int l) {
    const Frame F = relaunder(F0);
    unsigned char* ws = a.ws;
    const int lane = F.lane, i = lane & 15, q = lane >> 4;
    int j0, jstep, jend;
    if (r3_skip(F.G)) { if ((F.vcu & 15) == 0) { j0 = (F.vcu >> 4) * NWAVES + F.wave; jstep = (F.G >> 4) * NWAVES; jend = 128; }
                        else { j0 = 128 + (F.vcu - (F.vcu >> 4) - 1) * NWAVES + F.wave; jstep = (F.G - (F.G >> 4)) * NWAVES; jend = 128 + DECB * HB * 4; } }
    else { j0 = F.vcu * NWAVES + F.wave; jstep = F.G * NWAVES; jend = 128 + DECB * HB * 4; }
    for (int job = j0; job < jend; job += jstep) {
        int nchunk, item0, h, vs; float* sout; f32x4 S[4];
        if (job < 128) { const int pu = job; const int s = pu >> 5; h = (pu >> 2) & 7; vs = pu & 3; nchunk = SEQ / 64; item0 = s * 1024 + h;
            sout = a.out + OFF_WKVP + ((size_t)(l * NB + s) * HB + h) * 4096;
#pragma unroll
            for (int kt = 0; kt < 4; ++kt) S[kt] = (f32x4){0.f, 0.f, 0.f, 0.f}; }
        else { const int d = job - 128; const int b = d >> 5; h = (d >> 2) & 7; vs = d & 3; nchunk = 1; item0 = NITEM_P + b * 8 + h;
            sout = a.out + OFF_WKVS + ((size_t)(l * DECB + b) * HB + h) * 4096;
            const float* sin = a.in[I_SWKV] + ((size_t)(l * DECB + b) * HB + h) * 4096 + (16 * vs + i) * 64 + 4 * q;
#pragma unroll
            for (int kt = 0; kt < 4; ++kt) S[kt] = *(const f32x4*)(sin + 16 * kt); }
        const int v = 16 * vs + i;
        const int itl = item0 + 8 * (nchunk - 1);
        R2St r0, r1, r2;
        r2_load(r0, ws, item0, lane, vs);
        r2_load(r1, ws, min(item0 + 8, itl), lane, vs);
        r2_load(r2, ws, min(item0 + 16, itl), lane, vs);
        int c = 0;
#pragma unroll 1
        for (; c + 3 <= nchunk; c += 3) {
            const int it = item0 + 8 * c;
            r2_step(r0, S, ws, it, vs, lane);      r2_load(r0, ws, min(it + 24, itl), lane, vs);
            r2_step(r1, S, ws, it + 8, vs, lane);  r2_load(r1, ws, min(it + 32, itl), lane, vs);
            r2_step(r2, S, ws, it + 16, vs, lane); r2_load(r2, ws, min(it + 40, itl), lane, vs);
        }
        if (c < nchunk) { r2_step(r0, S, ws, item0 + 8 * c, vs, lane); ++c; }
        if (c < nchunk) { r2_step(r1, S, ws, item0 + 8 * c, vs, lane); ++c; }
#pragma unroll
        for (int kt = 0; kt < 4; ++kt) *(f32x4*)(sout + (size_t)v * 64 + 16 * kt + 4 * q) = S[kt];
    }
}
struct R3In { bf16x8 af[2]; u32x2 ot[4], gg[4], bn[4]; };
__device__ __forceinline__ void r3_load(R3In& p, const unsigned char* ws, int u, int lane) {
    const int it = u >> 2, tt = u & 3;
    const bf16* QT = (const bf16*)(ws + WS_QT) + (size_t)it * 4096; const bf16* OT = (const bf16*)(ws + WS_OT) + (size_t)it * 4096;
    const bf16* GG = (const bf16*)(ws + WS_GG) + (size_t)it * 4096; const bf16* BON = (const bf16*)(ws + WS_BON) + (size_t)it * 4096;
#pragma unroll
    for (int s = 0; s < 2; ++s) p.af[s] = *(const bf16x8*)(QT + ((tt * 2 + s) * 64 + lane) * 8);
#pragma unroll
    for (int vs = 0; vs < 4; ++vs) { const int o = ((vs * 4 + tt) * 64 + lane) * 4; p.ot[vs] = *(const u32x2*)(OT + o); p.gg[vs] = *(const u32x2*)(GG + o); p.bn[vs] = *(const u32x2*)(BON + o); }
}
__device__ __forceinline__ void r3_loadb(bf16x8 (&b)[4][2], const unsigned char* ws, int it, int lane) {
#pragma unroll
    for (int vs = 0; vs < 4; ++vs)
#pragma unroll
        for (int s = 0; s < 2; ++s) b[vs][s] = *(const bf16x8*)(ws + WS_SC + (size_t)it * 8192 + (size_t)((vs * 2 + s) * 64 + lane) * 16);
}
__device__ __forceinline__ void r3_loadb_dec(bf16x8 (&b)[4][2], const float* sin, int lane) {
    const int i = lane & 15, q = lane >> 4;
#pragma unroll
    for (int vs = 0; vs < 4; ++vs)
#pragma unroll
        for (int s = 0; s < 2; ++s) { const float* p = sin + (16 * vs + i) * 64 + 32 * s + 4 * q; const f32x4 x0 = *(const f32x4*)p, x1 = *(const f32x4*)(p + 16);
            v4u w; w.x = cvtpk(x0[0], x0[1]); w.y = cvtpk(x0[2], x0[3]); w.z = cvtpk(x1[0], x1[1]); w.w = cvtpk(x1[2], x1[3]); b[vs][s] = __builtin_bit_cast(bf16x8, w); }
}
template <bool DEC>
__device__ __forceinline__ void ph_rwkv3(const Frame& F0, const Args& a, int l) {
    const Frame F = relaunder(F0);
    const unsigned char* ws = a.ws;
    bf16* YB = (bf16*)(a.ws + WS_YAB) + (size_t)M * 512; const float* lg = a.in[I_LNXG] + l * 512; const float* lb = a.in[I_LNXB] + l * 512;
    const float* sdec = a.in[I_SWKV] + (size_t)l * DECB * HB * 4096;
    const int lane = F.lane, i = lane & 15, q = lane >> 4;
    LAS unsigned char* st = F.lds + F.wave * 2304;
    const int gw = F.vcu * NWAVES + F.wave, NW = F.G * NWAVES; constexpr int NU = NITEM_P * 4, NUD = DECB * HB * 2;
    int wv, NWk;
    if (DEC && !r3_skip(F.G)) { wv = gw; NWk = NW; }
    else if (DEC || r3_skip(F.G)) { if ((F.vcu & 15) == 0) return; wv = (F.vcu - (F.vcu >> 4) - 1) * NWAVES + F.wave; NWk = (F.G - (F.G >> 4)) * NWAVES; }
    else { wv = gw; NWk = NW; }
    const int u0 = DEC ? 0 : (int)((long)wv * NU / NWk), u1 = DEC ? (wv < NUD ? (NUD - wv + NWk - 1) / NWk : 0) : (int)((long)(wv + 1) * NU / NWk);
    auto unit_at = [&](int k) -> int { if (!DEC) return k; const int e = wv + k * NWk; return (NITEM_P + (e >> 1)) * 4 + (e & 1); };
    auto loadb = [&](bf16x8 (&b)[4][2], int it) { if (DEC) r3_loadb_dec(b, sdec + (size_t)(it - NITEM_P) * 4096, lane); else r3_loadb(b, ws, it, lane); };
    if (u0 >= u1) return;
    auto up4 = [](u32x2 w) -> f32x4 { return (f32x4){__uint_as_float(w.x << 16), __uint_as_float(w.x & 0xffff0000u), __uint_as_float(w.y << 16), __uint_as_float(w.y & 0xffff0000u)}; };
    R3In cur, nxt, nx2; bf16x8 bfr[4][2], bfn[4][2];
    r3_load(nxt, ws, unit_at(u0), lane); r3_load(nx2, ws, unit_at(u0 + 1 < u1 ? u0 + 1 : u0), lane); loadb(bfn, unit_at(u0) >> 2);
    int cit = -1; float lgv[4], lbv[4];
#pragma unroll 1
    for (int k = u0; k < u1; ++k) {
        const int u = unit_at(k); const int it = u >> 2, tt = u & 3;
        cur = nxt; nxt = nx2;
        if (it != cit) {
#pragma unroll
            for (int vs = 0; vs < 4; ++vs) { bfr[vs][0] = bfn[vs][0]; bfr[vs][1] = bfn[vs][1]; }
            cit = it; const int h = it & 7;
#pragma unroll
            for (int vs = 0; vs < 4; ++vs) { lgv[vs] = lg[h * 64 + 16 * vs + i]; lbv[vs] = lb[h * 64 + 16 * vs + i]; }
        }
        { const int un = unit_at(k + 1 < u1 ? k + 1 : k); r3_load(nx2, ws, unit_at(k + 2 < u1 ? k + 2 : u1 - 1), lane); if ((un >> 2) != it) loadb(bfn, un >> 2); }
        const bool dec = it >= NITEM_P;
        if (dec && tt >= 2) continue;
        const int h = it & 7, row0 = dec ? MP + DECS * ((it - NITEM_P) >> 3) : (it >> 10) * SEQ + 64 * ((it >> 3) & 127);
        f32x4 acc[4];
#pragma unroll
        for (int vs = 0; vs < 4; ++vs) { acc[vs] = up4(cur.ot[vs]); acc[vs] = mfma16(cur.af[0], bfr[vs][0], acc[vs]); acc[vs] = mfma16(cur.af[1], bfr[vs][1], acc[vs]); }
        f32x4 sm = (acc[0] + acc[1]) + (acc[2] + acc[3]);
#pragma unroll
        for (int r = 0; r < 4; ++r) sm[r] = red16(sm[r]);
        const f32x4 mean = sm * (1.f / 64.f);
        f32x4 s2 = {0.f, 0.f, 0.f, 0.f};
#pragma unroll
        for (int vs = 0; vs < 4; ++vs) { acc[vs] = acc[vs] - mean; s2 += acc[vs] * acc[vs]; }
#pragma unroll
        for (int r = 0; r < 4; ++r) s2[r] = red16(s2[r]);
        f32x4 rstd;
#pragma unroll
        for (int r = 0; r < 4; ++r) rstd[r] = __builtin_amdgcn_rsqf(s2[r] * (1.f / 64.f) + GN_EPS);
#pragma unroll
        for (int vs = 0; vs < 4; ++vs) { const int v = 16 * vs + i;
            const f32x4 y = (acc[vs] * rstd * lgv[vs] + lbv[vs] + up4(cur.bn[vs])) * up4(cur.gg[vs]);
#pragma unroll
            for (int r = 0; r < 4; ++r) LP(u16, st)[(4 * q + r) * 72 + v] = f2bf1(y[r]); }
        { const int trow = lane >> 2, c8 = (lane & 3) * 2;
          bf16* yp = YB + (size_t)(row0 + 16 * tt + trow) * 512 + h * 64 + 8 * c8;
          *(v4u*)yp = *LP(const v4u, st + (trow * 72 + 8 * c8) * 2); *(v4u*)(yp + 8) = *LP(const v4u, st + (trow * 72 + 8 * c8 + 8) * 2); }
    }
}
constexpr int NPH_LAYER = 13, NPH = 2 + DEPTH * NPH_LAYER;
#ifndef MK_LAUNCH_PER_PHASE
#define MK_LAUNCH_PER_PHASE 0
#endif
typedef const __attribute__((address_space(4))) Args* KArgsPtr;
__device__ __forceinline__ const Args& kargs() { KArgsPtr p = (KArgsPtr)__builtin_amdgcn_kernarg_segment_ptr(); asm volatile("" : "+s"(p)); return *(const Args*)p; }
template <unsigned PHMASK> __global__ void __launch_bounds__(NTHR, 2) fwd(Args args_unused) {
    extern __shared__ __attribute__((aligned(16))) unsigned char lds_raw[];
    Frame F;
    F.lds = (LAS unsigned char*)lds_raw;
    F.tid = 0; F.lane = 0; F.wave = __builtin_amdgcn_readfirstlane((int)threadIdx.x >> 6);
    F.G = gridDim.x; { const int bx = blockIdx.x; F.vcu = (F.G % 8 == 0) ? (bx % 8) * (F.G / 8) + bx / 8 : bx; }
    volatile LAS unsigned* MISC = (volatile LAS unsigned*)(F.lds + LDSCTL_OFF);
    for (int u = threadIdx.x; u < (LDS_BYTES - LDSCTL_OFF) / 4; u += NTHR) ((LAS unsigned*)(F.lds + LDSCTL_OFF))[u] = 0u;
    __syncthreads();
    int lo, hi; { const Args& a = kargs(); lo = a.ph_lo; hi = a.ph_hi; }
    XcdBarrier bar; { const Args& a = kargs(); bar.bar = (unsigned*)(a.ws + WS_CTL) + CW_BAR; } bar.x = 0; bar.st = nullptr;
    if (hi - lo > 1) bar = xcd_barrier_post(bar.bar, MISC + 8);
    bar.wave = F.wave;
#define IN(k) (lo <= (k) && (k) < hi)
#define ON(n, k) (((PHMASK >> (n)) & 1u) && IN(k))
#define SEAM(k) do { if (IN(k) && IN((k) + 1)) xcd_barrier(bar); } while (0)
#define WSP(T, off) ((T*)(a.ws + (off)))
#ifndef REP_MASK
#define REP_MASK 0u
#endif
#define REPS(n) ((((REP_MASK) >> (n)) & 1u) ? 2 : 1)
    if (ON(13, 0)) { const Args& a = kargs(); ph_prologue(F, a); } SEAM(0);
    if (ON(14, 1)) { const Args& a = kargs(); ph_ln<false, false, false, true>(F, a.in[I_XP], a.in[I_XS], nullptr, 0.f, nullptr, nullptr, nullptr, WSP(float, WS_MOD), nullptr, WSP(bf16, WS_U)); } SEAM(1);
#pragma unroll 1
    for (int l = 0; l < DEPTH; ++l) {
        const int pb = 2 + l * NPH_LAYER;
        const size_t wlo = WS_W + (size_t)l * WL_SIZE, modo = WS_MOD + (size_t)l * NSEQ * 9216 * 4;
        for (int rep_ = 0; rep_ < REPS(0); ++rep_) if (ON(0, pb + 0)) { if (rep_) xcd_barrier(bar); const Args& a = kargs(); pg8::Gemm g{WSP(bf16, WS_U), WSP(const bf16, wlo + WL_GU0), M, NGU, D}; pg8::StaticOrder S; S.init(M, NGU, opq(F.G), opq((int)blockIdx.x)); pg8::EpiSwiglu E{WSP(bf16, WS_ACT), DFF};
            pg8::gemm_phase<pg8::EpiSwiglu, pg8::StaticOrder, true, true>(F.lds, g, S, E, opq(F.wave));
            if (l + 1 < DEPTH) ph_conv_idle(F, a, l + 1, NPAN * (NGU / 256)); } SEAM(pb + 0);
        for (int rep_ = 0; rep_ < REPS(1); ++rep_) if (ON(1, pb + 1)) { if (rep_) xcd_barrier(bar); const Args& a = kargs(); pg8::Gemm g{WSP(bf16, WS_ACT), WSP(const bf16, wlo + WL_DN0), M, D, DFF}; pg8::SplitOrder S; S.init(MP, D, opq(F.G), opq((int)blockIdx.x), DFF / 256); pg8::EpiF32S E{WSP(bf16, WS_F), WSP(float, WS_FP), D, MP, MD};
            pg8::gemm_phase<pg8::EpiF32S, pg8::SplitOrder, true, true>(F.lds, g, S, E, opq(F.wave)); } SEAM(pb + 1);
        for (int rep_ = 0; rep_ < REPS(2); ++rep_) if (ON(2, pb + 2)) { if (rep_) xcd_barrier(bar); const Args& a = kargs(); const float* modl = WSP(float, modo);
            if (l == 0) ph_ln<true, false, true, true>(F, a.in[I_XP], a.in[I_XS], WSP(bf16, WS_F), 0.5f, modl + 2 * D, a.in[I_LNG] + (l * 3 + 0) * D, a.in[I_LNB] + (l * 3 + 0) * D, modl + 3 * D, nullptr, WSP(bf16, WS_U), WSP(float, WS_FP), DFF / 256, nullptr, WSP(bf16, WS_XB));
            else ph_ln<true, true, true, true>(F, nullptr, nullptr, WSP(bf16, WS_F), 0.5f, modl + 2 * D, a.in[I_LNG] + (l * 3 + 0) * D, a.in[I_LNB] + (l * 3 + 0) * D, modl + 3 * D, nullptr, WSP(bf16, WS_U), WSP(float, WS_FP), DFF / 256, WSP(const bf16, WS_XB), WSP(bf16, WS_XB)); } SEAM(pb + 2);
        for (int rep_ = 0; rep_ < REPS(3); ++rep_) if (ON(3, pb + 3)) { if (rep_) xcd_barrier(bar); const Args& a = kargs(); pg8::Gemm g{WSP(bf16, WS_U), WSP(const bf16, wlo + WL_IG), M, NIG, D}; pg8::StaticOrder S; S.init(M, NIG, opq(F.G), opq((int)blockIdx.x));
            pg8::EpiProj E{WSP(bf16, WS_Q), WSP(bf16, WS_KB), WSP(bf16, WS_VB), WSP(bf16, WS_PRW), WSP(bf16, WS_GATES), a.in[I_BGATE] + l * 2048,
                a.out + OFF_KP + (size_t)l * MP * 512, a.out + OFF_VP + (size_t)l * MP * 512, a.out + OFF_KS + (size_t)l * MD * 512, a.out + OFF_VS + (size_t)l * MD * 512,
                a.out + OFF_SHP + (size_t)l * NB * NRW, a.out + OFF_SHS + (size_t)l * DECB * NRW, QSCALE};
            pg8::gemm_phase<pg8::EpiProj, pg8::StaticOrder, true, true>(F.lds, g, S, E, opq(F.wave)); } SEAM(pb + 3);
        for (int rep_ = 0; rep_ < REPS(4); ++rep_) if (ON(4, pb + 4)) { if (rep_) xcd_barrier(bar); const Args& a = kargs(); ph_rwkv1(F, a, l); } SEAM(pb + 4);
        if (ON(5, pb + 5)) { const Args& a = kargs(); ph_rwkv2(F, a, l); }
        if (ON(5, pb + 5)) { const Args& a = kargs(); ph_rwkv3<true>(F, a, l); }
        if (ON(5, pb + 5)) { const Args& a = kargs();
            AttnP P{WSP(bf16, WS_Q), WSP(bf16, WS_KB), WSP(bf16, WS_VB), a.in[I_CK] + (size_t)l * DECB * PAST * 512, a.in[I_CV] + (size_t)l * DECB * PAST * 512, WSP(bf16, WS_YAB), a.in[I_RELB], a.in[I_SUBG] + l * 128,
                    WSP(float, WS_LAM)[l], 1.0f - (0.8f - 0.6f * expf(-0.3f * (float)l))};
            ph_attn(F, P, (unsigned*)(a.ws + WS_CTL) + CW_QUEUE + 64 * l); } SEAM(pb + 5);
        if (ON(6, pb + 6)) { const Args& a = kargs(); ph_rwkv3<false>(F, a, l); }
#pragma unroll 1
        for (int pass = 0; pass < 2; ++pass) { if (pass) SEAM(pb + 6);
            if (pass ? ON(7, pb + 7) : ON(6, pb + 6)) { const Args& a = kargs(); pg8::Gemm g{WSP(bf16, WS_YAB), WSP(const bf16, wlo + WL_BR), 2 * M, 2048, 512};
                const int G_ = opq(F.G), bx_ = opq((int)blockIdx.x), vcu_ = opq(F.vcu); const bool sk = r3_skip(G_);
                pg8::PairOrder S{pass ? (MP / 256) * 4 : NPAN * 4, (pass || !sk) ? G_ : (G_ >> 4), pass ? bx_ : (!sk ? bx_ : ((vcu_ & 15) == 0 ? (vcu_ >> 4) : NPAN * 4)), NPAN, pass ? 0 : (MP / 256) * 4};
                pg8::EpiMerge E{WSP(bf16, WS_MERGED), WSP(bf16, WS_GATES), NPAN};
                pg8::gemm_phase<pg8::EpiMerge, pg8::PairOrder, true, true>(F.lds, g, S, E, opq(F.wave)); } }
        SEAM(pb + 7);
        for (int rep_ = 0; rep_ < REPS(8); ++rep_) if (ON(8, pb + 8)) { if (rep_) xcd_barrier(bar); const Args& a = kargs(); pg8::Gemm g{WSP(bf16, WS_MERGED), WSP(const bf16, wlo + WL_O), M, D, D}; pg8::SplitOrder S; S.init(MP, D, opq(F.G), opq((int)blockIdx.x), D / 256); pg8::EpiF32S E{WSP(bf16, WS_F), WSP(float, WS_FP), D, MP, MD};
            pg8::gemm_phase<pg8::EpiF32S, pg8::SplitOrder, true, true>(F.lds, g, S, E, opq(F.wave)); } SEAM(pb + 8);
        for (int rep_ = 0; rep_ < REPS(9); ++rep_) if (ON(9, pb + 9)) { if (rep_) xcd_barrier(bar); const Args& a = kargs(); const float* modl = WSP(float, modo);
            ph_ln<true, true, true, true>(F, nullptr, nullptr, WSP(bf16, WS_F), 1.0f, modl + 5 * D, a.in[I_LNG] + (l * 3 + 1) * D, a.in[I_LNB] + (l * 3 + 1) * D, modl + 6 * D, nullptr, WSP(bf16, WS_U), WSP(float, WS_FP), D / 256, WSP(const bf16, WS_XB), WSP(bf16, WS_XB)); } SEAM(pb + 9);
        for (int rep_ = 0; rep_ < REPS(10); ++rep_) if (ON(10, pb + 10)) { if (rep_) xcd_barrier(bar); const Args& a = kargs(); pg8::Gemm g{WSP(bf16, WS_U), WSP(const bf16, wlo + WL_GU1), M, NGU, D}; pg8::StaticOrder S; S.init(M, NGU, opq(F.G), opq((int)blockIdx.x)); pg8::EpiSwiglu E{WSP(bf16, WS_ACT), DFF};
            pg8::gemm_phase<pg8::EpiSwiglu, pg8::StaticOrder, true, true>(F.lds, g, S, E, opq(F.wave)); } SEAM(pb + 10);
        for (int rep_ = 0; rep_ < REPS(11); ++rep_) if (ON(11, pb + 11)) { if (rep_) xcd_barrier(bar); const Args& a = kargs(); pg8::Gemm g{WSP(bf16, WS_ACT), WSP(const bf16, wlo + WL_DN1), M, D, DFF}; pg8::SplitOrder S; S.init(MP, D, opq(F.G), opq((int)blockIdx.x), DFF / 256); pg8::EpiF32S E{WSP(bf16, WS_F), WSP(float, WS_FP), D, MP, MD};
            pg8::gemm_phase<pg8::EpiF32S, pg8::SplitOrder, true, true>(F.lds, g, S, E, opq(F.wave)); } SEAM(pb + 11);
        for (int rep_ = 0; rep_ < REPS(12); ++rep_) if (ON(12, pb + 12)) { if (rep_) xcd_barrier(bar); const Args& a = kargs(); const float* modl = WSP(float, modo);
            if (l + 1 < DEPTH) ph_ln<true, true, true, true>(F, nullptr, nullptr, WSP(bf16, WS_F), 0.5f, modl + 8 * D, a.in[I_LNG] + (l * 3 + 2) * D, a.in[I_LNB] + (l * 3 + 2) * D, modl + (size_t)NSEQ * 9216, nullptr, WSP(bf16, WS_U), WSP(float, WS_FP), DFF / 256, WSP(const bf16, WS_XB), WSP(bf16, WS_XB));
            else ph_ln<true, true, false, false>(F, nullptr, nullptr, WSP(bf16, WS_F), 0.5f, modl + 8 * D, a.in[I_LNG] + (l * 3 + 2) * D, a.in[I_LNB] + (l * 3 + 2) * D, nullptr, a.out, nullptr, WSP(float, WS_FP), DFF / 256, WSP(const bf16, WS_XB), nullptr); } SEAM(pb + 12);
    }
#undef IN
#undef ON
#undef SEAM
#undef WSP
}

#if MK_LAUNCH_PER_PHASE
static const void* phase_fn(int k) {
    switch (k) { case 0: return (const void*)fwd<1u << 0>; case 1: return (const void*)fwd<1u << 1>; case 2: return (const void*)fwd<1u << 2>; case 3: return (const void*)fwd<1u << 3>;
        case 4: return (const void*)fwd<1u << 4>; case 5: return (const void*)fwd<1u << 5>; case 6: return (const void*)fwd<1u << 6>; case 7: return (const void*)fwd<1u << 7>;
        case 8: return (const void*)fwd<1u << 8>; case 9: return (const void*)fwd<1u << 9>; case 10: return (const void*)fwd<1u << 10>; case 11: return (const void*)fwd<1u << 11>;
        case 12: return (const void*)fwd<1u << 12>; case 13: return (const void*)fwd<1u << 13>; case 14: return (const void*)fwd<1u << 14>; default: return (const void*)fwd<1u << 15>; }
}
#else
#ifndef FULL_MASK
#define FULL_MASK 0xFFFFu
#endif
static const void* phase_fn(int) { return (const void*)fwd<FULL_MASK>; }
#endif

extern "C" void kernel_launch(void* const* d_in, const int* in_sizes, int n_in, void* d_out, int out_size, void* d_ws, size_t ws_size, hipStream_t stream) {
    static int grid = 0;
    if (grid == 0) {
        if (n_in != 34 || (size_t)out_size != OUT_TOTAL || ws_size < WS_END) { fprintf(stderr, "kernel_launch: unexpected shapes: n_in %d out %d ws %zu (need %zu)\n", n_in, out_size, ws_size, (size_t)WS_END); grid = -1; return; }
        int dev = 0, cus = 0, per_cu = 0;
        if (hipGetDevice(&dev) != hipSuccess || hipDeviceGetAttribute(&cus, hipDeviceAttributeMultiprocessorCount, dev) != hipSuccess) { grid = -1; return; }
        for (int k = 0; k < 16; ++k) if (hipFuncSetAttribute(phase_fn(k), hipFuncAttributeMaxDynamicSharedMemorySize, LDS_BYTES) != hipSuccess) { fprintf(stderr, "kernel_launch: hipFuncSetAttribute failed\n"); grid = -1; return; }
        if (hipOccupancyMaxActiveBlocksPerMultiprocessor(&per_cu, phase_fn(15), NTHR, LDS_BYTES) != hipSuccess || per_cu < 1) fprintf(stderr, "kernel_launch: occupancy query reports %d\n", per_cu);
        (void)hipGetLastError();
        grid = cus;
    }
    if (grid < 0) return;
    (void)hipMemsetAsync((char*)d_ws + WS_CTL, 0, CTL_ZERO_BYTES, stream);
    Args a{};
    for (int i = 0; i < 34; ++i) a.in[i] = (const float*)d_in[i];
    a.out = (float*)d_out; a.ws = (unsigned char*)d_ws;
#if MK_LAUNCH_PER_PHASE
#ifndef MAXPH
#define MAXPH NPH
#endif
    for (int p = 0; p < MAXPH; ++p) { a.ph_lo = p; a.ph_hi = p + 1; const int kind = p < 2 ? 13 + p : (p - 2) % NPH_LAYER; void* kargs[] = {&a}; (void)hipLaunchKernel(phase_fn(kind), dim3(grid), dim3(NTHR), kargs, LDS_BYTES, stream); }
#else
    a.ph_lo = 0; a.ph_hi = NPH; { void* kargs[] = {&a}; (void)hipLaunchKernel(phase_fn(15), dim3(grid), dim3(NTHR), kargs, LDS_BYTES, stream); }
#endif
}
```
